# Optimizing an MI355X kernel written in HIP

```python
import math
import jax, jax.numpy as jnp
from jax import lax
import numpy as np

D_MODEL = 1024
BATCH = 2
SEQ = 16384
DEPTH = 2

HEAD_DIM = 64
MIX_WIDTH = D_MODEL
N_HEADS_TOTAL = MIX_WIDTH // HEAD_DIM
N_HEADS_DIFF = N_HEADS_TOTAL // 4
N_HEADS_DIL = (N_HEADS_TOTAL - N_HEADS_DIFF) // 2
N_HEADS_NA = N_HEADS_TOTAL - N_HEADS_DIFF - N_HEADS_DIL
DIFF_QK_DIM = HEAD_DIM // 2
DIL_PATTERNS = ((128, 1), (512, 4), (2048, 16))
GRID_W = 64
NA_KH = 8
NA_KW = 16
D_FF = 2816
CONV_W = 3
ROPE_THETA = 10000.0
Q_BLOCK = 128
EPS = 1e-6
NEG = -1e30

kernel_name = "hybrid_diff_dilated_neighborhood_encoder"


def rms_norm(x, g):
    xf = x.astype(jnp.float32)
    y = xf * lax.rsqrt(jnp.mean(xf * xf, axis=-1, keepdims=True) + EPS)
    return y.astype(x.dtype) * g


def rope(x, pos):
    half = x.shape[-1] // 2
    inv = ROPE_THETA ** (-jnp.arange(half, dtype=jnp.float32) / half)
    ang = pos[..., None] * inv
    cos, sin = jnp.cos(ang), jnp.sin(ang)
    x1 = x[..., :half].astype(jnp.float32)
    x2 = x[..., half:].astype(jnp.float32)
    return jnp.concatenate([x1 * cos - x2 * sin, x2 * cos + x1 * sin], axis=-1).astype(x.dtype)


def diff_attention(q, k, v, diff_lambda, subln_g, layer_idx):
    B, H, S, _, DQK = q.shape
    DH = v.shape[-1]
    lam_init = 0.8 - 0.6 * math.exp(-0.3 * layer_idx)
    lq1, lk1, lq2, lk2 = diff_lambda[0], diff_lambda[1], diff_lambda[2], diff_lambda[3]
    lam = (jnp.exp(jnp.sum(lq1 * lk1).astype(jnp.float32))
           - jnp.exp(jnp.sum(lq2 * lk2).astype(jnp.float32)) + lam_init)
    scale = DQK ** -0.5
    n_blk = S // Q_BLOCK
    qb = q.reshape(B, H, n_blk, Q_BLOCK, 2, DQK).transpose(2, 0, 1, 3, 4, 5)

    def block(qi):
        s = jnp.einsum('bhqmd,bhkmd->bhmqk', qi, k).astype(jnp.float32) * scale
        p = jax.nn.softmax(s, axis=-1)
        a = p[:, :, 0] - lam * p[:, :, 1]
        return jnp.einsum('bhqk,bhkd->bhqd', a.astype(v.dtype), v)

    o = lax.map(block, qb)
    o = o.transpose(1, 2, 0, 3, 4).reshape(B, H, S, DH)
    return rms_norm(o, subln_g) * (1.0 - lam_init)


def banded_window_attention(q, k, v, r):
    lead = q.shape[:-2]
    L, DH = q.shape[-2:]
    n = -(-L // r)
    padl = [(0, 0)] * len(lead)
    qb = jnp.pad(q, padl + [(0, n * r - L), (0, 0)]).reshape(*lead, n, r, DH)

    def key_blocks(t):
        tp = jnp.pad(t, padl + [(r, (n + 1) * r - L), (0, 0)]).reshape(*lead, n + 2, r, DH)
        return jnp.concatenate([tp[..., :-2, :, :], tp[..., 1:-1, :, :], tp[..., 2:, :, :]], axis=-2)

    kb, vb = key_blocks(k), key_blocks(v)
    qi = jnp.arange(r)[:, None]
    kj = jnp.arange(3 * r)[None, :]
    key_pos = jnp.arange(n)[:, None, None] * r - r + kj
    mask = (kj >= qi) & (kj <= qi + 2 * r) & (key_pos >= 0) & (key_pos < L)
    s = jnp.einsum('...nqd,...nkd->...nqk', qb, kb).astype(jnp.float32) * (DH ** -0.5)
    s = jnp.where(mask, s, NEG)
    m = jnp.max(s, axis=-1, keepdims=True)
    p = jnp.exp(s - m)
    den = jnp.sum(p, axis=-1)
    o = jnp.einsum('...nqk,...nkd->...nqd', (p / den[..., None]).astype(v.dtype), vb)
    lse = m[..., 0] + jnp.log(den)
    return o.reshape(*lead, n * r, DH)[..., :L, :], lse.reshape(*lead, n * r)[..., :L]


def dilated_attention(q, k, v):
    B, H, S, DH = q.shape
    outs, lses = [], []
    for window, dil in DIL_PATTERNS:
        r = window // (2 * dil)
        L = S // dil

        def split(t):
            return t.reshape(B, H, L, dil, DH).transpose(0, 1, 3, 2, 4)

        o, lse = banded_window_attention(split(q), split(k), split(v), r)
        outs.append(o.transpose(0, 1, 3, 2, 4).reshape(B, H, S, DH))
        lses.append(lse.transpose(0, 1, 3, 2).reshape(B, H, S))
    w = jax.nn.softmax(jnp.stack(lses, axis=0), axis=0)
    out = jnp.sum(w[..., None] * jnp.stack(outs, axis=0).astype(jnp.float32), axis=0)
    return out.astype(q.dtype)


def neighborhood_attention(q, k, v, rpb):
    B, H, S, DH = q.shape
    rows = S // GRID_W
    kh = min(NA_KH, rows)
    kw = NA_KW
    qg = q.reshape(B, H, rows, GRID_W, DH)
    kg = k.reshape(B, H, rows, GRID_W, DH)
    vg = v.reshape(B, H, rows, GRID_W, DH)
    r = jnp.arange(rows)
    row_start = jnp.clip(r - kh // 2, 0, rows - kh)
    key_rows = row_start[:, None] + jnp.arange(kh)[None, :]
    kr = kg[:, :, key_rows]
    vr = vg[:, :, key_rows]
    col = jnp.arange(GRID_W)
    col_start = jnp.clip(col - kw // 2, 0, GRID_W - kw)
    col_mask = (col[None, :] >= col_start[:, None]) & (col[None, :] < col_start[:, None] + kw)
    dr = key_rows - r[:, None] + (NA_KH - 1)
    dc = jnp.clip(col[None, :] - col[:, None], -(kw - 1), kw - 1) + (NA_KW - 1)
    bias = rpb[:, dr[:, None, :, None], dc[None, :, None, :]]
    s = jnp.einsum('bhrqd,bhrjkd->bhrqjk', qg, kr).astype(jnp.float32) * (DH ** -0.5)
    s = s + bias[None].astype(jnp.float32)
    s = jnp.where(col_mask[:, None, :], s, NEG)
    p = jax.nn.softmax(s.reshape(B, H, rows, GRID_W, kh * GRID_W), axis=-1)
    o = jnp.einsum('bhrqn,bhrnd->bhrqd', p.astype(v.dtype), vr.reshape(B, H, rows, kh * GRID_W, DH))
    return o.reshape(B, H, S, DH)


def hybrid_mixer(h, w_in, diff_lambda, diff_subln, na_rpb, w_out, layer_idx):
    B, S, _ = h.shape
    proj = h @ w_in
    wa, wb, wc = N_HEADS_DIFF * HEAD_DIM, N_HEADS_DIL * HEAD_DIM, N_HEADS_NA * HEAD_DIM
    offs = np.cumsum([wa, wa, wa, wb, wb, wb, wc, wc, wc])[:-1].tolist()
    qa, ka, va, qb, kb, vb, qc, kc, vc = jnp.split(proj, offs, axis=-1)
    pos = jnp.arange(S, dtype=jnp.float32)

    def heads(t, n_h):
        return t.reshape(B, S, n_h, HEAD_DIM).transpose(0, 2, 1, 3)

    def diff_heads(t):
        return t.reshape(B, S, N_HEADS_DIFF, 2, DIFF_QK_DIM).transpose(0, 2, 1, 3, 4)

    def merge(o):
        return o.transpose(0, 2, 1, 3).reshape(B, S, -1)

    o_a = diff_attention(rope(diff_heads(qa), pos[:, None]), rope(diff_heads(ka), pos[:, None]),
                         heads(va, N_HEADS_DIFF), diff_lambda, diff_subln, layer_idx)
    o_b = dilated_attention(rope(heads(qb, N_HEADS_DIL), pos), rope(heads(kb, N_HEADS_DIL), pos),
                            heads(vb, N_HEADS_DIL))
    o_c = neighborhood_attention(heads(qc, N_HEADS_NA), heads(kc, N_HEADS_NA), heads(vc, N_HEADS_NA), na_rpb)
    o = jnp.concatenate([merge(o_a), merge(o_b), merge(o_c)], axis=-1)
    return o @ w_out


def conv_glu_ffn(h, w_up, conv_w, conv_b, w_down):
    S = h.shape[1]
    g, u = jnp.split(h @ w_up, 2, axis=-1)
    pad = CONV_W // 2
    gp = jnp.pad(g, ((0, 0), (pad, pad), (0, 0)))
    gc = conv_b
    for j in range(CONV_W):
        gc = gc + gp[:, j:j + S] * conv_w[j]
    return (jax.nn.silu(gc) * u) @ w_down


def setup_inputs(seed: int = 0) -> dict:
    key = jax.random.key(seed)
    ks = jax.random.split(key, 16)
    D = D_MODEL

    def nrm(k, shape, s):
        return jax.random.normal(k, shape, jnp.float32) * s

    return {
        "x": nrm(ks[0], (BATCH, SEQ, D), 1.0),
        "c": nrm(ks[1], (BATCH, D), 1.0),
        "w_ada": nrm(ks[2], (DEPTH, D, 6 * D), 0.5 * D ** -0.5),
        "b_ada": nrm(ks[3], (DEPTH, 6 * D), 0.02),
        "g_attn": 1.0 + nrm(ks[4], (DEPTH, D), 0.02),
        "w_in": nrm(ks[5], (DEPTH, D, 3 * MIX_WIDTH), D ** -0.5),
        "diff_lambda": nrm(ks[6], (DEPTH, 4, DIFF_QK_DIM), 0.1),
        "diff_subln": 1.0 + nrm(ks[7], (DEPTH, HEAD_DIM), 0.02),
        "na_rpb": nrm(ks[8], (DEPTH, N_HEADS_NA, 2 * NA_KH - 1, 2 * NA_KW - 1), 0.1),
        "w_out": nrm(ks[9], (DEPTH, MIX_WIDTH, D), MIX_WIDTH ** -0.5),
        "g_ffn": 1.0 + nrm(ks[10], (DEPTH, D), 0.02),
        "w_up": nrm(ks[11], (DEPTH, D, 2 * D_FF), D ** -0.5),
        "conv_w": nrm(ks[12], (DEPTH, CONV_W, D_FF), CONV_W ** -0.5),
        "conv_b": nrm(ks[13], (DEPTH, D_FF), 0.02),
        "w_down": nrm(ks[14], (DEPTH, D_FF, D), D_FF ** -0.5),
        "g_final": 1.0 + nrm(ks[15], (D,), 0.02),
    }


def reference(x, c, w_ada, b_ada, g_attn, w_in, diff_lambda, diff_subln, na_rpb, w_out,
              g_ffn, w_up, conv_w, conv_b, w_down, g_final):
    for l in range(DEPTH):
        mod = jax.nn.silu(c) @ w_ada[l] + b_ada[l]
        sh_a, sc_a, gt_a, sh_f, sc_f, gt_f = [m[:, None, :] for m in jnp.split(mod, 6, axis=-1)]
        h = rms_norm(x, g_attn[l]) * (1.0 + sc_a) + sh_a
        x = x + gt_a * hybrid_mixer(h, w_in[l], diff_lambda[l], diff_subln[l], na_rpb[l], w_out[l], l)
        h = rms_norm(x, g_ffn[l]) * (1.0 + sc_f) + sh_f
        x = x + gt_f * conv_glu_ffn(h, w_up[l], conv_w[l], conv_b[l], w_down[l])
    return rms_norm(x, g_final)
```

```cpp
#include <hip/hip_runtime.h>
#include <hip/hip_cooperative_groups.h>
#include <cstdio>
#include <cstring>
namespace cg = cooperative_groups;

#ifndef COOP
#define COOP 0
#endif

#define DI __device__ __forceinline__
typedef unsigned short u16;
using bf16x8 = __attribute__((ext_vector_type(8))) short;
using s16x4  = __attribute__((ext_vector_type(4))) short;
using f32x16 = __attribute__((ext_vector_type(16))) float;
typedef __bf16 bf2_t __attribute__((ext_vector_type(2)));
typedef float f2_t __attribute__((ext_vector_type(2)));
#define MFMA32(a, b, c) __builtin_amdgcn_mfma_f32_32x32x16_bf16((a), (b), (c), 0, 0, 0)

constexpr int S = 16384, NTOK = 32768, DFF = 2816, NPROJ = 3072;
constexpr int NBLK_THREADS = 256;
constexpr float LOG2E = 1.4426950408889634f;
constexpr float QSCALE_DIFF = 0.25503486164919736f;
constexpr float QSCALE_64   = 0.18033688011112042f;
constexpr float NEGBIG = -1e30f;

__device__ const float ROPE_INV16[16] = {
1.000000000e+00f, 5.623413324e-01f, 3.162277639e-01f, 1.778279394e-01f, 1.000000015e-01f, 5.623413250e-02f, 3.162277490e-02f, 1.778279431e-02f, 9.999999776e-03f, 5.623413250e-03f, 3.162277630e-03f, 1.778279431e-03f, 1.000000047e-03f, 5.623413017e-04f, 3.162277571e-04f, 1.778279402e-04f};
__device__ const float ROPE_INV32[32] = {
1.000000000e+00f, 7.498942018e-01f, 5.623413324e-01f, 4.216965139e-01f, 3.162277639e-01f, 2.371373773e-01f, 1.778279394e-01f, 1.333521456e-01f, 1.000000015e-01f, 7.498942316e-02f, 5.623413250e-02f, 4.216964915e-02f, 3.162277490e-02f, 2.371373773e-02f, 1.778279431e-02f, 1.333521400e-02f, 9.999999776e-03f, 7.498942316e-03f, 5.623413250e-03f, 4.216964822e-03f, 3.162277630e-03f, 2.371373819e-03f, 1.778279431e-03f, 1.333521446e-03f, 1.000000047e-03f, 7.498941850e-04f, 5.623413017e-04f, 4.216965172e-04f, 3.162277571e-04f, 2.371373703e-04f, 1.778279402e-04f, 1.333521504e-04f};

struct Params {
  const float *x, *c, *w_ada, *b_ada, *g_attn, *w_in, *diff_lambda, *diff_subln, *na_rpb, *w_out, *g_ffn, *w_up, *conv_w, *conv_b, *w_down, *g_final;
  float* out;
  u16 *wt_in, *wt_out, *wt_up, *wt_down;
  float* mod;
  unsigned* kmax;
  u16 *h, *o, *proj, *act;
  float lam_init[2];
  int ph_lo, ph_hi;
};

DI unsigned pack2(float a, float b) { f2_t v = {a, b}; return __builtin_bit_cast(unsigned, __builtin_convertvector(v, bf2_t)); }
DI u16 f2bf(float a) { return (u16)(pack2(a, 0.f) & 0xffffu); }
DI float bf2f(u16 v) { return __uint_as_float(((unsigned)v) << 16); }
DI float bflo(unsigned v) { return __uint_as_float(v << 16); }
DI float bfhi(unsigned v) { return __uint_as_float(v & 0xffff0000u); }
DI int crow(int i, int hh) { return (i & 3) + 8 * (i >> 2) + 4 * hh; }
DI float exp2_hw(float x) { return __builtin_amdgcn_exp2f(x); }
DI int otid() { int t = threadIdx.x; asm volatile("" : "+v"(t)); return t; }

DI int wmap_in(int np) {
  if (np < 512) { int base = np & ~63, w = np & 63, nb = w >> 5, c = w & 31; return base + (c >> 4) * 32 + nb * 16 + (c & 15); }
  return np;
}
DI int wmap_up(int np) {
  int jt = np >> 7, w = np & 127, q = w >> 5, c = w & 31;
  int gcol = 64 * jt + (q >> 1) * 32 + c;
  return (q & 1) ? (DFF + gcol) : gcol;
}

DI void phase_prep(const Params& p, float* smf) {
  const int tid = otid();
  if (blockIdx.x == 0 && tid < 64) p.kmax[tid] = 0u;
  constexpr int N_ADA = 192;
  constexpr int T_IN = 16 * 48, T_OUT = 16 * 16, T_UP = 16 * 88, T_DOWN = 44 * 16;
  constexpr int T_LAYER = T_IN + T_OUT + T_UP + T_DOWN;
  const int total = N_ADA + 2 * T_LAYER;
  for (int it = blockIdx.x; it < total; it += gridDim.x) {
    if (it < N_ADA) {
      const int l = it / 96, cgp = it % 96;
      float* sc = smf;
      float* red = smf + 2048;
      for (int i = tid; i < 2048; i += 256) { float v = p.c[i]; sc[i] = v / (1.f + __expf(-v)); }
      __syncthreads();
      const int kq = tid >> 6, cc = tid & 63, col = cgp * 64 + cc;
      const float* wp = p.w_ada + ((size_t)l * 1024 + kq * 256) * 6144 + col;
      float a0 = 0.f, a1 = 0.f;
#pragma unroll 8
      for (int k = 0; k < 256; ++k) { float w = wp[(size_t)k * 6144]; a0 += sc[kq * 256 + k] * w; a1 += sc[1024 + kq * 256 + k] * w; }
      red[(kq * 2 + 0) * 64 + cc] = a0; red[(kq * 2 + 1) * 64 + cc] = a1;
      __syncthreads();
      if (tid < 128) {
        const int b = tid >> 6, c2 = tid & 63;
        float s = red[(0 * 2 + b) * 64 + c2] + red[(1 * 2 + b) * 64 + c2] + red[(2 * 2 + b) * 64 + c2] + red[(3 * 2 + b) * 64 + c2];
        p.mod[(l * 2 + b) * 6144 + cgp * 64 + c2] = s + p.b_ada[l * 6144 + cgp * 64 + c2];
      }
    } else {
      int idx = it - N_ADA; const int l = idx / T_LAYER; int j = idx % T_LAYER;
      const float* W; u16* dst; int Kd, N, tk, tn, kind;
      if (j < T_IN) { W = p.w_in + (size_t)l * 1024 * 3072; dst = p.wt_in + (size_t)l * 3072 * 1024; Kd = 1024; N = 3072; tk = j / 48; tn = j % 48; kind = 0; }
      else if (j < T_IN + T_OUT) { j -= T_IN; W = p.w_out + (size_t)l * 1024 * 1024; dst = p.wt_out + (size_t)l * 1024 * 1024; Kd = 1024; N = 1024; tk = j / 16; tn = j % 16; kind = 1; }
      else if (j < T_IN + T_OUT + T_UP) { j -= T_IN + T_OUT; W = p.w_up + (size_t)l * 1024 * 5632; dst = p.wt_up + (size_t)l * 5632 * 1024; Kd = 1024; N = 5632; tk = j / 88; tn = j % 88; kind = 2; }
      else { j -= T_IN + T_OUT + T_UP; W = p.w_down + (size_t)l * 2816 * 1024; dst = p.wt_down + (size_t)l * 1024 * 2816; Kd = 2816; N = 1024; tk = j / 16; tn = j % 16; kind = 3; }
      const int k0 = tk * 64, n0 = tn * 64;
      float* tile = smf;
      const int nn = tid & 63;
      int np = n0 + nn;
      const int srccol = (kind == 0) ? wmap_in(np) : (kind == 2) ? wmap_up(np) : np;
#pragma unroll 4
      for (int i = 0; i < 16; ++i) { const int kk = i * 4 + (tid >> 6); tile[kk * 65 + nn] = W[(size_t)(k0 + kk) * N + srccol]; }
      __syncthreads();
      const int nrow = tid >> 2, kc = (tid & 3) * 16;
      unsigned pk[8];
#pragma unroll
      for (int q = 0; q < 8; ++q) pk[q] = pack2(tile[(kc + 2 * q) * 65 + nrow], tile[(kc + 2 * q + 1) * 65 + nrow]);
      uint4* dp = (uint4*)(dst + (size_t)(n0 + nrow) * Kd + k0 + kc);
      dp[0] = make_uint4(pk[0], pk[1], pk[2], pk[3]);
      dp[1] = make_uint4(pk[4], pk[5], pk[6], pk[7]);
    }
    __syncthreads();
  }
}

DI float wave_sum(float v) {
#pragma unroll
  for (int o = 32; o >= 1; o >>= 1) v += __shfl_xor(v, o);
  return v;
}

template <int MODE>
DI void phase_norm(const float* xin, const float* g, const float* modl, int sh_off, int sc_off, u16* hout, float* fout) {
  const int tid = otid(); const int lane = tid & 63, w = tid >> 6;
  for (int row = blockIdx.x * 4 + w; row < NTOK; row += gridDim.x * 4) {
    const int b = row >> 14;
    const float4* xr = (const float4*)(xin + (size_t)row * 1024);
    float4 v[4];
#pragma unroll
    for (int i = 0; i < 4; ++i) v[i] = xr[lane + i * 64];
    float ss = 0.f;
#pragma unroll
    for (int i = 0; i < 4; ++i) ss += v[i].x * v[i].x + v[i].y * v[i].y + v[i].z * v[i].z + v[i].w * v[i].w;
    ss = wave_sum(ss);
    const float inv = rsqrtf(ss * (1.f / 1024.f) + 1e-6f);
#pragma unroll
    for (int i = 0; i < 4; ++i) {
      const int col = (lane + i * 64) * 4;
      const float4 g4 = *(const float4*)(g + col);
      if (MODE == 0) {
        const float4 sc4 = *(const float4*)(modl + b * 6144 + sc_off + col);
        const float4 sh4 = *(const float4*)(modl + b * 6144 + sh_off + col);
        float y0 = v[i].x * inv * g4.x * (1.f + sc4.x) + sh4.x;
        float y1 = v[i].y * inv * g4.y * (1.f + sc4.y) + sh4.y;
        float y2 = v[i].z * inv * g4.z * (1.f + sc4.z) + sh4.z;
        float y3 = v[i].w * inv * g4.w * (1.f + sc4.w) + sh4.w;
        *(uint2*)(hout + (size_t)row * 1024 + col) = make_uint2(pack2(y0, y1), pack2(y2, y3));
      } else {
        float4 y; y.x = v[i].x * inv * g4.x; y.y = v[i].y * inv * g4.y; y.z = v[i].z * inv * g4.z; y.w = v[i].w * inv * g4.w;
        *(float4*)(fout + (size_t)row * 1024 + col) = y;
      }
    }
  }
}

constexpr int LDT = 72;
constexpr int GEMM_BUF = 128 * LDT;
DI void gemm_mainloop(const u16* __restrict__ A, int K, int m0, int rlo, int rhi,
                      const u16* __restrict__ Bt, int n0, u16* sm, f32x16 (&acc)[2][2]) {
  const int tid = otid(), lane = tid & 63, w = tid >> 6, r = lane & 31, hh = lane >> 5;
  const int wm = w >> 1, wn = w & 1;
  u16* As = sm; u16* Bs = sm + 2 * GEMM_BUF;
  const int lrow = tid >> 3, kc = (tid & 7) * 8;
  const u16* ap[4];
#pragma unroll
  for (int i = 0; i < 4; ++i) { int row = m0 + lrow + i * 32; row = row < rlo ? rlo : (row > rhi ? rhi : row); ap[i] = A + (size_t)row * K + kc; }
  const u16* bp = Bt + (size_t)(n0 + lrow) * K + kc;
#pragma unroll
  for (int mb = 0; mb < 2; ++mb)
#pragma unroll
    for (int nb = 0; nb < 2; ++nb)
#pragma unroll
      for (int i = 0; i < 16; ++i) acc[mb][nb][i] = 0.f;
  uint4 ra[4], rb[4];
#pragma unroll
  for (int i = 0; i < 4; ++i) { ra[i] = *(const uint4*)(ap[i]); rb[i] = *(const uint4*)(bp + (size_t)i * 32 * K); }
#pragma unroll
  for (int i = 0; i < 4; ++i) { *(uint4*)(As + (lrow + i * 32) * LDT + kc) = ra[i]; *(uint4*)(Bs + (lrow + i * 32) * LDT + kc) = rb[i]; }
  __syncthreads();
  const int KT = K >> 6;
  for (int kt = 0; kt < KT; ++kt) {
    const int buf = kt & 1;
    if (kt + 1 < KT) {
      const int ko = (kt + 1) * 64;
#pragma unroll
      for (int i = 0; i < 4; ++i) { ra[i] = *(const uint4*)(ap[i] + ko); rb[i] = *(const uint4*)(bp + (size_t)i * 32 * K + ko); }
    }
    const u16* Ab = As + buf * GEMM_BUF + (wm * 64 + r) * LDT + 8 * hh;
    const u16* Bb = Bs + buf * GEMM_BUF + (wn * 64 + r) * LDT + 8 * hh;
#pragma unroll
    for (int s = 0; s < 4; ++s) {
      const bf16x8 a0 = *(const bf16x8*)(Ab + s * 16);
      const bf16x8 a1 = *(const bf16x8*)(Ab + 32 * LDT + s * 16);
      const bf16x8 b0 = *(const bf16x8*)(Bb + s * 16);
      const bf16x8 b1 = *(const bf16x8*)(Bb + 32 * LDT + s * 16);
      acc[0][0] = MFMA32(a0, b0, acc[0][0]);
      acc[0][1] = MFMA32(a0, b1, acc[0][1]);
      acc[1][0] = MFMA32(a1, b0, acc[1][0]);
      acc[1][1] = MFMA32(a1, b1, acc[1][1]);
    }
    if (kt + 1 < KT) {
      const int nb_ = buf ^ 1;
#pragma unroll
      for (int i = 0; i < 4; ++i) { *(uint4*)(As + nb_ * GEMM_BUF + (lrow + i * 32) * LDT + kc) = ra[i]; *(uint4*)(Bs + nb_ * GEMM_BUF + (lrow + i * 32) * LDT + kc) = rb[i]; }
    }
    __syncthreads();
  }
}

DI void sincos_big(float ang, float& sn, float& cs) {
  const float c_hi = 1.591549367e-01f, c_lo = 6.420638243e-09f;
  const float rh = ang * c_hi;
  const float e = __builtin_fmaf(ang, c_hi, -rh);
  const float fr = rh - floorf(rh);
  const float rev = fr + (e + ang * c_lo);
  sn = __builtin_amdgcn_sinf(rev);
  cs = __builtin_amdgcn_cosf(rev);
}

DI void phase_proj(const Params& p, int layer, u16* sm) {
  const int tid = otid(), lane = tid & 63, w = tid >> 6, r = lane & 31, hh = lane >> 5;
  const int wm = w >> 1, wn = w & 1;
  const u16* Bt = p.wt_in + (size_t)layer * 3072 * 1024;
  constexpr int NT = 24, TILES = 256 * NT;
  for (int t = blockIdx.x; t < TILES; t += gridDim.x) {
    const int mt = t / NT, nt = t % NT;
    const int m0 = mt * 128, n0 = nt * 128;
    f32x16 acc[2][2];
    gemm_mainloop(p.h, 1024, m0, 0, NTOK - 1, Bt, n0, sm, acc);
    const int col0 = n0 + wn * 64;
    int mode;
    float scale = 1.f;
    if (col0 < 256) { mode = 1; scale = QSCALE_DIFF; }
    else if (col0 < 512) { mode = 1; }
    else if (col0 < 768) { mode = 0; }
    else if (col0 < 1152) { mode = 2; scale = QSCALE_64; }
    else if (col0 < 1536) { mode = 2; }
    else if (col0 < 1920) { mode = 0; }
    else if (col0 < 2304) { mode = 0; scale = QSCALE_64; }
    else { mode = 0; }
    float inv = 0.f;
    if (mode == 1) inv = ROPE_INV16[r & 15];
    if (mode == 2) inv = ROPE_INV32[r];
#pragma unroll
    for (int mb = 0; mb < 2; ++mb) {
#pragma unroll
      for (int i = 0; i < 16; ++i) {
        const int row = m0 + wm * 64 + mb * 32 + crow(i, hh);
        float x1 = acc[mb][0][i], x2 = acc[mb][1][i];
        if (mode != 0) {
          const float pos = (float)(row & (S - 1));
          const float ang = __fmul_rn(pos, inv);
          float sn, cs; sincos_big(ang, sn, cs);
          const float y1 = x1 * cs - x2 * sn, y2 = x2 * cs + x1 * sn;
          x1 = y1; x2 = y2;
        }
        x1 *= scale; x2 *= scale;
        u16* dp = p.proj + (size_t)row * NPROJ + col0 + r;
        dp[0] = f2bf(x1); dp[32] = f2bf(x2);
      }
    }
  }
}

DI void phase_resid_gemm(const u16* A, int K, const u16* Bt, const float* xold, float* xnew, const float* modl, int gate_off, u16* sm) {
  const int tid = otid(), lane = tid & 63, w = tid >> 6, r = lane & 31, hh = lane >> 5;
  const int wm = w >> 1, wn = w & 1;
  constexpr int NT = 8, TILES = 256 * NT;
  for (int t = blockIdx.x; t < TILES; t += gridDim.x) {
    const int mt = t / NT, nt = t % NT;
    const int m0 = mt * 128, n0 = nt * 128;
    f32x16 acc[2][2];
    gemm_mainloop(A, K, m0, 0, NTOK - 1, Bt, n0, sm, acc);
    const int b = m0 >> 14;
#pragma unroll
    for (int nb = 0; nb < 2; ++nb) {
      const int col = n0 + wn * 64 + nb * 32 + r;
      const float gate = modl[b * 6144 + gate_off + col];
#pragma unroll
      for (int mb = 0; mb < 2; ++mb)
#pragma unroll
        for (int i = 0; i < 16; ++i) {
          const size_t off = (size_t)(m0 + wm * 64 + mb * 32 + crow(i, hh)) * 1024 + col;
          xnew[off] = xold[off] + gate * acc[mb][nb][i];
        }
    }
  }
}

DI void phase_up(const Params& p, int layer, u16* sm) {
  const int tid = otid(), lane = tid & 63, w = tid >> 6, r = lane & 31, hh = lane >> 5;
  const int wm = w >> 1, wn = w & 1;
  const u16* Bt = p.wt_up + (size_t)layer * 5632 * 1024;
  const float* cw = p.conv_w + (size_t)layer * 3 * DFF;
  const float* cb = p.conv_b + (size_t)layer * DFF;
  constexpr int NT = 44, MT = 131, TILES = 2 * MT * NT;
  float* G = (float*)sm;
  for (int t = blockIdx.x; t < TILES; t += gridDim.x) {
    const int nt = t % NT, mtb = t / NT, b = mtb / MT, ti = mtb % MT;
    const int tok0 = 126 * ti - 1;
    const int m0 = b * S + tok0;
    f32x16 acc[2][2];
    gemm_mainloop(p.h, 1024, m0, b * S, b * S + S - 1, Bt, nt * 128, sm, acc);
    const int gc = wn * 32 + r;
#pragma unroll
    for (int mb = 0; mb < 2; ++mb)
#pragma unroll
      for (int i = 0; i < 16; ++i) {
        const int R = wm * 64 + mb * 32 + crow(i, hh);
        const int tok = tok0 + R;
        G[R * 64 + gc] = (tok >= 0 && tok < S) ? acc[mb][0][i] : 0.f;
      }
    __syncthreads();
    const int col = 64 * nt + gc;
    const float w0 = cw[col], w1 = cw[DFF + col], w2 = cw[2 * DFF + col], bb = cb[col];
#pragma unroll
    for (int mb = 0; mb < 2; ++mb)
#pragma unroll
      for (int i = 0; i < 16; ++i) {
        const int R = wm * 64 + mb * 32 + crow(i, hh);
        const int tok = tok0 + R;
        if (R >= 1 && R <= 126 && tok < S) {
          const float gm = G[(R - 1) * 64 + gc], gp = G[(R + 1) * 64 + gc];
          const float cv = bb + w0 * gm + w1 * acc[mb][0][i] + w2 * gp;
          const float a = cv / (1.f + __expf(-cv)) * acc[mb][1][i];
          p.act[(size_t)(b * S + tok) * DFF + col] = f2bf(a);
        }
      }
    __syncthreads();
  }
}

constexpr int VT_STRIDE = 36;
constexpr int VT_WAVE = 2 * 64 * VT_STRIDE;

template <int MODE>
DI void local_attn_item(const Params& p, int layer, int item, u16* sm) {
  const int tid = otid(), lane = tid & 63, w = tid >> 6, r = lane & 31, hh = lane >> 5;
  u16* Vt = sm + w * VT_WAVE;
  const int unit = item * 4 + w;
  const int b = unit / (6 * 512), rem = unit % (6 * 512), head = rem / 512, u = rem % 512;
  const u16* prow = p.proj + (size_t)b * S * NPROJ;
  int tq, qcol, kcol, vcol, nblk, ocol;
  int t0 = 0, rr = 0, half = 0, row_start = 0;
  if (MODE == 0) {
    const int res = u & 15, chunk = u >> 4;
    t0 = res + 512 * chunk; tq = t0 + 16 * r;
    qcol = 768 + head * 64; kcol = 1152 + head * 64; vcol = 1536 + head * 64; nblk = 33; ocol = 256 + head * 64;
  } else {
    rr = u >> 1; half = u & 1; tq = rr * 64 + half * 32 + r;
    row_start = rr - 4; row_start = row_start < 0 ? 0 : (row_start > 248 ? 248 : row_start);
    qcol = 1920 + head * 64; kcol = 2304 + head * 64; vcol = 2688 + head * 64; nblk = 16; ocol = 640 + head * 64;
  }
  const float* rpb = p.na_rpb + ((size_t)layer * 6 + head) * 15 * 31;
  bf16x8 qf[4];
#pragma unroll
  for (int s = 0; s < 4; ++s) qf[s] = *(const bf16x8*)(prow + (size_t)tq * NPROJ + qcol + s * 16 + 8 * hh);

  auto geom = [&](int kbi, int& kbase, int& kstride, int& lim) {
    if (MODE == 0) {
      if (kbi < 20) { kstride = 1; kbase = t0 - 64 + kbi * 32; lim = 64; }
      else if (kbi < 28) { kstride = 4; kbase = t0 - 256 + 4 * (kbi - 20) * 32; lim = 256; }
      else { kstride = 16; kbase = t0 - 1024 + 16 * (kbi - 28) * 32; lim = 1024; }
    } else {
      kstride = 1; kbase = (row_start + (kbi >> 1)) * 64 + (kbi & 1) * 32; lim = 0;
    }
  };
  bf16x8 kf[4]; uint4 vr[4];
  auto load_blk = [&](int kbi) {
    int kbase, kstride, lim; geom(kbi, kbase, kstride, lim);
    int kt = kbase + kstride * r; kt = kt < 0 ? 0 : (kt > S - 1 ? S - 1 : kt);
#pragma unroll
    for (int s = 0; s < 4; ++s) kf[s] = *(const bf16x8*)(prow + (size_t)kt * NPROJ + kcol + s * 16 + 8 * hh);
#pragma unroll
    for (int i = 0; i < 4; ++i) {
      const int id = lane + i * 64, key = id >> 3, ch = id & 7;
      int vt = kbase + kstride * key; vt = vt < 0 ? 0 : (vt > S - 1 ? S - 1 : vt);
      vr[i] = *(const uint4*)(prow + (size_t)vt * NPROJ + vcol + ch * 8);
    }
  };
  f32x16 O[2];
#pragma unroll
  for (int mb = 0; mb < 2; ++mb)
#pragma unroll
    for (int i = 0; i < 16; ++i) O[mb][i] = 0.f;
  float m_run = NEGBIG, l_run = 0.f;
  load_blk(0);
  for (int kbi = 0; kbi < nblk; ++kbi) {
    u16* Vb = Vt + (kbi & 1) * 64 * VT_STRIDE;
#pragma unroll
    for (int i = 0; i < 4; ++i) {
      const int id = lane + i * 64, key = id >> 3, ch = id & 7;
      const unsigned e[4] = {vr[i].x, vr[i].y, vr[i].z, vr[i].w};
#pragma unroll
      for (int q = 0; q < 4; ++q) {
        Vb[(ch * 8 + 2 * q) * VT_STRIDE + key] = (u16)(e[q] & 0xffffu);
        Vb[(ch * 8 + 2 * q + 1) * VT_STRIDE + key] = (u16)(e[q] >> 16);
      }
    }
    f32x16 Sc;
#pragma unroll
    for (int i = 0; i < 16; ++i) Sc[i] = 0.f;
#pragma unroll
    for (int s = 0; s < 4; ++s) Sc = MFMA32(kf[s], qf[s], Sc);
    int kbase, kstride, lim; geom(kbi, kbase, kstride, lim);
    if (kbi + 1 < nblk) load_blk(kbi + 1);
    float sv[16]; bool vd[16]; float tmax = NEGBIG;
#pragma unroll
    for (int i = 0; i < 16; ++i) {
      const int kk = crow(i, hh);
      const int kt = kbase + kstride * kk;
      bool valid; float s = Sc[i];
      if (MODE == 0) {
        int dq = kt - tq; dq = dq < 0 ? -dq : dq;
        valid = (kt >= 0) && (kt < S) && (dq <= lim);
      } else {
        const int kc = kt & 63, krow = kt >> 6, qc = half * 32 + r;
        int cs = qc - 8; cs = cs < 0 ? 0 : (cs > 48 ? 48 : cs);
        valid = (kc >= cs) && (kc < cs + 16);
        int dc = kc - qc; dc = dc < -15 ? -15 : (dc > 15 ? 15 : dc);
        const float bias = rpb[(krow - rr + 7) * 31 + dc + 15];
        s += bias * LOG2E;
      }
      vd[i] = valid; sv[i] = valid ? s : NEGBIG; tmax = fmaxf(tmax, sv[i]);
    }
    tmax = fmaxf(tmax, __shfl_xor(tmax, 32));
    const float m_new = fmaxf(m_run, tmax);
    const float alpha = exp2_hw(m_run - m_new);
    m_run = m_new; l_run *= alpha;
#pragma unroll
    for (int mb = 0; mb < 2; ++mb)
#pragma unroll
      for (int i = 0; i < 16; ++i) O[mb][i] *= alpha;
    float pv[16];
#pragma unroll
    for (int i = 0; i < 16; ++i) { pv[i] = vd[i] ? exp2_hw(sv[i] - m_new) : 0.f; l_run += pv[i]; }
    bf16x8 pk[2];
#pragma unroll
    for (int sp = 0; sp < 2; ++sp) {
      unsigned q4[4];
#pragma unroll
      for (int q = 0; q < 4; ++q) q4[q] = pack2(pv[8 * sp + 2 * q], pv[8 * sp + 2 * q + 1]);
      pk[sp] = __builtin_bit_cast(bf16x8, make_uint4(q4[0], q4[1], q4[2], q4[3]));
    }
    __syncthreads();
#pragma unroll
    for (int sp = 0; sp < 2; ++sp)
#pragma unroll
      for (int mb = 0; mb < 2; ++mb) {
        const u16* vp = Vb + (mb * 32 + r) * VT_STRIDE + 16 * sp + 4 * hh;
        const s16x4 lo = *(const s16x4*)vp, hi = *(const s16x4*)(vp + 8);
        const bf16x8 vf = __builtin_shufflevector(lo, hi, 0, 1, 2, 3, 4, 5, 6, 7);
        O[mb] = MFMA32(vf, pk[sp], O[mb]);
      }
  }
  const float l = l_run + __shfl_xor(l_run, 32);
  const float il = 1.f / l;
  u16* op = p.o + (size_t)(b * S + tq) * 1024 + ocol;
#pragma unroll
  for (int mb = 0; mb < 2; ++mb)
#pragma unroll
    for (int g = 0; g < 4; ++g) {
      const int d = mb * 32 + 8 * g + 4 * hh;
      *(uint2*)(op + d) = make_uint2(pack2(O[mb][4 * g] * il, O[mb][4 * g + 1] * il), pack2(O[mb][4 * g + 2] * il, O[mb][4 * g + 3] * il));
    }
  __syncthreads();
}

DI void kmax_item(const Params& p, int layer, int kidx) {
  const int tid = otid(); const int gid = kidx * 256 + tid;
  const int row = gid >> 2, head = gid & 3, b = row >> 14;
  const uint4* kp = (const uint4*)(p.proj + (size_t)row * NPROJ + 256 + head * 64);
  float n0 = 0.f, n1 = 0.f;
#pragma unroll
  for (int c = 0; c < 8; ++c) {
    const uint4 v = kp[c];
    const unsigned e[4] = {v.x, v.y, v.z, v.w};
    float s = 0.f;
#pragma unroll
    for (int q = 0; q < 4; ++q) { const float a = bflo(e[q]), bq = bfhi(e[q]); s += a * a + bq * bq; }
    if ((c >> 1) & 1) n1 += s; else n0 += s;
  }
#pragma unroll
  for (int o = 4; o <= 32; o <<= 1) { n0 = fmaxf(n0, __shfl_xor(n0, o)); n1 = fmaxf(n1, __shfl_xor(n1, o)); }
  if ((tid & 63) < 4) {
    unsigned* km = p.kmax + layer * 16 + (b * 4 + head) * 2;
    atomicMax(km, __float_as_uint(n0)); atomicMax(km + 1, __float_as_uint(n1));
  }
}

DI void phase_local(const Params& p, int layer, u16* sm) {
  constexpr int N_DIL = 1536, N_NA = 1536, N_KM = 512;
  for (int it = blockIdx.x; it < N_DIL + N_NA + N_KM; it += gridDim.x) {
    if (it < N_DIL) local_attn_item<0>(p, layer, it, sm);
    else if (it < N_DIL + N_NA) local_attn_item<1>(p, layer, it - N_DIL, sm);
    else kmax_item(p, layer, it - N_DIL - N_NA);
  }
}

constexpr int KS_STRIDE = 72, VS_STRIDE = 68;
constexpr int KS_BUF = 64 * KS_STRIDE, VS_BUF = 64 * VS_STRIDE;
DI void phase_diff(const Params& p, int layer, u16* sm) {
  const int tid = otid(), lane = tid & 63, w = tid >> 6, r = lane & 31, hh = lane >> 5;
  u16* Ks = sm; u16* Vs = sm + 2 * KS_BUF;
  float lam;
  {
    const float* dl = p.diff_lambda + layer * 128;
    float a = 0.f, c2 = 0.f;
    if (lane < 32) { a = dl[lane] * dl[32 + lane]; c2 = dl[64 + lane] * dl[96 + lane]; }
    a = wave_sum(a); c2 = wave_sum(c2);
    lam = __expf(a) - __expf(c2) + p.lam_init[layer];
  }
  const float lam_init = p.lam_init[layer];
  const float* sg = p.diff_subln + layer * 64;
  for (int it = blockIdx.x; it < 1024; it += gridDim.x) {
    const int bh = it >> 7, qb = it & 127, b = bh >> 2, head = bh & 3;
    const u16* prow = p.proj + (size_t)b * S * NPROJ;
    const int tq = qb * 128 + w * 32 + r;
    bf16x8 qf[2][2];
    float qn[2];
#pragma unroll
    for (int m = 0; m < 2; ++m) {
      qn[m] = 0.f;
#pragma unroll
      for (int s = 0; s < 2; ++s) {
        qf[m][s] = *(const bf16x8*)(prow + (size_t)tq * NPROJ + head * 64 + s * 32 + m * 16 + 8 * hh);
#pragma unroll
        for (int j = 0; j < 8; ++j) { const float v = bf2f((u16)qf[m][s][j]); qn[m] += v * v; }
      }
      qn[m] += __shfl_xor(qn[m], 32);
    }
    float mbnd[2];
#pragma unroll
    for (int m = 0; m < 2; ++m) {
      const float km = __uint_as_float(p.kmax[layer * 16 + bh * 2 + m]);
      mbnd[m] = sqrtf(qn[m] * km);
    }
    f32x16 O[2][2];
#pragma unroll
    for (int m = 0; m < 2; ++m)
#pragma unroll
      for (int mb = 0; mb < 2; ++mb)
#pragma unroll
        for (int i = 0; i < 16; ++i) O[m][mb][i] = 0.f;
    float lsum[2] = {0.f, 0.f};
    uint4 kr[2], vr[2];
    const int key0 = tid >> 3, ch = tid & 7;
    const u16* kg = prow + (size_t)key0 * NPROJ + 256 + head * 64 + ch * 8;
    auto gload = [&](int kt) {
#pragma unroll
      for (int i = 0; i < 2; ++i) {
        const u16* src = kg + (size_t)(kt * 64 + i * 32) * NPROJ;
        kr[i] = *(const uint4*)src; vr[i] = *(const uint4*)(src + 256);
      }
    };
    auto lstore = [&](int buf) {
#pragma unroll
      for (int i = 0; i < 2; ++i) {
        const int key = key0 + i * 32;
        *(uint4*)(Ks + buf * KS_BUF + key * KS_STRIDE + ch * 8) = kr[i];
        const unsigned e[4] = {vr[i].x, vr[i].y, vr[i].z, vr[i].w};
        u16* vb = Vs + buf * VS_BUF + (ch * 8) * VS_STRIDE + key;
#pragma unroll
        for (int q = 0; q < 4; ++q) { vb[(2 * q) * VS_STRIDE] = (u16)(e[q] & 0xffffu); vb[(2 * q + 1) * VS_STRIDE] = (u16)(e[q] >> 16); }
      }
    };
    gload(0); lstore(0);
    __syncthreads();
    for (int kt = 0; kt < 256; ++kt) {
      const int buf = kt & 1;
      if (kt + 1 < 256) gload(kt + 1);
#pragma unroll
      for (int sub = 0; sub < 2; ++sub) {
        bf16x8 pk[2][2];
#pragma unroll
        for (int m = 0; m < 2; ++m) {
          f32x16 Sc;
#pragma unroll
          for (int i = 0; i < 16; ++i) Sc[i] = 0.f;
#pragma unroll
          for (int s = 0; s < 2; ++s) {
            const bf16x8 kf = *(const bf16x8*)(Ks + buf * KS_BUF + (sub * 32 + r) * KS_STRIDE + s * 32 + m * 16 + 8 * hh);
            Sc = MFMA32(kf, qf[m][s], Sc);
          }
          float pv[16];
#pragma unroll
          for (int i = 0; i < 16; ++i) { pv[i] = exp2_hw(Sc[i] - mbnd[m]); lsum[m] += pv[i]; }
#pragma unroll
          for (int sp = 0; sp < 2; ++sp) {
            unsigned q4[4];
#pragma unroll
            for (int q = 0; q < 4; ++q) q4[q] = pack2(pv[8 * sp + 2 * q], pv[8 * sp + 2 * q + 1]);
            pk[m][sp] = __builtin_bit_cast(bf16x8, make_uint4(q4[0], q4[1], q4[2], q4[3]));
          }
        }
#pragma unroll
        for (int sp = 0; sp < 2; ++sp)
#pragma unroll
          for (int mb = 0; mb < 2; ++mb) {
            const u16* vp = Vs + buf * VS_BUF + (mb * 32 + r) * VS_STRIDE + sub * 32 + 16 * sp + 4 * hh;
            const s16x4 lo = *(const s16x4*)vp, hi = *(const s16x4*)(vp + 8);
            const bf16x8 vf = __builtin_shufflevector(lo, hi, 0, 1, 2, 3, 4, 5, 6, 7);
            O[0][mb] = MFMA32(vf, pk[0][sp], O[0][mb]);
            O[1][mb] = MFMA32(vf, pk[1][sp], O[1][mb]);
          }
      }
      if (kt + 1 < 256) lstore(buf ^ 1);
      __syncthreads();
    }
    const float l0 = lsum[0] + __shfl_xor(lsum[0], 32);
    const float l1 = lsum[1] + __shfl_xor(lsum[1], 32);
    const float i0 = 1.f / l0, i1 = lam / l1;
    float ss = 0.f;
#pragma unroll
    for (int mb = 0; mb < 2; ++mb)
#pragma unroll
      for (int i = 0; i < 16; ++i) { const float v = O[0][mb][i] * i0 - O[1][mb][i] * i1; O[0][mb][i] = v; ss += v * v; }
    ss += __shfl_xor(ss, 32);
    const float inv = rsqrtf(ss * (1.f / 64.f) + 1e-6f) * (1.f - lam_init);
    u16* op = p.o + (size_t)(b * S + tq) * 1024 + head * 64;
#pragma unroll
    for (int mb = 0; mb < 2; ++mb)
#pragma unroll
      for (int g = 0; g < 4; ++g) {
        const int d = mb * 32 + 8 * g + 4 * hh;
        const float4 g4 = *(const float4*)(sg + d);
        *(uint2*)(op + d) = make_uint2(pack2(O[0][mb][4 * g] * inv * g4.x, O[0][mb][4 * g + 1] * inv * g4.y),
                                       pack2(O[0][mb][4 * g + 2] * inv * g4.z, O[0][mb][4 * g + 3] * inv * g4.w));
      }
  }
}

constexpr int SMEM_BYTES = 4 * GEMM_BUF * 2;
constexpr int N_PHASES = 18;

DI void run_phase(const Params& p, int ph, u16* sm) {
  if (ph == 0) { phase_prep(p, (float*)sm); return; }
  if (ph == 17) { phase_norm<1>(p.out, p.g_final, nullptr, 0, 0, nullptr, p.out); return; }
  const int layer = (ph - 1) >> 3, sub = (ph - 1) & 7;
  const float* modl = p.mod + layer * 2 * 6144;
  const float* xcur = (layer == 0) ? p.x : p.out;
  switch (sub) {
    case 0: phase_norm<0>(xcur, p.g_attn + layer * 1024, modl, 0, 1024, p.h, nullptr); break;
    case 1: phase_proj(p, layer, sm); break;
    case 2: phase_local(p, layer, sm); break;
    case 3: phase_diff(p, layer, sm); break;
    case 4: phase_resid_gemm(p.o, 1024, p.wt_out + (size_t)layer * 1024 * 1024, xcur, p.out, modl, 2048, sm); break;
    case 5: phase_norm<0>(p.out, p.g_ffn + layer * 1024, modl, 3072, 4096, p.h, nullptr); break;
    case 6: phase_up(p, layer, sm); break;
    case 7: phase_resid_gemm(p.act, DFF, p.wt_down + (size_t)layer * 1024 * DFF, p.out, p.out, modl, 5120, sm); break;
  }
}

__global__ void __launch_bounds__(NBLK_THREADS, 2) mega_kernel(Params p) {
  __shared__ __attribute__((aligned(16))) u16 sm[SMEM_BYTES / 2];
#if COOP
  cg::grid_group grid = cg::this_grid();
#endif
#if COOP
  phase_prep(p, (float*)sm);
  grid.sync();
#pragma unroll 1
  for (int layer = 0; layer < 2; ++layer) {
    const float* modl = p.mod + layer * 2 * 6144;
    const float* xcur = (layer == 0) ? p.x : p.out;
    phase_norm<0>(xcur, p.g_attn + layer * 1024, modl, 0, 1024, p.h, nullptr); grid.sync();
    phase_proj(p, layer, sm); grid.sync();
    phase_local(p, layer, sm); grid.sync();
    phase_diff(p, layer, sm); grid.sync();
    phase_resid_gemm(p.o, 1024, p.wt_out + (size_t)layer * 1024 * 1024, xcur, p.out, modl, 2048, sm); grid.sync();
    phase_norm<0>(p.out, p.g_ffn + layer * 1024, modl, 3072, 4096, p.h, nullptr); grid.sync();
    phase_up(p, layer, sm); grid.sync();
    phase_resid_gemm(p.act, DFF, p.wt_down + (size_t)layer * 1024 * DFF, p.out, p.out, modl, 5120, sm); grid.sync();
  }
  phase_norm<1>(p.out, p.g_final, nullptr, 0, 0, nullptr, p.out);
#else
  for (int ph = p.ph_lo; ph < p.ph_hi; ++ph) run_phase(p, ph, sm);
#endif
}

extern "C" void kernel_launch(void* const* d_in, const int* in_sizes, int n_in, void* d_out, int out_size, void* d_ws, size_t ws_size, hipStream_t stream) {
  (void)in_sizes; (void)n_in; (void)out_size;
  Params p;
  memset(&p, 0, sizeof(p));
  p.x = (const float*)d_in[0]; p.c = (const float*)d_in[1]; p.w_ada = (const float*)d_in[2]; p.b_ada = (const float*)d_in[3];
  p.g_attn = (const float*)d_in[4]; p.w_in = (const float*)d_in[5]; p.diff_lambda = (const float*)d_in[6]; p.diff_subln = (const float*)d_in[7];
  p.na_rpb = (const float*)d_in[8]; p.w_out = (const float*)d_in[9]; p.g_ffn = (const float*)d_in[10]; p.w_up = (const float*)d_in[11];
  p.conv_w = (const float*)d_in[12]; p.conv_b = (const float*)d_in[13]; p.w_down = (const float*)d_in[14]; p.g_final = (const float*)d_in[15];
  p.out = (float*)d_out;
  char* ws = (char*)d_ws; size_t off = 0;
  auto take = [&](size_t bytes) { char* q = ws + off; off += (bytes + 255) & ~(size_t)255; return q; };
  p.wt_in = (u16*)take((size_t)2 * 3072 * 1024 * 2);
  p.wt_out = (u16*)take((size_t)2 * 1024 * 1024 * 2);
  p.wt_up = (u16*)take((size_t)2 * 5632 * 1024 * 2);
  p.wt_down = (u16*)take((size_t)2 * 1024 * 2816 * 2);
  p.mod = (float*)take((size_t)2 * 2 * 6144 * 4);
  p.kmax = (unsigned*)take(256);
  p.h = (u16*)take((size_t)NTOK * 1024 * 2);
  p.o = (u16*)take((size_t)NTOK * 1024 * 2);
  p.proj = (u16*)take((size_t)NTOK * NPROJ * 2);
  p.act = p.proj;
  if (off > ws_size) { fprintf(stderr, "workspace too small: need %zu have %zu\n", off, ws_size); return; }
  p.lam_init[0] = 0.2f; p.lam_init[1] = 0.35550906759096934f;
  static int grid_blocks = 0;
  if (!grid_blocks) {
    int dev = 0, cus = 0, per_cu = 0;
    hipGetDevice(&dev);
    hipDeviceGetAttribute(&cus, hipDeviceAttributeMultiprocessorCount, dev);
    hipOccupancyMaxActiveBlocksPerMultiprocessor(&per_cu, mega_kernel, NBLK_THREADS, 0);
    if (per_cu > 2) per_cu = 2;
    if (per_cu < 1) per_cu = 1;
    grid_blocks = cus * per_cu;
  }
#if COOP
  p.ph_lo = 0; p.ph_hi = N_PHASES;
  void* args[] = {&p};
  hipError_t e = hipLaunchCooperativeKernel((void*)mega_kernel, dim3(grid_blocks), dim3(NBLK_THREADS), args, 0, stream);
  if (e != hipSuccess) fprintf(stderr, "cooperative launch failed: %s (grid %d)\n", hipGetErrorString(e), grid_blocks);
#else
  for (int ph = 0; ph < N_PHASES; ++ph) {
    p.ph_lo = ph; p.ph_hi = ph + 1;
    hipLaunchKernelGGL(mega_kernel, dim3(grid_blocks), dim3(NBLK_THREADS), 0, stream, p);
  }
#endif
}
```

```cpp
#include <hip/hip_runtime.h>
#include <hip/hip_cooperative_groups.h>
#include <cstdio>
#include <cstring>
namespace cg = cooperative_groups;

#ifndef COOP
#define COOP 1
#endif

#define DI __device__ __forceinline__
typedef unsigned short u16;
using bf16x8 = __attribute__((ext_vector_type(8))) short;
using s16x4  = __attribute__((ext_vector_type(4))) short;
using f32x16 = __attribute__((ext_vector_type(16))) float;
typedef __bf16 bf2_t __attribute__((ext_vector_type(2)));
typedef float f2_t __attribute__((ext_vector_type(2)));
#define MFMA32(a, b, c) __builtin_amdgcn_mfma_f32_32x32x16_bf16((a), (b), (c), 0, 0, 0)

constexpr int S = 16384, NTOK = 32768, DFF = 2816, NPROJ = 3072;
constexpr int NBLK_THREADS = 256;
constexpr float LOG2E = 1.4426950408889634f;
constexpr float QSCALE_DIFF = 0.25503486164919736f;
constexpr float QSCALE_64   = 0.18033688011112042f;
constexpr float NEGBIG = -1e30f;

__device__ const float ROPE_INV16[16] = {
1.000000000e+00f, 5.623413324e-01f, 3.162277639e-01f, 1.778279394e-01f, 1.000000015e-01f, 5.623413250e-02f, 3.162277490e-02f, 1.778279431e-02f, 9.999999776e-03f, 5.623413250e-03f, 3.162277630e-03f, 1.778279431e-03f, 1.000000047e-03f, 5.623413017e-04f, 3.162277571e-04f, 1.778279402e-04f};
__device__ const float ROPE_INV32[32] = {
1.000000000e+00f, 7.498942018e-01f, 5.623413324e-01f, 4.216965139e-01f, 3.162277639e-01f, 2.371373773e-01f, 1.778279394e-01f, 1.333521456e-01f, 1.000000015e-01f, 7.498942316e-02f, 5.623413250e-02f, 4.216964915e-02f, 3.162277490e-02f, 2.371373773e-02f, 1.778279431e-02f, 1.333521400e-02f, 9.999999776e-03f, 7.498942316e-03f, 5.623413250e-03f, 4.216964822e-03f, 3.162277630e-03f, 2.371373819e-03f, 1.778279431e-03f, 1.333521446e-03f, 1.000000047e-03f, 7.498941850e-04f, 5.623413017e-04f, 4.216965172e-04f, 3.162277571e-04f, 2.371373703e-04f, 1.778279402e-04f, 1.333521504e-04f};

struct Params {
  const float *x, *c, *w_ada, *b_ada, *g_attn, *w_in, *diff_lambda, *diff_subln, *na_rpb, *w_out, *g_ffn, *w_up, *conv_w, *conv_b, *w_down, *g_final;
  float* out;
  u16 *wt_in, *wt_out, *wt_up, *wt_down;
  float* mod;
  unsigned* kmax;
  u16 *h, *o, *proj, *act;
  float lam_init[2];
  int ph_lo, ph_hi;
};

DI unsigned pack2(float a, float b) { f2_t v = {a, b}; return __builtin_bit_cast(unsigned, __builtin_convertvector(v, bf2_t)); }
DI u16 f2bf(float a) { return (u16)(pack2(a, 0.f) & 0xffffu); }
DI float bf2f(u16 v) { return __uint_as_float(((unsigned)v) << 16); }
DI float bflo(unsigned v) { return __uint_as_float(v << 16); }
DI float bfhi(unsigned v) { return __uint_as_float(v & 0xffff0000u); }
DI int crow(int i, int hh) { return (i & 3) + 8 * (i >> 2) + 4 * hh; }
DI float exp2_hw(float x) { return __builtin_amdgcn_exp2f(x); }
DI int otid() { int t = threadIdx.x; asm volatile("" : "+v"(t)); return t; }

DI int wmap_in(int np) {
  if (np < 512) { int base = np & ~63, w = np & 63, nb = w >> 5, c = w & 31; return base + (c >> 4) * 32 + nb * 16 + (c & 15); }
  return np;
}
DI int wmap_up(int np) {
  int jt = np >> 7, w = np & 127, q = w >> 5, c = w & 31;
  int gcol = 64 * jt + (q >> 1) * 32 + c;
  return (q & 1) ? (DFF + gcol) : gcol;
}

DI void phase_prep(const Params& p, float* smf) {
  const int tid = otid();
  if (blockIdx.x == 0 && tid < 64) p.kmax[tid] = 0u;
  constexpr int N_ADA = 192;
  constexpr int T_IN = 16 * 48, T_OUT = 16 * 16, T_UP = 16 * 88, T_DOWN = 44 * 16;
  constexpr int T_LAYER = T_IN + T_OUT + T_UP + T_DOWN;
  const int total = N_ADA + 2 * T_LAYER;
  for (int it = blockIdx.x; it < total; it += gridDim.x) {
    if (it < N_ADA) {
      const int l = it / 96, cgp = it % 96;
      float* sc = smf;
      float* red = smf + 2048;
      for (int i = tid; i < 2048; i += 256) { float v = p.c[i]; sc[i] = v / (1.f + __expf(-v)); }
      __syncthreads();
      const int kq = tid >> 6, cc = tid & 63, col = cgp * 64 + cc;
      const float* wp = p.w_ada + ((size_t)l * 1024 + kq * 256) * 6144 + col;
      float a0 = 0.f, a1 = 0.f;
#pragma unroll 8
      for (int k = 0; k < 256; ++k) { float w = wp[(size_t)k * 6144]; a0 += sc[kq * 256 + k] * w; a1 += sc[1024 + kq * 256 + k] * w; }
      red[(kq * 2 + 0) * 64 + cc] = a0; red[(kq * 2 + 1) * 64 + cc] = a1;
      __syncthreads();
      if (tid < 128) {
        const int b = tid >> 6, c2 = tid & 63;
        float s = red[(0 * 2 + b) * 64 + c2] + red[(1 * 2 + b) * 64 + c2] + red[(2 * 2 + b) * 64 + c2] + red[(3 * 2 + b) * 64 + c2];
        p.mod[(l * 2 + b) * 6144 + cgp * 64 + c2] = s + p.b_ada[l * 6144 + cgp * 64 + c2];
      }
    } else {
      int idx = it - N_ADA; const int l = idx / T_LAYER; int j = idx % T_LAYER;
      const float* W; u16* dst; int Kd, N, tk, tn, kind;
      if (j < T_IN) { W = p.w_in + (size_t)l * 1024 * 3072; dst = p.wt_in + (size_t)l * 3072 * 1024; Kd = 1024; N = 3072; tk = j / 48; tn = j % 48; kind = 0; }
      else if (j < T_IN + T_OUT) { j -= T_IN; W = p.w_out + (size_t)l * 1024 * 1024; dst = p.wt_out + (size_t)l * 1024 * 1024; Kd = 1024; N = 1024; tk = j / 16; tn = j % 16; kind = 1; }
      else if (j < T_IN + T_OUT + T_UP) { j -= T_IN + T_OUT; W = p.w_up + (size_t)l * 1024 * 5632; dst = p.wt_up + (size_t)l * 5632 * 1024; Kd = 1024; N = 5632; tk = j / 88; tn = j % 88; kind = 2; }
      else { j -= T_IN + T_OUT + T_UP; W = p.w_down + (size_t)l * 2816 * 1024; dst = p.wt_down + (size_t)l * 1024 * 2816; Kd = 2816; N = 1024; tk = j / 16; tn = j % 16; kind = 3; }
      const int k0 = tk * 64, n0 = tn * 64;
      float* tile = smf;
      const int nn = tid & 63;
      int np = n0 + nn;
      const int srccol = (kind == 0) ? wmap_in(np) : (kind == 2) ? wmap_up(np) : np;
#pragma unroll 4
      for (int i = 0; i < 16; ++i) { const int kk = i * 4 + (tid >> 6); tile[kk * 65 + nn] = W[(size_t)(k0 + kk) * N + srccol]; }
      __syncthreads();
      const int nrow = tid >> 2, kc = (tid & 3) * 16;
      unsigned pk[8];
#pragma unroll
      for (int q = 0; q < 8; ++q) pk[q] = pack2(tile[(kc + 2 * q) * 65 + nrow], tile[(kc + 2 * q + 1) * 65 + nrow]);
      uint4* dp = (uint4*)(dst + (size_t)(n0 + nrow) * Kd + k0 + kc);
      dp[0] = make_uint4(pk[0], pk[1], pk[2], pk[3]);
      dp[1] = make_uint4(pk[4], pk[5], pk[6], pk[7]);
    }
    __syncthreads();
  }
}

DI float wave_sum(float v) {
#pragma unroll
  for (int o = 32; o >= 1; o >>= 1) v += __shfl_xor(v, o);
  return v;
}

template <int MODE>
DI void phase_norm(const float* xin, const float* g, const float* modl, int sh_off, int sc_off, u16* hout, float* fout) {
  const int tid = otid(); const int lane = tid & 63, w = tid >> 6;
  for (int row = blockIdx.x * 4 + w; row < NTOK; row += gridDim.x * 4) {
    const int b = row >> 14;
    const float4* xr = (const float4*)(xin + (size_t)row * 1024);
    float4 v[4];
#pragma unroll
    for (int i = 0; i < 4; ++i) v[i] = xr[lane + i * 64];
    float ss = 0.f;
#pragma unroll
    for (int i = 0; i < 4; ++i) ss += v[i].x * v[i].x + v[i].y * v[i].y + v[i].z * v[i].z + v[i].w * v[i].w;
    ss = wave_sum(ss);
    const float inv = rsqrtf(ss * (1.f / 1024.f) + 1e-6f);
#pragma unroll
    for (int i = 0; i < 4; ++i) {
      const int col = (lane + i * 64) * 4;
      const float4 g4 = *(const float4*)(g + col);
      if (MODE == 0) {
        const float4 sc4 = *(const float4*)(modl + b * 6144 + sc_off + col);
        const float4 sh4 = *(const float4*)(modl + b * 6144 + sh_off + col);
        float y0 = v[i].x * inv * g4.x * (1.f + sc4.x) + sh4.x;
        float y1 = v[i].y * inv * g4.y * (1.f + sc4.y) + sh4.y;
        float y2 = v[i].z * inv * g4.z * (1.f + sc4.z) + sh4.z;
        float y3 = v[i].w * inv * g4.w * (1.f + sc4.w) + sh4.w;
        *(uint2*)(hout + (size_t)row * 1024 + col) = make_uint2(pack2(y0, y1), pack2(y2, y3));
      } else {
        float4 y; y.x = v[i].x * inv * g4.x; y.y = v[i].y * inv * g4.y; y.z = v[i].z * inv * g4.z; y.w = v[i].w * inv * g4.w;
        *(float4*)(fout + (size_t)row * 1024 + col) = y;
      }
    }
  }
}

constexpr int LDT = 72;
constexpr int GEMM_BUF = 128 * LDT;
DI void gemm_mainloop(const u16* __restrict__ A, int K, int m0, int rlo, int rhi,
                      const u16* __restrict__ Bt, int n0, u16* sm, f32x16 (&acc)[2][2]) {
  const int tid = otid(), lane = tid & 63, w = tid >> 6, r = lane & 31, hh = lane >> 5;
  const int wm = w >> 1, wn = w & 1;
  u16* As = sm; u16* Bs = sm + 2 * GEMM_BUF;
  const int lrow = tid >> 3, kc = (tid & 7) * 8;
  const u16* ap[4];
#pragma unroll
  for (int i = 0; i < 4; ++i) { int row = m0 + lrow + i * 32; row = row < rlo ? rlo : (row > rhi ? rhi : row); ap[i] = A + (size_t)row * K + kc; }
  const u16* bp = Bt + (size_t)(n0 + lrow) * K + kc;
#pragma unroll
  for (int mb = 0; mb < 2; ++mb)
#pragma unroll
    for (int nb = 0; nb < 2; ++nb)
#pragma unroll
      for (int i = 0; i < 16; ++i) acc[mb][nb][i] = 0.f;
  uint4 ra[4], rb[4];
#pragma unroll
  for (int i = 0; i < 4; ++i) { ra[i] = *(const uint4*)(ap[i]); rb[i] = *(const uint4*)(bp + (size_t)i * 32 * K); }
#pragma unroll
  for (int i = 0; i < 4; ++i) { *(uint4*)(As + (lrow + i * 32) * LDT + kc) = ra[i]; *(uint4*)(Bs + (lrow + i * 32) * LDT + kc) = rb[i]; }
  __syncthreads();
  const int KT = K >> 6;
  for (int kt = 0; kt < KT; ++kt) {
    const int buf = kt & 1;
    if (kt + 1 < KT) {
      const int ko = (kt + 1) * 64;
#pragma unroll
      for (int i = 0; i < 4; ++i) { ra[i] = *(const uint4*)(ap[i] + ko); rb[i] = *(const uint4*)(bp + (size_t)i * 32 * K + ko); }
    }
    const u16* Ab = As + buf * GEMM_BUF + (wm * 64 + r) * LDT + 8 * hh;
    const u16* Bb = Bs + buf * GEMM_BUF + (wn * 64 + r) * LDT + 8 * hh;
#pragma unroll
    for (int s = 0; s < 4; ++s) {
      const bf16x8 a0 = *(const bf16x8*)(Ab + s * 16);
      const bf16x8 a1 = *(const bf16x8*)(Ab + 32 * LDT + s * 16);
      const bf16x8 b0 = *(const bf16x8*)(Bb + s * 16);
      const bf16x8 b1 = *(const bf16x8*)(Bb + 32 * LDT + s * 16);
      acc[0][0] = MFMA32(a0, b0, acc[0][0]);
      acc[0][1] = MFMA32(a0, b1, acc[0][1]);
      acc[1][0] = MFMA32(a1, b0, acc[1][0]);
      acc[1][1] = MFMA32(a1, b1, acc[1][1]);
    }
    if (kt + 1 < KT) {
      const int nb_ = buf ^ 1;
#pragma unroll
      for (int i = 0; i < 4; ++i) { *(uint4*)(As + nb_ * GEMM_BUF + (lrow + i * 32) * LDT + kc) = ra[i]; *(uint4*)(Bs + nb_ * GEMM_BUF + (lrow + i * 32) * LDT + kc) = rb[i]; }
    }
    __syncthreads();
  }
}

DI void sincos_big(float ang, float& sn, float& cs) {
  const float c_hi = 1.591549367e-01f, c_lo = 6.420638243e-09f;
  const float rh = ang * c_hi;
  const float e = __builtin_fmaf(ang, c_hi, -rh);
  const float fr = rh - floorf(rh);
  const float rev = fr + (e + ang * c_lo);
  sn = __builtin_amdgcn_sinf(rev);
  cs = __builtin_amdgcn_cosf(rev);
}

DI void phase_proj(const Params& p, int layer, u16* sm) {
  const int tid = otid(), lane = tid & 63, w = tid >> 6, r = lane & 31, hh = lane >> 5;
  const int wm = w >> 1, wn = w & 1;
  const u16* Bt = p.wt_in + (size_t)layer * 3072 * 1024;
  constexpr int NT = 24, TILES = 256 * NT;
  for (int t = blockIdx.x; t < TILES; t += gridDim.x) {
    const int mt = t / NT, nt = t % NT;
    const int m0 = mt * 128, n0 = nt * 128;
    f32x16 acc[2][2];
    gemm_mainloop(p.h, 1024, m0, 0, NTOK - 1, Bt, n0, sm, acc);
    const int col0 = n0 + wn * 64;
    int mode;
    float scale = 1.f;
    if (col0 < 256) { mode = 1; scale = QSCALE_DIFF; }
    else if (col0 < 512) { mode = 1; }
    else if (col0 < 768) { mode = 0; }
    else if (col0 < 1152) { mode = 2; scale = QSCALE_64; }
    else if (col0 < 1536) { mode = 2; }
    else if (col0 < 1920) { mode = 0; }
    else if (col0 < 2304) { mode = 0; scale = QSCALE_64; }
    else { mode = 0; }
    float inv = 0.f;
    if (mode == 1) inv = ROPE_INV16[r & 15];
    if (mode == 2) inv = ROPE_INV32[r];
#pragma unroll
    for (int mb = 0; mb < 2; ++mb) {
#pragma unroll
      for (int i = 0; i < 16; ++i) {
        const int row = m0 + wm * 64 + mb * 32 + crow(i, hh);
        float x1 = acc[mb][0][i], x2 = acc[mb][1][i];
        if (mode != 0) {
          const float pos = (float)(row & (S - 1));
          const float ang = __fmul_rn(pos, inv);
          float sn, cs; sincos_big(ang, sn, cs);
          const float y1 = x1 * cs - x2 * sn, y2 = x2 * cs + x1 * sn;
          x1 = y1; x2 = y2;
        }
        x1 *= scale; x2 *= scale;
        u16* dp = p.proj + (size_t)row * NPROJ + col0 + r;
        dp[0] = f2bf(x1); dp[32] = f2bf(x2);
      }
    }
  }
}

DI void phase_resid_gemm(const u16* A, int K, const u16* Bt, const float* xold, float* xnew, const float* modl, int gate_off, u16* sm) {
  const int tid = otid(), lane = tid & 63, w = tid >> 6, r = lane & 31, hh = lane >> 5;
  const int wm = w >> 1, wn = w & 1;
  constexpr int NT = 8, TILES = 256 * NT;
  for (int t = blockIdx.x; t < TILES; t += gridDim.x) {
    const int mt = t / NT, nt = t % NT;
    const int m0 = mt * 128, n0 = nt * 128;
    f32x16 acc[2][2];
    gemm_mainloop(A, K, m0, 0, NTOK - 1, Bt, n0, sm, acc);
    const int b = m0 >> 14;
#pragma unroll
    for (int nb = 0; nb < 2; ++nb) {
      const int col = n0 + wn * 64 + nb * 32 + r;
      const float gate = modl[b * 6144 + gate_off + col];
#pragma unroll
      for (int mb = 0; mb < 2; ++mb)
#pragma unroll
        for (int i = 0; i < 16; ++i) {
          const size_t off = (size_t)(m0 + wm * 64 + mb * 32 + crow(i, hh)) * 1024 + col;
          xnew[off] = xold[off] + gate * acc[mb][nb][i];
        }
    }
  }
}

DI void phase_up(const Params& p, int layer, u16* sm) {
  const int tid = otid(), lane = tid & 63, w = tid >> 6, r = lane & 31, hh = lane >> 5;
  const int wm = w >> 1, wn = w & 1;
  const u16* Bt = p.wt_up + (size_t)layer * 5632 * 1024;
  const float* cw = p.conv_w + (size_t)layer * 3 * DFF;
  const float* cb = p.conv_b + (size_t)layer * DFF;
  constexpr int NT = 44, MT = 131, TILES = 2 * MT * NT;
  float* G = (float*)sm;
  for (int t = blockIdx.x; t < TILES; t += gridDim.x) {
    const int nt = t % NT, mtb = t / NT, b = mtb / MT, ti = mtb % MT;
    const int tok0 = 126 * ti - 1;
    const int m0 = b * S + tok0;
    f32x16 acc[2][2];
    gemm_mainloop(p.h, 1024, m0, b * S, b * S + S - 1, Bt, nt * 128, sm, acc);
    const int gc = wn * 32 + r;
#pragma unroll
    for (int mb = 0; mb < 2; ++mb)
#pragma unroll
      for (int i = 0; i < 16; ++i) {
        const int R = wm * 64 + mb * 32 + crow(i, hh);
        const int tok = tok0 + R;
        G[R * 64 + gc] = (tok >= 0 && tok < S) ? acc[mb][0][i] : 0.f;
      }
    __syncthreads();
    const int col = 64 * nt + gc;
    const float w0 = cw[col], w1 = cw[DFF + col], w2 = cw[2 * DFF + col], bb = cb[col];
#pragma unroll
    for (int mb = 0; mb < 2; ++mb)
#pragma unroll
      for (int i = 0; i < 16; ++i) {
        const int R = wm * 64 + mb * 32 + crow(i, hh);
        const int tok = tok0 + R;
        if (R >= 1 && R <= 126 && tok < S) {
          const float gm = G[(R - 1) * 64 + gc], gp = G[(R + 1) * 64 + gc];
          const float cv = bb + w0 * gm + w1 * acc[mb][0][i] + w2 * gp;
          const float a = cv / (1.f + __expf(-cv)) * acc[mb][1][i];
          p.act[(size_t)(b * S + tok) * DFF + col] = f2bf(a);
        }
      }
    __syncthreads();
  }
}

constexpr int VT_STRIDE = 36;
constexpr int VT_WAVE = 2 * 64 * VT_STRIDE;

template <int MODE>
DI void local_attn_item(const Params& p, int layer, int item, u16* sm) {
  const int tid = otid(), lane = tid & 63, w = tid >> 6, r = lane & 31, hh = lane >> 5;
  u16* Vt = sm + w * VT_WAVE;
  const int unit = item * 4 + w;
  const int b = unit / (6 * 512), rem = unit % (6 * 512), head = rem / 512, u = rem % 512;
  const u16* prow = p.proj + (size_t)b * S * NPROJ;
  int tq, qcol, kcol, vcol, nblk, ocol;
  int t0 = 0, rr = 0, half = 0, row_start = 0;
  if (MODE == 0) {
    const int res = u & 15, chunk = u >> 4;
    t0 = res + 512 * chunk; tq = t0 + 16 * r;
    qcol = 768 + head * 64; kcol = 1152 + head * 64; vcol = 1536 + head * 64; nblk = 33; ocol = 256 + head * 64;
  } else {
    rr = u >> 1; half = u & 1; tq = rr * 64 + half * 32 + r;
    row_start = rr - 4; row_start = row_start < 0 ? 0 : (row_start > 248 ? 248 : row_start);
    qcol = 1920 + head * 64; kcol = 2304 + head * 64; vcol = 2688 + head * 64; nblk = 16; ocol = 640 + head * 64;
  }
  const float* rpb = p.na_rpb + ((size_t)layer * 6 + head) * 15 * 31;
  bf16x8 qf[4];
#pragma unroll
  for (int s = 0; s < 4; ++s) qf[s] = *(const bf16x8*)(prow + (size_t)tq * NPROJ + qcol + s * 16 + 8 * hh);

  auto geom = [&](int kbi, int& kbase, int& kstride, int& lim) {
    if (MODE == 0) {
      if (kbi < 20) { kstride = 1; kbase = t0 - 64 + kbi * 32; lim = 64; }
      else if (kbi < 28) { kstride = 4; kbase = t0 - 256 + 4 * (kbi - 20) * 32; lim = 256; }
      else { kstride = 16; kbase = t0 - 1024 + 16 * (kbi - 28) * 32; lim = 1024; }
    } else {
      kstride = 1; kbase = (row_start + (kbi >> 1)) * 64 + (kbi & 1) * 32; lim = 0;
    }
  };
  bf16x8 kf[4]; uint4 vr[4];
  auto load_blk = [&](int kbi) {
    int kbase, kstride, lim; geom(kbi, kbase, kstride, lim);
    int kt = kbase + kstride * r; kt = kt < 0 ? 0 : (kt > S - 1 ? S - 1 : kt);
#pragma unroll
    for (int s = 0; s < 4; ++s) kf[s] = *(const bf16x8*)(prow + (size_t)kt * NPROJ + kcol + s * 16 + 8 * hh);
#pragma unroll
    for (int i = 0; i < 4; ++i) {
      const int id = lane + i * 64, key = id >> 3, ch = id & 7;
      int vt = kbase + kstride * key; vt = vt < 0 ? 0 : (vt > S - 1 ? S - 1 : vt);
      vr[i] = *(const uint4*)(prow + (size_t)vt * NPROJ + vcol + ch * 8);
    }
  };
  f32x16 O[2];
#pragma unroll
  for (int mb = 0; mb < 2; ++mb)
#pragma unroll
    for (int i = 0; i < 16; ++i) O[mb][i] = 0.f;
  float m_run = NEGBIG, l_run = 0.f;
  load_blk(0);
  for (int kbi = 0; kbi < nblk; ++kbi) {
    u16* Vb = Vt + (kbi & 1) * 64 * VT_STRIDE;
#pragma unroll
    for (int i = 0; i < 4; ++i) {
      const int id = lane + i * 64, key = id >> 3, ch = id & 7;
      const unsigned e[4] = {vr[i].x, vr[i].y, vr[i].z, vr[i].w};
#pragma unroll
      for (int q = 0; q < 4; ++q) {
        Vb[(ch * 8 + 2 * q) * VT_STRIDE + key] = (u16)(e[q] & 0xffffu);
        Vb[(ch * 8 + 2 * q + 1) * VT_STRIDE + key] = (u16)(e[q] >> 16);
      }
    }
    f32x16 Sc;
#pragma unroll
    for (int i = 0; i < 16; ++i) Sc[i] = 0.f;
#pragma unroll
    for (int s = 0; s < 4; ++s) Sc = MFMA32(kf[s], qf[s], Sc);
    int kbase, kstride, lim; geom(kbi, kbase, kstride, lim);
    if (kbi + 1 < nblk) load_blk(kbi + 1);
    float sv[16]; bool vd[16]; float tmax = NEGBIG;
#pragma unroll
    for (int i = 0; i < 16; ++i) {
      const int kk = crow(i, hh);
      const int kt = kbase + kstride * kk;
      bool valid; float s = Sc[i];
      if (MODE == 0) {
        int dq = kt - tq; dq = dq < 0 ? -dq : dq;
        valid = (kt >= 0) && (kt < S) && (dq <= lim);
      } else {
        const int kc = kt & 63, krow = kt >> 6, qc = half * 32 + r;
        int cs = qc - 8; cs = cs < 0 ? 0 : (cs > 48 ? 48 : cs);
        valid = (kc >= cs) && (kc < cs + 16);
        int dc = kc - qc; dc = dc < -15 ? -15 : (dc > 15 ? 15 : dc);
        const float bias = rpb[(krow - rr + 7) * 31 + dc + 15];
        s += bias * LOG2E;
      }
      vd[i] = valid; sv[i] = valid ? s : NEGBIG; tmax = fmaxf(tmax, sv[i]);
    }
    tmax = fmaxf(tmax, __shfl_xor(tmax, 32));
    const float m_new = fmaxf(m_run, tmax);
    const float alpha = exp2_hw(m_run - m_new);
    m_run = m_new; l_run *= alpha;
#pragma unroll
    for (int mb = 0; mb < 2; ++mb)
#pragma unroll
      for (int i = 0; i < 16; ++i) O[mb][i] *= alpha;
    float pv[16];
#pragma unroll
    for (int i = 0; i < 16; ++i) { pv[i] = vd[i] ? exp2_hw(sv[i] - m_new) : 0.f; l_run += pv[i]; }
    bf16x8 pk[2];
#pragma unroll
    for (int sp = 0; sp < 2; ++sp) {
      unsigned q4[4];
#pragma unroll
      for (int q = 0; q < 4; ++q) q4[q] = pack2(pv[8 * sp + 2 * q], pv[8 * sp + 2 * q + 1]);
      pk[sp] = __builtin_bit_cast(bf16x8, make_uint4(q4[0], q4[1], q4[2], q4[3]));
    }
    __syncthreads();
#pragma unroll
    for (int sp = 0; sp < 2; ++sp)
#pragma unroll
      for (int mb = 0; mb < 2; ++mb) {
        const u16* vp = Vb + (mb * 32 + r) * VT_STRIDE + 16 * sp + 4 * hh;
        const s16x4 lo = *(const s16x4*)vp, hi = *(const s16x4*)(vp + 8);
        const bf16x8 vf = __builtin_shufflevector(lo, hi, 0, 1, 2, 3, 4, 5, 6, 7);
        O[mb] = MFMA32(vf, pk[sp], O[mb]);
      }
  }
  const float l = l_run + __shfl_xor(l_run, 32);
  const float il = 1.f / l;
  u16* op = p.o + (size_t)(b * S + tq) * 1024 + ocol;
#pragma unroll
  for (int mb = 0; mb < 2; ++mb)
#pragma unroll
    for (int g = 0; g < 4; ++g) {
      const int d = mb * 32 + 8 * g + 4 * hh;
      *(uint2*)(op + d) = make_uint2(pack2(O[mb][4 * g] * il, O[mb][4 * g + 1] * il), pack2(O[mb][4 * g + 2] * il, O[mb][4 * g + 3] * il));
    }
  __syncthreads();
}

DI void kmax_item(const Params& p, int layer, int kidx) {
  const int tid = otid(); const int gid = kidx * 256 + tid;
  const int row = gid >> 2, head = gid & 3, b = row >> 14;
  const uint4* kp = (const uint4*)(p.proj + (size_t)row * NPROJ + 256 + head * 64);
  float n0 = 0.f, n1 = 0.f;
#pragma unroll
  for (int c = 0; c < 8; ++c) {
    const uint4 v = kp[c];
    const unsigned e[4] = {v.x, v.y, v.z, v.w};
    float s = 0.f;
#pragma unroll
    for (int q = 0; q < 4; ++q) { const float a = bflo(e[q]), bq = bfhi(e[q]); s += a * a + bq * bq; }
    if ((c >> 1) & 1) n1 += s; else n0 += s;
  }
#pragma unroll
  for (int o = 4; o <= 32; o <<= 1) { n0 = fmaxf(n0, __shfl_xor(n0, o)); n1 = fmaxf(n1, __shfl_xor(n1, o)); }
  if ((tid & 63) < 4) {
    unsigned* km = p.kmax + layer * 16 + (b * 4 + head) * 2;
    atomicMax(km, __float_as_uint(n0)); atomicMax(km + 1, __float_as_uint(n1));
  }
}

DI void phase_local(const Params& p, int layer, u16* sm) {
  constexpr int N_DIL = 1536, N_NA = 1536, N_KM = 512;
  for (int it = blockIdx.x; it < N_DIL + N_NA + N_KM; it += gridDim.x) {
    if (it < N_DIL) local_attn_item<0>(p, layer, it, sm);
    else if (it < N_DIL + N_NA) local_attn_item<1>(p, layer, it - N_DIL, sm);
    else kmax_item(p, layer, it - N_DIL - N_NA);
  }
}

constexpr int KS_STRIDE = 72, VS_STRIDE = 68;
constexpr int KS_BUF = 64 * KS_STRIDE, VS_BUF = 64 * VS_STRIDE;
DI void phase_diff(const Params& p, int layer, u16* sm) {
  const int tid = otid(), lane = tid & 63, w = tid >> 6, r = lane & 31, hh = lane >> 5;
  u16* Ks = sm; u16* Vs = sm + 2 * KS_BUF;
  float lam;
  {
    const float* dl = p.diff_lambda + layer * 128;
    float a = 0.f, c2 = 0.f;
    if (lane < 32) { a = dl[lane] * dl[32 + lane]; c2 = dl[64 + lane] * dl[96 + lane]; }
    a = wave_sum(a); c2 = wave_sum(c2);
    lam = __expf(a) - __expf(c2) + p.lam_init[layer];
  }
  const float lam_init = p.lam_init[layer];
  const float* sg = p.diff_subln + layer * 64;
  for (int it = blockIdx.x; it < 1024; it += gridDim.x) {
    const int bh = it >> 7, qb = it & 127, b = bh >> 2, head = bh & 3;
    const u16* prow = p.proj + (size_t)b * S * NPROJ;
    const int tq = qb * 128 + w * 32 + r;
    bf16x8 qf[2][2];
    float qn[2];
#pragma unroll
    for (int m = 0; m < 2; ++m) {
      qn[m] = 0.f;
#pragma unroll
      for (int s = 0; s < 2; ++s) {
        qf[m][s] = *(const bf16x8*)(prow + (size_t)tq * NPROJ + head * 64 + s * 32 + m * 16 + 8 * hh);
#pragma unroll
        for (int j = 0; j < 8; ++j) { const float v = bf2f((u16)qf[m][s][j]); qn[m] += v * v; }
      }
      qn[m] += __shfl_xor(qn[m], 32);
    }
    float mbnd[2];
#pragma unroll
    for (int m = 0; m < 2; ++m) {
      const float km = __uint_as_float(p.kmax[layer * 16 + bh * 2 + m]);
      mbnd[m] = sqrtf(qn[m] * km);
    }
    f32x16 O[2][2];
#pragma unroll
    for (int m = 0; m < 2; ++m)
#pragma unroll
      for (int mb = 0; mb < 2; ++mb)
#pragma unroll
        for (int i = 0; i < 16; ++i) O[m][mb][i] = 0.f;
    float lsum[2] = {0.f, 0.f};
    uint4 kr[2], vr[2];
    const int key0 = tid >> 3, ch = tid & 7;
    const u16* kg = prow + (size_t)key0 * NPROJ + 256 + head * 64 + ch * 8;
    auto gload = [&](int kt) {
#pragma unroll
      for (int i = 0; i < 2; ++i) {
        const u16* src = kg + (size_t)(kt * 64 + i * 32) * NPROJ;
        kr[i] = *(const uint4*)src; vr[i] = *(const uint4*)(src + 256);
      }
    };
    auto lstore = [&](int buf) {
#pragma unroll
      for (int i = 0; i < 2; ++i) {
        const int key = key0 + i * 32;
        *(uint4*)(Ks + buf * KS_BUF + key * KS_STRIDE + ch * 8) = kr[i];
        const unsigned e[4] = {vr[i].x, vr[i].y, vr[i].z, vr[i].w};
        u16* vb = Vs + buf * VS_BUF + (ch * 8) * VS_STRIDE + key;
#pragma unroll
        for (int q = 0; q < 4; ++q) { vb[(2 * q) * VS_STRIDE] = (u16)(e[q] & 0xffffu); vb[(2 * q + 1) * VS_STRIDE] = (u16)(e[q] >> 16); }
      }
    };
    gload(0); lstore(0);
    __syncthreads();
    for (int kt = 0; kt < 256; ++kt) {
      const int buf = kt & 1;
      if (kt + 1 < 256) gload(kt + 1);
#pragma unroll
      for (int sub = 0; sub < 2; ++sub) {
        bf16x8 pk[2][2];
#pragma unroll
        for (int m = 0; m < 2; ++m) {
          f32x16 Sc;
#pragma unroll
          for (int i = 0; i < 16; ++i) Sc[i] = 0.f;
#pragma unroll
          for (int s = 0; s < 2; ++s) {
            const bf16x8 kf = *(const bf16x8*)(Ks + buf * KS_BUF + (sub * 32 + r) * KS_STRIDE + s * 32 + m * 16 + 8 * hh);
            Sc = MFMA32(kf, qf[m][s], Sc);
          }
          float pv[16];
#pragma unroll
          for (int i = 0; i < 16; ++i) { pv[i] = exp2_hw(Sc[i] - mbnd[m]); lsum[m] += pv[i]; }
#pragma unroll
          for (int sp = 0; sp < 2; ++sp) {
            unsigned q4[4];
#pragma unroll
            for (int q = 0; q < 4; ++q) q4[q] = pack2(pv[8 * sp + 2 * q], pv[8 * sp + 2 * q + 1]);
            pk[m][sp] = __builtin_bit_cast(bf16x8, make_uint4(q4[0], q4[1], q4[2], q4[3]));
          }
        }
#pragma unroll
        for (int sp = 0; sp < 2; ++sp)
#pragma unroll
          for (int mb = 0; mb < 2; ++mb) {
            const u16* vp = Vs + buf * VS_BUF + (mb * 32 + r) * VS_STRIDE + sub * 32 + 16 * sp + 4 * hh;
            const s16x4 lo = *(const s16x4*)vp, hi = *(const s16x4*)(vp + 8);
            const bf16x8 vf = __builtin_shufflevector(lo, hi, 0, 1, 2, 3, 4, 5, 6, 7);
            O[0][mb] = MFMA32(vf, pk[0][sp], O[0][mb]);
            O[1][mb] = MFMA32(vf, pk[1][sp], O[1][mb]);
          }
      }
      if (kt + 1 < 256) lstore(buf ^ 1);
      __syncthreads();
    }
    const float l0 = lsum[0] + __shfl_xor(lsum[0], 32);
    const float l1 = lsum[1] + __shfl_xor(lsum[1], 32);
    const float i0 = 1.f / l0, i1 = lam / l1;
    float ss = 0.f;
#pragma unroll
    for (int mb = 0; mb < 2; ++mb)
#pragma unroll
      for (int i = 0; i < 16; ++i) { const float v = O[0][mb][i] * i0 - O[1][mb][i] * i1; O[0][mb][i] = v; ss += v * v; }
    ss += __shfl_xor(ss, 32);
    const float inv = rsqrtf(ss * (1.f / 64.f) + 1e-6f) * (1.f - lam_init);
    u16* op = p.o + (size_t)(b * S + tq) * 1024 + head * 64;
#pragma unroll
    for (int mb = 0; mb < 2; ++mb)
#pragma unroll
      for (int g = 0; g < 4; ++g) {
        const int d = mb * 32 + 8 * g + 4 * hh;
        const float4 g4 = *(const float4*)(sg + d);
        *(uint2*)(op + d) = make_uint2(pack2(O[0][mb][4 * g] * inv * g4.x, O[0][mb][4 * g + 1] * inv * g4.y),
                                       pack2(O[0][mb][4 * g + 2] * inv * g4.z, O[0][mb][4 * g + 3] * inv * g4.w));
      }
  }
}

constexpr int SMEM_BYTES = 4 * GEMM_BUF * 2;
constexpr int N_PHASES = 18;

DI void run_phase(const Params& p, int ph, u16* sm) {
  if (ph == 0) { phase_prep(p, (float*)sm); return; }
  if (ph == 17) { phase_norm<1>(p.out, p.g_final, nullptr, 0, 0, nullptr, p.out); return; }
  const int layer = (ph - 1) >> 3, sub = (ph - 1) & 7;
  const float* modl = p.mod + layer * 2 * 6144;
  const float* xcur = (layer == 0) ? p.x : p.out;
  switch (sub) {
    case 0: phase_norm<0>(xcur, p.g_attn + layer * 1024, modl, 0, 1024, p.h, nullptr); break;
    case 1: phase_proj(p, layer, sm); break;
    case 2: phase_local(p, layer, sm); break;
    case 3: phase_diff(p, layer, sm); break;
    case 4: phase_resid_gemm(p.o, 1024, p.wt_out + (size_t)layer * 1024 * 1024, xcur, p.out, modl, 2048, sm); break;
    case 5: phase_norm<0>(p.out, p.g_ffn + layer * 1024, modl, 3072, 4096, p.h, nullptr); break;
    case 6: phase_up(p, layer, sm); break;
    case 7: phase_resid_gemm(p.act, DFF, p.wt_down + (size_t)layer * 1024 * DFF, p.out, p.out, modl, 5120, sm); break;
  }
}

__global__ void __launch_bounds__(NBLK_THREADS, 2) mega_kernel(Params p) {
  __shared__ __attribute__((aligned(16))) u16 sm[SMEM_BYTES / 2];
#if COOP
  cg::grid_group grid = cg::this_grid();
#endif
#if COOP
  phase_prep(p, (float*)sm);
  grid.sync();
#pragma unroll 1
  for (int layer = 0; layer < 2; ++layer) {
    const float* modl = p.mod + layer * 2 * 6144;
    const float* xcur = (layer == 0) ? p.x : p.out;
    phase_norm<0>(xcur, p.g_attn + layer * 1024, modl, 0, 1024, p.h, nullptr); grid.sync();
    phase_proj(p, layer, sm); grid.sync();
    phase_local(p, layer, sm); grid.sync();
    phase_diff(p, layer, sm); grid.sync();
    phase_resid_gemm(p.o, 1024, p.wt_out + (size_t)layer * 1024 * 1024, xcur, p.out, modl, 2048, sm); grid.sync();
    phase_norm<0>(p.out, p.g_ffn + layer * 1024, modl, 3072, 4096, p.h, nullptr); grid.sync();
    phase_up(p, layer, sm); grid.sync();
    phase_resid_gemm(p.act, DFF, p.wt_down + (size_t)layer * 1024 * DFF, p.out, p.out, modl, 5120, sm); grid.sync();
  }
  phase_norm<1>(p.out, p.g_final, nullptr, 0, 0, nullptr, p.out);
#else
  for (int ph = p.ph_lo; ph < p.ph_hi; ++ph) run_phase(p, ph, sm);
#endif
}

extern "C" void kernel_launch(void* const* d_in, const int* in_sizes, int n_in, void* d_out, int out_size, void* d_ws, size_t ws_size, hipStream_t stream) {
  (void)in_sizes; (void)n_in; (void)out_size;
  Params p;
  memset(&p, 0, sizeof(p));
  p.x = (const float*)d_in[0]; p.c = (const float*)d_in[1]; p.w_ada = (const float*)d_in[2]; p.b_ada = (const float*)d_in[3];
  p.g_attn = (const float*)d_in[4]; p.w_in = (const float*)d_in[5]; p.diff_lambda = (const float*)d_in[6]; p.diff_subln = (const float*)d_in[7];
  p.na_rpb = (const float*)d_in[8]; p.w_out = (const float*)d_in[9]; p.g_ffn = (const float*)d_in[10]; p.w_up = (const float*)d_in[11];
  p.conv_w = (const float*)d_in[12]; p.conv_b = (const float*)d_in[13]; p.w_down = (const float*)d_in[14]; p.g_final = (const float*)d_in[15];
  p.out = (float*)d_out;
  char* ws = (char*)d_ws; size_t off = 0;
  auto take = [&](size_t bytes) { char* q = ws + off; off += (bytes + 255) & ~(size_t)255; return q; };
  p.wt_in = (u16*)take((size_t)2 * 3072 * 1024 * 2);
  p.wt_out = (u16*)take((size_t)2 * 1024 * 1024 * 2);
  p.wt_up = (u16*)take((size_t)2 * 5632 * 1024 * 2);
  p.wt_down = (u16*)take((size_t)2 * 1024 * 2816 * 2);
  p.mod = (float*)take((size_t)2 * 2 * 6144 * 4);
  p.kmax = (unsigned*)take(256);
  p.h = (u16*)take((size_t)NTOK * 1024 * 2);
  p.o = (u16*)take((size_t)NTOK * 1024 * 2);
  p.proj = (u16*)take((size_t)NTOK * NPROJ * 2);
  p.act = p.proj;
  if (off > ws_size) { fprintf(stderr, "workspace too small: need %zu have %zu\n", off, ws_size); return; }
  p.lam_init[0] = 0.2f; p.lam_init[1] = 0.35550906759096934f;
  static int grid_blocks = 0;
  if (!grid_blocks) {
    int dev = 0, cus = 0, per_cu = 0;
    hipGetDevice(&dev);
    hipDeviceGetAttribute(&cus, hipDeviceAttributeMultiprocessorCount, dev);
    hipOccupancyMaxActiveBlocksPerMultiprocessor(&per_cu, mega_kernel, NBLK_THREADS, 0);
    if (per_cu > 2) per_cu = 2;
    if (per_cu < 1) per_cu = 1;
    grid_blocks = cus * per_cu;
  }
#if COOP
  p.ph_lo = 0; p.ph_hi = N_PHASES;
  void* args[] = {&p};
  hipError_t e = hipLaunchCooperativeKernel((void*)mega_kernel, dim3(grid_blocks), dim3(NBLK_THREADS), args, 0, stream);
  if (e != hipSuccess) fprintf(stderr, "cooperative launch failed: %s (grid %d)\n", hipGetErrorString(e), grid_blocks);
#else
  for (int ph = 0; ph < N_PHASES; ++ph) {
    p.ph_lo = ph; p.ph_hi = ph + 1;
    hipLaunchKernelGGL(mega_kernel, dim3(grid_blocks), dim3(NBLK_THREADS), 0, stream, p);
  }
#endif
}
```

```cpp
#include <hip/hip_runtime.h>
#include <hip/hip_cooperative_groups.h>
#include <cstdio>
#include <cstring>
namespace cg = cooperative_groups;

#ifndef COOP
#define COOP 1
#endif

#define DI __device__ __forceinline__
#define LAS __attribute__((address_space(3)))
typedef unsigned short u16;
using bf16x8 = __attribute__((ext_vector_type(8))) short;
using s16x4  = __attribute__((ext_vector_type(4))) short;
using f32x16 = __attribute__((ext_vector_type(16))) float;
using f32x4  = __attribute__((ext_vector_type(4))) float;
typedef __bf16 bf2_t __attribute__((ext_vector_type(2)));
typedef float f2_t __attribute__((ext_vector_type(2)));
#define MFMA32(a, b, c) __builtin_amdgcn_mfma_f32_32x32x16_bf16((a), (b), (c), 0, 0, 0)

constexpr int S = 16384, NTOK = 32768, DFF = 2816, NPROJ = 3072;
constexpr int NTHR = 512, NWAVE = 8;
constexpr float LOG2E = 1.4426950408889634f;
constexpr float QSCALE_DIFF = 0.25503486164919736f;
constexpr float QSCALE_64   = 0.18033688011112042f;
constexpr float NEGBIG = -1e30f;
constexpr int LDS_BYTES = 131072;

__device__ const float ROPE_INV16[16] = {
1.000000000e+00f, 5.623413324e-01f, 3.162277639e-01f, 1.778279394e-01f, 1.000000015e-01f, 5.623413250e-02f, 3.162277490e-02f, 1.778279431e-02f, 9.999999776e-03f, 5.623413250e-03f, 3.162277630e-03f, 1.778279431e-03f, 1.000000047e-03f, 5.623413017e-04f, 3.162277571e-04f, 1.778279402e-04f};
__device__ const float ROPE_INV32[32] = {
1.000000000e+00f, 7.498942018e-01f, 5.623413324e-01f, 4.216965139e-01f, 3.162277639e-01f, 2.371373773e-01f, 1.778279394e-01f, 1.333521456e-01f, 1.000000015e-01f, 7.498942316e-02f, 5.623413250e-02f, 4.216964915e-02f, 3.162277490e-02f, 2.371373773e-02f, 1.778279431e-02f, 1.333521400e-02f, 9.999999776e-03f, 7.498942316e-03f, 5.623413250e-03f, 4.216964822e-03f, 3.162277630e-03f, 2.371373819e-03f, 1.778279431e-03f, 1.333521446e-03f, 1.000000047e-03f, 7.498941850e-04f, 5.623413017e-04f, 4.216965172e-04f, 3.162277571e-04f, 2.371373703e-04f, 1.778279402e-04f, 1.333521504e-04f};

struct Params {
  const float *x, *c, *w_ada, *b_ada, *g_attn, *w_in, *diff_lambda, *diff_subln, *na_rpb, *w_out, *g_ffn, *w_up, *conv_w, *conv_b, *w_down, *g_final;
  float* out;
  u16 *wt_in, *wt_out, *wt_up, *wt_down;
  float* mod;
  unsigned* kmax;
  u16 *h, *o, *proj, *act;
  float lam_init[2];
  int ph_lo, ph_hi;
};

DI unsigned pack2(float a, float b) { f2_t v = {a, b}; return __builtin_bit_cast(unsigned, __builtin_convertvector(v, bf2_t)); }
DI float bf2f(u16 v) { return __uint_as_float(((unsigned)v) << 16); }
DI float bflo(unsigned v) { return __uint_as_float(v << 16); }
DI float bfhi(unsigned v) { return __uint_as_float(v & 0xffff0000u); }
DI int crow(int i, int hh) { return (i & 3) + 8 * (i >> 2) + 4 * hh; }
DI float exp2_hw(float x) { return __builtin_amdgcn_exp2f(x); }
DI int otid() { int t = threadIdx.x; asm volatile("" : "+v"(t)); return t; }

DI int wmap_in(int np) {
  if (np >= 768 && np < 1536) { const int hb = np & ~63, w = np & 63, g = w >> 5, n = (w >> 4) & 1, i = w & 15; return hb + 16 * g + i + 32 * n; }
  return np;
}
DI int wmap_up(int np) {
  const int pn = np >> 8, w = np & 255, bj = w >> 7, q = w & 127;
  return bj ? (DFF + 128 * pn + q) : (128 * pn + q);
}

DI void phase_prep(const Params& p, float* smf) {
  const int tid = otid();
  if (blockIdx.x == 0 && tid < 64) p.kmax[tid] = 0u;
  constexpr int N_ADA = 192;
  constexpr int T_IN = 16 * 24, T_OUT = 16 * 8, T_UP = 16 * 44, T_DOWN = 44 * 8;
  constexpr int T_LAYER = T_IN + T_OUT + T_UP + T_DOWN;
  const int total = N_ADA + 2 * T_LAYER;
  for (int it = blockIdx.x; it < total; it += gridDim.x) {
    if (it < N_ADA) {
      const int l = it / 96, cgp = it % 96;
      float* sc = smf;
      float* red = smf + 2048;
      for (int i = tid; i < 2048; i += NTHR) { float v = p.c[i]; sc[i] = v / (1.f + __expf(-v)); }
      __syncthreads();
      const int kq = tid >> 6, cc = tid & 63, col = cgp * 64 + cc;
      const float* wp = p.w_ada + ((size_t)l * 1024 + kq * 128) * 6144 + col;
      float a0 = 0.f, a1 = 0.f;
#pragma unroll 8
      for (int k = 0; k < 128; ++k) { float w = wp[(size_t)k * 6144]; a0 += sc[kq * 128 + k] * w; a1 += sc[1024 + kq * 128 + k] * w; }
      red[(kq * 2 + 0) * 64 + cc] = a0; red[(kq * 2 + 1) * 64 + cc] = a1;
      __syncthreads();
      if (tid < 128) {
        const int b = tid >> 6, c2 = tid & 63;
        float s = 0.f;
#pragma unroll
        for (int q = 0; q < 8; ++q) s += red[(q * 2 + b) * 64 + c2];
        p.mod[(l * 2 + b) * 6144 + cgp * 64 + c2] = s + p.b_ada[l * 6144 + cgp * 64 + c2];
      }
    } else {
      int idx = it - N_ADA; const int l = idx / T_LAYER; int j = idx % T_LAYER;
      const float* W; u16* dst; int Kd, N, tk, tn, kind;
      if (j < T_IN) { W = p.w_in + (size_t)l * 1024 * 3072; dst = p.wt_in + (size_t)l * 3072 * 1024; Kd = 1024; N = 3072; tk = j / 24; tn = j % 24; kind = 0; }
      else if (j < T_IN + T_OUT) { j -= T_IN; W = p.w_out + (size_t)l * 1024 * 1024; dst = p.wt_out + (size_t)l * 1024 * 1024; Kd = 1024; N = 1024; tk = j / 8; tn = j % 8; kind = 1; }
      else if (j < T_IN + T_OUT + T_UP) { j -= T_IN + T_OUT; W = p.w_up + (size_t)l * 1024 * 5632; dst = p.wt_up + (size_t)l * 5632 * 1024; Kd = 1024; N = 5632; tk = j / 44; tn = j % 44; kind = 2; }
      else { j -= T_IN + T_OUT + T_UP; W = p.w_down + (size_t)l * 2816 * 1024; dst = p.wt_down + (size_t)l * 1024 * 2816; Kd = 2816; N = 1024; tk = j / 8; tn = j % 8; kind = 3; }
      const int hb = tid >> 8, t = tid & 255;
      const int k0 = tk * 64, n0 = (tn * 2 + hb) * 64;
      float* tile = smf + hb * (64 * 65);
      const int nn = t & 63;
      const int np = n0 + nn;
      const int srccol = (kind == 0) ? wmap_in(np) : (kind == 2) ? wmap_up(np) : np;
#pragma unroll 4
      for (int i = 0; i < 16; ++i) { const int kk = i * 4 + (t >> 6); tile[kk * 65 + nn] = W[(size_t)(k0 + kk) * N + srccol]; }
      __syncthreads();
      const int nrow = t >> 2, kc = (t & 3) * 16;
      unsigned pk[8];
#pragma unroll
      for (int q = 0; q < 8; ++q) pk[q] = pack2(tile[(kc + 2 * q) * 65 + nrow], tile[(kc + 2 * q + 1) * 65 + nrow]);
      uint4* dp = (uint4*)(dst + (size_t)(n0 + nrow) * Kd + k0 + kc);
      dp[0] = make_uint4(pk[0], pk[1], pk[2], pk[3]);
      dp[1] = make_uint4(pk[4], pk[5], pk[6], pk[7]);
    }
    __syncthreads();
  }
}

DI float wave_sum(float v) {
#pragma unroll
  for (int o = 32; o >= 1; o >>= 1) v += __shfl_xor(v, o);
  return v;
}

template <int MODE>
DI void phase_norm(const float* xin, const float* g, const float* modl, int sh_off, int sc_off, u16* hout, float* fout) {
  const int tid = otid(); const int lane = tid & 63, w = tid >> 6;
  for (int row = blockIdx.x * NWAVE + w; row < NTOK; row += gridDim.x * NWAVE) {
    const int b = row >> 14;
    const float4* xr = (const float4*)(xin + (size_t)row * 1024);
    float4 v[4];
#pragma unroll
    for (int i = 0; i < 4; ++i) v[i] = xr[lane + i * 64];
    float ss = 0.f;
#pragma unroll
    for (int i = 0; i < 4; ++i) ss += v[i].x * v[i].x + v[i].y * v[i].y + v[i].z * v[i].z + v[i].w * v[i].w;
    ss = wave_sum(ss);
    const float inv = rsqrtf(ss * (1.f / 1024.f) + 1e-6f);
#pragma unroll
    for (int i = 0; i < 4; ++i) {
      const int col = (lane + i * 64) * 4;
      const float4 g4 = *(const float4*)(g + col);
      if (MODE == 0) {
        const float4 sc4 = *(const float4*)(modl + b * 6144 + sc_off + col);
        const float4 sh4 = *(const float4*)(modl + b * 6144 + sh_off + col);
        float y0 = v[i].x * inv * g4.x * (1.f + sc4.x) + sh4.x;
        float y1 = v[i].y * inv * g4.y * (1.f + sc4.y) + sh4.y;
        float y2 = v[i].z * inv * g4.z * (1.f + sc4.z) + sh4.z;
        float y3 = v[i].w * inv * g4.w * (1.f + sc4.w) + sh4.w;
        *(uint2*)(hout + (size_t)row * 1024 + col) = make_uint2(pack2(y0, y1), pack2(y2, y3));
      } else {
        float4 y; y.x = v[i].x * inv * g4.x; y.y = v[i].y * inv * g4.y; y.z = v[i].z * inv * g4.z; y.w = v[i].w * inv * g4.w;
        *(float4*)(fout + (size_t)row * 1024 + col) = y;
      }
    }
  }
}

namespace pg8 {
constexpr int BM = 256, BK = 64, HALF = 128, HTB = HALF * BK * 2, NXCD = 8, WGM = 8;
DI int lds_byte(int r, int c) { const int st = (r >> 4) * 2 + (c >> 5), rr = r & 15, cc = c & 31, ob = rr * 64 + cc * 2; return st * 1024 + (ob ^ (((ob >> 9) & 1) << 5)); }
DI void stage_rc(int b, int& R, int& C) { const int st = b / 1024, sb = b % 1024, swz = sb ^ (((sb >> 9) & 1) << 5); R = (st >> 1) * 16 + swz / 64; C = (st & 1) * 32 + (swz % 64) / 2; }
struct Unit { int pm, pn; };
struct StaticOrder {
  int nM, nN, nwg, G, c;
  DI void init(int nM_, int nN_, int G_, int c_) { nM = nM_; nN = nN_; nwg = nM * nN; G = G_; c = c_; }
  DI bool next(int i, Unit& u) const {
    const long L = (long)i * G + c; if (L >= nwg) return false;
    int wgid = (int)L; { const int q = nwg / NXCD, r = nwg % NXCD, xcd = wgid % NXCD, off = wgid / NXCD; wgid = (xcd < r ? xcd * (q + 1) : r * (q + 1) + (xcd - r) * q) + off; }
    const int nig = WGM * nN, gid = wgid / nig, fm = gid * WGM, gsz = (nM - fm) < WGM ? (nM - fm) : WGM;
    u.pm = fm + ((wgid % nig) % gsz); u.pn = (wgid % nig) / gsz; return true;
  }
};
struct AMapPlain { static constexpr int HALF_ROWS = 128; static DI int row(int R) { return R; } static DI long tile_row0(int pm) { return (long)pm * 256; } };
struct AMapHalo  { static constexpr int HALF_ROWS = 124; static DI int row(int R) { return 62 * (R >> 6) + (R & 63); } static DI long tile_row0(int pm) { const int b = pm / 67, ti = pm % 67; return (long)b * S + 248 * ti - 1; } };

template <class AMap, class Epi>
DI void gemm_phase(LAS unsigned char* lds, const u16* Aptr, const u16* Btptr, int K, const StaticOrder& SO, const Epi& E) {
  const int tid = otid(), wid = __builtin_amdgcn_readfirstlane(tid >> 6), lane = tid & 63, wr = wid >> 2, wc = wid & 3, fr = lane & 15, fq = lane >> 4;
  const int nt = K / BK;
  unsigned voffA[2], voffB[2];
#pragma unroll
  for (int i = 0; i < 2; ++i) { int R, C; stage_rc(tid * 16 + i * 8192, R, C);
    voffA[i] = (unsigned)(AMap::row(R) * K + C) * 2u; voffB[i] = (unsigned)(R * K + C) * 2u; }
  const size_t kstep = (size_t)(BK * 2);
  const size_t hstepA = (size_t)AMap::HALF_ROWS * K * 2, hstepB = (size_t)HALF * K * 2;
  const size_t tstepB = 2 * hstepB;
  const size_t rowB = (size_t)K * 2;
  const unsigned ldsw = (unsigned)wid * 1024u;
  const int aoff = lds_byte(wr * 64 + fr, fq * 8), boff = lds_byte(wc * 32 + fr, fq * 8);
#define PG8_SA(b, h) (((b) * 2 + (h)) * HTB)
#define PG8_SB(b, h) ((4 + (b) * 2 + (h)) * HTB)
#define PG8_STAGE(bufoff, gbase, voff) do { _Pragma("unroll") for (int _i = 0; _i < 2; ++_i) \
        __builtin_amdgcn_global_load_lds((const unsigned*)((const char*)(gbase) + (voff)[_i]), (LAS unsigned*)(lds + (bufoff) + ldsw + _i * 8192), 16, 0, 0); } while (0)
#define PG8_LDA(dst, b, h) do { _Pragma("unroll") for (int m = 0; m < 4; ++m) _Pragma("unroll") for (int k = 0; k < 2; ++k) dst[m][k] = *(const LAS bf16x8*)(lds + PG8_SA(b, h) + aoff + m * 2048 + k * 1024); } while (0)
#define PG8_LDB(dst, b, h) do { _Pragma("unroll") for (int n = 0; n < 2; ++n) _Pragma("unroll") for (int k = 0; k < 2; ++k) dst[n][k] = *(const LAS bf16x8*)(lds + PG8_SB(b, h) + boff + n * 2048 + k * 1024); } while (0)
#define PG8_MMA(ai, bj, At, Bt) do { __builtin_amdgcn_s_setprio(1); _Pragma("unroll") for (int m = 0; m < 4; ++m) _Pragma("unroll") for (int n = 0; n < 2; ++n) _Pragma("unroll") for (int k = 0; k < 2; ++k) \
        acc[ai][bj][m][n] = __builtin_amdgcn_mfma_f32_16x16x32_bf16(Bt[n][k], At[m][k], acc[ai][bj][m][n], 0, 0, 0); __builtin_amdgcn_s_setprio(0); } while (0)
#define PG8_WAIT_V(n) asm volatile("s_waitcnt vmcnt(" #n ")" ::: "memory")
#define PG8_WAIT_L(n) asm volatile("s_waitcnt lgkmcnt(" #n ")" ::: "memory")
#define PG8_BAR __builtin_amdgcn_s_barrier()
#define PG8_SCHED __builtin_amdgcn_sched_barrier(0)
  Unit cur, nxt; int ui = 0;
  if (!SO.next(0, cur)) return;
  f32x4 acc[2][2][4][2];
#pragma unroll
  for (int a = 0; a < 2; ++a)
#pragma unroll
    for (int b = 0; b < 2; ++b)
#pragma unroll
      for (int m = 0; m < 4; ++m)
#pragma unroll
        for (int n = 0; n < 2; ++n) acc[a][b][m][n] = (f32x4){0.f, 0.f, 0.f, 0.f};
  bf16x8 At[4][2], B0[2][2], B1[2][2];
  const char* cA = (const char*)Aptr + AMap::tile_row0(cur.pm) * (long)rowB; const char* cB = (const char*)Btptr + (size_t)cur.pn * tstepB;
  PG8_STAGE(PG8_SB(0, 0), cB, voffB); PG8_STAGE(PG8_SA(0, 0), cA, voffA); PG8_STAGE(PG8_SB(0, 1), cB + hstepB, voffB); PG8_STAGE(PG8_SA(0, 1), cA + hstepA, voffA);
  if (wr == 1) PG8_BAR;
  PG8_WAIT_V(4); PG8_BAR;
  PG8_STAGE(PG8_SB(1, 0), cB + kstep, voffB); PG8_STAGE(PG8_SA(1, 0), cA + kstep, voffA); PG8_STAGE(PG8_SB(1, 1), cB + hstepB + kstep, voffB);
  PG8_WAIT_V(6); PG8_BAR;
  for (;;) {
    const bool has_next = SO.next(ui + 1, nxt);
    const char* nA = has_next ? (const char*)Aptr + AMap::tile_row0(nxt.pm) * (long)rowB : cA; const char* nB = has_next ? (const char*)Btptr + (size_t)nxt.pn * tstepB : cB;
    for (int t = 0; t < nt; t += 2) {
      const bool last = (t == nt - 2);
      const char* a1 = cA + (size_t)(t + 1) * kstep;
      const char* a2 = last ? nA : cA + (size_t)(t + 2) * kstep; const char* b2 = last ? nB : cB + (size_t)(t + 2) * kstep;
      const char* a3 = a2 + kstep; const char* b3 = b2 + kstep;
      PG8_LDB(B0, 0, 0); PG8_SCHED; PG8_LDA(At, 0, 0); PG8_STAGE(PG8_SA(1, 1), a1 + hstepA, voffA);
      PG8_WAIT_L(8); PG8_BAR; PG8_WAIT_L(0); PG8_MMA(0, 0, At, B0); PG8_BAR; PG8_SCHED;
      PG8_LDB(B1, 0, 1); PG8_STAGE(PG8_SB(0, 0), b2, voffB);
      PG8_BAR; PG8_WAIT_L(0); PG8_MMA(0, 1, At, B1); PG8_BAR;
      PG8_LDA(At, 0, 1); PG8_STAGE(PG8_SA(0, 0), a2, voffA);
      PG8_BAR; PG8_WAIT_L(0); PG8_MMA(1, 0, At, B0); PG8_BAR; PG8_SCHED;
      PG8_STAGE(PG8_SB(0, 1), b2 + hstepB, voffB);
      PG8_WAIT_V(6); PG8_BAR; PG8_MMA(1, 1, At, B1); PG8_BAR;
      PG8_LDB(B0, 1, 0); PG8_SCHED; PG8_LDA(At, 1, 0); PG8_STAGE(PG8_SA(0, 1), a2 + hstepA, voffA);
      PG8_WAIT_L(8); PG8_BAR; PG8_WAIT_L(0); PG8_MMA(0, 0, At, B0); PG8_BAR; PG8_SCHED;
      PG8_LDB(B1, 1, 1); PG8_STAGE(PG8_SB(1, 0), b3, voffB);
      PG8_BAR; PG8_WAIT_L(0); PG8_MMA(0, 1, At, B1); PG8_BAR;
      PG8_LDA(At, 1, 1); PG8_STAGE(PG8_SA(1, 0), a3, voffA);
      PG8_BAR; PG8_WAIT_L(0); PG8_MMA(1, 0, At, B0); PG8_BAR; PG8_SCHED;
      PG8_STAGE(PG8_SB(1, 1), b3 + hstepB, voffB);
      PG8_WAIT_V(6); PG8_BAR; PG8_MMA(1, 1, At, B1); PG8_BAR;
    }
    E(acc, cur, wr, wc, fr, fq);
    if (!has_next) break;
#pragma unroll
    for (int a = 0; a < 2; ++a)
#pragma unroll
      for (int b = 0; b < 2; ++b)
#pragma unroll
        for (int m = 0; m < 4; ++m)
#pragma unroll
          for (int n = 0; n < 2; ++n) acc[a][b][m][n] = (f32x4){0.f, 0.f, 0.f, 0.f};
    cur = nxt; cA = nA; cB = nB; ++ui;
  }
  PG8_WAIT_V(0);
  if (wr == 0) PG8_BAR;
  PG8_BAR;
#undef PG8_SA
#undef PG8_SB
#undef PG8_STAGE
#undef PG8_LDA
#undef PG8_LDB
#undef PG8_MMA
#undef PG8_WAIT_V
#undef PG8_WAIT_L
#undef PG8_BAR
#undef PG8_SCHED
}
}

DI void sincos_big(float ang, float& sn, float& cs) {
  const float c_hi = 1.591549367e-01f, c_lo = 6.420638243e-09f;
  const float rh = ang * c_hi;
  const float e = __builtin_fmaf(ang, c_hi, -rh);
  const float fr = rh - floorf(rh);
  const float rev = fr + (e + ang * c_lo);
  sn = __builtin_amdgcn_sinf(rev);
  cs = __builtin_amdgcn_cosf(rev);
}

struct EpiProj {
  u16* proj;
  DI void operator()(const f32x4 (&acc)[2][2][4][2], const pg8::Unit& u, int wr, int wc, int fr, int fq) const {
    const f32x4 i16 = *(const f32x4*)(ROPE_INV16 + 4 * fq);
    const f32x4 i32v = *(const f32x4*)(ROPE_INV32 + 16 * (wc & 1) + 4 * fq);
#pragma unroll
    for (int bj = 0; bj < 2; ++bj) {
      const int gcol0 = u.pn * 256 + bj * 128 + wc * 32;
      int mode; float scale = 1.f;
      if (gcol0 < 256) { mode = 1; scale = QSCALE_DIFF; }
      else if (gcol0 < 512) { mode = 1; }
      else if (gcol0 < 768) { mode = 0; }
      else if (gcol0 < 1152) { mode = 2; scale = QSCALE_64; }
      else if (gcol0 < 1536) { mode = 2; }
      else if (gcol0 < 1920) { mode = 0; }
      else if (gcol0 < 2304) { mode = 0; scale = QSCALE_64; }
      else { mode = 0; }
      f32x4 invv;
#pragma unroll
      for (int e = 0; e < 4; ++e) invv[e] = (mode == 1) ? i16[e] : i32v[e];
      int c1, c2;
      if (mode == 2) { const int hb = gcol0 & ~63, g = wc & 1; c1 = hb + 16 * g + 4 * fq; c2 = c1 + 32; }
      else { c1 = gcol0 + 4 * fq; c2 = c1 + 16; }
#pragma unroll
      for (int ai = 0; ai < 2; ++ai)
#pragma unroll
        for (int m = 0; m < 4; ++m) {
          const int row = u.pm * 256 + ai * 128 + wr * 64 + m * 16 + fr;
          f32x4 x1 = acc[ai][bj][m][0], x2 = acc[ai][bj][m][1];
          if (mode != 0) {
            const float pos = (float)(row & (S - 1));
#pragma unroll
            for (int e = 0; e < 4; ++e) {
              const float ang = __fmul_rn(pos, invv[e]);
              float sn, cs; sincos_big(ang, sn, cs);
              const float y1 = x1[e] * cs - x2[e] * sn, y2 = x2[e] * cs + x1[e] * sn;
              x1[e] = y1; x2[e] = y2;
            }
          }
          u16* dp = proj + (size_t)row * NPROJ;
          *(uint2*)(dp + c1) = make_uint2(pack2(x1[0] * scale, x1[1] * scale), pack2(x1[2] * scale, x1[3] * scale));
          *(uint2*)(dp + c2) = make_uint2(pack2(x2[0] * scale, x2[1] * scale), pack2(x2[2] * scale, x2[3] * scale));
        }
    }
  }
};

struct EpiResid {
  const float* xold; float* xnew; const float* gate;
  DI void operator()(const f32x4 (&acc)[2][2][4][2], const pg8::Unit& u, int wr, int wc, int fr, int fq) const {
    const int b = (u.pm * 256) >> 14;
    const int col0 = u.pn * 256 + wc * 32 + 4 * fq;
    f32x4 gv[2][2];
#pragma unroll
    for (int bj = 0; bj < 2; ++bj)
#pragma unroll
      for (int n = 0; n < 2; ++n) gv[bj][n] = *(const f32x4*)(gate + b * 6144 + col0 + bj * 128 + n * 16);
#pragma unroll
    for (int ai = 0; ai < 2; ++ai)
#pragma unroll
      for (int m = 0; m < 4; ++m) {
        const size_t off = (size_t)(u.pm * 256 + ai * 128 + wr * 64 + m * 16 + fr) * 1024 + col0;
        f32x4 xo[2][2];
#pragma unroll
        for (int bj = 0; bj < 2; ++bj)
#pragma unroll
          for (int n = 0; n < 2; ++n) xo[bj][n] = *(const f32x4*)(xold + off + bj * 128 + n * 16);
#pragma unroll
        for (int bj = 0; bj < 2; ++bj)
#pragma unroll
          for (int n = 0; n < 2; ++n) *(f32x4*)(xnew + off + bj * 128 + n * 16) = xo[bj][n] + gv[bj][n] * acc[ai][bj][m][n];
        asm volatile("" ::: "memory");
      }
  }
};

DI float dpp_ror1(float v)  { return __builtin_bit_cast(float, __builtin_amdgcn_update_dpp(0, __builtin_bit_cast(int, v), 0x121, 0xf, 0xf, false)); }
DI float dpp_ror15(float v) { return __builtin_bit_cast(float, __builtin_amdgcn_update_dpp(0, __builtin_bit_cast(int, v), 0x12F, 0xf, 0xf, false)); }
struct EpiUp {
  u16* act; const float* cw; const float* cb;
  DI void operator()(const f32x4 (&acc)[2][2][4][2], const pg8::Unit& u, int wr, int wc, int fr, int fq) const {
    const int b = u.pm / 67, ti = u.pm % 67;
#pragma unroll
    for (int n = 0; n < 2; ++n) {
      const int col = u.pn * 128 + wc * 32 + n * 16 + 4 * fq;
      const f32x4 w0 = *(const f32x4*)(cw + col), w1 = *(const f32x4*)(cw + DFF + col), w2 = *(const f32x4*)(cw + 2 * DFF + col), bb = *(const f32x4*)(cb + col);
#pragma unroll
      for (int ai = 0; ai < 2; ++ai) {
        const int tokb = 248 * ti - 1 + 62 * (2 * ai + wr);
        f32x4 g[4];
#pragma unroll
        for (int m = 0; m < 4; ++m) {
          const int tok = tokb + 16 * m + fr;
          const bool ok = (tok >= 0) && (tok < S);
#pragma unroll
          for (int e = 0; e < 4; ++e) g[m][e] = ok ? acc[ai][0][m][n][e] : 0.f;
        }
#pragma unroll
        for (int m = 0; m < 4; ++m) {
          const int q = 16 * m + fr, tok = tokb + q;
          f32x4 r;
#pragma unroll
          for (int e = 0; e < 4; ++e) {
            const float srcm = (fr == 15 && m > 0) ? g[m > 0 ? m - 1 : 0][e] : g[m][e];
            const float srcp = (fr == 0 && m < 3) ? g[m < 3 ? m + 1 : 3][e] : g[m][e];
            const float gm = dpp_ror1(srcm), gp = dpp_ror15(srcp);
            const float cv = bb[e] + w0[e] * gm + w1[e] * g[m][e] + w2[e] * gp;
            r[e] = cv / (1.f + __expf(-cv)) * acc[ai][1][m][n][e];
          }
          if (q >= 1 && q <= 62 && tok < S)
            *(uint2*)(act + (size_t)(b * S + tok) * DFF + col) = make_uint2(pack2(r[0], r[1]), pack2(r[2], r[3]));
        }
      }
    }
  }
};

constexpr int VT_STRIDE = 36;
constexpr int VT_WAVE = 2 * 64 * VT_STRIDE;

template <int MODE>
DI void local_attn_item(const Params& p, int layer, int item, u16* sm) {
  const int tid = otid(), lane = tid & 63, w = tid >> 6, r = lane & 31, hh = lane >> 5;
  u16* Vt = sm + w * VT_WAVE;
  const int unit = item * NWAVE + w;
  const int b = unit / (6 * 512), rem = unit % (6 * 512), head = rem / 512, u = rem % 512;
  const u16* prow = p.proj + (size_t)b * S * NPROJ;
  int tq, qcol, kcol, vcol, nblk, ocol;
  int t0 = 0, rr = 0, half = 0, row_start = 0;
  if (MODE == 0) {
    const int res = u & 15, chunk = u >> 4;
    t0 = res + 512 * chunk; tq = t0 + 16 * r;
    qcol = 768 + head * 64; kcol = 1152 + head * 64; vcol = 1536 + head * 64; nblk = 33; ocol = 256 + head * 64;
  } else {
    rr = u >> 1; half = u & 1; tq = rr * 64 + half * 32 + r;
    row_start = rr - 4; row_start = row_start < 0 ? 0 : (row_start > 248 ? 248 : row_start);
    qcol = 1920 + head * 64; kcol = 2304 + head * 64; vcol = 2688 + head * 64; nblk = 16; ocol = 640 + head * 64;
  }
  const float* rpb = p.na_rpb + ((size_t)layer * 6 + head) * 15 * 31;
  bf16x8 qf[4];
#pragma unroll
  for (int s = 0; s < 4; ++s) qf[s] = *(const bf16x8*)(prow + (size_t)tq * NPROJ + qcol + s * 16 + 8 * hh);

  auto geom = [&](int kbi, int& kbase, int& kstride, int& lim) {
    if (MODE == 0) {
      if (kbi < 20) { kstride = 1; kbase = t0 - 64 + kbi * 32; lim = 64; }
      else if (kbi < 28) { kstride = 4; kbase = t0 - 256 + 4 * (kbi - 20) * 32; lim = 256; }
      else { kstride = 16; kbase = t0 - 1024 + 16 * (kbi - 28) * 32; lim = 1024; }
    } else {
      kstride = 1; kbase = (row_start + (kbi >> 1)) * 64 + (kbi & 1) * 32; lim = 0;
    }
  };
  bf16x8 kf[4]; uint4 vr[4];
  auto load_blk = [&](int kbi) {
    int kbase, kstride, lim; geom(kbi, kbase, kstride, lim);
    int kt = kbase + kstride * r; kt = kt < 0 ? 0 : (kt > S - 1 ? S - 1 : kt);
#pragma unroll
    for (int s = 0; s < 4; ++s) kf[s] = *(const bf16x8*)(prow + (size_t)kt * NPROJ + kcol + s * 16 + 8 * hh);
#pragma unroll
    for (int i = 0; i < 4; ++i) {
      const int id = lane + i * 64, key = id >> 3, ch = id & 7;
      int vt = kbase + kstride * key; vt = vt < 0 ? 0 : (vt > S - 1 ? S - 1 : vt);
      vr[i] = *(const uint4*)(prow + (size_t)vt * NPROJ + vcol + ch * 8);
    }
  };
  f32x16 O[2];
#pragma unroll
  for (int mb = 0; mb < 2; ++mb)
#pragma unroll
    for (int i = 0; i < 16; ++i) O[mb][i] = 0.f;
  float m_run = NEGBIG, l_run = 0.f;
  load_blk(0);
  for (int kbi = 0; kbi < nblk; ++kbi) {
    u16* Vb = Vt + (kbi & 1) * 64 * VT_STRIDE;
#pragma unroll
    for (int i = 0; i < 4; ++i) {
      const int id = lane + i * 64, key = id >> 3, ch = id & 7;
      const unsigned e[4] = {vr[i].x, vr[i].y, vr[i].z, vr[i].w};
#pragma unroll
      for (int q = 0; q < 4; ++q) {
        Vb[(ch * 8 + 2 * q) * VT_STRIDE + key] = (u16)(e[q] & 0xffffu);
        Vb[(ch * 8 + 2 * q + 1) * VT_STRIDE + key] = (u16)(e[q] >> 16);
      }
    }
    f32x16 Sc;
#pragma unroll
    for (int i = 0; i < 16; ++i) Sc[i] = 0.f;
#pragma unroll
    for (int s = 0; s < 4; ++s) Sc = MFMA32(kf[s], qf[s], Sc);
    int kbase, kstride, lim; geom(kbi, kbase, kstride, lim);
    if (kbi + 1 < nblk) load_blk(kbi + 1);
    float sv[16]; bool vd[16]; float tmax = NEGBIG;
#pragma unroll
    for (int i = 0; i < 16; ++i) {
      const int kk = crow(i, hh);
      const int kt = kbase + kstride * kk;
      bool valid; float s = Sc[i];
      if (MODE == 0) {
        int dq = kt - tq; dq = dq < 0 ? -dq : dq;
        valid = (kt >= 0) && (kt < S) && (dq <= lim);
      } else {
        const int kc = kt & 63, krow = kt >> 6, qc = half * 32 + r;
        int cs = qc - 8; cs = cs < 0 ? 0 : (cs > 48 ? 48 : cs);
        valid = (kc >= cs) && (kc < cs + 16);
        int dc = kc - qc; dc = dc < -15 ? -15 : (dc > 15 ? 15 : dc);
        const float bias = rpb[(krow - rr + 7) * 31 + dc + 15];
        s += bias * LOG2E;
      }
      vd[i] = valid; sv[i] = valid ? s : NEGBIG; tmax = fmaxf(tmax, sv[i]);
    }
    tmax = fmaxf(tmax, __shfl_xor(tmax, 32));
    const float m_new = fmaxf(m_run, tmax);
    const float alpha = exp2_hw(m_run - m_new);
    m_run = m_new; l_run *= alpha;
#pragma unroll
    for (int mb = 0; mb < 2; ++mb)
#pragma unroll
      for (int i = 0; i < 16; ++i) O[mb][i] *= alpha;
    float pv[16];
#pragma unroll
    for (int i = 0; i < 16; ++i) { pv[i] = vd[i] ? exp2_hw(sv[i] - m_new) : 0.f; l_run += pv[i]; }
    bf16x8 pk[2];
#pragma unroll
    for (int sp = 0; sp < 2; ++sp) {
      unsigned q4[4];
#pragma unroll
      for (int q = 0; q < 4; ++q) q4[q] = pack2(pv[8 * sp + 2 * q], pv[8 * sp + 2 * q + 1]);
      pk[sp] = __builtin_bit_cast(bf16x8, make_uint4(q4[0], q4[1], q4[2], q4[3]));
    }
    __syncthreads();
#pragma unroll
    for (int sp = 0; sp < 2; ++sp)
#pragma unroll
      for (int mb = 0; mb < 2; ++mb) {
        const u16* vp = Vb + (mb * 32 + r) * VT_STRIDE + 16 * sp + 4 * hh;
        const s16x4 lo = *(const s16x4*)vp, hi = *(const s16x4*)(vp + 8);
        const bf16x8 vf = __builtin_shufflevector(lo, hi, 0, 1, 2, 3, 4, 5, 6, 7);
        O[mb] = MFMA32(vf, pk[sp], O[mb]);
      }
  }
  const float l = l_run + __shfl_xor(l_run, 32);
  const float il = 1.f / l;
  u16* op = p.o + (size_t)(b * S + tq) * 1024 + ocol;
#pragma unroll
  for (int mb = 0; mb < 2; ++mb)
#pragma unroll
    for (int g = 0; g < 4; ++g) {
      const int d = mb * 32 + 8 * g + 4 * hh;
      *(uint2*)(op + d) = make_uint2(pack2(O[mb][4 * g] * il, O[mb][4 * g + 1] * il), pack2(O[mb][4 * g + 2] * il, O[mb][4 * g + 3] * il));
    }
  __syncthreads();
}

DI void kmax_item(const Params& p, int layer, int kidx) {
  const int tid = otid(); const int gid = kidx * NTHR + tid;
  const int row = gid >> 2, head = gid & 3, b = row >> 14;
  const uint4* kp = (const uint4*)(p.proj + (size_t)row * NPROJ + 256 + head * 64);
  float n0 = 0.f, n1 = 0.f;
#pragma unroll
  for (int c = 0; c < 8; ++c) {
    const uint4 v = kp[c];
    const unsigned e[4] = {v.x, v.y, v.z, v.w};
    float s = 0.f;
#pragma unroll
    for (int q = 0; q < 4; ++q) { const float a = bflo(e[q]), bq = bfhi(e[q]); s += a * a + bq * bq; }
    if (c >= 4) n1 += s; else n0 += s;
  }
#pragma unroll
  for (int o = 4; o <= 32; o <<= 1) { n0 = fmaxf(n0, __shfl_xor(n0, o)); n1 = fmaxf(n1, __shfl_xor(n1, o)); }
  if ((tid & 63) < 4) {
    unsigned* km = p.kmax + layer * 16 + (b * 4 + head) * 2;
    atomicMax(km, __float_as_uint(n0)); atomicMax(km + 1, __float_as_uint(n1));
  }
}

DI void phase_local(const Params& p, int layer, u16* sm) {
  constexpr int N_DIL = 768, N_NA = 768, N_KM = 256;
  for (int it = blockIdx.x; it < N_DIL + N_NA + N_KM; it += gridDim.x) {
    if (it < N_DIL) local_attn_item<0>(p, layer, it, sm);
    else if (it < N_DIL + N_NA) local_attn_item<1>(p, layer, it - N_DIL, sm);
    else kmax_item(p, layer, it - N_DIL - N_NA);
  }
}

constexpr int KS_STRIDE = 72, VS_STRIDE = 68;
constexpr int KS_BUF = 64 * KS_STRIDE, VS_BUF = 64 * VS_STRIDE;
DI void phase_diff(const Params& p, int layer, u16* sm) {
  const int tid = otid(), lane = tid & 63, w = tid >> 6, r = lane & 31, hh = lane >> 5;
  u16* Ks = sm; u16* Vs = sm + 2 * KS_BUF;
  float lam;
  {
    const float* dl = p.diff_lambda + layer * 128;
    float a = 0.f, c2 = 0.f;
    if (lane < 32) { a = dl[lane] * dl[32 + lane]; c2 = dl[64 + lane] * dl[96 + lane]; }
    a = wave_sum(a); c2 = wave_sum(c2);
    lam = __expf(a) - __expf(c2) + p.lam_init[layer];
  }
  const float lam_init = p.lam_init[layer];
  const float* sg = p.diff_subln + layer * 64;
  for (int it = blockIdx.x; it < 512; it += gridDim.x) {
    const int bh = it >> 6, qb = it & 63, b = bh >> 2, head = bh & 3;
    const u16* prow = p.proj + (size_t)b * S * NPROJ;
    const int tq = qb * 256 + w * 32 + r;
    bf16x8 qf[2][2];
    float qn[2];
#pragma unroll
    for (int m = 0; m < 2; ++m) {
      qn[m] = 0.f;
#pragma unroll
      for (int s = 0; s < 2; ++s) {
        qf[m][s] = *(const bf16x8*)(prow + (size_t)tq * NPROJ + head * 64 + m * 32 + s * 16 + 8 * hh);
#pragma unroll
        for (int j = 0; j < 8; ++j) { const float v = bf2f((u16)qf[m][s][j]); qn[m] += v * v; }
      }
      qn[m] += __shfl_xor(qn[m], 32);
    }
    float mbnd[2];
#pragma unroll
    for (int m = 0; m < 2; ++m) {
      const float km = __uint_as_float(p.kmax[layer * 16 + bh * 2 + m]);
      mbnd[m] = sqrtf(qn[m] * km);
    }
    f32x16 O[2][2];
#pragma unroll
    for (int m = 0; m < 2; ++m)
#pragma unroll
      for (int mb = 0; mb < 2; ++mb)
#pragma unroll
        for (int i = 0; i < 16; ++i) O[m][mb][i] = 0.f;
    float lsum[2] = {0.f, 0.f};
    uint4 kr, vr;
    const int key0 = tid >> 3, ch = tid & 7;
    const u16* kg = prow + (size_t)key0 * NPROJ + 256 + head * 64 + ch * 8;
    auto gload = [&](int kt) {
      const u16* src = kg + (size_t)(kt * 64) * NPROJ;
      kr = *(const uint4*)src; vr = *(const uint4*)(src + 256);
    };
    auto lstore = [&](int buf) {
      *(uint4*)(Ks + buf * KS_BUF + key0 * KS_STRIDE + ch * 8) = kr;
      const unsigned e[4] = {vr.x, vr.y, vr.z, vr.w};
      u16* vb = Vs + buf * VS_BUF + (ch * 8) * VS_STRIDE + key0;
#pragma unroll
      for (int q = 0; q < 4; ++q) { vb[(2 * q) * VS_STRIDE] = (u16)(e[q] & 0xffffu); vb[(2 * q + 1) * VS_STRIDE] = (u16)(e[q] >> 16); }
    };
    gload(0); lstore(0);
    __syncthreads();
    for (int kt = 0; kt < 256; ++kt) {
      const int buf = kt & 1;
      if (kt + 1 < 256) gload(kt + 1);
#pragma unroll
      for (int sub = 0; sub < 2; ++sub) {
#pragma unroll
        for (int m = 0; m < 2; ++m) {
          f32x16 Sc;
#pragma unroll
          for (int i = 0; i < 16; ++i) Sc[i] = 0.f;
#pragma unroll
          for (int s = 0; s < 2; ++s) {
            const bf16x8 kf = *(const bf16x8*)(Ks + buf * KS_BUF + (sub * 32 + r) * KS_STRIDE + m * 32 + s * 16 + 8 * hh);
            Sc = MFMA32(kf, qf[m][s], Sc);
          }
          bf16x8 pk[2];
#pragma unroll
          for (int sp = 0; sp < 2; ++sp) {
            unsigned q4[4];
#pragma unroll
            for (int q = 0; q < 4; ++q) {
              const float p0 = exp2_hw(Sc[8 * sp + 2 * q] - mbnd[m]), p1 = exp2_hw(Sc[8 * sp + 2 * q + 1] - mbnd[m]);
              lsum[m] += p0; lsum[m] += p1;
              q4[q] = pack2(p0, p1);
            }
            pk[sp] = __builtin_bit_cast(bf16x8, make_uint4(q4[0], q4[1], q4[2], q4[3]));
          }
#pragma unroll
          for (int sp = 0; sp < 2; ++sp)
#pragma unroll
            for (int mb = 0; mb < 2; ++mb) {
              const u16* vp = Vs + buf * VS_BUF + (mb * 32 + r) * VS_STRIDE + sub * 32 + 16 * sp + 4 * hh;
              const s16x4 lo = *(const s16x4*)vp, hi = *(const s16x4*)(vp + 8);
              const bf16x8 vf = __builtin_shufflevector(lo, hi, 0, 1, 2, 3, 4, 5, 6, 7);
              O[m][mb] = MFMA32(vf, pk[sp], O[m][mb]);
            }
        }
        __builtin_amdgcn_sched_barrier(0);
      }
      if (kt + 1 < 256) lstore(buf ^ 1);
      __syncthreads();
    }
    const float l0 = lsum[0] + __shfl_xor(lsum[0], 32);
    const float l1 = lsum[1] + __shfl_xor(lsum[1], 32);
    const float i0 = 1.f / l0, i1 = lam / l1;
    float ss = 0.f;
#pragma unroll
    for (int mb = 0; mb < 2; ++mb)
#pragma unroll
      for (int i = 0; i < 16; ++i) { const float v = O[0][mb][i] * i0 - O[1][mb][i] * i1; O[0][mb][i] = v; ss += v * v; }
    ss += __shfl_xor(ss, 32);
    const float inv = rsqrtf(ss * (1.f / 64.f) + 1e-6f) * (1.f - lam_init);
    u16* op = p.o + (size_t)(b * S + tq) * 1024 + head * 64;
#pragma unroll
    for (int mb = 0; mb < 2; ++mb)
#pragma unroll
      for (int g = 0; g < 4; ++g) {
        const int d = mb * 32 + 8 * g + 4 * hh;
        const float4 g4 = *(const float4*)(sg + d);
        *(uint2*)(op + d) = make_uint2(pack2(O[0][mb][4 * g] * inv * g4.x, O[0][mb][4 * g + 1] * inv * g4.y),
                                       pack2(O[0][mb][4 * g + 2] * inv * g4.z, O[0][mb][4 * g + 3] * inv * g4.w));
      }
  }
}

DI void phase_proj(const Params& p, int layer, LAS unsigned char* lds) {
  pg8::StaticOrder so; so.init(128, 12, gridDim.x, blockIdx.x);
  EpiProj e; e.proj = p.proj;
  pg8::gemm_phase<pg8::AMapPlain>(lds, p.h, p.wt_in + (size_t)layer * 3072 * 1024, 1024, so, e);
}
DI void phase_resid(const u16* A, int K, const u16* Bt, const float* xold, float* xnew, const float* gate, LAS unsigned char* lds) {
  pg8::StaticOrder so; so.init(128, 4, gridDim.x, blockIdx.x);
  EpiResid e; e.xold = xold; e.xnew = xnew; e.gate = gate;
  pg8::gemm_phase<pg8::AMapPlain>(lds, A, Bt, K, so, e);
}
DI void phase_up(const Params& p, int layer, LAS unsigned char* lds) {
  pg8::StaticOrder so; so.init(134, 22, gridDim.x, blockIdx.x);
  EpiUp e; e.act = p.act; e.cw = p.conv_w + (size_t)layer * 3 * DFF; e.cb = p.conv_b + (size_t)layer * DFF;
  pg8::gemm_phase<pg8::AMapHalo>(lds, p.h, p.wt_up + (size_t)layer * 5632 * 1024, 1024, so, e);
}

constexpr int N_PHASES = 18;

DI void run_phase(const Params& p, int ph, unsigned char* smraw) {
  u16* sm = (u16*)smraw;
  LAS unsigned char* lds = (LAS unsigned char*)smraw;
  if (ph == 0) { phase_prep(p, (float*)smraw); return; }
  if (ph == 17) { phase_norm<1>(p.out, p.g_final, nullptr, 0, 0, nullptr, p.out); return; }
  const int layer = (ph - 1) >> 3, sub = (ph - 1) & 7;
  const float* modl = p.mod + layer * 2 * 6144;
  const float* xcur = (layer == 0) ? p.x : p.out;
  switch (sub) {
    case 0: phase_norm<0>(xcur, p.g_attn + layer * 1024, modl, 0, 1024, p.h, nullptr); break;
    case 1: phase_proj(p, layer, lds); break;
    case 2: phase_local(p, layer, sm); break;
    case 3: phase_diff(p, layer, sm); break;
    case 4: phase_resid(p.o, 1024, p.wt_out + (size_t)layer * 1024 * 1024, xcur, p.out, modl + 2048, lds); break;
    case 5: phase_norm<0>(p.out, p.g_ffn + layer * 1024, modl, 3072, 4096, p.h, nullptr); break;
    case 6: phase_up(p, layer, lds); break;
    case 7: phase_resid(p.act, DFF, p.wt_down + (size_t)layer * 1024 * DFF, p.out, p.out, modl + 5120, lds); break;
  }
}

__global__ void __launch_bounds__(NTHR, 2) mega_kernel(Params p) {
  __shared__ __attribute__((aligned(16))) unsigned char smraw[LDS_BYTES];
#if COOP
  cg::grid_group grid = cg::this_grid();
  u16* sm = (u16*)smraw;
  LAS unsigned char* lds = (LAS unsigned char*)smraw;
  phase_prep(p, (float*)smraw);
  grid.sync();
#pragma unroll 1
  for (int layer = 0; layer < 2; ++layer) {
    const float* modl = p.mod + layer * 2 * 6144;
    const float* xcur = (layer == 0) ? p.x : p.out;
    phase_norm<0>(xcur, p.g_attn + layer * 1024, modl, 0, 1024, p.h, nullptr); grid.sync();
    phase_proj(p, layer, lds); grid.sync();
    phase_local(p, layer, sm); grid.sync();
    phase_diff(p, layer, sm); grid.sync();
    phase_resid(p.o, 1024, p.wt_out + (size_t)layer * 1024 * 1024, xcur, p.out, modl + 2048, lds); grid.sync();
    phase_norm<0>(p.out, p.g_ffn + layer * 1024, modl, 3072, 4096, p.h, nullptr); grid.sync();
    phase_up(p, layer, lds); grid.sync();
    phase_resid(p.act, DFF, p.wt_down + (size_t)layer * 1024 * DFF, p.out, p.out, modl + 5120, lds); grid.sync();
  }
  phase_norm<1>(p.out, p.g_final, nullptr, 0, 0, nullptr, p.out);
#else
  for (int ph = p.ph_lo; ph < p.ph_hi; ++ph) run_phase(p, ph, smraw);
#endif
}

extern "C" void kernel_launch(void* const* d_in, const int* in_sizes, int n_in, void* d_out, int out_size, void* d_ws, size_t ws_size, hipStream_t stream) {
  (void)in_sizes; (void)n_in; (void)out_size;
  Params p;
  memset(&p, 0, sizeof(p));
  p.x = (const float*)d_in[0]; p.c = (const float*)d_in[1]; p.w_ada = (const float*)d_in[2]; p.b_ada = (const float*)d_in[3];
  p.g_attn = (const float*)d_in[4]; p.w_in = (const float*)d_in[5]; p.diff_lambda = (const float*)d_in[6]; p.diff_subln = (const float*)d_in[7];
  p.na_rpb = (const float*)d_in[8]; p.w_out = (const float*)d_in[9]; p.g_ffn = (const float*)d_in[10]; p.w_up = (const float*)d_in[11];
  p.conv_w = (const float*)d_in[12]; p.conv_b = (const float*)d_in[13]; p.w_down = (const float*)d_in[14]; p.g_final = (const float*)d_in[15];
  p.out = (float*)d_out;
  char* ws = (char*)d_ws; size_t off = 0;
  auto take = [&](size_t bytes) { char* q = ws + off; off += (bytes + 255) & ~(size_t)255; return q; };
  p.wt_in = (u16*)take((size_t)2 * 3072 * 1024 * 2);
  p.wt_out = (u16*)take((size_t)2 * 1024 * 1024 * 2);
  p.wt_up = (u16*)take((size_t)2 * 5632 * 1024 * 2);
  p.wt_down = (u16*)take((size_t)2 * 1024 * 2816 * 2);
  p.mod = (float*)take((size_t)2 * 2 * 6144 * 4);
  p.kmax = (unsigned*)take(256);
  (void)take(4096);
  p.h = (u16*)take((size_t)NTOK * 1024 * 2);
  p.o = (u16*)take((size_t)NTOK * 1024 * 2);
  p.proj = (u16*)take((size_t)NTOK * NPROJ * 2);
  p.act = p.proj;
  if (off > ws_size) { fprintf(stderr, "workspace too small: need %zu have %zu\n", off, ws_size); return; }
  p.lam_init[0] = 0.2f; p.lam_init[1] = 0.35550906759096934f;
  static int grid_blocks = 0;
  if (!grid_blocks) {
    int dev = 0, cus = 0, per_cu = 0;
    (void)hipGetDevice(&dev);
    (void)hipDeviceGetAttribute(&cus, hipDeviceAttributeMultiprocessorCount, dev);
    (void)hipOccupancyMaxActiveBlocksPerMultiprocessor(&per_cu, mega_kernel, NTHR, 0);
    if (per_cu > 1) per_cu = 1;
    if (per_cu < 1) per_cu = 1;
    grid_blocks = cus * per_cu;
  }
#if COOP
  p.ph_lo = 0; p.ph_hi = N_PHASES;
  void* args[] = {&p};
  hipError_t e = hipLaunchCooperativeKernel((void*)mega_kernel, dim3(grid_blocks), dim3(NTHR), args, 0, stream);
  if (e != hipSuccess) fprintf(stderr, "cooperative launch failed: %s (grid %d)\n", hipGetErrorString(e), grid_blocks);
#else
  for (int ph = 0; ph < N_PHASES; ++ph) {
    p.ph_lo = ph; p.ph_hi = ph + 1;
    hipLaunchKernelGGL(mega_kernel, dim3(grid_blocks), dim3(NTHR), 0, stream, p);
  }
#endif
}
```

```cpp
#include <hip/hip_runtime.h>
#include <hip/hip_cooperative_groups.h>
#include <cstdio>
#include <cstring>
namespace cg = cooperative_groups;

#ifndef COOP
#define COOP 1
#endif

#define DI __device__ __forceinline__
#define LAS __attribute__((address_space(3)))
typedef unsigned short u16;
using bf16x8 = __attribute__((ext_vector_type(8))) short;
using s16x4  = __attribute__((ext_vector_type(4))) short;
using f32x16 = __attribute__((ext_vector_type(16))) float;
using f32x4  = __attribute__((ext_vector_type(4))) float;
typedef __bf16 bf2_t __attribute__((ext_vector_type(2)));
typedef float f2_t __attribute__((ext_vector_type(2)));
#define MFMA32(a, b, c) __builtin_amdgcn_mfma_f32_32x32x16_bf16((a), (b), (c), 0, 0, 0)

constexpr int S = 16384, NTOK = 32768, DFF = 2816, NPROJ = 3072;
constexpr int NTHR = 512, NWAVE = 8;
constexpr float LOG2E = 1.4426950408889634f;
constexpr float QSCALE_DIFF = 0.25503486164919736f;
constexpr float QSCALE_64   = 0.18033688011112042f;
constexpr float NEGBIG = -1e30f;
constexpr int LDS_BYTES = 131072;

__device__ const float ROPE_INV16[16] = {
1.000000000e+00f, 5.623413324e-01f, 3.162277639e-01f, 1.778279394e-01f, 1.000000015e-01f, 5.623413250e-02f, 3.162277490e-02f, 1.778279431e-02f, 9.999999776e-03f, 5.623413250e-03f, 3.162277630e-03f, 1.778279431e-03f, 1.000000047e-03f, 5.623413017e-04f, 3.162277571e-04f, 1.778279402e-04f};
__device__ const float ROPE_INV32[32] = {
1.000000000e+00f, 7.498942018e-01f, 5.623413324e-01f, 4.216965139e-01f, 3.162277639e-01f, 2.371373773e-01f, 1.778279394e-01f, 1.333521456e-01f, 1.000000015e-01f, 7.498942316e-02f, 5.623413250e-02f, 4.216964915e-02f, 3.162277490e-02f, 2.371373773e-02f, 1.778279431e-02f, 1.333521400e-02f, 9.999999776e-03f, 7.498942316e-03f, 5.623413250e-03f, 4.216964822e-03f, 3.162277630e-03f, 2.371373819e-03f, 1.778279431e-03f, 1.333521446e-03f, 1.000000047e-03f, 7.498941850e-04f, 5.623413017e-04f, 4.216965172e-04f, 3.162277571e-04f, 2.371373703e-04f, 1.778279402e-04f, 1.333521504e-04f};

struct Params {
  const float *x, *c, *w_ada, *b_ada, *g_attn, *w_in, *diff_lambda, *diff_subln, *na_rpb, *w_out, *g_ffn, *w_up, *conv_w, *conv_b, *w_down, *g_final;
  float* out;
  u16 *wt_in, *wt_out, *wt_up, *wt_down;
  float* mod;
  unsigned* kmax;
  unsigned* bar;
  u16 *h, *o, *proj, *act;
  float lam_init[2];
  int ph_lo, ph_hi;
};

DI unsigned pack2(float a, float b) { f2_t v = {a, b}; return __builtin_bit_cast(unsigned, __builtin_convertvector(v, bf2_t)); }
DI float bf2f(u16 v) { return __uint_as_float(((unsigned)v) << 16); }
DI float bflo(unsigned v) { return __uint_as_float(v << 16); }
DI float bfhi(unsigned v) { return __uint_as_float(v & 0xffff0000u); }
DI int crow(int i, int hh) { return (i & 3) + 8 * (i >> 2) + 4 * hh; }
DI float exp2_hw(float x) { return __builtin_amdgcn_exp2f(x); }
DI int otid() { int t = threadIdx.x; asm volatile("" : "+v"(t)); return t; }


#define XB_TMO      128
#define XB_XCNT(j)  (256  + 64 * (j))
#define XB_XSUB(j)  (1280 + 64 * (j))
#define XB_XGEN(j)  (2304 + 64 * (j))
#define XB_TOP      3328
#define XB_TOPGEN   3392
#define XCD_BAR_WORDS 3456
#define XB_SPIN_CAP (1u << 21)
DI unsigned xb_ld(unsigned* p)              { return __hip_atomic_load(p, __ATOMIC_RELAXED, __HIP_MEMORY_SCOPE_AGENT); }
DI unsigned xb_add(unsigned* p, unsigned v) { return __hip_atomic_fetch_add(p, v, __ATOMIC_RELAXED, __HIP_MEMORY_SCOPE_AGENT); }
DI unsigned xb_xcc_id() { return (unsigned)__builtin_amdgcn_s_getreg((3 << 11) | 20) & 0xFu; }
#define XB_SPIN(cond, bar) do { unsigned _sp = 0; while (cond) { __builtin_amdgcn_s_sleep(1); \
    if ((++_sp & 255u) == 0u) { if (xb_ld(&(bar)[XB_TMO])) break; if (_sp > XB_SPIN_CAP) { atomicAdd(&(bar)[XB_TMO], 1u); break; } } } } while (0)
struct XcdBarrier { unsigned* bar; unsigned x; volatile LAS unsigned* st; };
DI XcdBarrier xcd_barrier_post(unsigned* bar, volatile LAS unsigned* st) {
  XcdBarrier b; b.bar = bar; b.x = xb_xcc_id(); b.st = st;
  if (threadIdx.x == 0) (void)xb_add(&bar[XB_XCNT(b.x)], 1u);
  return b;
}
DI void xcd_barrier_complete(unsigned* bar, unsigned x, unsigned& nloc, unsigned& nx) {
  const unsigned G = gridDim.x * gridDim.y * gridDim.z;
  unsigned sum, cnt, mine, sp = 0u;
  for (;;) {
    sum = 0u; cnt = 0u; mine = 0u;
#pragma unroll
    for (unsigned j = 0; j < 16; ++j) { const unsigned c = xb_ld(&bar[XB_XCNT(j)]); sum += c; cnt += (c > 0u) ? 1u : 0u; mine = (j == x) ? c : mine; }
    if (sum == G) break;
    __builtin_amdgcn_s_sleep(1);
    if ((++sp & 255u) == 0u) { if (xb_ld(&bar[XB_TMO])) break; if (sp > XB_SPIN_CAP) { atomicAdd(&bar[XB_TMO], 1u); break; } }
  }
  nloc = mine > 0u ? mine : 1u; nx = cnt > 0u ? cnt : 1u;
}
DI void xcd_barrier(const XcdBarrier& b) {
  asm volatile("s_waitcnt vmcnt(0)" ::: "memory");
  __syncthreads();
  if (threadIdx.x == 0) {
    unsigned* bar = b.bar;
    __builtin_amdgcn_s_waitcnt(0);
    unsigned nloc = b.st[0], nx = b.st[1];
    if (nloc == 0u) { xcd_barrier_complete(bar, b.x, nloc, nx); b.st[0] = nloc; b.st[1] = nx; }
    const unsigned old = xb_add(&bar[XB_XSUB(b.x)], 1u);
    const unsigned gen = old / nloc;
    if (old + 1u == (gen + 1u) * nloc) {
      __builtin_amdgcn_fence(__ATOMIC_RELEASE, "agent");
      asm volatile("s_waitcnt vmcnt(0)" ::: "memory");
      const unsigned og = xb_add(&bar[XB_TOP], 1u);
      const unsigned tg = og / nx;
      if (og + 1u == (tg + 1u) * nx) xb_add(&bar[XB_TOPGEN], 1u);
      else XB_SPIN(xb_ld(&bar[XB_TOPGEN]) == tg, bar);
      __builtin_amdgcn_fence(__ATOMIC_ACQUIRE, "agent");
      xb_add(&bar[XB_XGEN(b.x)], 1u);
      asm volatile("s_waitcnt vmcnt(0)" ::: "memory");
    } else {
      XB_SPIN(xb_ld(&bar[XB_XGEN(b.x)]) == gen, bar);
      __builtin_amdgcn_fence(__ATOMIC_ACQUIRE, "agent");
      asm volatile("s_waitcnt vmcnt(0)" ::: "memory");
    }
  }
  __syncthreads();
}

DI int wmap_in(int np) {
  if (np >= 768 && np < 1536) { const int hb = np & ~63, w = np & 63, g = w >> 5, n = (w >> 4) & 1, i = w & 15; return hb + 16 * g + i + 32 * n; }
  return np;
}
DI int wmap_up(int np) {
  const int pn = np >> 8, w = np & 255, bj = w >> 7, q = w & 127;
  return bj ? (DFF + 128 * pn + q) : (128 * pn + q);
}

DI void phase_prep(const Params& p, float* smf) {
  const int tid = otid();
  if (blockIdx.x == 0 && tid < 64) p.kmax[tid] = 0u;
  constexpr int N_ADA = 192;
  constexpr int T_IN = 16 * 24, T_OUT = 16 * 8, T_UP = 16 * 44, T_DOWN = 44 * 8;
  constexpr int T_LAYER = T_IN + T_OUT + T_UP + T_DOWN;
  const int total = N_ADA + 2 * T_LAYER;
  for (int it = blockIdx.x; it < total; it += gridDim.x) {
    if (it < N_ADA) {
      const int l = it / 96, cgp = it % 96;
      float* sc = smf;
      float* red = smf + 2048;
      for (int i = tid; i < 2048; i += NTHR) { float v = p.c[i]; sc[i] = v / (1.f + __expf(-v)); }
      __syncthreads();
      const int kq = tid >> 6, cc = tid & 63, col = cgp * 64 + cc;
      const float* wp = p.w_ada + ((size_t)l * 1024 + kq * 128) * 6144 + col;
      float a0 = 0.f, a1 = 0.f;
#pragma unroll 8
      for (int k = 0; k < 128; ++k) { float w = wp[(size_t)k * 6144]; a0 += sc[kq * 128 + k] * w; a1 += sc[1024 + kq * 128 + k] * w; }
      red[(kq * 2 + 0) * 64 + cc] = a0; red[(kq * 2 + 1) * 64 + cc] = a1;
      __syncthreads();
      if (tid < 128) {
        const int b = tid >> 6, c2 = tid & 63;
        float s = 0.f;
#pragma unroll
        for (int q = 0; q < 8; ++q) s += red[(q * 2 + b) * 64 + c2];
        p.mod[(l * 2 + b) * 6144 + cgp * 64 + c2] = s + p.b_ada[l * 6144 + cgp * 64 + c2];
      }
    } else {
      int idx = it - N_ADA; const int l = idx / T_LAYER; int j = idx % T_LAYER;
      const float* W; u16* dst; int Kd, N, tk, tn, kind;
      if (j < T_IN) { W = p.w_in + (size_t)l * 1024 * 3072; dst = p.wt_in + (size_t)l * 3072 * 1024; Kd = 1024; N = 3072; tk = j / 24; tn = j % 24; kind = 0; }
      else if (j < T_IN + T_OUT) { j -= T_IN; W = p.w_out + (size_t)l * 1024 * 1024; dst = p.wt_out + (size_t)l * 1024 * 1024; Kd = 1024; N = 1024; tk = j / 8; tn = j % 8; kind = 1; }
      else if (j < T_IN + T_OUT + T_UP) { j -= T_IN + T_OUT; W = p.w_up + (size_t)l * 1024 * 5632; dst = p.wt_up + (size_t)l * 5632 * 1024; Kd = 1024; N = 5632; tk = j / 44; tn = j % 44; kind = 2; }
      else { j -= T_IN + T_OUT + T_UP; W = p.w_down + (size_t)l * 2816 * 1024; dst = p.wt_down + (size_t)l * 1024 * 2816; Kd = 2816; N = 1024; tk = j / 8; tn = j % 8; kind = 3; }
      const int hb = tid >> 8, t = tid & 255;
      const int k0 = tk * 64, n0 = (tn * 2 + hb) * 64;
      float* tile = smf + hb * (64 * 65);
      const int nn = t & 63;
      const int np = n0 + nn;
      const int srccol = (kind == 0) ? wmap_in(np) : (kind == 2) ? wmap_up(np) : np;
#pragma unroll 4
      for (int i = 0; i < 16; ++i) { const int kk = i * 4 + (t >> 6); tile[kk * 65 + nn] = W[(size_t)(k0 + kk) * N + srccol]; }
      __syncthreads();
      const int nrow = t >> 2, kc = (t & 3) * 16;
      unsigned pk[8];
#pragma unroll
      for (int q = 0; q < 8; ++q) pk[q] = pack2(tile[(kc + 2 * q) * 65 + nrow], tile[(kc + 2 * q + 1) * 65 + nrow]);
      uint4* dp = (uint4*)(dst + (size_t)(n0 + nrow) * Kd + k0 + kc);
      dp[0] = make_uint4(pk[0], pk[1], pk[2], pk[3]);
      dp[1] = make_uint4(pk[4], pk[5], pk[6], pk[7]);
    }
    __syncthreads();
  }
}

DI float wave_sum(float v) {
#pragma unroll
  for (int o = 32; o >= 1; o >>= 1) v += __shfl_xor(v, o);
  return v;
}

template <int MODE>
DI void phase_norm(const float* xin, const float* g, const float* modl, int sh_off, int sc_off, u16* hout, float* fout) {
  const int tid = otid(); const int lane = tid & 63, w = tid >> 6;
  for (int row = blockIdx.x * NWAVE + w; row < NTOK; row += gridDim.x * NWAVE) {
    const int b = row >> 14;
    const float4* xr = (const float4*)(xin + (size_t)row * 1024);
    float4 v[4];
#pragma unroll
    for (int i = 0; i < 4; ++i) v[i] = xr[lane + i * 64];
    float ss = 0.f;
#pragma unroll
    for (int i = 0; i < 4; ++i) ss += v[i].x * v[i].x + v[i].y * v[i].y + v[i].z * v[i].z + v[i].w * v[i].w;
    ss = wave_sum(ss);
    const float inv = rsqrtf(ss * (1.f / 1024.f) + 1e-6f);
#pragma unroll
    for (int i = 0; i < 4; ++i) {
      const int col = (lane + i * 64) * 4;
      const float4 g4 = *(const float4*)(g + col);
      if (MODE == 0) {
        const float4 sc4 = *(const float4*)(modl + b * 6144 + sc_off + col);
        const float4 sh4 = *(const float4*)(modl + b * 6144 + sh_off + col);
        float y0 = v[i].x * inv * g4.x * (1.f + sc4.x) + sh4.x;
        float y1 = v[i].y * inv * g4.y * (1.f + sc4.y) + sh4.y;
        float y2 = v[i].z * inv * g4.z * (1.f + sc4.z) + sh4.z;
        float y3 = v[i].w * inv * g4.w * (1.f + sc4.w) + sh4.w;
        *(uint2*)(hout + (size_t)row * 1024 + col) = make_uint2(pack2(y0, y1), pack2(y2, y3));
      } else {
        float4 y; y.x = v[i].x * inv * g4.x; y.y = v[i].y * inv * g4.y; y.z = v[i].z * inv * g4.z; y.w = v[i].w * inv * g4.w;
        *(float4*)(fout + (size_t)row * 1024 + col) = y;
      }
    }
  }
}

namespace pg8 {
constexpr int BM = 256, BK = 64, HALF = 128, HTB = HALF * BK * 2, NXCD = 8, WGM = 8;
DI int lds_byte(int r, int c) { const int st = (r >> 4) * 2 + (c >> 5), rr = r & 15, cc = c & 31, ob = rr * 64 + cc * 2; return st * 1024 + (ob ^ (((ob >> 9) & 1) << 5)); }
DI void stage_rc(int b, int& R, int& C) { const int st = b / 1024, sb = b % 1024, swz = sb ^ (((sb >> 9) & 1) << 5); R = (st >> 1) * 16 + swz / 64; C = (st & 1) * 32 + (swz % 64) / 2; }
struct Unit { int pm, pn; };
struct StaticOrder {
  int nM, nN, nwg, G, c;
  DI void init(int nM_, int nN_, int G_, int c_) { nM = nM_; nN = nN_; nwg = nM * nN; G = G_; c = c_; }
  DI bool next(int i, Unit& u) const {
    const long L = (long)i * G + c; if (L >= nwg) return false;
    int wgid = (int)L; { const int q = nwg / NXCD, r = nwg % NXCD, xcd = wgid % NXCD, off = wgid / NXCD; wgid = (xcd < r ? xcd * (q + 1) : r * (q + 1) + (xcd - r) * q) + off; }
    const int nig = WGM * nN, gid = wgid / nig, fm = gid * WGM, gsz = (nM - fm) < WGM ? (nM - fm) : WGM;
    u.pm = fm + ((wgid % nig) % gsz); u.pn = (wgid % nig) / gsz; return true;
  }
};
struct AMapPlain { static constexpr int HALF_ROWS = 128; static DI int row(int R) { return R; } static DI long tile_row0(int pm) { return (long)pm * 256; } };
struct AMapHalo  { static constexpr int HALF_ROWS = 124; static DI int row(int R) { return 62 * (R >> 6) + (R & 63); } static DI long tile_row0(int pm) { const int b = pm / 67, ti = pm % 67; return (long)b * S + 248 * ti - 1; } };

template <class AMap, class Epi>
DI void gemm_phase(LAS unsigned char* lds, const u16* Aptr, const u16* Btptr, int K, const StaticOrder& SO, const Epi& E) {
  const int tid = otid(), wid = __builtin_amdgcn_readfirstlane(tid >> 6), lane = tid & 63, wr = wid >> 2, wc = wid & 3, fr = lane & 15, fq = lane >> 4;
  const int nt = K / BK;
  unsigned voffA[2], voffB[2];
#pragma unroll
  for (int i = 0; i < 2; ++i) { int R, C; stage_rc(tid * 16 + i * 8192, R, C);
    voffA[i] = (unsigned)(AMap::row(R) * K + C) * 2u; voffB[i] = (unsigned)(R * K + C) * 2u; }
  const size_t kstep = (size_t)(BK * 2);
  const size_t hstepA = (size_t)AMap::HALF_ROWS * K * 2, hstepB = (size_t)HALF * K * 2;
  const size_t tstepB = 2 * hstepB;
  const size_t rowB = (size_t)K * 2;
  const unsigned ldsw = (unsigned)wid * 1024u;
  const int aoff = lds_byte(wr * 64 + fr, fq * 8), boff = lds_byte(wc * 32 + fr, fq * 8);
#define PG8_SA(b, h) (((b) * 2 + (h)) * HTB)
#define PG8_SB(b, h) ((4 + (b) * 2 + (h)) * HTB)
#define PG8_STAGE(bufoff, gbase, voff) do { _Pragma("unroll") for (int _i = 0; _i < 2; ++_i) \
        __builtin_amdgcn_global_load_lds((const unsigned*)((const char*)(gbase) + (voff)[_i]), (LAS unsigned*)(lds + (bufoff) + ldsw + _i * 8192), 16, 0, 0); } while (0)
#define PG8_LDA(dst, b, h) do { _Pragma("unroll") for (int m = 0; m < 4; ++m) _Pragma("unroll") for (int k = 0; k < 2; ++k) dst[m][k] = *(const LAS bf16x8*)(lds + PG8_SA(b, h) + aoff + m * 2048 + k * 1024); } while (0)
#define PG8_LDB(dst, b, h) do { _Pragma("unroll") for (int n = 0; n < 2; ++n) _Pragma("unroll") for (int k = 0; k < 2; ++k) dst[n][k] = *(const LAS bf16x8*)(lds + PG8_SB(b, h) + boff + n * 2048 + k * 1024); } while (0)
#define PG8_MMA(ai, bj, At, Bt) do { __builtin_amdgcn_s_setprio(1); _Pragma("unroll") for (int m = 0; m < 4; ++m) _Pragma("unroll") for (int n = 0; n < 2; ++n) _Pragma("unroll") for (int k = 0; k < 2; ++k) \
        acc[ai][bj][m][n] = __builtin_amdgcn_mfma_f32_16x16x32_bf16(Bt[n][k], At[m][k], acc[ai][bj][m][n], 0, 0, 0); __builtin_amdgcn_s_setprio(0); } while (0)
#define PG8_WAIT_V(n) asm volatile("s_waitcnt vmcnt(" #n ")" ::: "memory")
#define PG8_WAIT_L(n) asm volatile("s_waitcnt lgkmcnt(" #n ")" ::: "memory")
#define PG8_BAR __builtin_amdgcn_s_barrier()
#define PG8_SCHED __builtin_amdgcn_sched_barrier(0)
  Unit cur, nxt; int ui = 0;
  if (!SO.next(0, cur)) return;
  f32x4 acc[2][2][4][2];
#pragma unroll
  for (int a = 0; a < 2; ++a)
#pragma unroll
    for (int b = 0; b < 2; ++b)
#pragma unroll
      for (int m = 0; m < 4; ++m)
#pragma unroll
        for (int n = 0; n < 2; ++n) acc[a][b][m][n] = (f32x4){0.f, 0.f, 0.f, 0.f};
  bf16x8 At[4][2], B0[2][2], B1[2][2];
  const char* cA = (const char*)Aptr + AMap::tile_row0(cur.pm) * (long)rowB; const char* cB = (const char*)Btptr + (size_t)cur.pn * tstepB;
  PG8_STAGE(PG8_SB(0, 0), cB, voffB); PG8_STAGE(PG8_SA(0, 0), cA, voffA); PG8_STAGE(PG8_SB(0, 1), cB + hstepB, voffB); PG8_STAGE(PG8_SA(0, 1), cA + hstepA, voffA);
  if (wr == 1) PG8_BAR;
  PG8_WAIT_V(4); PG8_BAR;
  PG8_STAGE(PG8_SB(1, 0), cB + kstep, voffB); PG8_STAGE(PG8_SA(1, 0), cA + kstep, voffA); PG8_STAGE(PG8_SB(1, 1), cB + hstepB + kstep, voffB);
  PG8_WAIT_V(6); PG8_BAR;
  for (;;) {
    const bool has_next = SO.next(ui + 1, nxt);
    const char* nA = has_next ? (const char*)Aptr + AMap::tile_row0(nxt.pm) * (long)rowB : cA; const char* nB = has_next ? (const char*)Btptr + (size_t)nxt.pn * tstepB : cB;
    for (int t = 0; t < nt; t += 2) {
      const bool last = (t == nt - 2);
      const char* a1 = cA + (size_t)(t + 1) * kstep;
      const char* a2 = last ? nA : cA + (size_t)(t + 2) * kstep; const char* b2 = last ? nB : cB + (size_t)(t + 2) * kstep;
      const char* a3 = a2 + kstep; const char* b3 = b2 + kstep;
      PG8_LDB(B0, 0, 0); PG8_SCHED; PG8_LDA(At, 0, 0); PG8_STAGE(PG8_SA(1, 1), a1 + hstepA, voffA);
      PG8_WAIT_L(8); PG8_BAR; PG8_WAIT_L(0); PG8_MMA(0, 0, At, B0); PG8_BAR; PG8_SCHED;
      PG8_LDB(B1, 0, 1); PG8_STAGE(PG8_SB(0, 0), b2, voffB);
      PG8_BAR; PG8_WAIT_L(0); PG8_MMA(0, 1, At, B1); PG8_BAR;
      PG8_LDA(At, 0, 1); PG8_STAGE(PG8_SA(0, 0), a2, voffA);
      PG8_BAR; PG8_WAIT_L(0); PG8_MMA(1, 0, At, B0); PG8_BAR; PG8_SCHED;
      PG8_STAGE(PG8_SB(0, 1), b2 + hstepB, voffB);
      PG8_WAIT_V(6); PG8_BAR; PG8_MMA(1, 1, At, B1); PG8_BAR;
      PG8_LDB(B0, 1, 0); PG8_SCHED; PG8_LDA(At, 1, 0); PG8_STAGE(PG8_SA(0, 1), a2 + hstepA, voffA);
      PG8_WAIT_L(8); PG8_BAR; PG8_WAIT_L(0); PG8_MMA(0, 0, At, B0); PG8_BAR; PG8_SCHED;
      PG8_LDB(B1, 1, 1); PG8_STAGE(PG8_SB(1, 0), b3, voffB);
      PG8_BAR; PG8_WAIT_L(0); PG8_MMA(0, 1, At, B1); PG8_BAR;
      PG8_LDA(At, 1, 1); PG8_STAGE(PG8_SA(1, 0), a3, voffA);
      PG8_BAR; PG8_WAIT_L(0); PG8_MMA(1, 0, At, B0); PG8_BAR; PG8_SCHED;
      PG8_STAGE(PG8_SB(1, 1), b3 + hstepB, voffB);
      PG8_WAIT_V(6); PG8_BAR; PG8_MMA(1, 1, At, B1); PG8_BAR;
    }
    E(acc, cur, wr, wc, fr, fq);
    if (!has_next) break;
#pragma unroll
    for (int a = 0; a < 2; ++a)
#pragma unroll
      for (int b = 0; b < 2; ++b)
#pragma unroll
        for (int m = 0; m < 4; ++m)
#pragma unroll
          for (int n = 0; n < 2; ++n) acc[a][b][m][n] = (f32x4){0.f, 0.f, 0.f, 0.f};
    cur = nxt; cA = nA; cB = nB; ++ui;
  }
  PG8_WAIT_V(0);
  if (wr == 0) PG8_BAR;
  PG8_BAR;
#undef PG8_SA
#undef PG8_SB
#undef PG8_STAGE
#undef PG8_LDA
#undef PG8_LDB
#undef PG8_MMA
#undef PG8_WAIT_V
#undef PG8_WAIT_L
#undef PG8_BAR
#undef PG8_SCHED
}
}

DI void sincos_big(float ang, float& sn, float& cs) {
  const float c_hi = 1.591549367e-01f, c_lo = 6.420638243e-09f;
  const float rh = ang * c_hi;
  const float e = __builtin_fmaf(ang, c_hi, -rh);
  const float fr = rh - floorf(rh);
  const float rev = fr + (e + ang * c_lo);
  sn = __builtin_amdgcn_sinf(rev);
  cs = __builtin_amdgcn_cosf(rev);
}

struct EpiProj {
  u16* proj;
  DI void operator()(const f32x4 (&acc)[2][2][4][2], const pg8::Unit& u, int wr, int wc, int fr, int fq) const {
    const f32x4 i16 = *(const f32x4*)(ROPE_INV16 + 4 * fq);
    const f32x4 i32v = *(const f32x4*)(ROPE_INV32 + 16 * (wc & 1) + 4 * fq);
#pragma unroll
    for (int bj = 0; bj < 2; ++bj) {
      const int gcol0 = u.pn * 256 + bj * 128 + wc * 32;
      int mode; float scale = 1.f;
      if (gcol0 < 256) { mode = 1; scale = QSCALE_DIFF; }
      else if (gcol0 < 512) { mode = 1; }
      else if (gcol0 < 768) { mode = 0; }
      else if (gcol0 < 1152) { mode = 2; scale = QSCALE_64; }
      else if (gcol0 < 1536) { mode = 2; }
      else if (gcol0 < 1920) { mode = 0; }
      else if (gcol0 < 2304) { mode = 0; scale = QSCALE_64; }
      else { mode = 0; }
      f32x4 invv;
#pragma unroll
      for (int e = 0; e < 4; ++e) invv[e] = (mode == 1) ? i16[e] : i32v[e];
      int c1, c2;
      if (mode == 2) { const int hb = gcol0 & ~63, g = wc & 1; c1 = hb + 16 * g + 4 * fq; c2 = c1 + 32; }
      else { c1 = gcol0 + 4 * fq; c2 = c1 + 16; }
#pragma unroll
      for (int ai = 0; ai < 2; ++ai)
#pragma unroll
        for (int m = 0; m < 4; ++m) {
          const int row = u.pm * 256 + ai * 128 + wr * 64 + m * 16 + fr;
          f32x4 x1 = acc[ai][bj][m][0], x2 = acc[ai][bj][m][1];
          if (mode != 0) {
            const float pos = (float)(row & (S - 1));
#pragma unroll
            for (int e = 0; e < 4; ++e) {
              const float ang = __fmul_rn(pos, invv[e]);
              float sn, cs; sincos_big(ang, sn, cs);
              const float y1 = x1[e] * cs - x2[e] * sn, y2 = x2[e] * cs + x1[e] * sn;
              x1[e] = y1; x2[e] = y2;
            }
          }
          u16* dp = proj + (size_t)row * NPROJ;
          *(uint2*)(dp + c1) = make_uint2(pack2(x1[0] * scale, x1[1] * scale), pack2(x1[2] * scale, x1[3] * scale));
          *(uint2*)(dp + c2) = make_uint2(pack2(x2[0] * scale, x2[1] * scale), pack2(x2[2] * scale, x2[3] * scale));
        }
    }
  }
};

struct EpiResid {
  const float* xold; float* xnew; const float* gate;
  DI void operator()(const f32x4 (&acc)[2][2][4][2], const pg8::Unit& u, int wr, int wc, int fr, int fq) const {
    const int b = (u.pm * 256) >> 14;
    const int col0 = u.pn * 256 + wc * 32 + 4 * fq;
    f32x4 gv[2][2];
#pragma unroll
    for (int bj = 0; bj < 2; ++bj)
#pragma unroll
      for (int n = 0; n < 2; ++n) gv[bj][n] = *(const f32x4*)(gate + b * 6144 + col0 + bj * 128 + n * 16);
#pragma unroll
    for (int ai = 0; ai < 2; ++ai)
#pragma unroll
      for (int m = 0; m < 4; ++m) {
        const size_t off = (size_t)(u.pm * 256 + ai * 128 + wr * 64 + m * 16 + fr) * 1024 + col0;
        f32x4 xo[2][2];
#pragma unroll
        for (int bj = 0; bj < 2; ++bj)
#pragma unroll
          for (int n = 0; n < 2; ++n) xo[bj][n] = *(const f32x4*)(xold + off + bj * 128 + n * 16);
#pragma unroll
        for (int bj = 0; bj < 2; ++bj)
#pragma unroll
          for (int n = 0; n < 2; ++n) *(f32x4*)(xnew + off + bj * 128 + n * 16) = xo[bj][n] + gv[bj][n] * acc[ai][bj][m][n];
        asm volatile("" ::: "memory");
      }
  }
};

DI float dpp_ror1(float v)  { return __builtin_bit_cast(float, __builtin_amdgcn_update_dpp(0, __builtin_bit_cast(int, v), 0x121, 0xf, 0xf, false)); }
DI float dpp_ror15(float v) { return __builtin_bit_cast(float, __builtin_amdgcn_update_dpp(0, __builtin_bit_cast(int, v), 0x12F, 0xf, 0xf, false)); }
struct EpiUp {
  u16* act; const float* cw; const float* cb;
  DI void operator()(const f32x4 (&acc)[2][2][4][2], const pg8::Unit& u, int wr, int wc, int fr, int fq) const {
    const int b = u.pm / 67, ti = u.pm % 67;
#pragma unroll
    for (int n = 0; n < 2; ++n) {
      const int col = u.pn * 128 + wc * 32 + n * 16 + 4 * fq;
      const f32x4 w0 = *(const f32x4*)(cw + col), w1 = *(const f32x4*)(cw + DFF + col), w2 = *(const f32x4*)(cw + 2 * DFF + col), bb = *(const f32x4*)(cb + col);
#pragma unroll
      for (int ai = 0; ai < 2; ++ai) {
        const int tokb = 248 * ti - 1 + 62 * (2 * ai + wr);
        f32x4 g[4];
#pragma unroll
        for (int m = 0; m < 4; ++m) {
          const int tok = tokb + 16 * m + fr;
          const bool ok = (tok >= 0) && (tok < S);
#pragma unroll
          for (int e = 0; e < 4; ++e) g[m][e] = ok ? acc[ai][0][m][n][e] : 0.f;
        }
#pragma unroll
        for (int m = 0; m < 4; ++m) {
          const int q = 16 * m + fr, tok = tokb + q;
          f32x4 r;
#pragma unroll
          for (int e = 0; e < 4; ++e) {
            const float srcm = (fr == 15 && m > 0) ? g[m > 0 ? m - 1 : 0][e] : g[m][e];
            const float srcp = (fr == 0 && m < 3) ? g[m < 3 ? m + 1 : 3][e] : g[m][e];
            const float gm = dpp_ror1(srcm), gp = dpp_ror15(srcp);
            const float cv = bb[e] + w0[e] * gm + w1[e] * g[m][e] + w2[e] * gp;
            r[e] = cv / (1.f + __expf(-cv)) * acc[ai][1][m][n][e];
          }
          if (q >= 1 && q <= 62 && tok < S)
            *(uint2*)(act + (size_t)(b * S + tok) * DFF + col) = make_uint2(pack2(r[0], r[1]), pack2(r[2], r[3]));
        }
      }
    }
  }
};

constexpr int VT_STRIDE = 36;
constexpr int VT_WAVE = 2 * 64 * VT_STRIDE;

template <int MODE>
DI void local_attn_item(const Params& p, int layer, int item, u16* sm) {
  const int tid = otid(), lane = tid & 63, w = tid >> 6, r = lane & 31, hh = lane >> 5;
  u16* Vt = sm + w * VT_WAVE;
  const int unit = item * NWAVE + w;
  const int b = unit / (6 * 512), rem = unit % (6 * 512), head = rem / 512, u = rem % 512;
  const u16* prow = p.proj + (size_t)b * S * NPROJ;
  int tq, qcol, kcol, vcol, nblk, ocol;
  int t0 = 0, rr = 0, half = 0, row_start = 0;
  if (MODE == 0) {
    const int res = u & 15, chunk = u >> 4;
    t0 = res + 512 * chunk; tq = t0 + 16 * r;
    qcol = 768 + head * 64; kcol = 1152 + head * 64; vcol = 1536 + head * 64; nblk = 33; ocol = 256 + head * 64;
  } else {
    rr = u >> 1; half = u & 1; tq = rr * 64 + half * 32 + r;
    row_start = rr - 4; row_start = row_start < 0 ? 0 : (row_start > 248 ? 248 : row_start);
    qcol = 1920 + head * 64; kcol = 2304 + head * 64; vcol = 2688 + head * 64; nblk = 16; ocol = 640 + head * 64;
  }
  const float* rpb = p.na_rpb + ((size_t)layer * 6 + head) * 15 * 31;
  bf16x8 qf[4];
#pragma unroll
  for (int s = 0; s < 4; ++s) qf[s] = *(const bf16x8*)(prow + (size_t)tq * NPROJ + qcol + s * 16 + 8 * hh);

  auto geom = [&](int kbi, int& kbase, int& kstride, int& lim) {
    if (MODE == 0) {
      if (kbi < 20) { kstride = 1; kbase = t0 - 64 + kbi * 32; lim = 64; }
      else if (kbi < 28) { kstride = 4; kbase = t0 - 256 + 4 * (kbi - 20) * 32; lim = 256; }
      else { kstride = 16; kbase = t0 - 1024 + 16 * (kbi - 28) * 32; lim = 1024; }
    } else {
      kstride = 1; kbase = (row_start + (kbi >> 1)) * 64 + (kbi & 1) * 32; lim = 0;
    }
  };
  bf16x8 kf[4]; uint4 vr[4];
  auto load_blk = [&](int kbi) {
    int kbase, kstride, lim; geom(kbi, kbase, kstride, lim);
    int kt = kbase + kstride * r; kt = kt < 0 ? 0 : (kt > S - 1 ? S - 1 : kt);
#pragma unroll
    for (int s = 0; s < 4; ++s) kf[s] = *(const bf16x8*)(prow + (size_t)kt * NPROJ + kcol + s * 16 + 8 * hh);
#pragma unroll
    for (int i = 0; i < 4; ++i) {
      const int id = lane + i * 64, key = id >> 3, ch = id & 7;
      int vt = kbase + kstride * key; vt = vt < 0 ? 0 : (vt > S - 1 ? S - 1 : vt);
      vr[i] = *(const uint4*)(prow + (size_t)vt * NPROJ + vcol + ch * 8);
    }
  };
  f32x16 O[2];
#pragma unroll
  for (int mb = 0; mb < 2; ++mb)
#pragma unroll
    for (int i = 0; i < 16; ++i) O[mb][i] = 0.f;
  float m_run = NEGBIG, l_run = 0.f;
  load_blk(0);
  for (int kbi = 0; kbi < nblk; ++kbi) {
    u16* Vb = Vt + (kbi & 1) * 64 * VT_STRIDE;
#pragma unroll
    for (int i = 0; i < 4; ++i) {
      const int id = lane + i * 64, key = id >> 3, ch = id & 7;
      const unsigned e[4] = {vr[i].x, vr[i].y, vr[i].z, vr[i].w};
#pragma unroll
      for (int q = 0; q < 4; ++q) {
        Vb[(ch * 8 + 2 * q) * VT_STRIDE + key] = (u16)(e[q] & 0xffffu);
        Vb[(ch * 8 + 2 * q + 1) * VT_STRIDE + key] = (u16)(e[q] >> 16);
      }
    }
    f32x16 Sc;
#pragma unroll
    for (int i = 0; i < 16; ++i) Sc[i] = 0.f;
#pragma unroll
    for (int s = 0; s < 4; ++s) Sc = MFMA32(kf[s], qf[s], Sc);
    int kbase, kstride, lim; geom(kbi, kbase, kstride, lim);
    if (kbi + 1 < nblk) load_blk(kbi + 1);
    float sv[16]; bool vd[16]; float tmax = NEGBIG;
#pragma unroll
    for (int i = 0; i < 16; ++i) {
      const int kk = crow(i, hh);
      const int kt = kbase + kstride * kk;
      bool valid; float s = Sc[i];
      if (MODE == 0) {
        int dq = kt - tq; dq = dq < 0 ? -dq : dq;
        valid = (kt >= 0) && (kt < S) && (dq <= lim);
      } else {
        const int kc = kt & 63, krow = kt >> 6, qc = half * 32 + r;
        int cs = qc - 8; cs = cs < 0 ? 0 : (cs > 48 ? 48 : cs);
        valid = (kc >= cs) && (kc < cs + 16);
        int dc = kc - qc; dc = dc < -15 ? -15 : (dc > 15 ? 15 : dc);
        const float bias = rpb[(krow - rr + 7) * 31 + dc + 15];
        s += bias * LOG2E;
      }
      vd[i] = valid; sv[i] = valid ? s : NEGBIG; tmax = fmaxf(tmax, sv[i]);
    }
    tmax = fmaxf(tmax, __shfl_xor(tmax, 32));
    const float m_new = fmaxf(m_run, tmax);
    const float alpha = exp2_hw(m_run - m_new);
    m_run = m_new; l_run *= alpha;
#pragma unroll
    for (int mb = 0; mb < 2; ++mb)
#pragma unroll
      for (int i = 0; i < 16; ++i) O[mb][i] *= alpha;
    float pv[16];
#pragma unroll
    for (int i = 0; i < 16; ++i) { pv[i] = vd[i] ? exp2_hw(sv[i] - m_new) : 0.f; l_run += pv[i]; }
    bf16x8 pk[2];
#pragma unroll
    for (int sp = 0; sp < 2; ++sp) {
      unsigned q4[4];
#pragma unroll
      for (int q = 0; q < 4; ++q) q4[q] = pack2(pv[8 * sp + 2 * q], pv[8 * sp + 2 * q + 1]);
      pk[sp] = __builtin_bit_cast(bf16x8, make_uint4(q4[0], q4[1], q4[2], q4[3]));
    }
    __syncthreads();
#pragma unroll
    for (int sp = 0; sp < 2; ++sp)
#pragma unroll
      for (int mb = 0; mb < 2; ++mb) {
        const u16* vp = Vb + (mb * 32 + r) * VT_STRIDE + 16 * sp + 4 * hh;
        const s16x4 lo = *(const s16x4*)vp, hi = *(const s16x4*)(vp + 8);
        const bf16x8 vf = __builtin_shufflevector(lo, hi, 0, 1, 2, 3, 4, 5, 6, 7);
        O[mb] = MFMA32(vf, pk[sp], O[mb]);
      }
  }
  const float l = l_run + __shfl_xor(l_run, 32);
  const float il = 1.f / l;
  u16* op = p.o + (size_t)(b * S + tq) * 1024 + ocol;
#pragma unroll
  for (int mb = 0; mb < 2; ++mb)
#pragma unroll
    for (int g = 0; g < 4; ++g) {
      const int d = mb * 32 + 8 * g + 4 * hh;
      *(uint2*)(op + d) = make_uint2(pack2(O[mb][4 * g] * il, O[mb][4 * g + 1] * il), pack2(O[mb][4 * g + 2] * il, O[mb][4 * g + 3] * il));
    }
  __syncthreads();
}

DI void kmax_item(const Params& p, int layer, int kidx) {
  const int tid = otid(); const int gid = kidx * NTHR + tid;
  const int row = gid >> 2, head = gid & 3, b = row >> 14;
  const uint4* kp = (const uint4*)(p.proj + (size_t)row * NPROJ + 256 + head * 64);
  float n0 = 0.f, n1 = 0.f;
#pragma unroll
  for (int c = 0; c < 8; ++c) {
    const uint4 v = kp[c];
    const unsigned e[4] = {v.x, v.y, v.z, v.w};
    float s = 0.f;
#pragma unroll
    for (int q = 0; q < 4; ++q) { const float a = bflo(e[q]), bq = bfhi(e[q]); s += a * a + bq * bq; }
    if (c >= 4) n1 += s; else n0 += s;
  }
#pragma unroll
  for (int o = 4; o <= 32; o <<= 1) { n0 = fmaxf(n0, __shfl_xor(n0, o)); n1 = fmaxf(n1, __shfl_xor(n1, o)); }
  if ((tid & 63) < 4) {
    unsigned* km = p.kmax + layer * 16 + (b * 4 + head) * 2;
    atomicMax(km, __float_as_uint(n0)); atomicMax(km + 1, __float_as_uint(n1));
  }
}

DI void phase_local(const Params& p, int layer, u16* sm) {
  constexpr int N_DIL = 768, N_NA = 768, N_KM = 256;
  for (int it = blockIdx.x; it < N_DIL + N_NA + N_KM; it += gridDim.x) {
    if (it < N_DIL) local_attn_item<0>(p, layer, it, sm);
    else if (it < N_DIL + N_NA) local_attn_item<1>(p, layer, it - N_DIL, sm);
    else kmax_item(p, layer, it - N_DIL - N_NA);
  }
}

constexpr int KS_STRIDE = 72, VS_STRIDE = 68;
constexpr int KS_BUF = 64 * KS_STRIDE, VS_BUF = 64 * VS_STRIDE;
DI void phase_diff(const Params& p, int layer, u16* sm) {
  const int tid = otid(), lane = tid & 63, w = tid >> 6, r = lane & 31, hh = lane >> 5;
  u16* Ks = sm; u16* Vs = sm + 2 * KS_BUF;
  float lam;
  {
    const float* dl = p.diff_lambda + layer * 128;
    float a = 0.f, c2 = 0.f;
    if (lane < 32) { a = dl[lane] * dl[32 + lane]; c2 = dl[64 + lane] * dl[96 + lane]; }
    a = wave_sum(a); c2 = wave_sum(c2);
    lam = __expf(a) - __expf(c2) + p.lam_init[layer];
  }
  const float lam_init = p.lam_init[layer];
  const float* sg = p.diff_subln + layer * 64;
  for (int it = blockIdx.x; it < 512; it += gridDim.x) {
    const int bh = it >> 6, qb = it & 63, b = bh >> 2, head = bh & 3;
    const u16* prow = p.proj + (size_t)b * S * NPROJ;
    const int tq = qb * 256 + w * 32 + r;
    bf16x8 qf[2][2];
    float qn[2];
#pragma unroll
    for (int m = 0; m < 2; ++m) {
      qn[m] = 0.f;
#pragma unroll
      for (int s = 0; s < 2; ++s) {
        qf[m][s] = *(const bf16x8*)(prow + (size_t)tq * NPROJ + head * 64 + m * 32 + s * 16 + 8 * hh);
#pragma unroll
        for (int j = 0; j < 8; ++j) { const float v = bf2f((u16)qf[m][s][j]); qn[m] += v * v; }
      }
      qn[m] += __shfl_xor(qn[m], 32);
    }
    float mbnd[2];
#pragma unroll
    for (int m = 0; m < 2; ++m) {
      const float km = __uint_as_float(p.kmax[layer * 16 + bh * 2 + m]);
      mbnd[m] = sqrtf(qn[m] * km);
    }
    f32x16 O[2][2];
#pragma unroll
    for (int m = 0; m < 2; ++m)
#pragma unroll
      for (int mb = 0; mb < 2; ++mb)
#pragma unroll
        for (int i = 0; i < 16; ++i) O[m][mb][i] = 0.f;
    float lsum[2] = {0.f, 0.f};
    uint4 kr, vr;
    const int key0 = tid >> 3, ch = tid & 7;
    const u16* kg = prow + (size_t)key0 * NPROJ + 256 + head * 64 + ch * 8;
    auto gload = [&](int kt) {
      const u16* src = kg + (size_t)(kt * 64) * NPROJ;
      kr = *(const uint4*)src; vr = *(const uint4*)(src + 256);
    };
    auto lstore = [&](int buf) {
      *(uint4*)(Ks + buf * KS_BUF + key0 * KS_STRIDE + ch * 8) = kr;
      const unsigned e[4] = {vr.x, vr.y, vr.z, vr.w};
      u16* vb = Vs + buf * VS_BUF + (ch * 8) * VS_STRIDE + key0;
#pragma unroll
      for (int q = 0; q < 4; ++q) { vb[(2 * q) * VS_STRIDE] = (u16)(e[q] & 0xffffu); vb[(2 * q + 1) * VS_STRIDE] = (u16)(e[q] >> 16); }
    };
    gload(0); lstore(0);
    __syncthreads();
    for (int kt = 0; kt < 256; ++kt) {
      const int buf = kt & 1;
      if (kt + 1 < 256) gload(kt + 1);
#pragma unroll
      for (int sub = 0; sub < 2; ++sub) {
#pragma unroll
        for (int m = 0; m < 2; ++m) {
          f32x16 Sc;
#pragma unroll
          for (int i = 0; i < 16; ++i) Sc[i] = 0.f;
#pragma unroll
          for (int s = 0; s < 2; ++s) {
            const bf16x8 kf = *(const bf16x8*)(Ks + buf * KS_BUF + (sub * 32 + r) * KS_STRIDE + m * 32 + s * 16 + 8 * hh);
            Sc = MFMA32(kf, qf[m][s], Sc);
          }
          bf16x8 pk[2];
#pragma unroll
          for (int sp = 0; sp < 2; ++sp) {
            unsigned q4[4];
#pragma unroll
            for (int q = 0; q < 4; ++q) {
              const float p0 = exp2_hw(Sc[8 * sp + 2 * q] - mbnd[m]), p1 = exp2_hw(Sc[8 * sp + 2 * q + 1] - mbnd[m]);
              lsum[m] += p0; lsum[m] += p1;
              q4[q] = pack2(p0, p1);
            }
            pk[sp] = __builtin_bit_cast(bf16x8, make_uint4(q4[0], q4[1], q4[2], q4[3]));
          }
#pragma unroll
          for (int sp = 0; sp < 2; ++sp)
#pragma unroll
            for (int mb = 0; mb < 2; ++mb) {
              const u16* vp = Vs + buf * VS_BUF + (mb * 32 + r) * VS_STRIDE + sub * 32 + 16 * sp + 4 * hh;
              const s16x4 lo = *(const s16x4*)vp, hi = *(const s16x4*)(vp + 8);
              const bf16x8 vf = __builtin_shufflevector(lo, hi, 0, 1, 2, 3, 4, 5, 6, 7);
              O[m][mb] = MFMA32(vf, pk[sp], O[m][mb]);
            }
        }
        __builtin_amdgcn_sched_barrier(0);
      }
      if (kt + 1 < 256) lstore(buf ^ 1);
      __syncthreads();
    }
    const float l0 = lsum[0] + __shfl_xor(lsum[0], 32);
    const float l1 = lsum[1] + __shfl_xor(lsum[1], 32);
    const float i0 = 1.f / l0, i1 = lam / l1;
    float ss = 0.f;
#pragma unroll
    for (int mb = 0; mb < 2; ++mb)
#pragma unroll
      for (int i = 0; i < 16; ++i) { const float v = O[0][mb][i] * i0 - O[1][mb][i] * i1; O[0][mb][i] = v; ss += v * v; }
    ss += __shfl_xor(ss, 32);
    const float inv = rsqrtf(ss * (1.f / 64.f) + 1e-6f) * (1.f - lam_init);
    u16* op = p.o + (size_t)(b * S + tq) * 1024 + head * 64;
#pragma unroll
    for (int mb = 0; mb < 2; ++mb)
#pragma unroll
      for (int g = 0; g < 4; ++g) {
        const int d = mb * 32 + 8 * g + 4 * hh;
        const float4 g4 = *(const float4*)(sg + d);
        *(uint2*)(op + d) = make_uint2(pack2(O[0][mb][4 * g] * inv * g4.x, O[0][mb][4 * g + 1] * inv * g4.y),
                                       pack2(O[0][mb][4 * g + 2] * inv * g4.z, O[0][mb][4 * g + 3] * inv * g4.w));
      }
  }
}

DI void phase_proj(const Params& p, int layer, LAS unsigned char* lds) {
  pg8::StaticOrder so; so.init(128, 12, gridDim.x, blockIdx.x);
  EpiProj e; e.proj = p.proj;
  pg8::gemm_phase<pg8::AMapPlain>(lds, p.h, p.wt_in + (size_t)layer * 3072 * 1024, 1024, so, e);
}
DI void phase_resid(const u16* A, int K, const u16* Bt, const float* xold, float* xnew, const float* gate, LAS unsigned char* lds) {
  pg8::StaticOrder so; so.init(128, 4, gridDim.x, blockIdx.x);
  EpiResid e; e.xold = xold; e.xnew = xnew; e.gate = gate;
  pg8::gemm_phase<pg8::AMapPlain>(lds, A, Bt, K, so, e);
}
DI void phase_up(const Params& p, int layer, LAS unsigned char* lds) {
  pg8::StaticOrder so; so.init(134, 22, gridDim.x, blockIdx.x);
  EpiUp e; e.act = p.act; e.cw = p.conv_w + (size_t)layer * 3 * DFF; e.cb = p.conv_b + (size_t)layer * DFF;
  pg8::gemm_phase<pg8::AMapHalo>(lds, p.h, p.wt_up + (size_t)layer * 5632 * 1024, 1024, so, e);
}

constexpr int N_PHASES = 18;

DI void run_phase(const Params& p, int ph, unsigned char* smraw) {
  u16* sm = (u16*)smraw;
  LAS unsigned char* lds = (LAS unsigned char*)smraw;
  if (ph == 0) { phase_prep(p, (float*)smraw); return; }
  if (ph == 17) { phase_norm<1>(p.out, p.g_final, nullptr, 0, 0, nullptr, p.out); return; }
  const int layer = (ph - 1) >> 3, sub = (ph - 1) & 7;
  const float* modl = p.mod + layer * 2 * 6144;
  const float* xcur = (layer == 0) ? p.x : p.out;
  switch (sub) {
    case 0: phase_norm<0>(xcur, p.g_attn + layer * 1024, modl, 0, 1024, p.h, nullptr); break;
    case 1: phase_proj(p, layer, lds); break;
    case 2: phase_local(p, layer, sm); break;
    case 3: phase_diff(p, layer, sm); break;
    case 4: phase_resid(p.o, 1024, p.wt_out + (size_t)layer * 1024 * 1024, xcur, p.out, modl + 2048, lds); break;
    case 5: phase_norm<0>(p.out, p.g_ffn + layer * 1024, modl, 3072, 4096, p.h, nullptr); break;
    case 6: phase_up(p, layer, lds); break;
    case 7: phase_resid(p.act, DFF, p.wt_down + (size_t)layer * 1024 * DFF, p.out, p.out, modl + 5120, lds); break;
  }
}

__global__ void __launch_bounds__(NTHR, 2) mega_kernel(Params p) {
  __shared__ __attribute__((aligned(16))) unsigned char smraw[LDS_BYTES];
#if COOP
  __shared__ uint4 xb_words;
  cg::grid_group grid = cg::this_grid();
  u16* sm = (u16*)smraw;
  LAS unsigned char* lds = (LAS unsigned char*)smraw;
  if (threadIdx.x == 0) xb_words = make_uint4(0u, 0u, 0u, 0u);
  __syncthreads();
  const XcdBarrier xb = xcd_barrier_post(p.bar, (volatile LAS unsigned*)&xb_words);
  phase_prep(p, (float*)smraw);
  grid.sync();
#pragma unroll 1
  for (int layer = 0; layer < 2; ++layer) {
    const float* modl = p.mod + layer * 2 * 6144;
    const float* xcur = (layer == 0) ? p.x : p.out;
    phase_norm<0>(xcur, p.g_attn + layer * 1024, modl, 0, 1024, p.h, nullptr); xcd_barrier(xb);
    phase_proj(p, layer, lds); xcd_barrier(xb);
    phase_local(p, layer, sm); xcd_barrier(xb);
    phase_diff(p, layer, sm); xcd_barrier(xb);
    phase_resid(p.o, 1024, p.wt_out + (size_t)layer * 1024 * 1024, xcur, p.out, modl + 2048, lds); xcd_barrier(xb);
    phase_norm<0>(p.out, p.g_ffn + layer * 1024, modl, 3072, 4096, p.h, nullptr); xcd_barrier(xb);
    phase_up(p, layer, lds); xcd_barrier(xb);
    phase_resid(p.act, DFF, p.wt_down + (size_t)layer * 1024 * DFF, p.out, p.out, modl + 5120, lds); xcd_barrier(xb);
  }
  phase_norm<1>(p.out, p.g_final, nullptr, 0, 0, nullptr, p.out);
#else
  for (int ph = p.ph_lo; ph < p.ph_hi; ++ph) run_phase(p, ph, smraw);
#endif
}

extern "C" void kernel_launch(void* const* d_in, const int* in_sizes, int n_in, void* d_out, int out_size, void* d_ws, size_t ws_size, hipStream_t stream) {
  (void)in_sizes; (void)n_in; (void)out_size;
  Params p;
  memset(&p, 0, sizeof(p));
  p.x = (const float*)d_in[0]; p.c = (const float*)d_in[1]; p.w_ada = (const float*)d_in[2]; p.b_ada = (const float*)d_in[3];
  p.g_attn = (const float*)d_in[4]; p.w_in = (const float*)d_in[5]; p.diff_lambda = (const float*)d_in[6]; p.diff_subln = (const float*)d_in[7];
  p.na_rpb = (const float*)d_in[8]; p.w_out = (const float*)d_in[9]; p.g_ffn = (const float*)d_in[10]; p.w_up = (const float*)d_in[11];
  p.conv_w = (const float*)d_in[12]; p.conv_b = (const float*)d_in[13]; p.w_down = (const float*)d_in[14]; p.g_final = (const float*)d_in[15];
  p.out = (float*)d_out;
  char* ws = (char*)d_ws; size_t off = 0;
  auto take = [&](size_t bytes) { char* q = ws + off; off += (bytes + 255) & ~(size_t)255; return q; };
  p.wt_in = (u16*)take((size_t)2 * 3072 * 1024 * 2);
  p.wt_out = (u16*)take((size_t)2 * 1024 * 1024 * 2);
  p.wt_up = (u16*)take((size_t)2 * 5632 * 1024 * 2);
  p.wt_down = (u16*)take((size_t)2 * 1024 * 2816 * 2);
  p.mod = (float*)take((size_t)2 * 2 * 6144 * 4);
  p.kmax = (unsigned*)take(256);
  p.bar = (unsigned*)take((size_t)XCD_BAR_WORDS * 4);
  (void)take(4096);
  p.h = (u16*)take((size_t)NTOK * 1024 * 2);
  p.o = (u16*)take((size_t)NTOK * 1024 * 2);
  p.proj = (u16*)take((size_t)NTOK * NPROJ * 2);
  p.act = p.proj;
  if (off > ws_size) { fprintf(stderr, "workspace too small: need %zu have %zu\n", off, ws_size); return; }
  p.lam_init[0] = 0.2f; p.lam_init[1] = 0.35550906759096934f;
  static int grid_blocks = 0;
  if (!grid_blocks) {
    int dev = 0, cus = 0, per_cu = 0;
    (void)hipGetDevice(&dev);
    (void)hipDeviceGetAttribute(&cus, hipDeviceAttributeMultiprocessorCount, dev);
    (void)hipOccupancyMaxActiveBlocksPerMultiprocessor(&per_cu, mega_kernel, NTHR, 0);
    if (per_cu > 1) per_cu = 1;
    if (per_cu < 1) per_cu = 1;
    grid_blocks = cus * per_cu;
  }
#if COOP
  p.ph_lo = 0; p.ph_hi = N_PHASES;
  (void)hipMemsetAsync(p.bar, 0, (size_t)XCD_BAR_WORDS * 4, stream);
  void* args[] = {&p};
  hipError_t e = hipLaunchCooperativeKernel((void*)mega_kernel, dim3(grid_blocks), dim3(NTHR), args, 0, stream);
  if (e != hipSuccess) fprintf(stderr, "cooperative launch failed: %s (grid %d)\n", hipGetErrorString(e), grid_blocks);
#else
  for (int ph = 0; ph < N_PHASES; ++ph) {
    p.ph_lo = ph; p.ph_hi = ph + 1;
    hipLaunchKernelGGL(mega_kernel, dim3(grid_blocks), dim3(NTHR), 0, stream, p);
  }
#endif
}
```

```cpp
#include <hip/hip_runtime.h>
#include <hip/hip_cooperative_groups.h>
#include <cstdio>
#include <cstring>
namespace cg = cooperative_groups;

#ifndef COOP
#define COOP 1
#endif

#define DI __device__ __forceinline__
#define LAS __attribute__((address_space(3)))
typedef unsigned short u16;
using bf16x8 = __attribute__((ext_vector_type(8))) short;
using s16x4  = __attribute__((ext_vector_type(4))) short;
using f32x16 = __attribute__((ext_vector_type(16))) float;
using f32x4  = __attribute__((ext_vector_type(4))) float;
typedef __bf16 bf2_t __attribute__((ext_vector_type(2)));
typedef float f2_t __attribute__((ext_vector_type(2)));
#define MFMA32(a, b, c) __builtin_amdgcn_mfma_f32_32x32x16_bf16((a), (b), (c), 0, 0, 0)

constexpr int S = 16384, NTOK = 32768, DFF = 2816, NPROJ = 3072;
constexpr int NTHR = 512, NWAVE = 8;
constexpr float LOG2E = 1.4426950408889634f;
constexpr float QSCALE_DIFF = 0.25503486164919736f;
constexpr float QSCALE_64   = 0.18033688011112042f;
constexpr float NEGBIG = -1e30f;
constexpr int LDS_BYTES = 131072;

__device__ const float ROPE_INV16[16] = {
1.000000000e+00f, 5.623413324e-01f, 3.162277639e-01f, 1.778279394e-01f, 1.000000015e-01f, 5.623413250e-02f, 3.162277490e-02f, 1.778279431e-02f, 9.999999776e-03f, 5.623413250e-03f, 3.162277630e-03f, 1.778279431e-03f, 1.000000047e-03f, 5.623413017e-04f, 3.162277571e-04f, 1.778279402e-04f};
__device__ const float ROPE_INV32[32] = {
1.000000000e+00f, 7.498942018e-01f, 5.623413324e-01f, 4.216965139e-01f, 3.162277639e-01f, 2.371373773e-01f, 1.778279394e-01f, 1.333521456e-01f, 1.000000015e-01f, 7.498942316e-02f, 5.623413250e-02f, 4.216964915e-02f, 3.162277490e-02f, 2.371373773e-02f, 1.778279431e-02f, 1.333521400e-02f, 9.999999776e-03f, 7.498942316e-03f, 5.623413250e-03f, 4.216964822e-03f, 3.162277630e-03f, 2.371373819e-03f, 1.778279431e-03f, 1.333521446e-03f, 1.000000047e-03f, 7.498941850e-04f, 5.623413017e-04f, 4.216965172e-04f, 3.162277571e-04f, 2.371373703e-04f, 1.778279402e-04f, 1.333521504e-04f};

struct Params {
  const float *x, *c, *w_ada, *b_ada, *g_attn, *w_in, *diff_lambda, *diff_subln, *na_rpb, *w_out, *g_ffn, *w_up, *conv_w, *conv_b, *w_down, *g_final;
  float* out;
  u16 *wt_in, *wt_out, *wt_up, *wt_down;
  float* mod;
  unsigned* kmax;
  unsigned* bar;
  u16 *h, *o, *proj, *act;
  float lam_init[2];
  int ph_lo, ph_hi;
};

typedef const __attribute__((address_space(4))) Params& KP;
DI const __attribute__((address_space(4))) Params* kp_fresh() {
  const __attribute__((address_space(4))) Params* q = (const __attribute__((address_space(4))) Params*)__builtin_amdgcn_kernarg_segment_ptr();
  asm volatile("" : "+s"(q));
  return q;
}
DI unsigned pack2(float a, float b) { f2_t v = {a, b}; return __builtin_bit_cast(unsigned, __builtin_convertvector(v, bf2_t)); }
DI float bf2f(u16 v) { return __uint_as_float(((unsigned)v) << 16); }
DI float bflo(unsigned v) { return __uint_as_float(v << 16); }
DI float bfhi(unsigned v) { return __uint_as_float(v & 0xffff0000u); }
DI int crow(int i, int hh) { return (i & 3) + 8 * (i >> 2) + 4 * hh; }
DI float exp2_hw(float x) { return __builtin_amdgcn_exp2f(x); }
DI int otid() { int t = threadIdx.x; asm volatile("" : "+v"(t)); return t; }


#define XB_TMO      128
#define XB_XCNT(j)  (256  + 64 * (j))
#define XB_XSUB(j)  (1280 + 64 * (j))
#define XB_XGEN(j)  (2304 + 64 * (j))
#define XB_TOP      3328
#define XB_TOPGEN   3392
#define XCD_BAR_WORDS 3456
#define XB_SPIN_CAP (1u << 21)
DI unsigned xb_ld(unsigned* p)              { return __hip_atomic_load(p, __ATOMIC_RELAXED, __HIP_MEMORY_SCOPE_AGENT); }
DI unsigned xb_add(unsigned* p, unsigned v) { return __hip_atomic_fetch_add(p, v, __ATOMIC_RELAXED, __HIP_MEMORY_SCOPE_AGENT); }
DI unsigned xb_xcc_id() { return (unsigned)__builtin_amdgcn_s_getreg((3 << 11) | 20) & 0xFu; }
#define XB_SPIN(cond, bar) do { unsigned _sp = 0; while (cond) { __builtin_amdgcn_s_sleep(1); \
    if ((++_sp & 255u) == 0u) { if (xb_ld(&(bar)[XB_TMO])) break; if (_sp > XB_SPIN_CAP) { atomicAdd(&(bar)[XB_TMO], 1u); break; } } } } while (0)
struct XcdBarrier { unsigned* bar; unsigned x; volatile LAS unsigned* st; };
DI XcdBarrier xcd_barrier_post(unsigned* bar, volatile LAS unsigned* st) {
  XcdBarrier b; b.bar = bar; b.x = xb_xcc_id(); b.st = st;
  if (threadIdx.x == 0) (void)xb_add(&bar[XB_XCNT(b.x)], 1u);
  return b;
}
DI void xcd_barrier_complete(unsigned* bar, unsigned x, unsigned& nloc, unsigned& nx) {
  const unsigned G = gridDim.x * gridDim.y * gridDim.z;
  unsigned sum, cnt, mine, sp = 0u;
  for (;;) {
    sum = 0u; cnt = 0u; mine = 0u;
#pragma unroll
    for (unsigned j = 0; j < 16; ++j) { const unsigned c = xb_ld(&bar[XB_XCNT(j)]); sum += c; cnt += (c > 0u) ? 1u : 0u; mine = (j == x) ? c : mine; }
    if (sum == G) break;
    __builtin_amdgcn_s_sleep(1);
    if ((++sp & 255u) == 0u) { if (xb_ld(&bar[XB_TMO])) break; if (sp > XB_SPIN_CAP) { atomicAdd(&bar[XB_TMO], 1u); break; } }
  }
  nloc = mine > 0u ? mine : 1u; nx = cnt > 0u ? cnt : 1u;
}
DI void xcd_barrier(const XcdBarrier& b) {
  asm volatile("s_waitcnt vmcnt(0)" ::: "memory");
  __syncthreads();
  if (threadIdx.x == 0) {
    unsigned* bar = b.bar;
    __builtin_amdgcn_s_waitcnt(0);
    unsigned nloc = b.st[0], nx = b.st[1];
    if (nloc == 0u) { xcd_barrier_complete(bar, b.x, nloc, nx); b.st[0] = nloc; b.st[1] = nx; }
    const unsigned old = xb_add(&bar[XB_XSUB(b.x)], 1u);
    const unsigned gen = old / nloc;
    if (old + 1u == (gen + 1u) * nloc) {
      __builtin_amdgcn_fence(__ATOMIC_RELEASE, "agent");
      asm volatile("s_waitcnt vmcnt(0)" ::: "memory");
      const unsigned og = xb_add(&bar[XB_TOP], 1u);
      const unsigned tg = og / nx;
      if (og + 1u == (tg + 1u) * nx) xb_add(&bar[XB_TOPGEN], 1u);
      else XB_SPIN(xb_ld(&bar[XB_TOPGEN]) == tg, bar);
      __builtin_amdgcn_fence(__ATOMIC_ACQUIRE, "agent");
      xb_add(&bar[XB_XGEN(b.x)], 1u);
      asm volatile("s_waitcnt vmcnt(0)" ::: "memory");
    } else {
      XB_SPIN(xb_ld(&bar[XB_XGEN(b.x)]) == gen, bar);
      __builtin_amdgcn_fence(__ATOMIC_ACQUIRE, "agent");
      asm volatile("s_waitcnt vmcnt(0)" ::: "memory");
    }
  }
  __syncthreads();
}

DI int wmap_in(int np) {
  if (np >= 768 && np < 1536) { const int hb = np & ~63, w = np & 63, g = w >> 5, n = (w >> 4) & 1, i = w & 15; return hb + 16 * g + i + 32 * n; }
  return np;
}
DI int wmap_up(int np) {
  const int pn = np >> 8, w = np & 255, bj = w >> 7, q = w & 127;
  return bj ? (DFF + 128 * pn + q) : (128 * pn + q);
}

DI void phase_prep(KP p, float* smf) {
  const int tid = otid();
  if (blockIdx.x == 0 && tid < 64) p.kmax[tid] = 0u;
  constexpr int N_ADA = 192;
  constexpr int T_IN = 16 * 24, T_OUT = 16 * 8, T_UP = 16 * 44, T_DOWN = 44 * 8;
  constexpr int T_LAYER = T_IN + T_OUT + T_UP + T_DOWN;
  const int total = N_ADA + 2 * T_LAYER;
  for (int it = blockIdx.x; it < total; it += gridDim.x) {
    if (it < N_ADA) {
      const int l = it / 96, cgp = it % 96;
      float* sc = smf;
      float* red = smf + 2048;
      for (int i = tid; i < 2048; i += NTHR) { float v = p.c[i]; sc[i] = v / (1.f + __expf(-v)); }
      __syncthreads();
      const int kq = tid >> 6, cc = tid & 63, col = cgp * 64 + cc;
      const float* wp = p.w_ada + ((size_t)l * 1024 + kq * 128) * 6144 + col;
      float a0 = 0.f, a1 = 0.f;
#pragma unroll 8
      for (int k = 0; k < 128; ++k) { float w = wp[(size_t)k * 6144]; a0 += sc[kq * 128 + k] * w; a1 += sc[1024 + kq * 128 + k] * w; }
      red[(kq * 2 + 0) * 64 + cc] = a0; red[(kq * 2 + 1) * 64 + cc] = a1;
      __syncthreads();
      if (tid < 128) {
        const int b = tid >> 6, c2 = tid & 63;
        float s = 0.f;
#pragma unroll
        for (int q = 0; q < 8; ++q) s += red[(q * 2 + b) * 64 + c2];
        p.mod[(l * 2 + b) * 6144 + cgp * 64 + c2] = s + p.b_ada[l * 6144 + cgp * 64 + c2];
      }
    } else {
      int idx = it - N_ADA; const int l = idx / T_LAYER; int j = idx % T_LAYER;
      const float* W; u16* dst; int Kd, N, tk, tn, kind;
      if (j < T_IN) { W = p.w_in + (size_t)l * 1024 * 3072; dst = p.wt_in + (size_t)l * 3072 * 1024; Kd = 1024; N = 3072; tk = j / 24; tn = j % 24; kind = 0; }
      else if (j < T_IN + T_OUT) { j -= T_IN; W = p.w_out + (size_t)l * 1024 * 1024; dst = p.wt_out + (size_t)l * 1024 * 1024; Kd = 1024; N = 1024; tk = j / 8; tn = j % 8; kind = 1; }
      else if (j < T_IN + T_OUT + T_UP) { j -= T_IN + T_OUT; W = p.w_up + (size_t)l * 1024 * 5632; dst = p.wt_up + (size_t)l * 5632 * 1024; Kd = 1024; N = 5632; tk = j / 44; tn = j % 44; kind = 2; }
      else { j -= T_IN + T_OUT + T_UP; W = p.w_down + (size_t)l * 2816 * 1024; dst = p.wt_down + (size_t)l * 1024 * 2816; Kd = 2816; N = 1024; tk = j / 8; tn = j % 8; kind = 3; }
      const int hb = tid >> 8, t = tid & 255;
      const int k0 = tk * 64, n0 = (tn * 2 + hb) * 64;
      float* tile = smf + hb * (64 * 65);
      const int nn = t & 63;
      const int np = n0 + nn;
      const int srccol = (kind == 0) ? wmap_in(np) : (kind == 2) ? wmap_up(np) : np;
#pragma unroll 4
      for (int i = 0; i < 16; ++i) { const int kk = i * 4 + (t >> 6); tile[kk * 65 + nn] = W[(size_t)(k0 + kk) * N + srccol]; }
      __syncthreads();
      const int nrow = t >> 2, kc = (t & 3) * 16;
      unsigned pk[8];
#pragma unroll
      for (int q = 0; q < 8; ++q) pk[q] = pack2(tile[(kc + 2 * q) * 65 + nrow], tile[(kc + 2 * q + 1) * 65 + nrow]);
      uint4* dp = (uint4*)(dst + (size_t)(n0 + nrow) * Kd + k0 + kc);
      dp[0] = make_uint4(pk[0], pk[1], pk[2], pk[3]);
      dp[1] = make_uint4(pk[4], pk[5], pk[6], pk[7]);
    }
    __syncthreads();
  }
}

DI float wave_sum(float v) {
#pragma unroll
  for (int o = 32; o >= 1; o >>= 1) v += __shfl_xor(v, o);
  return v;
}

template <int MODE>
DI void phase_norm(const float* xin, const float* g, const float* modl, int sh_off, int sc_off, u16* hout, float* fout) {
  const int tid = otid(); const int lane = tid & 63, w = tid >> 6;
  for (int row = blockIdx.x * NWAVE + w; row < NTOK; row += gridDim.x * NWAVE) {
    const int b = row >> 14;
    const float4* xr = (const float4*)(xin + (size_t)row * 1024);
    float4 v[4];
#pragma unroll
    for (int i = 0; i < 4; ++i) v[i] = xr[lane + i * 64];
    float ss = 0.f;
#pragma unroll
    for (int i = 0; i < 4; ++i) ss += v[i].x * v[i].x + v[i].y * v[i].y + v[i].z * v[i].z + v[i].w * v[i].w;
    ss = wave_sum(ss);
    const float inv = rsqrtf(ss * (1.f / 1024.f) + 1e-6f);
#pragma unroll
    for (int i = 0; i < 4; ++i) {
      const int col = (lane + i * 64) * 4;
      const float4 g4 = *(const float4*)(g + col);
      if (MODE == 0) {
        const float4 sc4 = *(const float4*)(modl + b * 6144 + sc_off + col);
        const float4 sh4 = *(const float4*)(modl + b * 6144 + sh_off + col);
        float y0 = v[i].x * inv * g4.x * (1.f + sc4.x) + sh4.x;
        float y1 = v[i].y * inv * g4.y * (1.f + sc4.y) + sh4.y;
        float y2 = v[i].z * inv * g4.z * (1.f + sc4.z) + sh4.z;
        float y3 = v[i].w * inv * g4.w * (1.f + sc4.w) + sh4.w;
        *(uint2*)(hout + (size_t)row * 1024 + col) = make_uint2(pack2(y0, y1), pack2(y2, y3));
      } else {
        float4 y; y.x = v[i].x * inv * g4.x; y.y = v[i].y * inv * g4.y; y.z = v[i].z * inv * g4.z; y.w = v[i].w * inv * g4.w;
        *(float4*)(fout + (size_t)row * 1024 + col) = y;
      }
    }
  }
}

namespace pg8 {
constexpr int BM = 256, BK = 64, HALF = 128, HTB = HALF * BK * 2, NXCD = 8, WGM = 8;
DI int lds_byte(int r, int c) { const int st = (r >> 4) * 2 + (c >> 5), rr = r & 15, cc = c & 31, ob = rr * 64 + cc * 2; return st * 1024 + (ob ^ (((ob >> 9) & 1) << 5)); }
DI void stage_rc(int b, int& R, int& C) { const int st = b / 1024, sb = b % 1024, swz = sb ^ (((sb >> 9) & 1) << 5); R = (st >> 1) * 16 + swz / 64; C = (st & 1) * 32 + (swz % 64) / 2; }
struct Unit { int pm, pn; };
struct StaticOrder {
  int nM, nN, nwg, G, c;
  DI void init(int nM_, int nN_, int G_, int c_) { nM = nM_; nN = nN_; nwg = nM * nN; G = G_; c = c_; }
  DI bool next(int i, Unit& u) const {
    const long L = (long)i * G + c; if (L >= nwg) return false;
    int wgid = (int)L; { const int q = nwg / NXCD, r = nwg % NXCD, xcd = wgid % NXCD, off = wgid / NXCD; wgid = (xcd < r ? xcd * (q + 1) : r * (q + 1) + (xcd - r) * q) + off; }
    const int nig = WGM * nN, gid = wgid / nig, fm = gid * WGM, gsz = (nM - fm) < WGM ? (nM - fm) : WGM;
    u.pm = fm + ((wgid % nig) % gsz); u.pn = (wgid % nig) / gsz; return true;
  }
};
struct AMapPlain { static constexpr int HALF_ROWS = 128; static DI int row(int R) { return R; } static DI long tile_row0(int pm) { return (long)pm * 256; } };
struct AMapHalo  { static constexpr int HALF_ROWS = 124; static DI int row(int R) { return 62 * (R >> 6) + (R & 63); } static DI long tile_row0(int pm) { const int b = pm / 67, ti = pm % 67; return (long)b * S + 248 * ti - 1; } };

template <class AMap, class Epi>
DI void gemm_phase(LAS unsigned char* lds, const u16* Aptr, const u16* Btptr, int K, const StaticOrder& SO, const Epi& E) {
  const int tid = otid(), wid = __builtin_amdgcn_readfirstlane(tid >> 6), lane = tid & 63, wr = wid >> 2, wc = wid & 3, fr = lane & 15, fq = lane >> 4;
  const int nt = K / BK;
  unsigned voffA[2], voffB[2];
#pragma unroll
  for (int i = 0; i < 2; ++i) { int R, C; stage_rc(tid * 16 + i * 8192, R, C);
    voffA[i] = (unsigned)(AMap::row(R) * K + C) * 2u; voffB[i] = (unsigned)(R * K + C) * 2u; }
  const size_t kstep = (size_t)(BK * 2);
  const size_t hstepA = (size_t)AMap::HALF_ROWS * K * 2, hstepB = (size_t)HALF * K * 2;
  const size_t tstepB = 2 * hstepB;
  const size_t rowB = (size_t)K * 2;
  const unsigned ldsw = (unsigned)wid * 1024u;
  const int aoff = lds_byte(wr * 64 + fr, fq * 8), boff = lds_byte(wc * 32 + fr, fq * 8);
#define PG8_SA(b, h) (((b) * 2 + (h)) * HTB)
#define PG8_SB(b, h) ((4 + (b) * 2 + (h)) * HTB)
#define PG8_STAGE(bufoff, gbase, voff) do { _Pragma("unroll") for (int _i = 0; _i < 2; ++_i) \
        __builtin_amdgcn_global_load_lds((const unsigned*)((const char*)(gbase) + (voff)[_i]), (LAS unsigned*)(lds + (bufoff) + ldsw + _i * 8192), 16, 0, 0); } while (0)
#define PG8_LDA(dst, b, h) do { _Pragma("unroll") for (int m = 0; m < 4; ++m) _Pragma("unroll") for (int k = 0; k < 2; ++k) dst[m][k] = *(const LAS bf16x8*)(lds + PG8_SA(b, h) + aoff + m * 2048 + k * 1024); } while (0)
#define PG8_LDB(dst, b, h) do { _Pragma("unroll") for (int n = 0; n < 2; ++n) _Pragma("unroll") for (int k = 0; k < 2; ++k) dst[n][k] = *(const LAS bf16x8*)(lds + PG8_SB(b, h) + boff + n * 2048 + k * 1024); } while (0)
#define PG8_MMA(ai, bj, At, Bt) do { __builtin_amdgcn_s_setprio(1); _Pragma("unroll") for (int m = 0; m < 4; ++m) _Pragma("unroll") for (int n = 0; n < 2; ++n) _Pragma("unroll") for (int k = 0; k < 2; ++k) \
        acc[ai][bj][m][n] = __builtin_amdgcn_mfma_f32_16x16x32_bf16(Bt[n][k], At[m][k], acc[ai][bj][m][n], 0, 0, 0); __builtin_amdgcn_s_setprio(0); } while (0)
#define PG8_WAIT_V(n) asm volatile("s_waitcnt vmcnt(" #n ")" ::: "memory")
#define PG8_WAIT_L(n) asm volatile("s_waitcnt lgkmcnt(" #n ")" ::: "memory")
#define PG8_BAR __builtin_amdgcn_s_barrier()
#define PG8_SCHED __builtin_amdgcn_sched_barrier(0)
  Unit cur, nxt; int ui = 0;
  if (!SO.next(0, cur)) return;
  f32x4 acc[2][2][4][2];
#pragma unroll
  for (int a = 0; a < 2; ++a)
#pragma unroll
    for (int b = 0; b < 2; ++b)
#pragma unroll
      for (int m = 0; m < 4; ++m)
#pragma unroll
        for (int n = 0; n < 2; ++n) acc[a][b][m][n] = (f32x4){0.f, 0.f, 0.f, 0.f};
  bf16x8 At[4][2], B0[2][2], B1[2][2];
  const char* cA = (const char*)Aptr + AMap::tile_row0(cur.pm) * (long)rowB; const char* cB = (const char*)Btptr + (size_t)cur.pn * tstepB;
  PG8_STAGE(PG8_SB(0, 0), cB, voffB); PG8_STAGE(PG8_SA(0, 0), cA, voffA); PG8_STAGE(PG8_SB(0, 1), cB + hstepB, voffB); PG8_STAGE(PG8_SA(0, 1), cA + hstepA, voffA);
  if (wr == 1) PG8_BAR;
  PG8_WAIT_V(4); PG8_BAR;
  PG8_STAGE(PG8_SB(1, 0), cB + kstep, voffB); PG8_STAGE(PG8_SA(1, 0), cA + kstep, voffA); PG8_STAGE(PG8_SB(1, 1), cB + hstepB + kstep, voffB);
  PG8_WAIT_V(6); PG8_BAR;
  for (;;) {
    const bool has_next = SO.next(ui + 1, nxt);
    const char* nA = has_next ? (const char*)Aptr + AMap::tile_row0(nxt.pm) * (long)rowB : cA; const char* nB = has_next ? (const char*)Btptr + (size_t)nxt.pn * tstepB : cB;
    for (int t = 0; t < nt; t += 2) {
      const bool last = (t == nt - 2);
      const char* a1 = cA + (size_t)(t + 1) * kstep;
      const char* a2 = last ? nA : cA + (size_t)(t + 2) * kstep; const char* b2 = last ? nB : cB + (size_t)(t + 2) * kstep;
      const char* a3 = a2 + kstep; const char* b3 = b2 + kstep;
      PG8_LDB(B0, 0, 0); PG8_SCHED; PG8_LDA(At, 0, 0); PG8_STAGE(PG8_SA(1, 1), a1 + hstepA, voffA);
      PG8_WAIT_L(8); PG8_BAR; PG8_WAIT_L(0); PG8_MMA(0, 0, At, B0); PG8_BAR; PG8_SCHED;
      PG8_LDB(B1, 0, 1); PG8_STAGE(PG8_SB(0, 0), b2, voffB);
      PG8_BAR; PG8_WAIT_L(0); PG8_MMA(0, 1, At, B1); PG8_BAR;
      PG8_LDA(At, 0, 1); PG8_STAGE(PG8_SA(0, 0), a2, voffA);
      PG8_BAR; PG8_WAIT_L(0); PG8_MMA(1, 0, At, B0); PG8_BAR; PG8_SCHED;
      PG8_STAGE(PG8_SB(0, 1), b2 + hstepB, voffB);
      PG8_WAIT_V(6); PG8_BAR; PG8_MMA(1, 1, At, B1); PG8_BAR;
      PG8_LDB(B0, 1, 0); PG8_SCHED; PG8_LDA(At, 1, 0); PG8_STAGE(PG8_SA(0, 1), a2 + hstepA, voffA);
      PG8_WAIT_L(8); PG8_BAR; PG8_WAIT_L(0); PG8_MMA(0, 0, At, B0); PG8_BAR; PG8_SCHED;
      PG8_LDB(B1, 1, 1); PG8_STAGE(PG8_SB(1, 0), b3, voffB);
      PG8_BAR; PG8_WAIT_L(0); PG8_MMA(0, 1, At, B1); PG8_BAR;
      PG8_LDA(At, 1, 1); PG8_STAGE(PG8_SA(1, 0), a3, voffA);
      PG8_BAR; PG8_WAIT_L(0); PG8_MMA(1, 0, At, B0); PG8_BAR; PG8_SCHED;
      PG8_STAGE(PG8_SB(1, 1), b3 + hstepB, voffB);
      PG8_WAIT_V(6); PG8_BAR; PG8_MMA(1, 1, At, B1); PG8_BAR;
    }
    E(acc, cur, wr, wc, fr, fq);
    if (!has_next) break;
#pragma unroll
    for (int a = 0; a < 2; ++a)
#pragma unroll
      for (int b = 0; b < 2; ++b)
#pragma unroll
        for (int m = 0; m < 4; ++m)
#pragma unroll
          for (int n = 0; n < 2; ++n) acc[a][b][m][n] = (f32x4){0.f, 0.f, 0.f, 0.f};
    cur = nxt; cA = nA; cB = nB; ++ui;
  }
  PG8_WAIT_V(0);
  if (wr == 0) PG8_BAR;
  PG8_BAR;
#undef PG8_SA
#undef PG8_SB
#undef PG8_STAGE
#undef PG8_LDA
#undef PG8_LDB
#undef PG8_MMA
#undef PG8_WAIT_V
#undef PG8_WAIT_L
#undef PG8_BAR
#undef PG8_SCHED
}
}

DI void sincos_big(float ang, float& sn, float& cs) {
  const float c_hi = 1.591549367e-01f, c_lo = 6.420638243e-09f;
  const float rh = ang * c_hi;
  const float e = __builtin_fmaf(ang, c_hi, -rh);
  const float fr = rh - floorf(rh);
  const float rev = fr + (e + ang * c_lo);
  sn = __builtin_amdgcn_sinf(rev);
  cs = __builtin_amdgcn_cosf(rev);
}

struct EpiProj {
  u16* proj;
  DI void operator()(const f32x4 (&acc)[2][2][4][2], const pg8::Unit& u, int wr, int wc, int fr, int fq) const {
    const f32x4 i16 = *(const f32x4*)(ROPE_INV16 + 4 * fq);
    const f32x4 i32v = *(const f32x4*)(ROPE_INV32 + 16 * (wc & 1) + 4 * fq);
#pragma unroll
    for (int bj = 0; bj < 2; ++bj) {
      const int gcol0 = u.pn * 256 + bj * 128 + wc * 32;
      int mode; float scale = 1.f;
      if (gcol0 < 256) { mode = 1; scale = QSCALE_DIFF; }
      else if (gcol0 < 512) { mode = 1; }
      else if (gcol0 < 768) { mode = 0; }
      else if (gcol0 < 1152) { mode = 2; scale = QSCALE_64; }
      else if (gcol0 < 1536) { mode = 2; }
      else if (gcol0 < 1920) { mode = 0; }
      else if (gcol0 < 2304) { mode = 0; scale = QSCALE_64; }
      else { mode = 0; }
      f32x4 invv;
#pragma unroll
      for (int e = 0; e < 4; ++e) invv[e] = (mode == 1) ? i16[e] : i32v[e];
      int c1, c2;
      if (mode == 2) { const int hb = gcol0 & ~63, g = wc & 1; c1 = hb + 16 * g + 4 * fq; c2 = c1 + 32; }
      else { c1 = gcol0 + 4 * fq; c2 = c1 + 16; }
#pragma unroll
      for (int ai = 0; ai < 2; ++ai)
#pragma unroll
        for (int m = 0; m < 4; ++m) {
          const int row = u.pm * 256 + ai * 128 + wr * 64 + m * 16 + fr;
          f32x4 x1 = acc[ai][bj][m][0], x2 = acc[ai][bj][m][1];
          if (mode != 0) {
            const float pos = (float)(row & (S - 1));
#pragma unroll
            for (int e = 0; e < 4; ++e) {
              const float ang = __fmul_rn(pos, invv[e]);
              float sn, cs; sincos_big(ang, sn, cs);
              const float y1 = x1[e] * cs - x2[e] * sn, y2 = x2[e] * cs + x1[e] * sn;
              x1[e] = y1; x2[e] = y2;
            }
          }
          u16* dp = proj + (size_t)row * NPROJ;
          *(uint2*)(dp + c1) = make_uint2(pack2(x1[0] * scale, x1[1] * scale), pack2(x1[2] * scale, x1[3] * scale));
          *(uint2*)(dp + c2) = make_uint2(pack2(x2[0] * scale, x2[1] * scale), pack2(x2[2] * scale, x2[3] * scale));
        }
    }
  }
};

struct EpiResid {
  const float* xold; float* xnew; const float* gate;
  DI void operator()(const f32x4 (&acc)[2][2][4][2], const pg8::Unit& u, int wr, int wc, int fr, int fq) const {
    const int b = (u.pm * 256) >> 14;
    const int col0 = u.pn * 256 + wc * 32 + 4 * fq;
    f32x4 gv[2][2];
#pragma unroll
    for (int bj = 0; bj < 2; ++bj)
#pragma unroll
      for (int n = 0; n < 2; ++n) gv[bj][n] = *(const f32x4*)(gate + b * 6144 + col0 + bj * 128 + n * 16);
#pragma unroll
    for (int ai = 0; ai < 2; ++ai)
#pragma unroll
      for (int m = 0; m < 4; ++m) {
        const size_t off = (size_t)(u.pm * 256 + ai * 128 + wr * 64 + m * 16 + fr) * 1024 + col0;
        f32x4 xo[2][2];
#pragma unroll
        for (int bj = 0; bj < 2; ++bj)
#pragma unroll
          for (int n = 0; n < 2; ++n) xo[bj][n] = *(const f32x4*)(xold + off + bj * 128 + n * 16);
#pragma unroll
        for (int bj = 0; bj < 2; ++bj)
#pragma unroll
          for (int n = 0; n < 2; ++n) *(f32x4*)(xnew + off + bj * 128 + n * 16) = xo[bj][n] + gv[bj][n] * acc[ai][bj][m][n];
        asm volatile("" ::: "memory");
      }
  }
};

DI float dpp_ror1(float v)  { return __builtin_bit_cast(float, __builtin_amdgcn_update_dpp(0, __builtin_bit_cast(int, v), 0x121, 0xf, 0xf, false)); }
DI float dpp_ror15(float v) { return __builtin_bit_cast(float, __builtin_amdgcn_update_dpp(0, __builtin_bit_cast(int, v), 0x12F, 0xf, 0xf, false)); }
struct EpiUp {
  u16* act; const float* cw; const float* cb;
  DI void operator()(const f32x4 (&acc)[2][2][4][2], const pg8::Unit& u, int wr, int wc, int fr, int fq) const {
    const int b = u.pm / 67, ti = u.pm % 67;
#pragma unroll
    for (int n = 0; n < 2; ++n) {
      const int col = u.pn * 128 + wc * 32 + n * 16 + 4 * fq;
      const f32x4 w0 = *(const f32x4*)(cw + col), w1 = *(const f32x4*)(cw + DFF + col), w2 = *(const f32x4*)(cw + 2 * DFF + col), bb = *(const f32x4*)(cb + col);
#pragma unroll
      for (int ai = 0; ai < 2; ++ai) {
        const int tokb = 248 * ti - 1 + 62 * (2 * ai + wr);
        f32x4 g[4];
#pragma unroll
        for (int m = 0; m < 4; ++m) {
          const int tok = tokb + 16 * m + fr;
          const bool ok = (tok >= 0) && (tok < S);
#pragma unroll
          for (int e = 0; e < 4; ++e) g[m][e] = ok ? acc[ai][0][m][n][e] : 0.f;
        }
#pragma unroll
        for (int m = 0; m < 4; ++m) {
          const int q = 16 * m + fr, tok = tokb + q;
          f32x4 r;
#pragma unroll
          for (int e = 0; e < 4; ++e) {
            const float srcm = (fr == 15 && m > 0) ? g[m > 0 ? m - 1 : 0][e] : g[m][e];
            const float srcp = (fr == 0 && m < 3) ? g[m < 3 ? m + 1 : 3][e] : g[m][e];
            const float gm = dpp_ror1(srcm), gp = dpp_ror15(srcp);
            const float cv = bb[e] + w0[e] * gm + w1[e] * g[m][e] + w2[e] * gp;
            r[e] = cv * __builtin_amdgcn_rcpf(1.f + exp2_hw(-LOG2E * cv)) * acc[ai][1][m][n][e];
          }
          if (q >= 1 && q <= 62 && tok < S)
            *(uint2*)(act + (size_t)(b * S + tok) * DFF + col) = make_uint2(pack2(r[0], r[1]), pack2(r[2], r[3]));
        }
      }
    }
  }
};

constexpr int VROW = 96;
constexpr int VT_WAVE = 64 * VROW;
DI bf16x8 v_frag_tr(const u16* Vb, int kb0, int mb, int sp, int lane) {
  const int i16 = lane & 15, q = i16 >> 2, pp = i16 & 3, blk = (lane >> 4) & 1, hh = lane >> 5;
  const u16* a0 = Vb + (kb0 + 16 * sp + 4 * hh + q) * VROW + (mb * 2 + blk) * 16 + 4 * pp;
  const s16x4 lo = __builtin_amdgcn_ds_read_tr16_b64_v4i16((LAS s16x4*)a0);
  const s16x4 hi = __builtin_amdgcn_ds_read_tr16_b64_v4i16((LAS s16x4*)(a0 + 8 * VROW));
  return __builtin_shufflevector(lo, hi, 0, 1, 2, 3, 4, 5, 6, 7);
}

template <int MODE>
DI void local_attn_item(KP p, int layer, int item, u16* sm) {
  const int tid = otid(), lane = tid & 63, w = __builtin_amdgcn_readfirstlane(tid >> 6), r = lane & 31, hh = lane >> 5;
  u16* Vw = sm + w * VT_WAVE;
  const int unit = item * NWAVE + w;
  const int b = unit / (6 * 512), rem = unit % (6 * 512), head = rem / 512, u = rem % 512;
  const u16* prow = p.proj + (size_t)b * S * NPROJ;
  int tq, qcol, kcol, vcol, niter, ocol;
  int t0 = 0, rr = 0, half = 0, row_start = 0;
  if (MODE == 0) {
    const int res = u & 15, chunk = u >> 4;
    t0 = res + 512 * chunk; tq = t0 + 16 * r;
    qcol = 768 + head * 64; kcol = 1152 + head * 64; vcol = 1536 + head * 64; niter = 17; ocol = 256 + head * 64;
  } else {
    rr = u >> 1; half = u & 1; tq = rr * 64 + half * 32 + r;
    row_start = rr - 4; row_start = row_start < 0 ? 0 : (row_start > 248 ? 248 : row_start);
    qcol = 1920 + head * 64; kcol = 2304 + head * 64; vcol = 2688 + head * 64; niter = 8; ocol = 640 + head * 64;
  }
  const float* rpb = p.na_rpb + ((size_t)layer * 6 + head) * 15 * 31;
  bf16x8 qf[4];
#pragma unroll
  for (int s = 0; s < 4; ++s) qf[s] = *(const bf16x8*)(prow + (size_t)tq * NPROJ + qcol + s * 16 + 8 * hh);

  auto geom = [&](int kbi, int& kbase, int& kstride, int& lim) __attribute__((always_inline)) {
    if (MODE == 0) {
      if (kbi < 20) { kstride = 1; kbase = t0 - 64 + kbi * 32; lim = 64; }
      else if (kbi < 28) { kstride = 4; kbase = t0 - 256 + 4 * (kbi - 20) * 32; lim = 256; }
      else if (kbi < 33) { kstride = 16; kbase = t0 - 1024 + 16 * (kbi - 28) * 32; lim = 1024; }
      else { kstride = 1; kbase = t0; lim = -1; }
    } else {
      kstride = 1; kbase = (row_start + (kbi >> 1)) * 64 + (kbi & 1) * 32; lim = 0;
    }
  };
  bf16x8 kfa[4], kfb[4];
  auto load_k = [&](int kbi, bf16x8 (&kf)[4]) __attribute__((always_inline)) {
    int kbase, kstride, lim; geom(kbi, kbase, kstride, lim);
    int kt = kbase + kstride * r; kt = kt < 0 ? 0 : (kt > S - 1 ? S - 1 : kt);
#pragma unroll
    for (int s = 0; s < 4; ++s) kf[s] = *(const bf16x8*)(prow + (size_t)kt * NPROJ + kcol + s * 16 + 8 * hh);
  };
  auto load_v1 = [&](int kbi, int i) __attribute__((always_inline)) -> uint4 {
    int kbase, kstride, lim; geom(kbi, kbase, kstride, lim);
    const int id = lane + i * 64, key = id >> 3, ch = id & 7;
    int vt = kbase + kstride * key; vt = vt < 0 ? 0 : (vt > S - 1 ? S - 1 : vt);
    return *(const uint4*)(prow + (size_t)vt * NPROJ + vcol + ch * 8);
  };
  f32x16 O[2];
#pragma unroll
  for (int mb = 0; mb < 2; ++mb)
#pragma unroll
    for (int i = 0; i < 16; ++i) O[mb][i] = 0.f;
  float m_run = NEGBIG, l_run = 0.f;
  load_k(0, kfa); load_k(1, kfb);
  for (int it = 0; it < niter; ++it) {
    uint4 va0, va1, va2, va3, vb0, vb1, vb2, vb3;
    if (MODE == 0) {
      va0 = load_v1(2 * it, 0); va1 = load_v1(2 * it, 1); va2 = load_v1(2 * it, 2); va3 = load_v1(2 * it, 3);
      vb0 = load_v1(2 * it + 1, 0); vb1 = load_v1(2 * it + 1, 1); vb2 = load_v1(2 * it + 1, 2); vb3 = load_v1(2 * it + 1, 3);
    }
    f32x16 Sc[2];
#pragma unroll
    for (int i = 0; i < 16; ++i) { Sc[0][i] = 0.f; Sc[1][i] = 0.f; }
#pragma unroll
    for (int s = 0; s < 4; ++s) { Sc[0] = MFMA32(kfa[s], qf[s], Sc[0]); Sc[1] = MFMA32(kfb[s], qf[s], Sc[1]); }
    int kbase0, kstride0, lim0, kbase1, kstride1, lim1;
    geom(2 * it, kbase0, kstride0, lim0); geom(2 * it + 1, kbase1, kstride1, lim1);
    float sv[2][16]; float tmax = NEGBIG;
#pragma unroll
    for (int h2 = 0; h2 < 2; ++h2)
#pragma unroll
      for (int i = 0; i < 16; ++i) {
        const int kk = crow(i, hh);
        const int kt = (h2 ? kbase1 : kbase0) + (h2 ? kstride1 : kstride0) * kk;
        bool valid; float sc = Sc[h2][i];
        if (MODE == 0) {
          int dq = kt - tq; dq = dq < 0 ? -dq : dq;
          valid = ((unsigned)kt < (unsigned)S) && (dq <= (h2 ? lim1 : lim0));
        } else {
          const int kc = kt & 63, krow = kt >> 6, qc = half * 32 + r;
          int cs = qc - 8; cs = cs < 0 ? 0 : (cs > 48 ? 48 : cs);
          valid = (kc >= cs) && (kc < cs + 16);
          int dc = kc - qc; dc = dc < -15 ? -15 : (dc > 15 ? 15 : dc);
          const float* rowp = rpb + (row_start + it - rr + 7) * 31 + 15;
          (void)krow;
          sc += rowp[dc] * LOG2E;
        }
        sv[h2][i] = valid ? sc : NEGBIG; tmax = fmaxf(tmax, sv[h2][i]);
        if (MODE == 1 && i == 15) __builtin_amdgcn_sched_barrier(0);
      }
    tmax = fmaxf(tmax, __shfl_xor(tmax, 32));
    const float m_new = fmaxf(m_run, tmax);
    if (__builtin_amdgcn_ballot_w64(m_new > m_run) != 0ull) {
      const float alpha = exp2_hw(m_run - m_new);
      m_run = m_new; l_run *= alpha;
#pragma unroll
      for (int mb = 0; mb < 2; ++mb)
#pragma unroll
        for (int i = 0; i < 16; ++i) O[mb][i] *= alpha;
    }
    bf16x8 pk[2][2];
#pragma unroll
    for (int h2 = 0; h2 < 2; ++h2)
#pragma unroll
      for (int sp = 0; sp < 2; ++sp) {
        unsigned q4[4];
#pragma unroll
        for (int q = 0; q < 4; ++q) {
          const float s0 = sv[h2][8 * sp + 2 * q], s1 = sv[h2][8 * sp + 2 * q + 1];
          const float p0 = (s0 > -1e29f) ? exp2_hw(s0 - m_run) : 0.f, p1 = (s1 > -1e29f) ? exp2_hw(s1 - m_run) : 0.f;
          l_run += p0; l_run += p1;
          q4[q] = pack2(p0, p1);
        }
        pk[h2][sp] = __builtin_bit_cast(bf16x8, make_uint4(q4[0], q4[1], q4[2], q4[3]));
      }
    __builtin_amdgcn_sched_barrier(0);
    if (MODE == 1) {
      va0 = load_v1(2 * it, 0); va1 = load_v1(2 * it, 1); va2 = load_v1(2 * it, 2); va3 = load_v1(2 * it, 3);
      vb0 = load_v1(2 * it + 1, 0); vb1 = load_v1(2 * it + 1, 1); vb2 = load_v1(2 * it + 1, 2); vb3 = load_v1(2 * it + 1, 3);
    }
    if (it + 1 < niter) { load_k(2 * it + 2, kfa); load_k(2 * it + 3, kfb); }
    {
      u16* vdst = Vw + (lane >> 3) * VROW + (lane & 7) * 8;
      *(uint4*)(vdst) = va0; *(uint4*)(vdst + 8 * VROW) = va1; *(uint4*)(vdst + 16 * VROW) = va2; *(uint4*)(vdst + 24 * VROW) = va3;
      *(uint4*)(vdst + 32 * VROW) = vb0; *(uint4*)(vdst + 40 * VROW) = vb1; *(uint4*)(vdst + 48 * VROW) = vb2; *(uint4*)(vdst + 56 * VROW) = vb3;
    }
#pragma unroll
    for (int h2 = 0; h2 < 2; ++h2)
#pragma unroll
      for (int sp = 0; sp < 2; ++sp)
#pragma unroll
        for (int mb = 0; mb < 2; ++mb) {
          const bf16x8 vf = v_frag_tr(Vw, h2 * 32, mb, sp, lane);
          O[mb] = MFMA32(vf, pk[h2][sp], O[mb]);
        }
  }
  const float l = l_run + __shfl_xor(l_run, 32);
  const float il = 1.f / l;
  u16* op = p.o + (size_t)(b * S + tq) * 1024 + ocol;
#pragma unroll
  for (int mb = 0; mb < 2; ++mb)
#pragma unroll
    for (int g = 0; g < 4; ++g) {
      const int d = mb * 32 + 8 * g + 4 * hh;
      *(uint2*)(op + d) = make_uint2(pack2(O[mb][4 * g] * il, O[mb][4 * g + 1] * il), pack2(O[mb][4 * g + 2] * il, O[mb][4 * g + 3] * il));
    }
}

DI void kmax_item(KP p, int layer, int kidx) {
  const int tid = otid(); const int gid = kidx * NTHR + tid;
  const int row = gid >> 2, head = gid & 3, b = row >> 14;
  const uint4* kp = (const uint4*)(p.proj + (size_t)row * NPROJ + 256 + head * 64);
  float n0 = 0.f, n1 = 0.f;
#pragma unroll
  for (int c = 0; c < 8; ++c) {
    const uint4 v = kp[c];
    const unsigned e[4] = {v.x, v.y, v.z, v.w};
    float s = 0.f;
#pragma unroll
    for (int q = 0; q < 4; ++q) { const float a = bflo(e[q]), bq = bfhi(e[q]); s += a * a + bq * bq; }
    if (c >= 4) n1 += s; else n0 += s;
  }
#pragma unroll
  for (int o = 4; o <= 32; o <<= 1) { n0 = fmaxf(n0, __shfl_xor(n0, o)); n1 = fmaxf(n1, __shfl_xor(n1, o)); }
  if ((tid & 63) < 4) {
    unsigned* km = p.kmax + layer * 16 + (b * 4 + head) * 2;
    atomicMax(km, __float_as_uint(n0)); atomicMax(km + 1, __float_as_uint(n1));
  }
}

DI void phase_local(KP p, int layer, u16* sm) {
  constexpr int N_DIL = 768, N_NA = 768, N_KM = 256;
  for (int it = blockIdx.x; it < N_DIL + N_NA + N_KM; it += gridDim.x) {
    if (it < N_DIL) local_attn_item<0>(p, layer, it, sm);
    else if (it < N_DIL + N_NA) local_attn_item<1>(p, layer, it - N_DIL, sm);
    else kmax_item(p, layer, it - N_DIL - N_NA);
  }
}

constexpr int KS_STRIDE = 72;
constexpr int KS_BUF = 64 * KS_STRIDE, VS_BUF = 64 * VROW;
DI void phase_diff(KP p, int layer, u16* sm) {
  const int tid = otid(), lane = tid & 63, w = __builtin_amdgcn_readfirstlane(tid >> 6), r = lane & 31, hh = lane >> 5;
  u16* Ks = sm; u16* Vs = sm + 2 * KS_BUF;
  float lam;
  {
    const float* dl = p.diff_lambda + layer * 128;
    float a = 0.f, c2 = 0.f;
    if (lane < 32) { a = dl[lane] * dl[32 + lane]; c2 = dl[64 + lane] * dl[96 + lane]; }
    a = wave_sum(a); c2 = wave_sum(c2);
    lam = __expf(a) - __expf(c2) + p.lam_init[layer];
  }
  const float lam_init = p.lam_init[layer];
  const float* sg = p.diff_subln + layer * 64;
  for (int it = blockIdx.x; it < 512; it += gridDim.x) {
    const int bh = it >> 6, qb = it & 63, b = bh >> 2, head = bh & 3;
    const u16* prow = p.proj + (size_t)b * S * NPROJ;
    const int tq = qb * 256 + w * 32 + r;
    bf16x8 qf[2][2];
    float qn[2];
#pragma unroll
    for (int m = 0; m < 2; ++m) {
      qn[m] = 0.f;
#pragma unroll
      for (int s = 0; s < 2; ++s) {
        qf[m][s] = *(const bf16x8*)(prow + (size_t)tq * NPROJ + head * 64 + m * 32 + s * 16 + 8 * hh);
#pragma unroll
        for (int j = 0; j < 8; ++j) { const float v = bf2f((u16)qf[m][s][j]); qn[m] += v * v; }
      }
      qn[m] += __shfl_xor(qn[m], 32);
    }
    float mbnd[2];
#pragma unroll
    for (int m = 0; m < 2; ++m) {
      const float km = __uint_as_float(p.kmax[layer * 16 + bh * 2 + m]);
      mbnd[m] = fmaxf(sqrtf(qn[m] * km) - 100.f, 0.f);
    }
    const bool noshift = __builtin_amdgcn_ballot_w64(mbnd[0] == 0.f && mbnd[1] == 0.f) == ~0ull;
    f32x16 O[2][2];
#pragma unroll
    for (int m = 0; m < 2; ++m)
#pragma unroll
      for (int mb = 0; mb < 2; ++mb)
#pragma unroll
        for (int i = 0; i < 16; ++i) O[m][mb][i] = 0.f;
    float lsum[2] = {0.f, 0.f};
    uint4 kr, vr;
    const int key0 = tid >> 3, ch = tid & 7;
    const u16* kg = prow + (size_t)key0 * NPROJ + 256 + head * 64 + ch * 8;
    auto gload = [&](int kt) __attribute__((always_inline)) {
      const u16* src = kg + (size_t)(kt * 64) * NPROJ;
      kr = *(const uint4*)src; vr = *(const uint4*)(src + 256);
    };
    auto lstore = [&](int buf) __attribute__((always_inline)) {
      *(uint4*)(Ks + buf * KS_BUF + key0 * KS_STRIDE + ch * 8) = kr;
      *(uint4*)(Vs + buf * VS_BUF + key0 * VROW + ch * 8) = vr;
    };
    gload(0); lstore(0);
    __syncthreads();
    if (noshift) {
    for (int kt = 0; kt < 256; ++kt) {
      const int buf = kt & 1;
      if (kt + 1 < 256) gload(kt + 1);
#pragma unroll
      for (int sub = 0; sub < 2; ++sub) {
#pragma unroll
        for (int m = 0; m < 2; ++m) {
          f32x16 Sc;
#pragma unroll
          for (int i = 0; i < 16; ++i) Sc[i] = 0.f;
#pragma unroll
          for (int s = 0; s < 2; ++s) {
            const bf16x8 kf = *(const bf16x8*)(Ks + buf * KS_BUF + (sub * 32 + r) * KS_STRIDE + m * 32 + s * 16 + 8 * hh);
            Sc = MFMA32(kf, qf[m][s], Sc);
          }
          bf16x8 pk[2];
#pragma unroll
          for (int sp = 0; sp < 2; ++sp) {
            unsigned q4[4];
#pragma unroll
            for (int q = 0; q < 4; ++q) {
              const float p0 = exp2_hw(Sc[8 * sp + 2 * q]), p1 = exp2_hw(Sc[8 * sp + 2 * q + 1]);
              lsum[m] += p0; lsum[m] += p1;
              q4[q] = pack2(p0, p1);
            }
            pk[sp] = __builtin_bit_cast(bf16x8, make_uint4(q4[0], q4[1], q4[2], q4[3]));
          }
#pragma unroll
          for (int sp = 0; sp < 2; ++sp)
#pragma unroll
            for (int mb = 0; mb < 2; ++mb) {
              const bf16x8 vf = v_frag_tr(Vs + buf * VS_BUF, sub * 32, mb, sp, lane);
              O[m][mb] = MFMA32(vf, pk[sp], O[m][mb]);
            }
        }
        __builtin_amdgcn_sched_barrier(0);
      }
      if (kt + 1 < 256) lstore(buf ^ 1);
      __syncthreads();
    }
    } else {
    for (int kt = 0; kt < 256; ++kt) {
      const int buf = kt & 1;
      if (kt + 1 < 256) gload(kt + 1);
#pragma unroll
      for (int sub = 0; sub < 2; ++sub) {
#pragma unroll
        for (int m = 0; m < 2; ++m) {
          f32x16 Sc;
#pragma unroll
          for (int i = 0; i < 16; ++i) Sc[i] = 0.f;
#pragma unroll
          for (int s = 0; s < 2; ++s) {
            const bf16x8 kf = *(const bf16x8*)(Ks + buf * KS_BUF + (sub * 32 + r) * KS_STRIDE + m * 32 + s * 16 + 8 * hh);
            Sc = MFMA32(kf, qf[m][s], Sc);
          }
          bf16x8 pk[2];
#pragma unroll
          for (int sp = 0; sp < 2; ++sp) {
            unsigned q4[4];
#pragma unroll
            for (int q = 0; q < 4; ++q) {
              const float p0 = exp2_hw(Sc[8 * sp + 2 * q] - mbnd[m]), p1 = exp2_hw(Sc[8 * sp + 2 * q + 1] - mbnd[m]);
              lsum[m] += p0; lsum[m] += p1;
              q4[q] = pack2(p0, p1);
            }
            pk[sp] = __builtin_bit_cast(bf16x8, make_uint4(q4[0], q4[1], q4[2], q4[3]));
          }
#pragma unroll
          for (int sp = 0; sp < 2; ++sp)
#pragma unroll
            for (int mb = 0; mb < 2; ++mb) {
              const bf16x8 vf = v_frag_tr(Vs + buf * VS_BUF, sub * 32, mb, sp, lane);
              O[m][mb] = MFMA32(vf, pk[sp], O[m][mb]);
            }
        }
        __builtin_amdgcn_sched_barrier(0);
      }
      if (kt + 1 < 256) lstore(buf ^ 1);
      __syncthreads();
    }
    }
    const float l0 = lsum[0] + __shfl_xor(lsum[0], 32);
    const float l1 = lsum[1] + __shfl_xor(lsum[1], 32);
    const float i0 = 1.f / l0, i1 = lam / l1;
    float ss = 0.f;
#pragma unroll
    for (int mb = 0; mb < 2; ++mb)
#pragma unroll
      for (int i = 0; i < 16; ++i) { const float v = O[0][mb][i] * i0 - O[1][mb][i] * i1; O[0][mb][i] = v; ss += v * v; }
    ss += __shfl_xor(ss, 32);
    const float inv = rsqrtf(ss * (1.f / 64.f) + 1e-6f) * (1.f - lam_init);
    u16* op = p.o + (size_t)(b * S + tq) * 1024 + head * 64;
#pragma unroll
    for (int mb = 0; mb < 2; ++mb)
#pragma unroll
      for (int g = 0; g < 4; ++g) {
        const int d = mb * 32 + 8 * g + 4 * hh;
        const float4 g4 = *(const float4*)(sg + d);
        *(uint2*)(op + d) = make_uint2(pack2(O[0][mb][4 * g] * inv * g4.x, O[0][mb][4 * g + 1] * inv * g4.y),
                                       pack2(O[0][mb][4 * g + 2] * inv * g4.z, O[0][mb][4 * g + 3] * inv * g4.w));
      }
  }
}

DI void phase_proj(KP p, int layer, LAS unsigned char* lds) {
  pg8::StaticOrder so; so.init(128, 12, gridDim.x, blockIdx.x);
  EpiProj e; e.proj = p.proj;
  pg8::gemm_phase<pg8::AMapPlain>(lds, p.h, p.wt_in + (size_t)layer * 3072 * 1024, 1024, so, e);
}
DI void phase_resid(const u16* A, int K, const u16* Bt, const float* xold, float* xnew, const float* gate, LAS unsigned char* lds) {
  pg8::StaticOrder so; so.init(128, 4, gridDim.x, blockIdx.x);
  EpiResid e; e.xold = xold; e.xnew = xnew; e.gate = gate;
  pg8::gemm_phase<pg8::AMapPlain>(lds, A, Bt, K, so, e);
}
DI void phase_up(KP p, int layer, LAS unsigned char* lds) {
  pg8::StaticOrder so; so.init(134, 22, gridDim.x, blockIdx.x);
  EpiUp e; e.act = p.act; e.cw = p.conv_w + (size_t)layer * 3 * DFF; e.cb = p.conv_b + (size_t)layer * DFF;
  pg8::gemm_phase<pg8::AMapHalo>(lds, p.h, p.wt_up + (size_t)layer * 5632 * 1024, 1024, so, e);
}

constexpr int N_PHASES = 18;

DI void run_phase(KP p, int ph, unsigned char* smraw) {
  u16* sm = (u16*)smraw;
  LAS unsigned char* lds = (LAS unsigned char*)smraw;
  if (ph == 0) { phase_prep(p, (float*)smraw); return; }
  if (ph == 17) { phase_norm<1>(p.out, p.g_final, nullptr, 0, 0, nullptr, p.out); return; }
  const int layer = (ph - 1) >> 3, sub = (ph - 1) & 7;
  const float* modl = p.mod + layer * 2 * 6144;
  const float* xcur = (layer == 0) ? p.x : p.out;
  switch (sub) {
    case 0: phase_norm<0>(xcur, p.g_attn + layer * 1024, modl, 0, 1024, p.h, nullptr); break;
    case 1: phase_proj(p, layer, lds); break;
    case 2: phase_local(p, layer, sm); break;
    case 3: phase_diff(p, layer, sm); break;
    case 4: phase_resid(p.o, 1024, p.wt_out + (size_t)layer * 1024 * 1024, xcur, p.out, modl + 2048, lds); break;
    case 5: phase_norm<0>(p.out, p.g_ffn + layer * 1024, modl, 3072, 4096, p.h, nullptr); break;
    case 6: phase_up(p, layer, lds); break;
    case 7: phase_resid(p.act, DFF, p.wt_down + (size_t)layer * 1024 * DFF, p.out, p.out, modl + 5120, lds); break;
  }
}

__global__ void __launch_bounds__(NTHR, 2) mega_kernel(Params p) {
  __shared__ __attribute__((aligned(16))) unsigned char smraw[LDS_BYTES];
#if COOP
  __shared__ uint4 xb_words;
  cg::grid_group grid = cg::this_grid();
  u16* sm = (u16*)smraw;
  LAS unsigned char* lds = (LAS unsigned char*)smraw;
  if (threadIdx.x == 0) xb_words = make_uint4(0u, 0u, 0u, 0u);
  __syncthreads();
  const XcdBarrier xb = xcd_barrier_post(kp_fresh()->bar, (volatile LAS unsigned*)&xb_words);
  phase_prep(*kp_fresh(), (float*)smraw);
  grid.sync();
#pragma unroll 1
  for (int layer = 0; layer < 2; ++layer) {
    { KP q = *kp_fresh(); phase_norm<0>((layer == 0) ? q.x : q.out, q.g_attn + layer * 1024, q.mod + layer * 2 * 6144, 0, 1024, q.h, nullptr); } xcd_barrier(xb);
    phase_proj(*kp_fresh(), layer, lds); xcd_barrier(xb);
    phase_local(*kp_fresh(), layer, sm); xcd_barrier(xb);
    phase_diff(*kp_fresh(), layer, sm); xcd_barrier(xb);
    { KP q = *kp_fresh(); phase_resid(q.o, 1024, q.wt_out + (size_t)layer * 1024 * 1024, (layer == 0) ? q.x : q.out, q.out, q.mod + layer * 2 * 6144 + 2048, lds); } xcd_barrier(xb);
    { KP q = *kp_fresh(); phase_norm<0>(q.out, q.g_ffn + layer * 1024, q.mod + layer * 2 * 6144, 3072, 4096, q.h, nullptr); } xcd_barrier(xb);
    phase_up(*kp_fresh(), layer, lds); xcd_barrier(xb);
    { KP q = *kp_fresh(); phase_resid(q.act, DFF, q.wt_down + (size_t)layer * 1024 * DFF, q.out, q.out, q.mod + layer * 2 * 6144 + 5120, lds); } xcd_barrier(xb);
  }
  { KP q = *kp_fresh(); phase_norm<1>(q.out, q.g_final, nullptr, 0, 0, nullptr, q.out); }
#else
  { KP q = *kp_fresh(); for (int ph = q.ph_lo; ph < q.ph_hi; ++ph) run_phase(q, ph, smraw); }
#endif
}

extern "C" void kernel_launch(void* const* d_in, const int* in_sizes, int n_in, void* d_out, int out_size, void* d_ws, size_t ws_size, hipStream_t stream) {
  (void)in_sizes; (void)n_in; (void)out_size;
  Params p;
  memset(&p, 0, sizeof(p));
  p.x = (const float*)d_in[0]; p.c = (const float*)d_in[1]; p.w_ada = (const float*)d_in[2]; p.b_ada = (const float*)d_in[3];
  p.g_attn = (const float*)d_in[4]; p.w_in = (const float*)d_in[5]; p.diff_lambda = (const float*)d_in[6]; p.diff_subln = (const float*)d_in[7];
  p.na_rpb = (const float*)d_in[8]; p.w_out = (const float*)d_in[9]; p.g_ffn = (const float*)d_in[10]; p.w_up = (const float*)d_in[11];
  p.conv_w = (const float*)d_in[12]; p.conv_b = (const float*)d_in[13]; p.w_down = (const float*)d_in[14]; p.g_final = (const float*)d_in[15];
  p.out = (float*)d_out;
  char* ws = (char*)d_ws; size_t off = 0;
  auto take = [&](size_t bytes) { char* q = ws + off; off += (bytes + 255) & ~(size_t)255; return q; };
  p.wt_in = (u16*)take((size_t)2 * 3072 * 1024 * 2);
  p.wt_out = (u16*)take((size_t)2 * 1024 * 1024 * 2);
  p.wt_up = (u16*)take((size_t)2 * 5632 * 1024 * 2);
  p.wt_down = (u16*)take((size_t)2 * 1024 * 2816 * 2);
  p.mod = (float*)take((size_t)2 * 2 * 6144 * 4);
  p.kmax = (unsigned*)take(256);
  p.bar = (unsigned*)take((size_t)XCD_BAR_WORDS * 4);
  (void)take(4096);
  p.h = (u16*)take((size_t)NTOK * 1024 * 2);
  p.o = (u16*)take((size_t)NTOK * 1024 * 2);
  p.proj = (u16*)take((size_t)NTOK * NPROJ * 2);
  p.act = p.proj;
  if (off > ws_size) { fprintf(stderr, "workspace too small: need %zu have %zu\n", off, ws_size); return; }
  p.lam_init[0] = 0.2f; p.lam_init[1] = 0.35550906759096934f;
  static int grid_blocks = 0;
  if (!grid_blocks) {
    int dev = 0, cus = 0, per_cu = 0;
    (void)hipGetDevice(&dev);
    (void)hipDeviceGetAttribute(&cus, hipDeviceAttributeMultiprocessorCount, dev);
    (void)hipOccupancyMaxActiveBlocksPerMultiprocessor(&per_cu, mega_kernel, NTHR, 0);
    if (per_cu > 1) per_cu = 1;
    if (per_cu < 1) per_cu = 1;
    grid_blocks = cus * per_cu;
  }
#if COOP
  p.ph_lo = 0; p.ph_hi = N_PHASES;
  (void)hipMemsetAsync(p.bar, 0, (size_t)XCD_BAR_WORDS * 4, stream);
  void* args[] = {&p};
  hipError_t e = hipLaunchCooperativeKernel((void*)mega_kernel, dim3(grid_blocks), dim3(NTHR), args, 0, stream);
  if (e != hipSuccess) fprintf(stderr, "cooperative launch failed: %s (grid %d)\n", hipGetErrorString(e), grid_blocks);
#else
  for (int ph = 0; ph < N_PHASES; ++ph) {
    p.ph_lo = ph; p.ph_hi = ph + 1;
    hipLaunchKernelGGL(mega_kernel, dim3(grid_blocks), dim3(NTHR), 0, stream, p);
  }
#endif
}
```

```cpp
#include <hip/hip_runtime.h>
#include <hip/hip_cooperative_groups.h>
#include <cstdio>
#include <cstring>
namespace cg = cooperative_groups;

#ifndef COOP
#define COOP 1
#endif

#define DI __device__ __forceinline__
#define LAS __attribute__((address_space(3)))
typedef unsigned short u16;
using bf16x8 = __attribute__((ext_vector_type(8))) short;
using s16x4  = __attribute__((ext_vector_type(4))) short;
using f32x16 = __attribute__((ext_vector_type(16))) float;
using f32x4  = __attribute__((ext_vector_type(4))) float;
typedef __bf16 bf2_t __attribute__((ext_vector_type(2)));
typedef float f2_t __attribute__((ext_vector_type(2)));
#define MFMA32(a, b, c) __builtin_amdgcn_mfma_f32_32x32x16_bf16((a), (b), (c), 0, 0, 0)

constexpr int S = 16384, NTOK = 32768, DFF = 2816, NPROJ = 3072;
constexpr int NTHR = 512, NWAVE = 8;
constexpr float LOG2E = 1.4426950408889634f;
constexpr float QSCALE_DIFF = 0.25503486164919736f;
constexpr float QSCALE_64   = 0.18033688011112042f;
constexpr float NEGBIG = -1e30f;
constexpr int LDS_BYTES = 131072;

__device__ const float ROPE_INV16[16] = {
1.000000000e+00f, 5.623413324e-01f, 3.162277639e-01f, 1.778279394e-01f, 1.000000015e-01f, 5.623413250e-02f, 3.162277490e-02f, 1.778279431e-02f, 9.999999776e-03f, 5.623413250e-03f, 3.162277630e-03f, 1.778279431e-03f, 1.000000047e-03f, 5.623413017e-04f, 3.162277571e-04f, 1.778279402e-04f};
__device__ const float ROPE_INV32[32] = {
1.000000000e+00f, 7.498942018e-01f, 5.623413324e-01f, 4.216965139e-01f, 3.162277639e-01f, 2.371373773e-01f, 1.778279394e-01f, 1.333521456e-01f, 1.000000015e-01f, 7.498942316e-02f, 5.623413250e-02f, 4.216964915e-02f, 3.162277490e-02f, 2.371373773e-02f, 1.778279431e-02f, 1.333521400e-02f, 9.999999776e-03f, 7.498942316e-03f, 5.623413250e-03f, 4.216964822e-03f, 3.162277630e-03f, 2.371373819e-03f, 1.778279431e-03f, 1.333521446e-03f, 1.000000047e-03f, 7.498941850e-04f, 5.623413017e-04f, 4.216965172e-04f, 3.162277571e-04f, 2.371373703e-04f, 1.778279402e-04f, 1.333521504e-04f};

struct Params {
  const float *x, *c, *w_ada, *b_ada, *g_attn, *w_in, *diff_lambda, *diff_subln, *na_rpb, *w_out, *g_ffn, *w_up, *conv_w, *conv_b, *w_down, *g_final;
  float* out;
  u16 *wt_in, *wt_out, *wt_up, *wt_down;
  float* mod;
  unsigned* kmax;
  unsigned* bar;
  u16 *h, *o, *proj, *act, *odil;
  float* lse;
  float lam_init[2];
  int ph_lo, ph_hi;
};

typedef const __attribute__((address_space(4))) Params& KP;
DI const __attribute__((address_space(4))) Params* kp_fresh() {
  const __attribute__((address_space(4))) Params* q = (const __attribute__((address_space(4))) Params*)__builtin_amdgcn_kernarg_segment_ptr();
  asm volatile("" : "+s"(q));
  return q;
}
DI unsigned pack2(float a, float b) { f2_t v = {a, b}; return __builtin_bit_cast(unsigned, __builtin_convertvector(v, bf2_t)); }
DI float bf2f(u16 v) { return __uint_as_float(((unsigned)v) << 16); }
DI float bflo(unsigned v) { return __uint_as_float(v << 16); }
DI float bfhi(unsigned v) { return __uint_as_float(v & 0xffff0000u); }
DI int crow(int i, int hh) { return (i & 3) + 8 * (i >> 2) + 4 * hh; }
DI float exp2_hw(float x) { return __builtin_amdgcn_exp2f(x); }
DI int otid() { int t = threadIdx.x; asm volatile("" : "+v"(t)); return t; }


#define XB_TMO      128
#define XB_XCNT(j)  (256  + 64 * (j))
#define XB_XSUB(j)  (1280 + 64 * (j))
#define XB_XGEN(j)  (2304 + 64 * (j))
#define XB_TOP      3328
#define XB_TOPGEN   3392
#define XCD_BAR_WORDS 3456
#define XB_SPIN_CAP (1u << 21)
DI unsigned xb_ld(unsigned* p)              { return __hip_atomic_load(p, __ATOMIC_RELAXED, __HIP_MEMORY_SCOPE_AGENT); }
DI unsigned xb_add(unsigned* p, unsigned v) { return __hip_atomic_fetch_add(p, v, __ATOMIC_RELAXED, __HIP_MEMORY_SCOPE_AGENT); }
DI unsigned xb_xcc_id() { return (unsigned)__builtin_amdgcn_s_getreg((3 << 11) | 20) & 0xFu; }
#define XB_SPIN(cond, bar) do { unsigned _sp = 0; while (cond) { __builtin_amdgcn_s_sleep(1); \
    if ((++_sp & 255u) == 0u) { if (xb_ld(&(bar)[XB_TMO])) break; if (_sp > XB_SPIN_CAP) { atomicAdd(&(bar)[XB_TMO], 1u); break; } } } } while (0)
struct XcdBarrier { unsigned* bar; unsigned x; volatile LAS unsigned* st; };
DI XcdBarrier xcd_barrier_post(unsigned* bar, volatile LAS unsigned* st) {
  XcdBarrier b; b.bar = bar; b.x = xb_xcc_id(); b.st = st;
  if (threadIdx.x == 0) (void)xb_add(&bar[XB_XCNT(b.x)], 1u);
  return b;
}
DI void xcd_barrier_complete(unsigned* bar, unsigned x, unsigned& nloc, unsigned& nx) {
  const unsigned G = gridDim.x * gridDim.y * gridDim.z;
  unsigned sum, cnt, mine, sp = 0u;
  for (;;) {
    sum = 0u; cnt = 0u; mine = 0u;
#pragma unroll
    for (unsigned j = 0; j < 16; ++j) { const unsigned c = xb_ld(&bar[XB_XCNT(j)]); sum += c; cnt += (c > 0u) ? 1u : 0u; mine = (j == x) ? c : mine; }
    if (sum == G) break;
    __builtin_amdgcn_s_sleep(1);
    if ((++sp & 255u) == 0u) { if (xb_ld(&bar[XB_TMO])) break; if (sp > XB_SPIN_CAP) { atomicAdd(&bar[XB_TMO], 1u); break; } }
  }
  nloc = mine > 0u ? mine : 1u; nx = cnt > 0u ? cnt : 1u;
}
DI void xcd_barrier(const XcdBarrier& b) {
  asm volatile("s_waitcnt vmcnt(0)" ::: "memory");
  __syncthreads();
  if (threadIdx.x == 0) {
    unsigned* bar = b.bar;
    __builtin_amdgcn_s_waitcnt(0);
    unsigned nloc = b.st[0], nx = b.st[1];
    if (nloc == 0u) { xcd_barrier_complete(bar, b.x, nloc, nx); b.st[0] = nloc; b.st[1] = nx; }
    const unsigned old = xb_add(&bar[XB_XSUB(b.x)], 1u);
    const unsigned gen = old / nloc;
    if (old + 1u == (gen + 1u) * nloc) {
      __builtin_amdgcn_fence(__ATOMIC_RELEASE, "agent");
      asm volatile("s_waitcnt vmcnt(0)" ::: "memory");
      const unsigned og = xb_add(&bar[XB_TOP], 1u);
      const unsigned tg = og / nx;
      if (og + 1u == (tg + 1u) * nx) xb_add(&bar[XB_TOPGEN], 1u);
      else XB_SPIN(xb_ld(&bar[XB_TOPGEN]) == tg, bar);
      __builtin_amdgcn_fence(__ATOMIC_ACQUIRE, "agent");
      xb_add(&bar[XB_XGEN(b.x)], 1u);
      asm volatile("s_waitcnt vmcnt(0)" ::: "memory");
    } else {
      XB_SPIN(xb_ld(&bar[XB_XGEN(b.x)]) == gen, bar);
      __builtin_amdgcn_fence(__ATOMIC_ACQUIRE, "agent");
      asm volatile("s_waitcnt vmcnt(0)" ::: "memory");
    }
  }
  __syncthreads();
}

DI int wmap_in(int np) {
  if (np >= 768 && np < 1536) { const int hb = np & ~63, w = np & 63, g = w >> 5, n = (w >> 4) & 1, i = w & 15; return hb + 16 * g + i + 32 * n; }
  return np;
}
DI int wmap_up(int np) {
  const int pn = np >> 8, w = np & 255, bj = w >> 7, q = w & 127;
  return bj ? (DFF + 128 * pn + q) : (128 * pn + q);
}

DI void phase_prep(KP p, float* smf) {
  const int tid = otid();
  if (blockIdx.x == 0 && tid < 64) p.kmax[tid] = 0u;
  constexpr int N_ADA = 192;
  constexpr int T_IN = 16 * 24, T_OUT = 16 * 8, T_UP = 16 * 44, T_DOWN = 44 * 8;
  constexpr int T_LAYER = T_IN + T_OUT + T_UP + T_DOWN;
  const int total = N_ADA + 2 * T_LAYER;
  for (int it = blockIdx.x; it < total; it += gridDim.x) {
    if (it < N_ADA) {
      const int l = it / 96, cgp = it % 96;
      float* sc = smf;
      float* red = smf + 2048;
      for (int i = tid; i < 2048; i += NTHR) { float v = p.c[i]; sc[i] = v / (1.f + __expf(-v)); }
      __syncthreads();
      const int kq = tid >> 6, cc = tid & 63, col = cgp * 64 + cc;
      const float* wp = p.w_ada + ((size_t)l * 1024 + kq * 128) * 6144 + col;
      float a0 = 0.f, a1 = 0.f;
#pragma unroll 8
      for (int k = 0; k < 128; ++k) { float w = wp[(size_t)k * 6144]; a0 += sc[kq * 128 + k] * w; a1 += sc[1024 + kq * 128 + k] * w; }
      red[(kq * 2 + 0) * 64 + cc] = a0; red[(kq * 2 + 1) * 64 + cc] = a1;
      __syncthreads();
      if (tid < 128) {
        const int b = tid >> 6, c2 = tid & 63;
        float s = 0.f;
#pragma unroll
        for (int q = 0; q < 8; ++q) s += red[(q * 2 + b) * 64 + c2];
        p.mod[(l * 2 + b) * 6144 + cgp * 64 + c2] = s + p.b_ada[l * 6144 + cgp * 64 + c2];
      }
    } else {
      int idx = it - N_ADA; const int l = idx / T_LAYER; int j = idx % T_LAYER;
      const float* W; u16* dst; int Kd, N, tk, tn, kind;
      if (j < T_IN) { W = p.w_in + (size_t)l * 1024 * 3072; dst = p.wt_in + (size_t)l * 3072 * 1024; Kd = 1024; N = 3072; tk = j / 24; tn = j % 24; kind = 0; }
      else if (j < T_IN + T_OUT) { j -= T_IN; W = p.w_out + (size_t)l * 1024 * 1024; dst = p.wt_out + (size_t)l * 1024 * 1024; Kd = 1024; N = 1024; tk = j / 8; tn = j % 8; kind = 1; }
      else if (j < T_IN + T_OUT + T_UP) { j -= T_IN + T_OUT; W = p.w_up + (size_t)l * 1024 * 5632; dst = p.wt_up + (size_t)l * 5632 * 1024; Kd = 1024; N = 5632; tk = j / 44; tn = j % 44; kind = 2; }
      else { j -= T_IN + T_OUT + T_UP; W = p.w_down + (size_t)l * 2816 * 1024; dst = p.wt_down + (size_t)l * 1024 * 2816; Kd = 2816; N = 1024; tk = j / 8; tn = j % 8; kind = 3; }
      const int hb = tid >> 8, t = tid & 255;
      const int k0 = tk * 64, n0 = (tn * 2 + hb) * 64;
      float* tile = smf + hb * (64 * 65);
      const int nn = t & 63;
      const int np = n0 + nn;
      const int srccol = (kind == 0) ? wmap_in(np) : (kind == 2) ? wmap_up(np) : np;
#pragma unroll 4
      for (int i = 0; i < 16; ++i) { const int kk = i * 4 + (t >> 6); tile[kk * 65 + nn] = W[(size_t)(k0 + kk) * N + srccol]; }
      __syncthreads();
      const int nrow = t >> 2, kc = (t & 3) * 16;
      unsigned pk[8];
#pragma unroll
      for (int q = 0; q < 8; ++q) pk[q] = pack2(tile[(kc + 2 * q) * 65 + nrow], tile[(kc + 2 * q + 1) * 65 + nrow]);
      uint4* dp = (uint4*)(dst + (size_t)(n0 + nrow) * Kd + k0 + kc);
      dp[0] = make_uint4(pk[0], pk[1], pk[2], pk[3]);
      dp[1] = make_uint4(pk[4], pk[5], pk[6], pk[7]);
    }
    __syncthreads();
  }
}

DI float wave_sum(float v) {
#pragma unroll
  for (int o = 32; o >= 1; o >>= 1) v += __shfl_xor(v, o);
  return v;
}

template <int MODE>
DI void phase_norm(const float* xin, const float* g, const float* modl, int sh_off, int sc_off, u16* hout, float* fout) {
  const int tid = otid(); const int lane = tid & 63, w = tid >> 6;
  for (int row = blockIdx.x * NWAVE + w; row < NTOK; row += gridDim.x * NWAVE) {
    const int b = row >> 14;
    const float4* xr = (const float4*)(xin + (size_t)row * 1024);
    float4 v[4];
#pragma unroll
    for (int i = 0; i < 4; ++i) v[i] = xr[lane + i * 64];
    float ss = 0.f;
#pragma unroll
    for (int i = 0; i < 4; ++i) ss += v[i].x * v[i].x + v[i].y * v[i].y + v[i].z * v[i].z + v[i].w * v[i].w;
    ss = wave_sum(ss);
    const float inv = rsqrtf(ss * (1.f / 1024.f) + 1e-6f);
#pragma unroll
    for (int i = 0; i < 4; ++i) {
      const int col = (lane + i * 64) * 4;
      const float4 g4 = *(const float4*)(g + col);
      if (MODE == 0) {
        const float4 sc4 = *(const float4*)(modl + b * 6144 + sc_off + col);
        const float4 sh4 = *(const float4*)(modl + b * 6144 + sh_off + col);
        float y0 = v[i].x * inv * g4.x * (1.f + sc4.x) + sh4.x;
        float y1 = v[i].y * inv * g4.y * (1.f + sc4.y) + sh4.y;
        float y2 = v[i].z * inv * g4.z * (1.f + sc4.z) + sh4.z;
        float y3 = v[i].w * inv * g4.w * (1.f + sc4.w) + sh4.w;
        *(uint2*)(hout + (size_t)row * 1024 + col) = make_uint2(pack2(y0, y1), pack2(y2, y3));
      } else {
        float4 y; y.x = v[i].x * inv * g4.x; y.y = v[i].y * inv * g4.y; y.z = v[i].z * inv * g4.z; y.w = v[i].w * inv * g4.w;
        *(float4*)(fout + (size_t)row * 1024 + col) = y;
      }
    }
  }
}

namespace pg8 {
constexpr int BM = 256, BK = 64, HALF = 128, HTB = HALF * BK * 2, NXCD = 8, WGM = 8;
DI int lds_byte(int r, int c) { const int st = (r >> 4) * 2 + (c >> 5), rr = r & 15, cc = c & 31, ob = rr * 64 + cc * 2; return st * 1024 + (ob ^ (((ob >> 9) & 1) << 5)); }
DI void stage_rc(int b, int& R, int& C) { const int st = b / 1024, sb = b % 1024, swz = sb ^ (((sb >> 9) & 1) << 5); R = (st >> 1) * 16 + swz / 64; C = (st & 1) * 32 + (swz % 64) / 2; }
struct Unit { int pm, pn; };
struct StaticOrder {
  int nM, nN, nwg, G, c;
  DI void init(int nM_, int nN_, int G_, int c_) { nM = nM_; nN = nN_; nwg = nM * nN; G = G_; c = c_; }
  DI bool next(int i, Unit& u) const {
    const long L = (long)i * G + c; if (L >= nwg) return false;
    int wgid = (int)L; { const int q = nwg / NXCD, r = nwg % NXCD, xcd = wgid % NXCD, off = wgid / NXCD; wgid = (xcd < r ? xcd * (q + 1) : r * (q + 1) + (xcd - r) * q) + off; }
    const int nig = WGM * nN, gid = wgid / nig, fm = gid * WGM, gsz = (nM - fm) < WGM ? (nM - fm) : WGM;
    u.pm = fm + ((wgid % nig) % gsz); u.pn = (wgid % nig) / gsz; return true;
  }
};
struct AMapPlain { static constexpr int HALF_ROWS = 128; static DI int row(int R) { return R; } static DI long tile_row0(int pm) { return (long)pm * 256; } };
struct AMapHalo  { static constexpr int HALF_ROWS = 124; static DI int row(int R) { return 62 * (R >> 6) + (R & 63); } static DI long tile_row0(int pm) { const int b = pm / 67, ti = pm % 67; return (long)b * S + 248 * ti - 1; } };

template <class AMap, class Epi>
DI void gemm_phase(LAS unsigned char* lds, const u16* Aptr, const u16* Btptr, int K, const StaticOrder& SO, const Epi& E) {
  const int tid = otid(), wid = __builtin_amdgcn_readfirstlane(tid >> 6), lane = tid & 63, wr = wid >> 2, wc = wid & 3, fr = lane & 15, fq = lane >> 4;
  const int nt = K / BK;
  unsigned voffA[2], voffB[2];
#pragma unroll
  for (int i = 0; i < 2; ++i) { int R, C; stage_rc(tid * 16 + i * 8192, R, C);
    voffA[i] = (unsigned)(AMap::row(R) * K + C) * 2u; voffB[i] = (unsigned)(R * K + C) * 2u; }
  const size_t kstep = (size_t)(BK * 2);
  const size_t hstepA = (size_t)AMap::HALF_ROWS * K * 2, hstepB = (size_t)HALF * K * 2;
  const size_t tstepB = 2 * hstepB;
  const size_t rowB = (size_t)K * 2;
  const unsigned ldsw = (unsigned)wid * 1024u;
  const int aoff = lds_byte(wr * 64 + fr, fq * 8), boff = lds_byte(wc * 32 + fr, fq * 8);
#define PG8_SA(b, h) (((b) * 2 + (h)) * HTB)
#define PG8_SB(b, h) ((4 + (b) * 2 + (h)) * HTB)
#define PG8_STAGE(bufoff, gbase, voff) do { _Pragma("unroll") for (int _i = 0; _i < 2; ++_i) \
        __builtin_amdgcn_global_load_lds((const unsigned*)((const char*)(gbase) + (voff)[_i]), (LAS unsigned*)(lds + (bufoff) + ldsw + _i * 8192), 16, 0, 0); } while (0)
#define PG8_LDA(dst, b, h) do { _Pragma("unroll") for (int m = 0; m < 4; ++m) _Pragma("unroll") for (int k = 0; k < 2; ++k) dst[m][k] = *(const LAS bf16x8*)(lds + PG8_SA(b, h) + aoff + m * 2048 + k * 1024); } while (0)
#define PG8_LDB(dst, b, h) do { _Pragma("unroll") for (int n = 0; n < 2; ++n) _Pragma("unroll") for (int k = 0; k < 2; ++k) dst[n][k] = *(const LAS bf16x8*)(lds + PG8_SB(b, h) + boff + n * 2048 + k * 1024); } while (0)
#define PG8_MMA(ai, bj, At, Bt) do { __builtin_amdgcn_s_setprio(1); _Pragma("unroll") for (int m = 0; m < 4; ++m) _Pragma("unroll") for (int n = 0; n < 2; ++n) _Pragma("unroll") for (int k = 0; k < 2; ++k) \
        acc[ai][bj][m][n] = __builtin_amdgcn_mfma_f32_16x16x32_bf16(Bt[n][k], At[m][k], acc[ai][bj][m][n], 0, 0, 0); __builtin_amdgcn_s_setprio(0); } while (0)
#define PG8_WAIT_V(n) asm volatile("s_waitcnt vmcnt(" #n ")" ::: "memory")
#define PG8_WAIT_L(n) asm volatile("s_waitcnt lgkmcnt(" #n ")" ::: "memory")
#define PG8_BAR __builtin_amdgcn_s_barrier()
#define PG8_SCHED __builtin_amdgcn_sched_barrier(0)
  Unit cur, nxt; int ui = 0;
  if (!SO.next(0, cur)) return;
  f32x4 acc[2][2][4][2];
#pragma unroll
  for (int a = 0; a < 2; ++a)
#pragma unroll
    for (int b = 0; b < 2; ++b)
#pragma unroll
      for (int m = 0; m < 4; ++m)
#pragma unroll
        for (int n = 0; n < 2; ++n) acc[a][b][m][n] = (f32x4){0.f, 0.f, 0.f, 0.f};
  bf16x8 At[4][2], B0[2][2], B1[2][2];
  const char* cA = (const char*)Aptr + AMap::tile_row0(cur.pm) * (long)rowB; const char* cB = (const char*)Btptr + (size_t)cur.pn * tstepB;
  PG8_STAGE(PG8_SB(0, 0), cB, voffB); PG8_STAGE(PG8_SA(0, 0), cA, voffA); PG8_STAGE(PG8_SB(0, 1), cB + hstepB, voffB); PG8_STAGE(PG8_SA(0, 1), cA + hstepA, voffA);
  if (wr == 1) PG8_BAR;
  PG8_WAIT_V(4); PG8_BAR;
  PG8_STAGE(PG8_SB(1, 0), cB + kstep, voffB); PG8_STAGE(PG8_SA(1, 0), cA + kstep, voffA); PG8_STAGE(PG8_SB(1, 1), cB + hstepB + kstep, voffB);
  PG8_WAIT_V(6); PG8_BAR;
  for (;;) {
    const bool has_next = SO.next(ui + 1, nxt);
    const char* nA = has_next ? (const char*)Aptr + AMap::tile_row0(nxt.pm) * (long)rowB : cA; const char* nB = has_next ? (const char*)Btptr + (size_t)nxt.pn * tstepB : cB;
    for (int t = 0; t < nt; t += 2) {
      const bool last = (t == nt - 2);
      const char* a1 = cA + (size_t)(t + 1) * kstep;
      const char* a2 = last ? nA : cA + (size_t)(t + 2) * kstep; const char* b2 = last ? nB : cB + (size_t)(t + 2) * kstep;
      const char* a3 = a2 + kstep; const char* b3 = b2 + kstep;
      PG8_LDB(B0, 0, 0); PG8_SCHED; PG8_LDA(At, 0, 0); PG8_STAGE(PG8_SA(1, 1), a1 + hstepA, voffA);
      PG8_WAIT_L(8); PG8_BAR; PG8_WAIT_L(0); PG8_MMA(0, 0, At, B0); PG8_BAR; PG8_SCHED;
      PG8_LDB(B1, 0, 1); PG8_STAGE(PG8_SB(0, 0), b2, voffB);
      PG8_BAR; PG8_WAIT_L(0); PG8_MMA(0, 1, At, B1); PG8_BAR;
      PG8_LDA(At, 0, 1); PG8_STAGE(PG8_SA(0, 0), a2, voffA);
      PG8_BAR; PG8_WAIT_L(0); PG8_MMA(1, 0, At, B0); PG8_BAR; PG8_SCHED;
      PG8_STAGE(PG8_SB(0, 1), b2 + hstepB, voffB);
      PG8_WAIT_V(6); PG8_BAR; PG8_MMA(1, 1, At, B1); PG8_BAR;
      PG8_LDB(B0, 1, 0); PG8_SCHED; PG8_LDA(At, 1, 0); PG8_STAGE(PG8_SA(0, 1), a2 + hstepA, voffA);
      PG8_WAIT_L(8); PG8_BAR; PG8_WAIT_L(0); PG8_MMA(0, 0, At, B0); PG8_BAR; PG8_SCHED;
      PG8_LDB(B1, 1, 1); PG8_STAGE(PG8_SB(1, 0), b3, voffB);
      PG8_BAR; PG8_WAIT_L(0); PG8_MMA(0, 1, At, B1); PG8_BAR;
      PG8_LDA(At, 1, 1); PG8_STAGE(PG8_SA(1, 0), a3, voffA);
      PG8_BAR; PG8_WAIT_L(0); PG8_MMA(1, 0, At, B0); PG8_BAR; PG8_SCHED;
      PG8_STAGE(PG8_SB(1, 1), b3 + hstepB, voffB);
      PG8_WAIT_V(6); PG8_BAR; PG8_MMA(1, 1, At, B1); PG8_BAR;
    }
    E(acc, cur, wr, wc, fr, fq);
    if (!has_next) break;
#pragma unroll
    for (int a = 0; a < 2; ++a)
#pragma unroll
      for (int b = 0; b < 2; ++b)
#pragma unroll
        for (int m = 0; m < 4; ++m)
#pragma unroll
          for (int n = 0; n < 2; ++n) acc[a][b][m][n] = (f32x4){0.f, 0.f, 0.f, 0.f};
    cur = nxt; cA = nA; cB = nB; ++ui;
  }
  PG8_WAIT_V(0);
  if (wr == 0) PG8_BAR;
  PG8_BAR;
#undef PG8_SA
#undef PG8_SB
#undef PG8_STAGE
#undef PG8_LDA
#undef PG8_LDB
#undef PG8_MMA
#undef PG8_WAIT_V
#undef PG8_WAIT_L
#undef PG8_BAR
#undef PG8_SCHED
}
}

DI void sincos_big(float ang, float& sn, float& cs) {
  const float c_hi = 1.591549367e-01f, c_lo = 6.420638243e-09f;
  const float rh = ang * c_hi;
  const float e = __builtin_fmaf(ang, c_hi, -rh);
  const float fr = rh - floorf(rh);
  const float rev = fr + (e + ang * c_lo);
  sn = __builtin_amdgcn_sinf(rev);
  cs = __builtin_amdgcn_cosf(rev);
}

struct EpiProj {
  u16* proj;
  DI void operator()(const f32x4 (&acc)[2][2][4][2], const pg8::Unit& u, int wr, int wc, int fr, int fq) const {
    const f32x4 i16 = *(const f32x4*)(ROPE_INV16 + 4 * fq);
    const f32x4 i32v = *(const f32x4*)(ROPE_INV32 + 16 * (wc & 1) + 4 * fq);
#pragma unroll
    for (int bj = 0; bj < 2; ++bj) {
      const int gcol0 = u.pn * 256 + bj * 128 + wc * 32;
      int mode; float scale = 1.f;
      if (gcol0 < 256) { mode = 1; scale = QSCALE_DIFF; }
      else if (gcol0 < 512) { mode = 1; }
      else if (gcol0 < 768) { mode = 0; }
      else if (gcol0 < 1152) { mode = 2; scale = QSCALE_64; }
      else if (gcol0 < 1536) { mode = 2; }
      else if (gcol0 < 1920) { mode = 0; }
      else if (gcol0 < 2304) { mode = 0; scale = QSCALE_64; }
      else { mode = 0; }
      f32x4 invv;
#pragma unroll
      for (int e = 0; e < 4; ++e) invv[e] = (mode == 1) ? i16[e] : i32v[e];
      int c1, c2;
      if (mode == 2) { const int hb = gcol0 & ~63, g = wc & 1; c1 = hb + 16 * g + 4 * fq; c2 = c1 + 32; }
      else { c1 = gcol0 + 4 * fq; c2 = c1 + 16; }
#pragma unroll
      for (int ai = 0; ai < 2; ++ai)
#pragma unroll
        for (int m = 0; m < 4; ++m) {
          const int row = u.pm * 256 + ai * 128 + wr * 64 + m * 16 + fr;
          f32x4 x1 = acc[ai][bj][m][0], x2 = acc[ai][bj][m][1];
          if (mode != 0) {
            const float pos = (float)(row & (S - 1));
#pragma unroll
            for (int e = 0; e < 4; ++e) {
              const float ang = __fmul_rn(pos, invv[e]);
              float sn, cs; sincos_big(ang, sn, cs);
              const float y1 = x1[e] * cs - x2[e] * sn, y2 = x2[e] * cs + x1[e] * sn;
              x1[e] = y1; x2[e] = y2;
            }
          }
          u16* dp = proj + (size_t)row * NPROJ;
          *(uint2*)(dp + c1) = make_uint2(pack2(x1[0] * scale, x1[1] * scale), pack2(x1[2] * scale, x1[3] * scale));
          *(uint2*)(dp + c2) = make_uint2(pack2(x2[0] * scale, x2[1] * scale), pack2(x2[2] * scale, x2[3] * scale));
        }
    }
  }
};

struct EpiResid {
  const float* xold; float* xnew; const float* gate;
  DI void operator()(const f32x4 (&acc)[2][2][4][2], const pg8::Unit& u, int wr, int wc, int fr, int fq) const {
    const int b = (u.pm * 256) >> 14;
    const int col0 = u.pn * 256 + wc * 32 + 4 * fq;
    f32x4 gv[2][2];
#pragma unroll
    for (int bj = 0; bj < 2; ++bj)
#pragma unroll
      for (int n = 0; n < 2; ++n) gv[bj][n] = *(const f32x4*)(gate + b * 6144 + col0 + bj * 128 + n * 16);
#pragma unroll
    for (int ai = 0; ai < 2; ++ai)
#pragma unroll
      for (int m = 0; m < 4; ++m) {
        const size_t off = (size_t)(u.pm * 256 + ai * 128 + wr * 64 + m * 16 + fr) * 1024 + col0;
        f32x4 xo[2][2];
#pragma unroll
        for (int bj = 0; bj < 2; ++bj)
#pragma unroll
          for (int n = 0; n < 2; ++n) xo[bj][n] = *(const f32x4*)(xold + off + bj * 128 + n * 16);
#pragma unroll
        for (int bj = 0; bj < 2; ++bj)
#pragma unroll
          for (int n = 0; n < 2; ++n) *(f32x4*)(xnew + off + bj * 128 + n * 16) = xo[bj][n] + gv[bj][n] * acc[ai][bj][m][n];
        asm volatile("" ::: "memory");
      }
  }
};

DI float dpp_ror1(float v)  { return __builtin_bit_cast(float, __builtin_amdgcn_update_dpp(0, __builtin_bit_cast(int, v), 0x121, 0xf, 0xf, false)); }
DI float dpp_ror15(float v) { return __builtin_bit_cast(float, __builtin_amdgcn_update_dpp(0, __builtin_bit_cast(int, v), 0x12F, 0xf, 0xf, false)); }
struct EpiUp {
  u16* act; const float* cw; const float* cb;
  DI void operator()(const f32x4 (&acc)[2][2][4][2], const pg8::Unit& u, int wr, int wc, int fr, int fq) const {
    const int b = u.pm / 67, ti = u.pm % 67;
#pragma unroll
    for (int n = 0; n < 2; ++n) {
      const int col = u.pn * 128 + wc * 32 + n * 16 + 4 * fq;
      const f32x4 w0 = *(const f32x4*)(cw + col), w1 = *(const f32x4*)(cw + DFF + col), w2 = *(const f32x4*)(cw + 2 * DFF + col), bb = *(const f32x4*)(cb + col);
#pragma unroll
      for (int ai = 0; ai < 2; ++ai) {
        const int tokb = 248 * ti - 1 + 62 * (2 * ai + wr);
        f32x4 g[4];
#pragma unroll
        for (int m = 0; m < 4; ++m) {
          const int tok = tokb + 16 * m + fr;
          const bool ok = (tok >= 0) && (tok < S);
#pragma unroll
          for (int e = 0; e < 4; ++e) g[m][e] = ok ? acc[ai][0][m][n][e] : 0.f;
        }
#pragma unroll
        for (int m = 0; m < 4; ++m) {
          const int q = 16 * m + fr, tok = tokb + q;
          f32x4 r;
#pragma unroll
          for (int e = 0; e < 4; ++e) {
            const float srcm = (fr == 15 && m > 0) ? g[m > 0 ? m - 1 : 0][e] : g[m][e];
            const float srcp = (fr == 0 && m < 3) ? g[m < 3 ? m + 1 : 3][e] : g[m][e];
            const float gm = dpp_ror1(srcm), gp = dpp_ror15(srcp);
            const float cv = bb[e] + w0[e] * gm + w1[e] * g[m][e] + w2[e] * gp;
            r[e] = cv * __builtin_amdgcn_rcpf(1.f + exp2_hw(-LOG2E * cv)) * acc[ai][1][m][n][e];
          }
          if (q >= 1 && q <= 62 && tok < S)
            *(uint2*)(act + (size_t)(b * S + tok) * DFF + col) = make_uint2(pack2(r[0], r[1]), pack2(r[2], r[3]));
        }
      }
    }
  }
};

constexpr int VROW = 96;
constexpr int VT_WAVE = 64 * VROW;
DI bf16x8 v_frag_tr(const u16* Vb, int kb0, int mb, int sp, int lane) {
  const int i16 = lane & 15, q = i16 >> 2, pp = i16 & 3, blk = (lane >> 4) & 1, hh = lane >> 5;
  const u16* a0 = Vb + (kb0 + 16 * sp + 4 * hh + q) * VROW + (mb * 2 + blk) * 16 + 4 * pp;
  const s16x4 lo = __builtin_amdgcn_ds_read_tr16_b64_v4i16((LAS s16x4*)a0);
  const s16x4 hi = __builtin_amdgcn_ds_read_tr16_b64_v4i16((LAS s16x4*)(a0 + 8 * VROW));
  return __builtin_shufflevector(lo, hi, 0, 1, 2, 3, 4, 5, 6, 7);
}

DI void local_softmax_step(float (&sv)[2][16], float& m_run, float& l_run, f32x16 (&O)[2], bf16x8 (&pk)[2][2]) {
  float tmax = NEGBIG;
#pragma unroll
  for (int h2 = 0; h2 < 2; ++h2)
#pragma unroll
    for (int i = 0; i < 16; ++i) tmax = fmaxf(tmax, sv[h2][i]);
  tmax = fmaxf(tmax, __shfl_xor(tmax, 32));
  const float m_new = fmaxf(m_run, tmax);
  if (__builtin_amdgcn_ballot_w64(m_new > m_run) != 0ull) {
    const float alpha = exp2_hw(m_run - m_new);
    m_run = m_new; l_run *= alpha;
#pragma unroll
    for (int mb = 0; mb < 2; ++mb)
#pragma unroll
      for (int i = 0; i < 16; ++i) O[mb][i] *= alpha;
  }
#pragma unroll
  for (int h2 = 0; h2 < 2; ++h2)
#pragma unroll
    for (int sp = 0; sp < 2; ++sp) {
      unsigned q4[4];
#pragma unroll
      for (int q = 0; q < 4; ++q) {
        const float s0 = sv[h2][8 * sp + 2 * q], s1 = sv[h2][8 * sp + 2 * q + 1];
        const float p0 = (s0 > -1e29f) ? exp2_hw(s0 - m_run) : 0.f, p1 = (s1 > -1e29f) ? exp2_hw(s1 - m_run) : 0.f;
        l_run += p0; l_run += p1;
        q4[q] = pack2(p0, p1);
      }
      pk[h2][sp] = __builtin_bit_cast(bf16x8, make_uint4(q4[0], q4[1], q4[2], q4[3]));
    }
}
DI void local_store_out(const f32x16 (&O)[2], float l_run, u16* op, int hh) {
  const float l = l_run + __shfl_xor(l_run, 32);
  const float il = 1.f / l;
#pragma unroll
  for (int mb = 0; mb < 2; ++mb)
#pragma unroll
    for (int g = 0; g < 4; ++g) {
      const int d = mb * 32 + 8 * g + 4 * hh;
      *(uint2*)(op + d) = make_uint2(pack2(O[mb][4 * g] * il, O[mb][4 * g + 1] * il), pack2(O[mb][4 * g + 2] * il, O[mb][4 * g + 3] * il));
    }
}

constexpr int KS_STRIDE = 72;
constexpr int KS_BUF = 64 * KS_STRIDE, VS_BUF = 64 * VROW;
DI void swin_attn_item(KP p, int item, u16* sm) {
  const int tid = otid(), lane = tid & 63, w = __builtin_amdgcn_readfirstlane(tid >> 6), r = lane & 31, hh = lane >> 5;
  u16* Ks = sm; u16* Vs = sm + 2 * KS_BUF;
  const int bhp = item >> 6, sub = item & 63;
  const int pat = bhp % 3, bh = bhp / 3, head = bh % 6, b = bh / 6;
  const int sh = 2 * pat, L = S >> sh;
  const int cls = sub >> (6 - sh), pb = sub & ((64 >> sh) - 1);
  const int P = pb * 256;
  const int qp = P + 32 * w + r, tq = cls + (qp << sh);
  const u16* prow = p.proj + (size_t)b * S * NPROJ;
  bf16x8 qf[4];
#pragma unroll
  for (int s = 0; s < 4; ++s) qf[s] = *(const bf16x8*)(prow + (size_t)tq * NPROJ + 768 + head * 64 + s * 16 + 8 * hh);
  f32x16 O[2];
#pragma unroll
  for (int mb = 0; mb < 2; ++mb)
#pragma unroll
    for (int i = 0; i < 16; ++i) O[mb][i] = 0.f;
  float m_run = NEGBIG, l_run = 0.f;
  uint4 kr, vr;
  const int key0 = tid >> 3, ch = tid & 7;
  const u16* kg = prow + 1152 + head * 64 + ch * 8;
  auto gload = [&](int j) __attribute__((always_inline)) {
    int kp = P - 64 + 64 * j + key0; kp = kp < 0 ? 0 : (kp > L - 1 ? L - 1 : kp);
    const u16* src = kg + (size_t)(cls + (kp << sh)) * NPROJ;
    kr = *(const uint4*)src; vr = *(const uint4*)(src + 384);
  };
  auto lstore = [&](int buf) __attribute__((always_inline)) {
    *(uint4*)(Ks + buf * KS_BUF + key0 * KS_STRIDE + ch * 8) = kr;
    *(uint4*)(Vs + buf * VS_BUF + key0 * VROW + ch * 8) = vr;
  };
  gload(0); lstore(0);
  __syncthreads();
  const int jlo = w >> 1;
#pragma unroll 1
  for (int j = 0; j < 6; ++j) {
    const int buf = j & 1;
    if (j + 1 < 6) gload(j + 1);
    if (j >= jlo && j <= jlo + 2) {
      f32x16 Sc[2];
#pragma unroll
      for (int i = 0; i < 16; ++i) { Sc[0][i] = 0.f; Sc[1][i] = 0.f; }
#pragma unroll
      for (int s = 0; s < 4; ++s)
#pragma unroll
        for (int h2 = 0; h2 < 2; ++h2) {
          const bf16x8 kf = *(const bf16x8*)(Ks + buf * KS_BUF + (h2 * 32 + r) * KS_STRIDE + s * 16 + 8 * hh);
          Sc[h2] = MFMA32(kf, qf[s], Sc[h2]);
        }
      const int dbase = (64 * j - 32 * w) + 4 * hh - r;
      const int kbase = P - 64 + 64 * j + 4 * hh;
      float sv[2][16];
#pragma unroll
      for (int h2 = 0; h2 < 2; ++h2)
#pragma unroll
        for (int i = 0; i < 16; ++i) {
          const int c = h2 * 32 + (i & 3) + 8 * (i >> 2);
          const bool valid = ((unsigned)(dbase + c) <= 128u) && ((unsigned)(kbase + c) < (unsigned)L);
          sv[h2][i] = valid ? Sc[h2][i] : NEGBIG;
        }
      bf16x8 pk[2][2];
      local_softmax_step(sv, m_run, l_run, O, pk);
#pragma unroll
      for (int h2 = 0; h2 < 2; ++h2)
#pragma unroll
        for (int sp = 0; sp < 2; ++sp)
#pragma unroll
          for (int mb = 0; mb < 2; ++mb) {
            const bf16x8 vf = v_frag_tr(Vs + buf * VS_BUF, h2 * 32, mb, sp, lane);
            O[mb] = MFMA32(vf, pk[h2][sp], O[mb]);
          }
    }
    if (j + 1 < 6) lstore(buf ^ 1);
    __syncthreads();
  }
  const size_t orow = (size_t)pat * NTOK + (size_t)b * S + tq;
  const float l = l_run + __shfl_xor(l_run, 32);
  if (hh == 0) p.lse[orow * 6 + head] = m_run + __log2f(l);
  local_store_out(O, l_run, p.odil + orow * 384 + head * 64, hh);
}

DI void combine_dil(KP p) {
  const int tid = otid();
  for (int tc = blockIdx.x; tc < 256; tc += gridDim.x) {
#pragma unroll 1
    for (int idx = tid; idx < 128 * 48; idx += NTHR) {
      const int tok = tc * 128 + idx / 48, c8 = idx % 48, head = c8 >> 3;
      float ls[3], wgt[3];
#pragma unroll
      for (int q = 0; q < 3; ++q) ls[q] = p.lse[((size_t)q * NTOK + tok) * 6 + head];
      const float mx = fmaxf(ls[0], fmaxf(ls[1], ls[2]));
      float sum = 0.f;
#pragma unroll
      for (int q = 0; q < 3; ++q) { wgt[q] = exp2_hw(ls[q] - mx); sum += wgt[q]; }
      const float isum = 1.f / sum;
      float acc[8];
#pragma unroll
      for (int e = 0; e < 8; ++e) acc[e] = 0.f;
#pragma unroll
      for (int q = 0; q < 3; ++q) {
        const uint4 v = *(const uint4*)(p.odil + ((size_t)q * NTOK + tok) * 384 + c8 * 8);
        const float wq = wgt[q] * isum;
        acc[0] += wq * bflo(v.x); acc[1] += wq * bfhi(v.x); acc[2] += wq * bflo(v.y); acc[3] += wq * bfhi(v.y);
        acc[4] += wq * bflo(v.z); acc[5] += wq * bfhi(v.z); acc[6] += wq * bflo(v.w); acc[7] += wq * bfhi(v.w);
      }
      *(uint4*)(p.o + (size_t)tok * 1024 + 256 + c8 * 8) = make_uint4(pack2(acc[0], acc[1]), pack2(acc[2], acc[3]), pack2(acc[4], acc[5]), pack2(acc[6], acc[7]));
    }
  }
}

constexpr int RPB_PAD = 48, RPB_LDS = 15 * 31 + 2 * RPB_PAD;
DI void na_attn_item(KP p, int layer, int item, u16* sm) {
  const int tid = otid(), lane = tid & 63, w = __builtin_amdgcn_readfirstlane(tid >> 6), r = lane & 31, hh = lane >> 5;
  u16* Ks = sm; u16* Vs = sm + 2 * KS_BUF;
  const int b = item / (6 * 64), rem = item % (6 * 64), head = rem / 64, g = rem % 64;
  const int rr = 4 * g + (w >> 1), half = w & 1;
  const int tq = rr * 64 + half * 32 + r, qc = half * 32 + r;
  auto rstart = [](int x) { int v = x - 4; return v < 0 ? 0 : (v > 248 ? 248 : v); };
  const int my_rs = rstart(rr), rs_lo = rstart(4 * g), rs_hi = rstart(4 * g + 3) + 7;
  const u16* prow = p.proj + (size_t)b * S * NPROJ;
  const float* rpb = p.na_rpb + ((size_t)layer * 6 + head) * 15 * 31;
  bf16x8 qf[4];
#pragma unroll
  for (int s = 0; s < 4; ++s) qf[s] = *(const bf16x8*)(prow + (size_t)tq * NPROJ + 1920 + head * 64 + s * 16 + 8 * hh);
  int cs = qc - 8; cs = cs < 0 ? 0 : (cs > 48 ? 48 : cs);
  float* rtab = (float*)(sm + 2 * KS_BUF + 2 * VS_BUF);
  for (int i = tid; i < RPB_LDS; i += NTHR) { const int j = i - RPB_PAD; rtab[i] = (j >= 0 && j < 15 * 31) ? rpb[j] * LOG2E : 0.f; }
  const int vbase = 4 * hh - cs;
  f32x16 O[2];
#pragma unroll
  for (int mb = 0; mb < 2; ++mb)
#pragma unroll
    for (int i = 0; i < 16; ++i) O[mb][i] = 0.f;
  float m_run = NEGBIG, l_run = 0.f;
  uint4 kr, vr;
  const int key0 = tid >> 3, ch = tid & 7;
  const u16* kg = prow + (size_t)key0 * NPROJ + 2304 + head * 64 + ch * 8;
  auto gload = [&](int krow) __attribute__((always_inline)) {
    const u16* src = kg + (size_t)(krow * 64) * NPROJ;
    kr = *(const uint4*)src; vr = *(const uint4*)(src + 384);
  };
  auto lstore = [&](int buf) __attribute__((always_inline)) {
    *(uint4*)(Ks + buf * KS_BUF + key0 * KS_STRIDE + ch * 8) = kr;
    *(uint4*)(Vs + buf * VS_BUF + key0 * VROW + ch * 8) = vr;
  };
  gload(rs_lo); lstore(0);
  __syncthreads();
  for (int krow = rs_lo; krow <= rs_hi; ++krow) {
    const int buf = (krow - rs_lo) & 1;
    if (krow + 1 <= rs_hi) gload(krow + 1);
    if (krow >= my_rs && krow < my_rs + 8) {
      f32x16 Sc[2];
#pragma unroll
      for (int i = 0; i < 16; ++i) { Sc[0][i] = 0.f; Sc[1][i] = 0.f; }
#pragma unroll
      for (int s = 0; s < 4; ++s)
#pragma unroll
        for (int h2 = 0; h2 < 2; ++h2) {
          const bf16x8 kf = *(const bf16x8*)(Ks + buf * KS_BUF + (h2 * 32 + r) * KS_STRIDE + s * 16 + 8 * hh);
          Sc[h2] = MFMA32(kf, qf[s], Sc[h2]);
        }
      const float* rowp = rtab + RPB_PAD + (krow - rr + 7) * 31 + 15 + 4 * hh - qc;
      float sv[2][16];
#pragma unroll
      for (int h2 = 0; h2 < 2; ++h2)
#pragma unroll
        for (int i = 0; i < 16; ++i) {
          const int c = h2 * 32 + (i & 3) + 8 * (i >> 2);
          const bool valid = (unsigned)(vbase + c) < 16u;
          sv[h2][i] = valid ? (Sc[h2][i] + rowp[c]) : NEGBIG;
        }
      bf16x8 pk[2][2];
      local_softmax_step(sv, m_run, l_run, O, pk);
#pragma unroll
      for (int h2 = 0; h2 < 2; ++h2)
#pragma unroll
        for (int sp = 0; sp < 2; ++sp)
#pragma unroll
          for (int mb = 0; mb < 2; ++mb) {
            const bf16x8 vf = v_frag_tr(Vs + buf * VS_BUF, h2 * 32, mb, sp, lane);
            O[mb] = MFMA32(vf, pk[h2][sp], O[mb]);
          }
    }
    if (krow + 1 <= rs_hi) lstore(buf ^ 1);
    __syncthreads();
  }
  local_store_out(O, l_run, p.o + (size_t)(b * S + tq) * 1024 + 640 + head * 64, hh);
}

DI void kmax_item(KP p, int layer, int kidx) {
  const int tid = otid(); const int gid = kidx * NTHR + tid;
  const int row = gid >> 2, head = gid & 3, b = row >> 14;
  const uint4* kp = (const uint4*)(p.proj + (size_t)row * NPROJ + 256 + head * 64);
  float n0 = 0.f, n1 = 0.f;
#pragma unroll
  for (int c = 0; c < 8; ++c) {
    const uint4 v = kp[c];
    const unsigned e[4] = {v.x, v.y, v.z, v.w};
    float s = 0.f;
#pragma unroll
    for (int q = 0; q < 4; ++q) { const float a = bflo(e[q]), bq = bfhi(e[q]); s += a * a + bq * bq; }
    if (c >= 4) n1 += s; else n0 += s;
  }
#pragma unroll
  for (int o = 4; o <= 32; o <<= 1) { n0 = fmaxf(n0, __shfl_xor(n0, o)); n1 = fmaxf(n1, __shfl_xor(n1, o)); }
  if ((tid & 63) < 4) {
    unsigned* km = p.kmax + layer * 16 + (b * 4 + head) * 2;
    atomicMax(km, __float_as_uint(n0)); atomicMax(km + 1, __float_as_uint(n1));
  }
}

DI void phase_local(KP p, int layer, u16* sm) {
  constexpr int N_DIL = 2304, N_NA = 768, N_KM = 256;
  for (int it = blockIdx.x; it < N_DIL + N_NA + N_KM; it += gridDim.x) {
    __syncthreads();
    if (it < N_DIL) swin_attn_item(p, it, sm);
    else if (it < N_DIL + N_NA) na_attn_item(p, layer, it - N_DIL, sm);
    else kmax_item(p, layer, it - N_DIL - N_NA);
  }
}

DI void phase_diff(KP p, int layer, u16* sm) {
  combine_dil(p);
  const int tid = otid(), lane = tid & 63, w = __builtin_amdgcn_readfirstlane(tid >> 6), r = lane & 31, hh = lane >> 5;
  u16* Ks = sm; u16* Vs = sm + 2 * KS_BUF;
  float lam;
  {
    const float* dl = p.diff_lambda + layer * 128;
    float a = 0.f, c2 = 0.f;
    if (lane < 32) { a = dl[lane] * dl[32 + lane]; c2 = dl[64 + lane] * dl[96 + lane]; }
    a = wave_sum(a); c2 = wave_sum(c2);
    lam = __expf(a) - __expf(c2) + p.lam_init[layer];
  }
  const float lam_init = p.lam_init[layer];
  const float* sg = p.diff_subln + layer * 64;
  for (int it = blockIdx.x; it < 512; it += gridDim.x) {
    const int bh = it >> 6, qb = it & 63, b = bh >> 2, head = bh & 3;
    const u16* prow = p.proj + (size_t)b * S * NPROJ;
    const int tq = qb * 256 + w * 32 + r;
    bf16x8 qf[2][2];
    float qn[2];
#pragma unroll
    for (int m = 0; m < 2; ++m) {
      qn[m] = 0.f;
#pragma unroll
      for (int s = 0; s < 2; ++s) {
        qf[m][s] = *(const bf16x8*)(prow + (size_t)tq * NPROJ + head * 64 + m * 32 + s * 16 + 8 * hh);
#pragma unroll
        for (int j = 0; j < 8; ++j) { const float v = bf2f((u16)qf[m][s][j]); qn[m] += v * v; }
      }
      qn[m] += __shfl_xor(qn[m], 32);
    }
    float mbnd[2];
#pragma unroll
    for (int m = 0; m < 2; ++m) {
      const float km = __uint_as_float(p.kmax[layer * 16 + bh * 2 + m]);
      mbnd[m] = fmaxf(sqrtf(qn[m] * km) - 100.f, 0.f);
    }
    const bool noshift = __builtin_amdgcn_ballot_w64(mbnd[0] == 0.f && mbnd[1] == 0.f) == ~0ull;
    f32x16 O[2][2];
#pragma unroll
    for (int m = 0; m < 2; ++m)
#pragma unroll
      for (int mb = 0; mb < 2; ++mb)
#pragma unroll
        for (int i = 0; i < 16; ++i) O[m][mb][i] = 0.f;
    float lsum[2] = {0.f, 0.f};
    uint4 kr, vr, kr2, vr2, kr3, vr3;
    const int key0 = tid >> 3, ch = tid & 7;
    const u16* kg = prow + (size_t)key0 * NPROJ + 256 + head * 64 + ch * 8;
    auto gload = [&](int kt, uint4& kd, uint4& vd) __attribute__((always_inline)) {
      const u16* src = kg + (size_t)((kt & 255) * 64) * NPROJ;
      kd = *(const uint4*)src; vd = *(const uint4*)(src + 256);
    };
    auto lstore = [&](int buf) __attribute__((always_inline)) {
      *(uint4*)(Ks + buf * KS_BUF + key0 * KS_STRIDE + ch * 8) = kr;
      *(uint4*)(Vs + buf * VS_BUF + key0 * VROW + ch * 8) = vr;
    };
    gload(0, kr, vr); lstore(0);
    gload(1, kr, vr); gload(2, kr2, vr2);
    __syncthreads();
    if (noshift) {
    for (int kt = 0; kt < 256; ++kt) {
      const int buf = kt & 1;
      gload(kt + 3, kr3, vr3);
#pragma unroll
      for (int sub = 0; sub < 2; ++sub) {
#pragma unroll
        for (int m = 0; m < 2; ++m) {
          f32x16 Sc;
#pragma unroll
          for (int i = 0; i < 16; ++i) Sc[i] = 0.f;
#pragma unroll
          for (int s = 0; s < 2; ++s) {
            const bf16x8 kf = *(const bf16x8*)(Ks + buf * KS_BUF + (sub * 32 + r) * KS_STRIDE + m * 32 + s * 16 + 8 * hh);
            Sc = MFMA32(kf, qf[m][s], Sc);
          }
          bf16x8 pk[2];
#pragma unroll
          for (int sp = 0; sp < 2; ++sp) {
            unsigned q4[4];
#pragma unroll
            for (int q = 0; q < 4; ++q) {
              const float p0 = exp2_hw(Sc[8 * sp + 2 * q]), p1 = exp2_hw(Sc[8 * sp + 2 * q + 1]);
              lsum[m] += p0; lsum[m] += p1;
              q4[q] = pack2(p0, p1);
            }
            pk[sp] = __builtin_bit_cast(bf16x8, make_uint4(q4[0], q4[1], q4[2], q4[3]));
          }
#pragma unroll
          for (int sp = 0; sp < 2; ++sp)
#pragma unroll
            for (int mb = 0; mb < 2; ++mb) {
              const bf16x8 vf = v_frag_tr(Vs + buf * VS_BUF, sub * 32, mb, sp, lane);
              O[m][mb] = MFMA32(vf, pk[sp], O[m][mb]);
            }
        }
        __builtin_amdgcn_sched_barrier(0);
      }
      lstore(buf ^ 1);
      kr = kr2; vr = vr2; kr2 = kr3; vr2 = vr3;
      __syncthreads();
    }
    } else {
    for (int kt = 0; kt < 256; ++kt) {
      const int buf = kt & 1;
      gload(kt + 3, kr3, vr3);
#pragma unroll
      for (int sub = 0; sub < 2; ++sub) {
#pragma unroll
        for (int m = 0; m < 2; ++m) {
          f32x16 Sc;
#pragma unroll
          for (int i = 0; i < 16; ++i) Sc[i] = 0.f;
#pragma unroll
          for (int s = 0; s < 2; ++s) {
            const bf16x8 kf = *(const bf16x8*)(Ks + buf * KS_BUF + (sub * 32 + r) * KS_STRIDE + m * 32 + s * 16 + 8 * hh);
            Sc = MFMA32(kf, qf[m][s], Sc);
          }
          bf16x8 pk[2];
#pragma unroll
          for (int sp = 0; sp < 2; ++sp) {
            unsigned q4[4];
#pragma unroll
            for (int q = 0; q < 4; ++q) {
              const float p0 = exp2_hw(Sc[8 * sp + 2 * q] - mbnd[m]), p1 = exp2_hw(Sc[8 * sp + 2 * q + 1] - mbnd[m]);
              lsum[m] += p0; lsum[m] += p1;
              q4[q] = pack2(p0, p1);
            }
            pk[sp] = __builtin_bit_cast(bf16x8, make_uint4(q4[0], q4[1], q4[2], q4[3]));
          }
#pragma unroll
          for (int sp = 0; sp < 2; ++sp)
#pragma unroll
            for (int mb = 0; mb < 2; ++mb) {
              const bf16x8 vf = v_frag_tr(Vs + buf * VS_BUF, sub * 32, mb, sp, lane);
              O[m][mb] = MFMA32(vf, pk[sp], O[m][mb]);
            }
        }
        __builtin_amdgcn_sched_barrier(0);
      }
      lstore(buf ^ 1);
      kr = kr2; vr = vr2; kr2 = kr3; vr2 = vr3;
      __syncthreads();
    }
    }
    const float l0 = lsum[0] + __shfl_xor(lsum[0], 32);
    const float l1 = lsum[1] + __shfl_xor(lsum[1], 32);
    const float i0 = 1.f / l0, i1 = lam / l1;
    float ss = 0.f;
#pragma unroll
    for (int mb = 0; mb < 2; ++mb)
#pragma unroll
      for (int i = 0; i < 16; ++i) { const float v = O[0][mb][i] * i0 - O[1][mb][i] * i1; O[0][mb][i] = v; ss += v * v; }
    ss += __shfl_xor(ss, 32);
    const float inv = rsqrtf(ss * (1.f / 64.f) + 1e-6f) * (1.f - lam_init);
    u16* op = p.o + (size_t)(b * S + tq) * 1024 + head * 64;
#pragma unroll
    for (int mb = 0; mb < 2; ++mb)
#pragma unroll
      for (int g = 0; g < 4; ++g) {
        const int d = mb * 32 + 8 * g + 4 * hh;
        const float4 g4 = *(const float4*)(sg + d);
        *(uint2*)(op + d) = make_uint2(pack2(O[0][mb][4 * g] * inv * g4.x, O[0][mb][4 * g + 1] * inv * g4.y),
                                       pack2(O[0][mb][4 * g + 2] * inv * g4.z, O[0][mb][4 * g + 3] * inv * g4.w));
      }
  }
}

DI void phase_proj(KP p, int layer, LAS unsigned char* lds) {
  pg8::StaticOrder so; so.init(128, 12, gridDim.x, blockIdx.x);
  EpiProj e; e.proj = p.proj;
  pg8::gemm_phase<pg8::AMapPlain>(lds, p.h, p.wt_in + (size_t)layer * 3072 * 1024, 1024, so, e);
}
DI void phase_resid(const u16* A, int K, const u16* Bt, const float* xold, float* xnew, const float* gate, LAS unsigned char* lds) {
  pg8::StaticOrder so; so.init(128, 4, gridDim.x, blockIdx.x);
  EpiResid e; e.xold = xold; e.xnew = xnew; e.gate = gate;
  pg8::gemm_phase<pg8::AMapPlain>(lds, A, Bt, K, so, e);
}
DI void phase_up(KP p, int layer, LAS unsigned char* lds) {
  pg8::StaticOrder so; so.init(134, 22, gridDim.x, blockIdx.x);
  EpiUp e; e.act = p.act; e.cw = p.conv_w + (size_t)layer * 3 * DFF; e.cb = p.conv_b + (size_t)layer * DFF;
  pg8::gemm_phase<pg8::AMapHalo>(lds, p.h, p.wt_up + (size_t)layer * 5632 * 1024, 1024, so, e);
}

constexpr int N_PHASES = 18;

DI void run_phase(KP p, int ph, unsigned char* smraw) {
  u16* sm = (u16*)smraw;
  LAS unsigned char* lds = (LAS unsigned char*)smraw;
  if (ph == 0) { phase_prep(p, (float*)smraw); return; }
  if (ph == 17) { phase_norm<1>(p.out, p.g_final, nullptr, 0, 0, nullptr, p.out); return; }
  const int layer = (ph - 1) >> 3, sub = (ph - 1) & 7;
  const float* modl = p.mod + layer * 2 * 6144;
  const float* xcur = (layer == 0) ? p.x : p.out;
  switch (sub) {
    case 0: phase_norm<0>(xcur, p.g_attn + layer * 1024, modl, 0, 1024, p.h, nullptr); break;
    case 1: phase_proj(p, layer, lds); break;
    case 2: phase_local(p, layer, sm); break;
    case 3: phase_diff(p, layer, sm); break;
    case 4: phase_resid(p.o, 1024, p.wt_out + (size_t)layer * 1024 * 1024, xcur, p.out, modl + 2048, lds); break;
    case 5: phase_norm<0>(p.out, p.g_ffn + layer * 1024, modl, 3072, 4096, p.h, nullptr); break;
    case 6: phase_up(p, layer, lds); break;
    case 7: phase_resid(p.act, DFF, p.wt_down + (size_t)layer * 1024 * DFF, p.out, p.out, modl + 5120, lds); break;
  }
}

__global__ void __launch_bounds__(NTHR, 2) mega_kernel(Params p) {
  __shared__ __attribute__((aligned(16))) unsigned char smraw[LDS_BYTES];
#if COOP
  __shared__ uint4 xb_words;
  cg::grid_group grid = cg::this_grid();
  u16* sm = (u16*)smraw;
  LAS unsigned char* lds = (LAS unsigned char*)smraw;
  if (threadIdx.x == 0) xb_words = make_uint4(0u, 0u, 0u, 0u);
  __syncthreads();
  const XcdBarrier xb = xcd_barrier_post(kp_fresh()->bar, (volatile LAS unsigned*)&xb_words);
  phase_prep(*kp_fresh(), (float*)smraw);
  grid.sync();
#pragma unroll 1
  for (int layer = 0; layer < 2; ++layer) {
    { KP q = *kp_fresh(); phase_norm<0>((layer == 0) ? q.x : q.out, q.g_attn + layer * 1024, q.mod + layer * 2 * 6144, 0, 1024, q.h, nullptr); } xcd_barrier(xb);
    phase_proj(*kp_fresh(), layer, lds); xcd_barrier(xb);
    phase_local(*kp_fresh(), layer, sm); xcd_barrier(xb);
    phase_diff(*kp_fresh(), layer, sm); xcd_barrier(xb);
    { KP q = *kp_fresh(); phase_resid(q.o, 1024, q.wt_out + (size_t)layer * 1024 * 1024, (layer == 0) ? q.x : q.out, q.out, q.mod + layer * 2 * 6144 + 2048, lds); } xcd_barrier(xb);
    { KP q = *kp_fresh(); phase_norm<0>(q.out, q.g_ffn + layer * 1024, q.mod + layer * 2 * 6144, 3072, 4096, q.h, nullptr); } xcd_barrier(xb);
    phase_up(*kp_fresh(), layer, lds); xcd_barrier(xb);
    { KP q = *kp_fresh(); phase_resid(q.act, DFF, q.wt_down + (size_t)layer * 1024 * DFF, q.out, q.out, q.mod + layer * 2 * 6144 + 5120, lds); } xcd_barrier(xb);
  }
  { KP q = *kp_fresh(); phase_norm<1>(q.out, q.g_final, nullptr, 0, 0, nullptr, q.out); }
#else
  { KP q = *kp_fresh(); for (int ph = q.ph_lo; ph < q.ph_hi; ++ph) run_phase(q, ph, smraw); }
#endif
}

extern "C" void kernel_launch(void* const* d_in, const int* in_sizes, int n_in, void* d_out, int out_size, void* d_ws, size_t ws_size, hipStream_t stream) {
  (void)in_sizes; (void)n_in; (void)out_size;
  Params p;
  memset(&p, 0, sizeof(p));
  p.x = (const float*)d_in[0]; p.c = (const float*)d_in[1]; p.w_ada = (const float*)d_in[2]; p.b_ada = (const float*)d_in[3];
  p.g_attn = (const float*)d_in[4]; p.w_in = (const float*)d_in[5]; p.diff_lambda = (const float*)d_in[6]; p.diff_subln = (const float*)d_in[7];
  p.na_rpb = (const float*)d_in[8]; p.w_out = (const float*)d_in[9]; p.g_ffn = (const float*)d_in[10]; p.w_up = (const float*)d_in[11];
  p.conv_w = (const float*)d_in[12]; p.conv_b = (const float*)d_in[13]; p.w_down = (const float*)d_in[14]; p.g_final = (const float*)d_in[15];
  p.out = (float*)d_out;
  char* ws = (char*)d_ws; size_t off = 0;
  auto take = [&](size_t bytes) { char* q = ws + off; off += (bytes + 255) & ~(size_t)255; return q; };
  p.wt_in = (u16*)take((size_t)2 * 3072 * 1024 * 2);
  p.wt_out = (u16*)take((size_t)2 * 1024 * 1024 * 2);
  p.wt_up = (u16*)take((size_t)2 * 5632 * 1024 * 2);
  p.wt_down = (u16*)take((size_t)2 * 1024 * 2816 * 2);
  p.mod = (float*)take((size_t)2 * 2 * 6144 * 4);
  p.kmax = (unsigned*)take(256);
  p.bar = (unsigned*)take((size_t)XCD_BAR_WORDS * 4);
  (void)take(4096);
  p.h = (u16*)take((size_t)NTOK * 1024 * 2);
  p.o = (u16*)take((size_t)NTOK * 1024 * 2);
  p.proj = (u16*)take((size_t)NTOK * NPROJ * 2);
  p.odil = (u16*)take((size_t)3 * NTOK * 384 * 2);
  p.lse = (float*)take((size_t)3 * NTOK * 6 * 4);
  p.act = p.proj;
  if (off > ws_size) { fprintf(stderr, "workspace too small: need %zu have %zu\n", off, ws_size); return; }
  p.lam_init[0] = 0.2f; p.lam_init[1] = 0.35550906759096934f;
  static int grid_blocks = 0;
  if (!grid_blocks) {
    int dev = 0, cus = 0, per_cu = 0;
    (void)hipGetDevice(&dev);
    (void)hipDeviceGetAttribute(&cus, hipDeviceAttributeMultiprocessorCount, dev);
    (void)hipOccupancyMaxActiveBlocksPerMultiprocessor(&per_cu, mega_kernel, NTHR, 0);
    if (per_cu > 1) per_cu = 1;
    if (per_cu < 1) per_cu = 1;
    grid_blocks = cus * per_cu;
  }
#if COOP
  p.ph_lo = 0; p.ph_hi = N_PHASES;
  (void)hipMemsetAsync(p.bar, 0, (size_t)XCD_BAR_WORDS * 4, stream);
  void* args[] = {&p};
  hipError_t e = hipLaunchCooperativeKernel((void*)mega_kernel, dim3(grid_blocks), dim3(NTHR), args, 0, stream);
  if (e != hipSuccess) fprintf(stderr, "cooperative launch failed: %s (grid %d)\n", hipGetErrorString(e), grid_blocks);
#else
  for (int ph = 0; ph < N_PHASES; ++ph) {
    p.ph_lo = ph; p.ph_hi = ph + 1;
    hipLaunchKernelGGL(mega_kernel, dim3(grid_blocks), dim3(NTHR), 0, stream, p);
  }
#endif
}
```

```cpp
#include <hip/hip_runtime.h>
#include <hip/hip_cooperative_groups.h>
#include <cstdio>
#include <cstring>
namespace cg = cooperative_groups;

#ifndef COOP
#define COOP 1
#endif

#define DI __device__ __forceinline__
#define LAS __attribute__((address_space(3)))
typedef unsigned short u16;
using bf16x8 = __attribute__((ext_vector_type(8))) short;
using s16x4  = __attribute__((ext_vector_type(4))) short;
using f32x16 = __attribute__((ext_vector_type(16))) float;
using f32x4  = __attribute__((ext_vector_type(4))) float;
typedef __bf16 bf2_t __attribute__((ext_vector_type(2)));
typedef float f2_t __attribute__((ext_vector_type(2)));
#define MFMA32(a, b, c) __builtin_amdgcn_mfma_f32_32x32x16_bf16((a), (b), (c), 0, 0, 0)

constexpr int S = 16384, NTOK = 32768, DFF = 2816, NPROJ = 3072;
constexpr int NTHR = 512, NWAVE = 8;
constexpr float LOG2E = 1.4426950408889634f;
constexpr float QSCALE_DIFF = 0.25503486164919736f;
constexpr float QSCALE_64   = 0.18033688011112042f;
constexpr float NEGBIG = -1e30f;
constexpr int LDS_BYTES = 131072;

__device__ const float ROPE_INV16[16] = {
1.000000000e+00f, 5.623413324e-01f, 3.162277639e-01f, 1.778279394e-01f, 1.000000015e-01f, 5.623413250e-02f, 3.162277490e-02f, 1.778279431e-02f, 9.999999776e-03f, 5.623413250e-03f, 3.162277630e-03f, 1.778279431e-03f, 1.000000047e-03f, 5.623413017e-04f, 3.162277571e-04f, 1.778279402e-04f};
__device__ const float ROPE_INV32[32] = {
1.000000000e+00f, 7.498942018e-01f, 5.623413324e-01f, 4.216965139e-01f, 3.162277639e-01f, 2.371373773e-01f, 1.778279394e-01f, 1.333521456e-01f, 1.000000015e-01f, 7.498942316e-02f, 5.623413250e-02f, 4.216964915e-02f, 3.162277490e-02f, 2.371373773e-02f, 1.778279431e-02f, 1.333521400e-02f, 9.999999776e-03f, 7.498942316e-03f, 5.623413250e-03f, 4.216964822e-03f, 3.162277630e-03f, 2.371373819e-03f, 1.778279431e-03f, 1.333521446e-03f, 1.000000047e-03f, 7.498941850e-04f, 5.623413017e-04f, 4.216965172e-04f, 3.162277571e-04f, 2.371373703e-04f, 1.778279402e-04f, 1.333521504e-04f};

struct Params {
  const float *x, *c, *w_ada, *b_ada, *g_attn, *w_in, *diff_lambda, *diff_subln, *na_rpb, *w_out, *g_ffn, *w_up, *conv_w, *conv_b, *w_down, *g_final;
  float* out;
  u16 *wt_in, *wt_out, *wt_up, *wt_down;
  float* mod;
  unsigned* kmax;
  unsigned* bar;
  u16 *h, *o, *proj, *act, *odil;
  float* lse;
  float lam_init[2];
  int ph_lo, ph_hi;
};

typedef const __attribute__((address_space(4))) Params& KP;
DI const __attribute__((address_space(4))) Params* kp_fresh() {
  const __attribute__((address_space(4))) Params* q = (const __attribute__((address_space(4))) Params*)__builtin_amdgcn_kernarg_segment_ptr();
  asm volatile("" : "+s"(q));
  return q;
}
DI unsigned pack2(float a, float b) { f2_t v = {a, b}; return __builtin_bit_cast(unsigned, __builtin_convertvector(v, bf2_t)); }
DI float bf2f(u16 v) { return __uint_as_float(((unsigned)v) << 16); }
DI float bflo(unsigned v) { return __uint_as_float(v << 16); }
DI float bfhi(unsigned v) { return __uint_as_float(v & 0xffff0000u); }
DI int crow(int i, int hh) { return (i & 3) + 8 * (i >> 2) + 4 * hh; }
DI float exp2_hw(float x) { return __builtin_amdgcn_exp2f(x); }
DI int otid() { int t = threadIdx.x; asm volatile("" : "+v"(t)); return t; }


#define XB_TMO      128
#define XB_XCNT(j)  (256  + 64 * (j))
#define XB_XSUB(j)  (1280 + 64 * (j))
#define XB_XGEN(j)  (2304 + 64 * (j))
#define XB_TOP      3328
#define XB_TOPGEN   3392
#define XCD_BAR_WORDS 3456
#define XB_SPIN_CAP (1u << 21)
DI unsigned xb_ld(unsigned* p)              { return __hip_atomic_load(p, __ATOMIC_RELAXED, __HIP_MEMORY_SCOPE_AGENT); }
DI unsigned xb_add(unsigned* p, unsigned v) { return __hip_atomic_fetch_add(p, v, __ATOMIC_RELAXED, __HIP_MEMORY_SCOPE_AGENT); }
DI unsigned xb_xcc_id() { return (unsigned)__builtin_amdgcn_s_getreg((3 << 11) | 20) & 0xFu; }
#define XB_SPIN(cond, bar) do { unsigned _sp = 0; while (cond) { __builtin_amdgcn_s_sleep(1); \
    if ((++_sp & 255u) == 0u) { if (xb_ld(&(bar)[XB_TMO])) break; if (_sp > XB_SPIN_CAP) { atomicAdd(&(bar)[XB_TMO], 1u); break; } } } } while (0)
struct XcdBarrier { unsigned* bar; unsigned x; volatile LAS unsigned* st; };
DI XcdBarrier xcd_barrier_post(unsigned* bar, volatile LAS unsigned* st) {
  XcdBarrier b; b.bar = bar; b.x = xb_xcc_id(); b.st = st;
  if (threadIdx.x == 0) (void)xb_add(&bar[XB_XCNT(b.x)], 1u);
  return b;
}
DI void xcd_barrier_complete(unsigned* bar, unsigned x, unsigned& nloc, unsigned& nx) {
  const unsigned G = gridDim.x * gridDim.y * gridDim.z;
  unsigned sum, cnt, mine, sp = 0u;
  for (;;) {
    sum = 0u; cnt = 0u; mine = 0u;
#pragma unroll
    for (unsigned j = 0; j < 16; ++j) { const unsigned c = xb_ld(&bar[XB_XCNT(j)]); sum += c; cnt += (c > 0u) ? 1u : 0u; mine = (j == x) ? c : mine; }
    if (sum == G) break;
    __builtin_amdgcn_s_sleep(1);
    if ((++sp & 255u) == 0u) { if (xb_ld(&bar[XB_TMO])) break; if (sp > XB_SPIN_CAP) { atomicAdd(&bar[XB_TMO], 1u); break; } }
  }
  nloc = mine > 0u ? mine : 1u; nx = cnt > 0u ? cnt : 1u;
}
DI void xcd_barrier(const XcdBarrier& b) {
  asm volatile("s_waitcnt vmcnt(0)" ::: "memory");
  __syncthreads();
  if (threadIdx.x == 0) {
    unsigned* bar = b.bar;
    __builtin_amdgcn_s_waitcnt(0);
    unsigned nloc = b.st[0], nx = b.st[1];
    if (nloc == 0u) { xcd_barrier_complete(bar, b.x, nloc, nx); b.st[0] = nloc; b.st[1] = nx; }
    const unsigned old = xb_add(&bar[XB_XSUB(b.x)], 1u);
    const unsigned gen = old / nloc;
    if (old + 1u == (gen + 1u) * nloc) {
      __builtin_amdgcn_fence(__ATOMIC_RELEASE, "agent");
      asm volatile("s_waitcnt vmcnt(0)" ::: "memory");
      const unsigned og = xb_add(&bar[XB_TOP], 1u);
      const unsigned tg = og / nx;
      if (og + 1u == (tg + 1u) * nx) xb_add(&bar[XB_TOPGEN], 1u);
      else XB_SPIN(xb_ld(&bar[XB_TOPGEN]) == tg, bar);
      __builtin_amdgcn_fence(__ATOMIC_ACQUIRE, "agent");
      xb_add(&bar[XB_XGEN(b.x)], 1u);
      asm volatile("s_waitcnt vmcnt(0)" ::: "memory");
    } else {
      XB_SPIN(xb_ld(&bar[XB_XGEN(b.x)]) == gen, bar);
      __builtin_amdgcn_fence(__ATOMIC_ACQUIRE, "agent");
      asm volatile("s_waitcnt vmcnt(0)" ::: "memory");
    }
  }
  __syncthreads();
}

DI int wmap_in(int np) {
  if (np >= 768 && np < 1536) { const int hb = np & ~63, w = np & 63, g = w >> 5, n = (w >> 4) & 1, i = w & 15; return hb + 16 * g + i + 32 * n; }
  return np;
}
DI int wmap_up(int np) {
  const int pn = np >> 8, w = np & 255, bj = w >> 7, q = w & 127;
  return bj ? (DFF + 128 * pn + q) : (128 * pn + q);
}

DI void phase_prep(KP p, float* smf) {
  const int tid = otid();
  if (blockIdx.x == 0 && tid < 64) p.kmax[tid] = 0u;
  constexpr int N_ADA = 192;
  constexpr int T_IN = 16 * 24, T_OUT = 16 * 8, T_UP = 16 * 44, T_DOWN = 44 * 8;
  constexpr int T_LAYER = T_IN + T_OUT + T_UP + T_DOWN;
  const int total = N_ADA + 2 * T_LAYER;
  for (int it = blockIdx.x; it < total; it += gridDim.x) {
    if (it < N_ADA) {
      const int l = it / 96, cgp = it % 96;
      float* sc = smf;
      float* red = smf + 2048;
      for (int i = tid; i < 2048; i += NTHR) { float v = p.c[i]; sc[i] = v / (1.f + __expf(-v)); }
      __syncthreads();
      const int kq = tid >> 6, cc = tid & 63, col = cgp * 64 + cc;
      const float* wp = p.w_ada + ((size_t)l * 1024 + kq * 128) * 6144 + col;
      float a0 = 0.f, a1 = 0.f;
#pragma unroll 8
      for (int k = 0; k < 128; ++k) { float w = wp[(size_t)k * 6144]; a0 += sc[kq * 128 + k] * w; a1 += sc[1024 + kq * 128 + k] * w; }
      red[(kq * 2 + 0) * 64 + cc] = a0; red[(kq * 2 + 1) * 64 + cc] = a1;
      __syncthreads();
      if (tid < 128) {
        const int b = tid >> 6, c2 = tid & 63;
        float s = 0.f;
#pragma unroll
        for (int q = 0; q < 8; ++q) s += red[(q * 2 + b) * 64 + c2];
        p.mod[(l * 2 + b) * 6144 + cgp * 64 + c2] = s + p.b_ada[l * 6144 + cgp * 64 + c2];
      }
    } else {
      int idx = it - N_ADA; const int l = idx / T_LAYER; int j = idx % T_LAYER;
      const float* W; u16* dst; int Kd, N, tk, tn, kind;
      if (j < T_IN) { W = p.w_in + (size_t)l * 1024 * 3072; dst = p.wt_in + (size_t)l * 3072 * 1024; Kd = 1024; N = 3072; tk = j / 24; tn = j % 24; kind = 0; }
      else if (j < T_IN + T_OUT) { j -= T_IN; W = p.w_out + (size_t)l * 1024 * 1024; dst = p.wt_out + (size_t)l * 1024 * 1024; Kd = 1024; N = 1024; tk = j / 8; tn = j % 8; kind = 1; }
      else if (j < T_IN + T_OUT + T_UP) { j -= T_IN + T_OUT; W = p.w_up + (size_t)l * 1024 * 5632; dst = p.wt_up + (size_t)l * 5632 * 1024; Kd = 1024; N = 5632; tk = j / 44; tn = j % 44; kind = 2; }
      else { j -= T_IN + T_OUT + T_UP; W = p.w_down + (size_t)l * 2816 * 1024; dst = p.wt_down + (size_t)l * 1024 * 2816; Kd = 2816; N = 1024; tk = j / 8; tn = j % 8; kind = 3; }
      const int hb = tid >> 8, t = tid & 255;
      const int k0 = tk * 64, n0 = (tn * 2 + hb) * 64;
      float* tile = smf + hb * (64 * 65);
      const int nn = t & 63;
      const int np = n0 + nn;
      const int srccol = (kind == 0) ? wmap_in(np) : (kind == 2) ? wmap_up(np) : np;
#pragma unroll 4
      for (int i = 0; i < 16; ++i) { const int kk = i * 4 + (t >> 6); tile[kk * 65 + nn] = W[(size_t)(k0 + kk) * N + srccol]; }
      __syncthreads();
      const int nrow = t >> 2, kc = (t & 3) * 16;
      unsigned pk[8];
#pragma unroll
      for (int q = 0; q < 8; ++q) pk[q] = pack2(tile[(kc + 2 * q) * 65 + nrow], tile[(kc + 2 * q + 1) * 65 + nrow]);
      uint4* dp = (uint4*)(dst + (size_t)(n0 + nrow) * Kd + k0 + kc);
      dp[0] = make_uint4(pk[0], pk[1], pk[2], pk[3]);
      dp[1] = make_uint4(pk[4], pk[5], pk[6], pk[7]);
    }
    __syncthreads();
  }
}

DI float wave_sum(float v) {
#pragma unroll
  for (int o = 32; o >= 1; o >>= 1) v += __shfl_xor(v, o);
  return v;
}

template <int MODE>
DI void phase_norm(const float* xin, const float* g, const float* modl, int sh_off, int sc_off, u16* hout, float* fout) {
  const int tid = otid(); const int lane = tid & 63, w = tid >> 6;
  for (int row = blockIdx.x * NWAVE + w; row < NTOK; row += gridDim.x * NWAVE) {
    const int b = row >> 14;
    const float4* xr = (const float4*)(xin + (size_t)row * 1024);
    float4 v[4];
#pragma unroll
    for (int i = 0; i < 4; ++i) v[i] = xr[lane + i * 64];
    float ss = 0.f;
#pragma unroll
    for (int i = 0; i < 4; ++i) ss += v[i].x * v[i].x + v[i].y * v[i].y + v[i].z * v[i].z + v[i].w * v[i].w;
    ss = wave_sum(ss);
    const float inv = rsqrtf(ss * (1.f / 1024.f) + 1e-6f);
#pragma unroll
    for (int i = 0; i < 4; ++i) {
      const int col = (lane + i * 64) * 4;
      const float4 g4 = *(const float4*)(g + col);
      if (MODE == 0) {
        const float4 sc4 = *(const float4*)(modl + b * 6144 + sc_off + col);
        const float4 sh4 = *(const float4*)(modl + b * 6144 + sh_off + col);
        float y0 = v[i].x * inv * g4.x * (1.f + sc4.x) + sh4.x;
        float y1 = v[i].y * inv * g4.y * (1.f + sc4.y) + sh4.y;
        float y2 = v[i].z * inv * g4.z * (1.f + sc4.z) + sh4.z;
        float y3 = v[i].w * inv * g4.w * (1.f + sc4.w) + sh4.w;
        *(uint2*)(hout + (size_t)row * 1024 + col) = make_uint2(pack2(y0, y1), pack2(y2, y3));
      } else {
        float4 y; y.x = v[i].x * inv * g4.x; y.y = v[i].y * inv * g4.y; y.z = v[i].z * inv * g4.z; y.w = v[i].w * inv * g4.w;
        *(float4*)(fout + (size_t)row * 1024 + col) = y;
      }
    }
  }
}

namespace pg8 {
constexpr int BM = 256, BK = 64, HALF = 128, HTB = HALF * BK * 2, NXCD = 8, WGM = 8;
DI int lds_byte(int r, int c) { const int st = (r >> 4) * 2 + (c >> 5), rr = r & 15, cc = c & 31, ob = rr * 64 + cc * 2; return st * 1024 + (ob ^ (((ob >> 9) & 1) << 5)); }
DI void stage_rc(int b, int& R, int& C) { const int st = b / 1024, sb = b % 1024, swz = sb ^ (((sb >> 9) & 1) << 5); R = (st >> 1) * 16 + swz / 64; C = (st & 1) * 32 + (swz % 64) / 2; }
struct Unit { int pm, pn; };
struct StaticOrder {
  int nM, nN, nwg, G, c;
  DI void init(int nM_, int nN_, int G_, int c_) { nM = nM_; nN = nN_; nwg = nM * nN; G = G_; c = c_; }
  DI bool next(int i, Unit& u) const {
    const long L = (long)i * G + c; if (L >= nwg) return false;
    int wgid = (int)L; { const int q = nwg / NXCD, r = nwg % NXCD, xcd = wgid % NXCD, off = wgid / NXCD; wgid = (xcd < r ? xcd * (q + 1) : r * (q + 1) + (xcd - r) * q) + off; }
    const int nig = WGM * nN, gid = wgid / nig, fm = gid * WGM, gsz = (nM - fm) < WGM ? (nM - fm) : WGM;
    u.pm = fm + ((wgid % nig) % gsz); u.pn = (wgid % nig) / gsz; return true;
  }
};
struct AMapPlain { static constexpr int HALF_ROWS = 128; static DI int row(int R) { return R; } static DI long tile_row0(int pm) { return (long)pm * 256; } };
struct AMapHalo  { static constexpr int HALF_ROWS = 124; static DI int row(int R) { return 62 * (R >> 6) + (R & 63); } static DI long tile_row0(int pm) { const int b = pm / 67, ti = pm % 67; return (long)b * S + 248 * ti - 1; } };

template <class AMap, class Epi>
DI void gemm_phase(LAS unsigned char* lds, const u16* Aptr, const u16* Btptr, int K, const StaticOrder& SO, const Epi& E) {
  const int tid = otid(), wid = __builtin_amdgcn_readfirstlane(tid >> 6), lane = tid & 63, wr = wid >> 2, wc = wid & 3, fr = lane & 15, fq = lane >> 4;
  const int nt = K / BK;
  unsigned voffA[2], voffB[2];
#pragma unroll
  for (int i = 0; i < 2; ++i) { int R, C; stage_rc(tid * 16 + i * 8192, R, C);
    voffA[i] = (unsigned)(AMap::row(R) * K + C) * 2u; voffB[i] = (unsigned)(R * K + C) * 2u; }
  const size_t kstep = (size_t)(BK * 2);
  const size_t hstepA = (size_t)AMap::HALF_ROWS * K * 2, hstepB = (size_t)HALF * K * 2;
  const size_t tstepB = 2 * hstepB;
  const size_t rowB = (size_t)K * 2;
  const unsigned ldsw = (unsigned)wid * 1024u;
  const int aoff = lds_byte(wr * 64 + fr, fq * 8), boff = lds_byte(wc * 32 + fr, fq * 8);
#define PG8_SA(b, h) (((b) * 2 + (h)) * HTB)
#define PG8_SB(b, h) ((4 + (b) * 2 + (h)) * HTB)
#define PG8_STAGE(bufoff, gbase, voff) do { _Pragma("unroll") for (int _i = 0; _i < 2; ++_i) \
        __builtin_amdgcn_global_load_lds((const unsigned*)((const char*)(gbase) + (voff)[_i]), (LAS unsigned*)(lds + (bufoff) + ldsw + _i * 8192), 16, 0, 0); } while (0)
#define PG8_LDA(dst, b, h) do { _Pragma("unroll") for (int m = 0; m < 4; ++m) _Pragma("unroll") for (int k = 0; k < 2; ++k) dst[m][k] = *(const LAS bf16x8*)(lds + PG8_SA(b, h) + aoff + m * 2048 + k * 1024); } while (0)
#define PG8_LDB(dst, b, h) do { _Pragma("unroll") for (int n = 0; n < 2; ++n) _Pragma("unroll") for (int k = 0; k < 2; ++k) dst[n][k] = *(const LAS bf16x8*)(lds + PG8_SB(b, h) + boff + n * 2048 + k * 1024); } while (0)
#define PG8_MMA(ai, bj, At, Bt) do { __builtin_amdgcn_s_setprio(1); _Pragma("unroll") for (int m = 0; m < 4; ++m) _Pragma("unroll") for (int n = 0; n < 2; ++n) _Pragma("unroll") for (int k = 0; k < 2; ++k) \
        acc[ai][bj][m][n] = __builtin_amdgcn_mfma_f32_16x16x32_bf16(Bt[n][k], At[m][k], acc[ai][bj][m][n], 0, 0, 0); __builtin_amdgcn_s_setprio(0); } while (0)
#define PG8_WAIT_V(n) asm volatile("s_waitcnt vmcnt(" #n ")" ::: "memory")
#define PG8_WAIT_L(n) asm volatile("s_waitcnt lgkmcnt(" #n ")" ::: "memory")
#define PG8_BAR __builtin_amdgcn_s_barrier()
#define PG8_SCHED __builtin_amdgcn_sched_barrier(0)
  Unit cur, nxt; int ui = 0;
  if (!SO.next(0, cur)) return;
  f32x4 acc[2][2][4][2];
#pragma unroll
  for (int a = 0; a < 2; ++a)
#pragma unroll
    for (int b = 0; b < 2; ++b)
#pragma unroll
      for (int m = 0; m < 4; ++m)
#pragma unroll
        for (int n = 0; n < 2; ++n) acc[a][b][m][n] = (f32x4){0.f, 0.f, 0.f, 0.f};
  bf16x8 At[4][2], B0[2][2], B1[2][2];
  const char* cA = (const char*)Aptr + AMap::tile_row0(cur.pm) * (long)rowB; const char* cB = (const char*)Btptr + (size_t)cur.pn * tstepB;
  PG8_STAGE(PG8_SB(0, 0), cB, voffB); PG8_STAGE(PG8_SA(0, 0), cA, voffA); PG8_STAGE(PG8_SB(0, 1), cB + hstepB, voffB); PG8_STAGE(PG8_SA(0, 1), cA + hstepA, voffA);
  if (wr == 1) PG8_BAR;
  PG8_WAIT_V(4); PG8_BAR;
  PG8_STAGE(PG8_SB(1, 0), cB + kstep, voffB); PG8_STAGE(PG8_SA(1, 0), cA + kstep, voffA); PG8_STAGE(PG8_SB(1, 1), cB + hstepB + kstep, voffB);
  PG8_WAIT_V(6); PG8_BAR;
  for (;;) {
    const bool has_next = SO.next(ui + 1, nxt);
    const char* nA = has_next ? (const char*)Aptr + AMap::tile_row0(nxt.pm) * (long)rowB : cA; const char* nB = has_next ? (const char*)Btptr + (size_t)nxt.pn * tstepB : cB;
    for (int t = 0; t < nt; t += 2) {
      const bool last = (t == nt - 2);
      const char* a1 = cA + (size_t)(t + 1) * kstep;
      const char* a2 = last ? nA : cA + (size_t)(t + 2) * kstep; const char* b2 = last ? nB : cB + (size_t)(t + 2) * kstep;
      const char* a3 = a2 + kstep; const char* b3 = b2 + kstep;
      PG8_LDB(B0, 0, 0); PG8_SCHED; PG8_LDA(At, 0, 0); PG8_STAGE(PG8_SA(1, 1), a1 + hstepA, voffA);
      PG8_WAIT_L(8); PG8_BAR; PG8_WAIT_L(0); PG8_MMA(0, 0, At, B0); PG8_BAR; PG8_SCHED;
      PG8_LDB(B1, 0, 1); PG8_STAGE(PG8_SB(0, 0), b2, voffB);
      PG8_BAR; PG8_WAIT_L(0); PG8_MMA(0, 1, At, B1); PG8_BAR;
      PG8_LDA(At, 0, 1); PG8_STAGE(PG8_SA(0, 0), a2, voffA);
      PG8_BAR; PG8_WAIT_L(0); PG8_MMA(1, 0, At, B0); PG8_BAR; PG8_SCHED;
      PG8_STAGE(PG8_SB(0, 1), b2 + hstepB, voffB);
      PG8_WAIT_V(6); PG8_BAR; PG8_MMA(1, 1, At, B1); PG8_BAR;
      PG8_LDB(B0, 1, 0); PG8_SCHED; PG8_LDA(At, 1, 0); PG8_STAGE(PG8_SA(0, 1), a2 + hstepA, voffA);
      PG8_WAIT_L(8); PG8_BAR; PG8_WAIT_L(0); PG8_MMA(0, 0, At, B0); PG8_BAR; PG8_SCHED;
      PG8_LDB(B1, 1, 1); PG8_STAGE(PG8_SB(1, 0), b3, voffB);
      PG8_BAR; PG8_WAIT_L(0); PG8_MMA(0, 1, At, B1); PG8_BAR;
      PG8_LDA(At, 1, 1); PG8_STAGE(PG8_SA(1, 0), a3, voffA);
      PG8_BAR; PG8_WAIT_L(0); PG8_MMA(1, 0, At, B0); PG8_BAR; PG8_SCHED;
      PG8_STAGE(PG8_SB(1, 1), b3 + hstepB, voffB);
      PG8_WAIT_V(6); PG8_BAR; PG8_MMA(1, 1, At, B1); PG8_BAR;
    }
    E(acc, cur, wr, wc, fr, fq);
    if (!has_next) break;
#pragma unroll
    for (int a = 0; a < 2; ++a)
#pragma unroll
      for (int b = 0; b < 2; ++b)
#pragma unroll
        for (int m = 0; m < 4; ++m)
#pragma unroll
          for (int n = 0; n < 2; ++n) acc[a][b][m][n] = (f32x4){0.f, 0.f, 0.f, 0.f};
    cur = nxt; cA = nA; cB = nB; ++ui;
  }
  PG8_WAIT_V(0);
  if (wr == 0) PG8_BAR;
  PG8_BAR;
#undef PG8_SA
#undef PG8_SB
#undef PG8_STAGE
#undef PG8_LDA
#undef PG8_LDB
#undef PG8_MMA
#undef PG8_WAIT_V
#undef PG8_WAIT_L
#undef PG8_BAR
#undef PG8_SCHED
}
}

DI void sincos_big(float ang, float& sn, float& cs) {
  const float c_hi = 1.591549367e-01f, c_lo = 6.420638243e-09f;
  const float rh = ang * c_hi;
  const float e = __builtin_fmaf(ang, c_hi, -rh);
  const float fr = rh - floorf(rh);
  const float rev = fr + (e + ang * c_lo);
  sn = __builtin_amdgcn_sinf(rev);
  cs = __builtin_amdgcn_cosf(rev);
}

struct EpiProj {
  u16* proj;
  DI void operator()(const f32x4 (&acc)[2][2][4][2], const pg8::Unit& u, int wr, int wc, int fr, int fq) const {
    const f32x4 i16 = *(const f32x4*)(ROPE_INV16 + 4 * fq);
    const f32x4 i32v = *(const f32x4*)(ROPE_INV32 + 16 * (wc & 1) + 4 * fq);
#pragma unroll
    for (int bj = 0; bj < 2; ++bj) {
      const int gcol0 = u.pn * 256 + bj * 128 + wc * 32;
      int mode; float scale = 1.f;
      if (gcol0 < 256) { mode = 1; scale = QSCALE_DIFF; }
      else if (gcol0 < 512) { mode = 1; }
      else if (gcol0 < 768) { mode = 0; }
      else if (gcol0 < 1152) { mode = 2; scale = QSCALE_64; }
      else if (gcol0 < 1536) { mode = 2; }
      else if (gcol0 < 1920) { mode = 0; }
      else if (gcol0 < 2304) { mode = 0; scale = QSCALE_64; }
      else { mode = 0; }
      f32x4 invv;
#pragma unroll
      for (int e = 0; e < 4; ++e) invv[e] = (mode == 1) ? i16[e] : i32v[e];
      int c1, c2;
      if (mode == 2) { const int hb = gcol0 & ~63, g = wc & 1; c1 = hb + 16 * g + 4 * fq; c2 = c1 + 32; }
      else { c1 = gcol0 + 4 * fq; c2 = c1 + 16; }
#pragma unroll
      for (int ai = 0; ai < 2; ++ai)
#pragma unroll
        for (int m = 0; m < 4; ++m) {
          const int row = u.pm * 256 + ai * 128 + wr * 64 + m * 16 + fr;
          f32x4 x1 = acc[ai][bj][m][0], x2 = acc[ai][bj][m][1];
          if (mode != 0) {
            const float pos = (float)(row & (S - 1));
#pragma unroll
            for (int e = 0; e < 4; ++e) {
              const float ang = __fmul_rn(pos, invv[e]);
              float sn, cs; sincos_big(ang, sn, cs);
              const float y1 = x1[e] * cs - x2[e] * sn, y2 = x2[e] * cs + x1[e] * sn;
              x1[e] = y1; x2[e] = y2;
            }
          }
          u16* dp = proj + (size_t)row * NPROJ;
          *(uint2*)(dp + c1) = make_uint2(pack2(x1[0] * scale, x1[1] * scale), pack2(x1[2] * scale, x1[3] * scale));
          *(uint2*)(dp + c2) = make_uint2(pack2(x2[0] * scale, x2[1] * scale), pack2(x2[2] * scale, x2[3] * scale));
        }
    }
  }
};

struct EpiResid {
  const float* xold; float* xnew; const float* gate;
  DI void operator()(const f32x4 (&acc)[2][2][4][2], const pg8::Unit& u, int wr, int wc, int fr, int fq) const {
    const int b = (u.pm * 256) >> 14;
    const int col0 = u.pn * 256 + wc * 32 + 4 * fq;
    f32x4 gv[2][2];
#pragma unroll
    for (int bj = 0; bj < 2; ++bj)
#pragma unroll
      for (int n = 0; n < 2; ++n) gv[bj][n] = *(const f32x4*)(gate + b * 6144 + col0 + bj * 128 + n * 16);
#pragma unroll
    for (int ai = 0; ai < 2; ++ai)
#pragma unroll
      for (int m = 0; m < 4; ++m) {
        const size_t off = (size_t)(u.pm * 256 + ai * 128 + wr * 64 + m * 16 + fr) * 1024 + col0;
        f32x4 xo[2][2];
#pragma unroll
        for (int bj = 0; bj < 2; ++bj)
#pragma unroll
          for (int n = 0; n < 2; ++n) xo[bj][n] = *(const f32x4*)(xold + off + bj * 128 + n * 16);
#pragma unroll
        for (int bj = 0; bj < 2; ++bj)
#pragma unroll
          for (int n = 0; n < 2; ++n) *(f32x4*)(xnew + off + bj * 128 + n * 16) = xo[bj][n] + gv[bj][n] * acc[ai][bj][m][n];
        asm volatile("" ::: "memory");
      }
  }
};

DI float dpp_ror1(float v)  { return __builtin_bit_cast(float, __builtin_amdgcn_update_dpp(0, __builtin_bit_cast(int, v), 0x121, 0xf, 0xf, false)); }
DI float dpp_ror15(float v) { return __builtin_bit_cast(float, __builtin_amdgcn_update_dpp(0, __builtin_bit_cast(int, v), 0x12F, 0xf, 0xf, false)); }
struct EpiUp {
  u16* act; const float* cw; const float* cb;
  DI void operator()(const f32x4 (&acc)[2][2][4][2], const pg8::Unit& u, int wr, int wc, int fr, int fq) const {
    const int b = u.pm / 67, ti = u.pm % 67;
#pragma unroll
    for (int n = 0; n < 2; ++n) {
      const int col = u.pn * 128 + wc * 32 + n * 16 + 4 * fq;
      const f32x4 w0 = *(const f32x4*)(cw + col), w1 = *(const f32x4*)(cw + DFF + col), w2 = *(const f32x4*)(cw + 2 * DFF + col), bb = *(const f32x4*)(cb + col);
#pragma unroll
      for (int ai = 0; ai < 2; ++ai) {
        const int tokb = 248 * ti - 1 + 62 * (2 * ai + wr);
        f32x4 g[4];
#pragma unroll
        for (int m = 0; m < 4; ++m) {
          const int tok = tokb + 16 * m + fr;
          const bool ok = (tok >= 0) && (tok < S);
#pragma unroll
          for (int e = 0; e < 4; ++e) g[m][e] = ok ? acc[ai][0][m][n][e] : 0.f;
        }
#pragma unroll
        for (int m = 0; m < 4; ++m) {
          const int q = 16 * m + fr, tok = tokb + q;
          f32x4 r;
#pragma unroll
          for (int e = 0; e < 4; ++e) {
            const float srcm = (fr == 15 && m > 0) ? g[m > 0 ? m - 1 : 0][e] : g[m][e];
            const float srcp = (fr == 0 && m < 3) ? g[m < 3 ? m + 1 : 3][e] : g[m][e];
            const float gm = dpp_ror1(srcm), gp = dpp_ror15(srcp);
            const float cv = bb[e] + w0[e] * gm + w1[e] * g[m][e] + w2[e] * gp;
            r[e] = cv * __builtin_amdgcn_rcpf(1.f + exp2_hw(-LOG2E * cv)) * acc[ai][1][m][n][e];
          }
          if (q >= 1 && q <= 62 && tok < S)
            *(uint2*)(act + (size_t)(b * S + tok) * DFF + col) = make_uint2(pack2(r[0], r[1]), pack2(r[2], r[3]));
        }
      }
    }
  }
};

constexpr int VROW = 96;
constexpr int VT_WAVE = 64 * VROW;
DI bf16x8 v_frag_tr(const u16* Vb, int kb0, int mb, int sp, int lane) {
  const int i16 = lane & 15, q = i16 >> 2, pp = i16 & 3, blk = (lane >> 4) & 1, hh = lane >> 5;
  const u16* a0 = Vb + (kb0 + 16 * sp + 4 * hh + q) * VROW + (mb * 2 + blk) * 16 + 4 * pp;
  const s16x4 lo = __builtin_amdgcn_ds_read_tr16_b64_v4i16((LAS s16x4*)a0);
  const s16x4 hi = __builtin_amdgcn_ds_read_tr16_b64_v4i16((LAS s16x4*)(a0 + 8 * VROW));
  return __builtin_shufflevector(lo, hi, 0, 1, 2, 3, 4, 5, 6, 7);
}

DI void local_softmax_step(float (&sv)[2][16], float& m_run, float& l_run, f32x16 (&O)[2], bf16x8 (&pk)[2][2]) {
  float tmax = NEGBIG;
#pragma unroll
  for (int h2 = 0; h2 < 2; ++h2)
#pragma unroll
    for (int i = 0; i < 16; ++i) tmax = fmaxf(tmax, sv[h2][i]);
  tmax = fmaxf(tmax, __shfl_xor(tmax, 32));
  const float m_new = fmaxf(m_run, tmax);
  if (__builtin_amdgcn_ballot_w64(m_new > m_run) != 0ull) {
    const float alpha = exp2_hw(m_run - m_new);
    m_run = m_new; l_run *= alpha;
#pragma unroll
    for (int mb = 0; mb < 2; ++mb)
#pragma unroll
      for (int i = 0; i < 16; ++i) O[mb][i] *= alpha;
  }
#pragma unroll
  for (int h2 = 0; h2 < 2; ++h2)
#pragma unroll
    for (int sp = 0; sp < 2; ++sp) {
      unsigned q4[4];
#pragma unroll
      for (int q = 0; q < 4; ++q) {
        const float s0 = sv[h2][8 * sp + 2 * q], s1 = sv[h2][8 * sp + 2 * q + 1];
        const float p0 = exp2_hw(s0 - m_run), p1 = exp2_hw(s1 - m_run);
        l_run += p0; l_run += p1;
        q4[q] = pack2(p0, p1);
      }
      pk[h2][sp] = __builtin_bit_cast(bf16x8, make_uint4(q4[0], q4[1], q4[2], q4[3]));
    }
}
DI void local_store_out(const f32x16 (&O)[2], float l_run, u16* op, int hh) {
  const float l = l_run + __shfl_xor(l_run, 32);
  const float il = 1.f / l;
#pragma unroll
  for (int mb = 0; mb < 2; ++mb)
#pragma unroll
    for (int g = 0; g < 4; ++g) {
      const int d = mb * 32 + 8 * g + 4 * hh;
      *(uint2*)(op + d) = make_uint2(pack2(O[mb][4 * g] * il, O[mb][4 * g + 1] * il), pack2(O[mb][4 * g + 2] * il, O[mb][4 * g + 3] * il));
    }
}

constexpr int KS_STRIDE = 72;
constexpr int KS_BUF = 64 * KS_STRIDE, VS_BUF = 64 * VROW;
DI void swin_attn_item(KP p, int item, u16* sm) {
  const int tid = otid(), lane = tid & 63, w = __builtin_amdgcn_readfirstlane(tid >> 6), r = lane & 31, hh = lane >> 5;
  u16* Ks = sm; u16* Vs = sm + 2 * KS_BUF;
  const int bhp = item >> 6, sub = item & 63;
  const int pat = bhp % 3, bh = bhp / 3, head = bh % 6, b = bh / 6;
  const int sh = 2 * pat, L = S >> sh;
  const int cls = sub >> (6 - sh), pb = sub & ((64 >> sh) - 1);
  const int P = pb * 256;
  const int qp = P + 32 * w + r, tq = cls + (qp << sh);
  const u16* prow = p.proj + (size_t)b * S * NPROJ;
  bf16x8 qf[4];
#pragma unroll
  for (int s = 0; s < 4; ++s) qf[s] = *(const bf16x8*)(prow + (size_t)tq * NPROJ + 768 + head * 64 + s * 16 + 8 * hh);
  f32x16 O[2];
#pragma unroll
  for (int mb = 0; mb < 2; ++mb)
#pragma unroll
    for (int i = 0; i < 16; ++i) O[mb][i] = 0.f;
  float m_run = -1e20f, l_run = 0.f;
  const int key0 = tid >> 3, ch = tid & 7;
  const u16* kg = prow + 1152 + head * 64 + ch * 8;
  auto gk = [&](int j) __attribute__((always_inline)) -> const u16* {
    int kp = P - 64 + 64 * j + key0; kp = kp < 0 ? 0 : (kp > L - 1 ? L - 1 : kp);
    return kg + (size_t)(cls + (kp << sh)) * NPROJ;
  };
  const uint4 k0 = *(const uint4*)gk(0), v0 = *(const uint4*)(gk(0) + 384), k1 = *(const uint4*)gk(1), v1 = *(const uint4*)(gk(1) + 384);
  const uint4 k2 = *(const uint4*)gk(2), v2 = *(const uint4*)(gk(2) + 384), k3 = *(const uint4*)gk(3), v3 = *(const uint4*)(gk(3) + 384);
  const uint4 k4 = *(const uint4*)gk(4), v4 = *(const uint4*)(gk(4) + 384), k5 = *(const uint4*)gk(5), v5 = *(const uint4*)(gk(5) + 384);
  auto lstore = [&](int buf, const uint4& kr, const uint4& vr) __attribute__((always_inline)) {
    *(uint4*)(Ks + buf * KS_BUF + key0 * KS_STRIDE + ch * 8) = kr;
    *(uint4*)(Vs + buf * VS_BUF + key0 * VROW + ch * 8) = vr;
  };
  lstore(0, k0, v0);
  __syncthreads();
  const int jlo = w >> 1;
#pragma unroll
  for (int j = 0; j < 6; ++j) {
    const int buf = j & 1;
    if (j >= jlo && j <= jlo + 2) {
      f32x16 Sc[2];
#pragma unroll
      for (int i = 0; i < 16; ++i) { Sc[0][i] = 0.f; Sc[1][i] = 0.f; }
#pragma unroll
      for (int s = 0; s < 4; ++s)
#pragma unroll
        for (int h2 = 0; h2 < 2; ++h2) {
          const bf16x8 kf = *(const bf16x8*)(Ks + buf * KS_BUF + (h2 * 32 + r) * KS_STRIDE + s * 16 + 8 * hh);
          Sc[h2] = MFMA32(kf, qf[s], Sc[h2]);
        }
      const int dbase = (64 * j - 32 * w) + 4 * hh - r;
      const int kbase = P - 64 + 64 * j + 4 * hh;
      float sv[2][16];
#pragma unroll
      for (int h2 = 0; h2 < 2; ++h2)
#pragma unroll
        for (int i = 0; i < 16; ++i) {
          const int c = h2 * 32 + (i & 3) + 8 * (i >> 2);
          const bool valid = ((unsigned)(dbase + c) <= 128u) && ((unsigned)(kbase + c) < (unsigned)L);
          sv[h2][i] = valid ? Sc[h2][i] : NEGBIG;
        }
      bf16x8 pk[2][2];
      local_softmax_step(sv, m_run, l_run, O, pk);
#pragma unroll
      for (int h2 = 0; h2 < 2; ++h2)
#pragma unroll
        for (int sp = 0; sp < 2; ++sp)
#pragma unroll
          for (int mb = 0; mb < 2; ++mb) {
            const bf16x8 vf = v_frag_tr(Vs + buf * VS_BUF, h2 * 32, mb, sp, lane);
            O[mb] = MFMA32(vf, pk[h2][sp], O[mb]);
          }
    }
    if (j == 0) lstore(1, k1, v1);
    if (j == 1) lstore(0, k2, v2);
    if (j == 2) lstore(1, k3, v3);
    if (j == 3) lstore(0, k4, v4);
    if (j == 4) lstore(1, k5, v5);
    __syncthreads();
  }
  const size_t orow = (size_t)pat * NTOK + (size_t)b * S + tq;
  const float l = l_run + __shfl_xor(l_run, 32);
  if (hh == 0) p.lse[orow * 6 + head] = m_run + __log2f(l);
  local_store_out(O, l_run, p.odil + orow * 384 + head * 64, hh);
}

DI void combine_dil(KP p) {
  const int tid = otid();
  for (int tc = blockIdx.x; tc < 256; tc += gridDim.x) {
#pragma unroll 1
    for (int idx = tid; idx < 128 * 48; idx += NTHR) {
      const int tok = tc * 128 + idx / 48, c8 = idx % 48, head = c8 >> 3;
      float ls[3], wgt[3];
#pragma unroll
      for (int q = 0; q < 3; ++q) ls[q] = p.lse[((size_t)q * NTOK + tok) * 6 + head];
      const float mx = fmaxf(ls[0], fmaxf(ls[1], ls[2]));
      float sum = 0.f;
#pragma unroll
      for (int q = 0; q < 3; ++q) { wgt[q] = exp2_hw(ls[q] - mx); sum += wgt[q]; }
      const float isum = 1.f / sum;
      float acc[8];
#pragma unroll
      for (int e = 0; e < 8; ++e) acc[e] = 0.f;
#pragma unroll
      for (int q = 0; q < 3; ++q) {
        const uint4 v = *(const uint4*)(p.odil + ((size_t)q * NTOK + tok) * 384 + c8 * 8);
        const float wq = wgt[q] * isum;
        acc[0] += wq * bflo(v.x); acc[1] += wq * bfhi(v.x); acc[2] += wq * bflo(v.y); acc[3] += wq * bfhi(v.y);
        acc[4] += wq * bflo(v.z); acc[5] += wq * bfhi(v.z); acc[6] += wq * bflo(v.w); acc[7] += wq * bfhi(v.w);
      }
      *(uint4*)(p.o + (size_t)tok * 1024 + 256 + c8 * 8) = make_uint4(pack2(acc[0], acc[1]), pack2(acc[2], acc[3]), pack2(acc[4], acc[5]), pack2(acc[6], acc[7]));
    }
  }
}

constexpr int RPB_PAD = 48, RPB_LDS = 15 * 31 + 2 * RPB_PAD;
DI void na_attn_item(KP p, int layer, int item, u16* sm) {
  const int tid = otid(), lane = tid & 63, w = __builtin_amdgcn_readfirstlane(tid >> 6), r = lane & 31, hh = lane >> 5;
  u16* Ks = sm; u16* Vs = sm + 2 * KS_BUF;
  const int b = item / (6 * 64), rem = item % (6 * 64), head = rem / 64, g = rem % 64;
  const int rr = 4 * g + (w >> 1), half = w & 1;
  const int tq = rr * 64 + half * 32 + r, qc = half * 32 + r;
  auto rstart = [](int x) { int v = x - 4; return v < 0 ? 0 : (v > 248 ? 248 : v); };
  const int my_rs = rstart(rr), rs_lo = rstart(4 * g), rs_hi = rstart(4 * g + 3) + 7;
  const u16* prow = p.proj + (size_t)b * S * NPROJ;
  const float* rpb = p.na_rpb + ((size_t)layer * 6 + head) * 15 * 31;
  bf16x8 qf[4];
#pragma unroll
  for (int s = 0; s < 4; ++s) qf[s] = *(const bf16x8*)(prow + (size_t)tq * NPROJ + 1920 + head * 64 + s * 16 + 8 * hh);
  int cs = qc - 8; cs = cs < 0 ? 0 : (cs > 48 ? 48 : cs);
  float* rtab = (float*)(sm + 2 * KS_BUF + 2 * VS_BUF);
  for (int i = tid; i < RPB_LDS; i += NTHR) { const int j = i - RPB_PAD; rtab[i] = (j >= 0 && j < 15 * 31) ? rpb[j] * LOG2E : 0.f; }
  const int vbase = 4 * hh - cs;
  f32x16 O[2];
#pragma unroll
  for (int mb = 0; mb < 2; ++mb)
#pragma unroll
    for (int i = 0; i < 16; ++i) O[mb][i] = 0.f;
  float m_run = -1e20f, l_run = 0.f;
  uint4 kr, vr, kr2, vr2, kr3, vr3;
  const int key0 = tid >> 3, ch = tid & 7;
  const u16* kg = prow + (size_t)key0 * NPROJ + 2304 + head * 64 + ch * 8;
  auto gload = [&](int krow, uint4& kd, uint4& vd) __attribute__((always_inline)) {
    const u16* src = kg + (size_t)((krow > 255 ? 255 : krow) * 64) * NPROJ;
    kd = *(const uint4*)src; vd = *(const uint4*)(src + 384);
  };
  auto lstore = [&](int buf) __attribute__((always_inline)) {
    *(uint4*)(Ks + buf * KS_BUF + key0 * KS_STRIDE + ch * 8) = kr;
    *(uint4*)(Vs + buf * VS_BUF + key0 * VROW + ch * 8) = vr;
  };
  gload(rs_lo, kr, vr); lstore(0);
  gload(rs_lo + 1, kr, vr); gload(rs_lo + 2, kr2, vr2);
  __syncthreads();
  for (int krow = rs_lo; krow <= rs_hi; ++krow) {
    const int buf = (krow - rs_lo) & 1;
    gload(krow + 3, kr3, vr3);
    if (krow >= my_rs && krow < my_rs + 8) {
      f32x16 Sc[2];
#pragma unroll
      for (int i = 0; i < 16; ++i) { Sc[0][i] = 0.f; Sc[1][i] = 0.f; }
#pragma unroll
      for (int s = 0; s < 4; ++s)
#pragma unroll
        for (int h2 = 0; h2 < 2; ++h2) {
          const bf16x8 kf = *(const bf16x8*)(Ks + buf * KS_BUF + (h2 * 32 + r) * KS_STRIDE + s * 16 + 8 * hh);
          Sc[h2] = MFMA32(kf, qf[s], Sc[h2]);
        }
      const float* rowp = rtab + RPB_PAD + (krow - rr + 7) * 31 + 15 + 4 * hh - qc;
      float sv[2][16];
#pragma unroll
      for (int h2 = 0; h2 < 2; ++h2)
#pragma unroll
        for (int i = 0; i < 16; ++i) {
          const int c = h2 * 32 + (i & 3) + 8 * (i >> 2);
          const bool valid = (unsigned)(vbase + c) < 16u;
          sv[h2][i] = valid ? (Sc[h2][i] + rowp[c]) : NEGBIG;
        }
      bf16x8 pk[2][2];
      local_softmax_step(sv, m_run, l_run, O, pk);
#pragma unroll
      for (int h2 = 0; h2 < 2; ++h2)
#pragma unroll
        for (int sp = 0; sp < 2; ++sp)
#pragma unroll
          for (int mb = 0; mb < 2; ++mb) {
            const bf16x8 vf = v_frag_tr(Vs + buf * VS_BUF, h2 * 32, mb, sp, lane);
            O[mb] = MFMA32(vf, pk[h2][sp], O[mb]);
          }
    }
    lstore(buf ^ 1);
    kr = kr2; vr = vr2; kr2 = kr3; vr2 = vr3;
    __syncthreads();
  }
  local_store_out(O, l_run, p.o + (size_t)(b * S + tq) * 1024 + 640 + head * 64, hh);
}

DI void kmax_item(KP p, int layer, int kidx) {
  const int tid = otid(); const int gid = kidx * NTHR + tid;
  const int row = gid >> 2, head = gid & 3, b = row >> 14;
  const uint4* kp = (const uint4*)(p.proj + (size_t)row * NPROJ + 256 + head * 64);
  float n0 = 0.f, n1 = 0.f;
#pragma unroll
  for (int c = 0; c < 8; ++c) {
    const uint4 v = kp[c];
    const unsigned e[4] = {v.x, v.y, v.z, v.w};
    float s = 0.f;
#pragma unroll
    for (int q = 0; q < 4; ++q) { const float a = bflo(e[q]), bq = bfhi(e[q]); s += a * a + bq * bq; }
    if (c >= 4) n1 += s; else n0 += s;
  }
#pragma unroll
  for (int o = 4; o <= 32; o <<= 1) { n0 = fmaxf(n0, __shfl_xor(n0, o)); n1 = fmaxf(n1, __shfl_xor(n1, o)); }
  if ((tid & 63) < 4) {
    unsigned* km = p.kmax + layer * 16 + (b * 4 + head) * 2;
    atomicMax(km, __float_as_uint(n0)); atomicMax(km + 1, __float_as_uint(n1));
  }
}

DI void phase_local(KP p, int layer, u16* sm) {
  constexpr int N_DIL = 2304, N_NA = 768, N_KM = 256;
  for (int it = blockIdx.x; it < N_DIL + N_NA + N_KM; it += gridDim.x) {
    __syncthreads();
    if (it < N_DIL) swin_attn_item(p, it, sm);
    else if (it < N_DIL + N_NA) na_attn_item(p, layer, it - N_DIL, sm);
    else kmax_item(p, layer, it - N_DIL - N_NA);
  }
}

DI void phase_diff(KP p, int layer, u16* sm) {
  combine_dil(p);
  const int tid = otid(), lane = tid & 63, w = __builtin_amdgcn_readfirstlane(tid >> 6), r = lane & 31, hh = lane >> 5;
  u16* Ks = sm; u16* Vs = sm + 2 * KS_BUF;
  float lam;
  {
    const float* dl = p.diff_lambda + layer * 128;
    float a = 0.f, c2 = 0.f;
    if (lane < 32) { a = dl[lane] * dl[32 + lane]; c2 = dl[64 + lane] * dl[96 + lane]; }
    a = wave_sum(a); c2 = wave_sum(c2);
    lam = __expf(a) - __expf(c2) + p.lam_init[layer];
  }
  const float lam_init = p.lam_init[layer];
  const float* sg = p.diff_subln + layer * 64;
  for (int it = blockIdx.x; it < 512; it += gridDim.x) {
    const int bh = it >> 6, qb = it & 63, b = bh >> 2, head = bh & 3;
    const u16* prow = p.proj + (size_t)b * S * NPROJ;
    const int tq = qb * 256 + w * 32 + r;
    bf16x8 qf[2][2];
    float qn[2];
#pragma unroll
    for (int m = 0; m < 2; ++m) {
      qn[m] = 0.f;
#pragma unroll
      for (int s = 0; s < 2; ++s) {
        qf[m][s] = *(const bf16x8*)(prow + (size_t)tq * NPROJ + head * 64 + m * 32 + s * 16 + 8 * hh);
#pragma unroll
        for (int j = 0; j < 8; ++j) { const float v = bf2f((u16)qf[m][s][j]); qn[m] += v * v; }
      }
      qn[m] += __shfl_xor(qn[m], 32);
    }
    float mbnd[2];
#pragma unroll
    for (int m = 0; m < 2; ++m) {
      const float km = __uint_as_float(p.kmax[layer * 16 + bh * 2 + m]);
      mbnd[m] = fmaxf(sqrtf(qn[m] * km) - 100.f, 0.f);
    }
    const bool noshift = __builtin_amdgcn_ballot_w64(mbnd[0] == 0.f && mbnd[1] == 0.f) == ~0ull;
    f32x16 O[2][2];
#pragma unroll
    for (int m = 0; m < 2; ++m)
#pragma unroll
      for (int mb = 0; mb < 2; ++mb)
#pragma unroll
        for (int i = 0; i < 16; ++i) O[m][mb][i] = 0.f;
    float lsum[2] = {0.f, 0.f};
    uint4 kr, vr, kr2, vr2, kr3, vr3;
    const int key0 = tid >> 3, ch = tid & 7;
    const u16* kg = prow + (size_t)key0 * NPROJ + 256 + head * 64 + ch * 8;
    auto gload = [&](int kt, uint4& kd, uint4& vd) __attribute__((always_inline)) {
      const u16* src = kg + (size_t)((kt & 255) * 64) * NPROJ;
      kd = *(const uint4*)src; vd = *(const uint4*)(src + 256);
    };
    auto lstore = [&](int buf) __attribute__((always_inline)) {
      *(uint4*)(Ks + buf * KS_BUF + key0 * KS_STRIDE + ch * 8) = kr;
      *(uint4*)(Vs + buf * VS_BUF + key0 * VROW + ch * 8) = vr;
    };
    gload(0, kr, vr); lstore(0);
    gload(1, kr, vr); gload(2, kr2, vr2);
    __syncthreads();
    if (noshift) {
    for (int kt = 0; kt < 256; ++kt) {
      const int buf = kt & 1;
      gload(kt + 3, kr3, vr3);
#pragma unroll
      for (int sub = 0; sub < 2; ++sub) {
#pragma unroll
        for (int m = 0; m < 2; ++m) {
          f32x16 Sc;
#pragma unroll
          for (int i = 0; i < 16; ++i) Sc[i] = 0.f;
#pragma unroll
          for (int s = 0; s < 2; ++s) {
            const bf16x8 kf = *(const bf16x8*)(Ks + buf * KS_BUF + (sub * 32 + r) * KS_STRIDE + m * 32 + s * 16 + 8 * hh);
            Sc = MFMA32(kf, qf[m][s], Sc);
          }
          bf16x8 pk[2];
#pragma unroll
          for (int sp = 0; sp < 2; ++sp) {
            unsigned q4[4];
#pragma unroll
            for (int q = 0; q < 4; ++q) {
              const float p0 = exp2_hw(Sc[8 * sp + 2 * q]), p1 = exp2_hw(Sc[8 * sp + 2 * q + 1]);
              lsum[m] += p0; lsum[m] += p1;
              q4[q] = pack2(p0, p1);
            }
            pk[sp] = __builtin_bit_cast(bf16x8, make_uint4(q4[0], q4[1], q4[2], q4[3]));
          }
#pragma unroll
          for (int sp = 0; sp < 2; ++sp)
#pragma unroll
            for (int mb = 0; mb < 2; ++mb) {
              const bf16x8 vf = v_frag_tr(Vs + buf * VS_BUF, sub * 32, mb, sp, lane);
              O[m][mb] = MFMA32(vf, pk[sp], O[m][mb]);
            }
        }
        __builtin_amdgcn_sched_barrier(0);
      }
      lstore(buf ^ 1);
      kr = kr2; vr = vr2; kr2 = kr3; vr2 = vr3;
      __syncthreads();
    }
    } else {
    for (int kt = 0; kt < 256; ++kt) {
      const int buf = kt & 1;
      gload(kt + 3, kr3, vr3);
#pragma unroll
      for (int sub = 0; sub < 2; ++sub) {
#pragma unroll
        for (int m = 0; m < 2; ++m) {
          f32x16 Sc;
#pragma unroll
          for (int i = 0; i < 16; ++i) Sc[i] = 0.f;
#pragma unroll
          for (int s = 0; s < 2; ++s) {
            const bf16x8 kf = *(const bf16x8*)(Ks + buf * KS_BUF + (sub * 32 + r) * KS_STRIDE + m * 32 + s * 16 + 8 * hh);
            Sc = MFMA32(kf, qf[m][s], Sc);
          }
          bf16x8 pk[2];
#pragma unroll
          for (int sp = 0; sp < 2; ++sp) {
            unsigned q4[4];
#pragma unroll
            for (int q = 0; q < 4; ++q) {
              const float p0 = exp2_hw(Sc[8 * sp + 2 * q] - mbnd[m]), p1 = exp2_hw(Sc[8 * sp + 2 * q + 1] - mbnd[m]);
              lsum[m] += p0; lsum[m] += p1;
              q4[q] = pack2(p0, p1);
            }
            pk[sp] = __builtin_bit_cast(bf16x8, make_uint4(q4[0], q4[1], q4[2], q4[3]));
          }
#pragma unroll
          for (int sp = 0; sp < 2; ++sp)
#pragma unroll
            for (int mb = 0; mb < 2; ++mb) {
              const bf16x8 vf = v_frag_tr(Vs + buf * VS_BUF, sub * 32, mb, sp, lane);
              O[m][mb] = MFMA32(vf, pk[sp], O[m][mb]);
            }
        }
        __builtin_amdgcn_sched_barrier(0);
      }
      lstore(buf ^ 1);
      kr = kr2; vr = vr2; kr2 = kr3; vr2 = vr3;
      __syncthreads();
    }
    }
    const float l0 = lsum[0] + __shfl_xor(lsum[0], 32);
    const float l1 = lsum[1] + __shfl_xor(lsum[1], 32);
    const float i0 = 1.f / l0, i1 = lam / l1;
    float ss = 0.f;
#pragma unroll
    for (int mb = 0; mb < 2; ++mb)
#pragma unroll
      for (int i = 0; i < 16; ++i) { const float v = O[0][mb][i] * i0 - O[1][mb][i] * i1; O[0][mb][i] = v; ss += v * v; }
    ss += __shfl_xor(ss, 32);
    const float inv = rsqrtf(ss * (1.f / 64.f) + 1e-6f) * (1.f - lam_init);
    u16* op = p.o + (size_t)(b * S + tq) * 1024 + head * 64;
#pragma unroll
    for (int mb = 0; mb < 2; ++mb)
#pragma unroll
      for (int g = 0; g < 4; ++g) {
        const int d = mb * 32 + 8 * g + 4 * hh;
        const float4 g4 = *(const float4*)(sg + d);
        *(uint2*)(op + d) = make_uint2(pack2(O[0][mb][4 * g] * inv * g4.x, O[0][mb][4 * g + 1] * inv * g4.y),
                                       pack2(O[0][mb][4 * g + 2] * inv * g4.z, O[0][mb][4 * g + 3] * inv * g4.w));
      }
  }
}

DI void phase_proj(KP p, int layer, LAS unsigned char* lds) {
  pg8::StaticOrder so; so.init(128, 12, gridDim.x, blockIdx.x);
  EpiProj e; e.proj = p.proj;
  pg8::gemm_phase<pg8::AMapPlain>(lds, p.h, p.wt_in + (size_t)layer * 3072 * 1024, 1024, so, e);
}
DI void phase_resid(const u16* A, int K, const u16* Bt, const float* xold, float* xnew, const float* gate, LAS unsigned char* lds) {
  pg8::StaticOrder so; so.init(128, 4, gridDim.x, blockIdx.x);
  EpiResid e; e.xold = xold; e.xnew = xnew; e.gate = gate;
  pg8::gemm_phase<pg8::AMapPlain>(lds, A, Bt, K, so, e);
}
DI void phase_up(KP p, int layer, LAS unsigned char* lds) {
  pg8::StaticOrder so; so.init(134, 22, gridDim.x, blockIdx.x);
  EpiUp e; e.act = p.act; e.cw = p.conv_w + (size_t)layer * 3 * DFF; e.cb = p.conv_b + (size_t)layer * DFF;
  pg8::gemm_phase<pg8::AMapHalo>(lds, p.h, p.wt_up + (size_t)layer * 5632 * 1024, 1024, so, e);
}

constexpr int N_PHASES = 18;

DI void run_phase(KP p, int ph, unsigned char* smraw) {
  u16* sm = (u16*)smraw;
  LAS unsigned char* lds = (LAS unsigned char*)smraw;
  if (ph == 0) { phase_prep(p, (float*)smraw); return; }
  if (ph == 17) { phase_norm<1>(p.out, p.g_final, nullptr, 0, 0, nullptr, p.out); return; }
  const int layer = (ph - 1) >> 3, sub = (ph - 1) & 7;
  const float* modl = p.mod + layer * 2 * 6144;
  const float* xcur = (layer == 0) ? p.x : p.out;
  switch (sub) {
    case 0: phase_norm<0>(xcur, p.g_attn + layer * 1024, modl, 0, 1024, p.h, nullptr); break;
    case 1: phase_proj(p, layer, lds); break;
    case 2: phase_local(p, layer, sm); break;
    case 3: phase_diff(p, layer, sm); break;
    case 4: phase_resid(p.o, 1024, p.wt_out + (size_t)layer * 1024 * 1024, xcur, p.out, modl + 2048, lds); break;
    case 5: phase_norm<0>(p.out, p.g_ffn + layer * 1024, modl, 3072, 4096, p.h, nullptr); break;
    case 6: phase_up(p, layer, lds); break;
    case 7: phase_resid(p.act, DFF, p.wt_down + (size_t)layer * 1024 * DFF, p.out, p.out, modl + 5120, lds); break;
  }
}

__global__ void __launch_bounds__(NTHR, 2) mega_kernel(Params p) {
  extern __shared__ __attribute__((aligned(16))) unsigned char smraw[];
#if COOP
  cg::grid_group grid = cg::this_grid();
  u16* sm = (u16*)smraw;
  LAS unsigned char* lds = (LAS unsigned char*)smraw;
  if (threadIdx.x == 0) *(uint4*)(smraw + LDS_BYTES) = make_uint4(0u, 0u, 0u, 0u);
  __syncthreads();
  const XcdBarrier xb = xcd_barrier_post(kp_fresh()->bar, (volatile LAS unsigned*)(smraw + LDS_BYTES));
  phase_prep(*kp_fresh(), (float*)smraw);
  grid.sync();
#pragma unroll 1
  for (int layer = 0; layer < 2; ++layer) {
    { KP q = *kp_fresh(); phase_norm<0>((layer == 0) ? q.x : q.out, q.g_attn + layer * 1024, q.mod + layer * 2 * 6144, 0, 1024, q.h, nullptr); } xcd_barrier(xb);
    phase_proj(*kp_fresh(), layer, lds); xcd_barrier(xb);
    phase_local(*kp_fresh(), layer, sm); xcd_barrier(xb);
    phase_diff(*kp_fresh(), layer, sm); xcd_barrier(xb);
    { KP q = *kp_fresh(); phase_resid(q.o, 1024, q.wt_out + (size_t)layer * 1024 * 1024, (layer == 0) ? q.x : q.out, q.out, q.mod + layer * 2 * 6144 + 2048, lds); } xcd_barrier(xb);
    { KP q = *kp_fresh(); phase_norm<0>(q.out, q.g_ffn + layer * 1024, q.mod + layer * 2 * 6144, 3072, 4096, q.h, nullptr); } xcd_barrier(xb);
    phase_up(*kp_fresh(), layer, lds); xcd_barrier(xb);
    { KP q = *kp_fresh(); phase_resid(q.act, DFF, q.wt_down + (size_t)layer * 1024 * DFF, q.out, q.out, q.mod + layer * 2 * 6144 + 5120, lds); } xcd_barrier(xb);
  }
  { KP q = *kp_fresh(); phase_norm<1>(q.out, q.g_final, nullptr, 0, 0, nullptr, q.out); }
#else
  { KP q = *kp_fresh(); for (int ph = q.ph_lo; ph < q.ph_hi; ++ph) run_phase(q, ph, smraw); }
#endif
}

extern "C" void kernel_launch(void* const* d_in, const int* in_sizes, int n_in, void* d_out, int out_size, void* d_ws, size_t ws_size, hipStream_t stream) {
  (void)in_sizes; (void)n_in; (void)out_size;
  Params p;
  memset(&p, 0, sizeof(p));
  p.x = (const float*)d_in[0]; p.c = (const float*)d_in[1]; p.w_ada = (const float*)d_in[2]; p.b_ada = (const float*)d_in[3];
  p.g_attn = (const float*)d_in[4]; p.w_in = (const float*)d_in[5]; p.diff_lambda = (const float*)d_in[6]; p.diff_subln = (const float*)d_in[7];
  p.na_rpb = (const float*)d_in[8]; p.w_out = (const float*)d_in[9]; p.g_ffn = (const float*)d_in[10]; p.w_up = (const float*)d_in[11];
  p.conv_w = (const float*)d_in[12]; p.conv_b = (const float*)d_in[13]; p.w_down = (const float*)d_in[14]; p.g_final = (const float*)d_in[15];
  p.out = (float*)d_out;
  char* ws = (char*)d_ws; size_t off = 0;
  auto take = [&](size_t bytes) { char* q = ws + off; off += (bytes + 255) & ~(size_t)255; return q; };
  p.wt_in = (u16*)take((size_t)2 * 3072 * 1024 * 2);
  p.wt_out = (u16*)take((size_t)2 * 1024 * 1024 * 2);
  p.wt_up = (u16*)take((size_t)2 * 5632 * 1024 * 2);
  p.wt_down = (u16*)take((size_t)2 * 1024 * 2816 * 2);
  p.mod = (float*)take((size_t)2 * 2 * 6144 * 4);
  p.kmax = (unsigned*)take(256);
  p.bar = (unsigned*)take((size_t)XCD_BAR_WORDS * 4);
  (void)take(4096);
  p.h = (u16*)take((size_t)NTOK * 1024 * 2);
  p.o = (u16*)take((size_t)NTOK * 1024 * 2);
  p.proj = (u16*)take((size_t)NTOK * NPROJ * 2);
  p.odil = (u16*)take((size_t)3 * NTOK * 384 * 2);
  p.lse = (float*)take((size_t)3 * NTOK * 6 * 4);
  p.act = p.proj;
  if (off > ws_size) { fprintf(stderr, "workspace too small: need %zu have %zu\n", off, ws_size); return; }
  p.lam_init[0] = 0.2f; p.lam_init[1] = 0.35550906759096934f;
  static int grid_blocks = 0;
  if (!grid_blocks) {
    int dev = 0, cus = 0, per_cu = 0;
    (void)hipGetDevice(&dev);
    (void)hipDeviceGetAttribute(&cus, hipDeviceAttributeMultiprocessorCount, dev);
    (void)hipFuncSetAttribute((const void*)mega_kernel, hipFuncAttributeMaxDynamicSharedMemorySize, LDS_BYTES + 16);
    (void)hipOccupancyMaxActiveBlocksPerMultiprocessor(&per_cu, mega_kernel, NTHR, LDS_BYTES + 16);
    if (per_cu > 1) per_cu = 1;
    if (per_cu < 1) per_cu = 1;
    grid_blocks = cus * per_cu;
  }
#if COOP
  p.ph_lo = 0; p.ph_hi = N_PHASES;
  (void)hipMemsetAsync(p.bar, 0, (size_t)XCD_BAR_WORDS * 4, stream);
  void* args[] = {&p};
  hipError_t e = hipLaunchCooperativeKernel((void*)mega_kernel, dim3(grid_blocks), dim3(NTHR), args, LDS_BYTES + 16, stream);
  if (e != hipSuccess) fprintf(stderr, "cooperative launch failed: %s (grid %d)\n", hipGetErrorString(e), grid_blocks);
#else
  for (int ph = 0; ph < N_PHASES; ++ph) {
    p.ph_lo = ph; p.ph_hi = ph + 1;
    hipLaunchKernelGGL(mega_kernel, dim3(grid_blocks), dim3(NTHR), LDS_BYTES + 16, stream, p);
  }
#endif
}
```

```cpp
#include <hip/hip_runtime.h>
#include <hip/hip_cooperative_groups.h>
#include <cstdio>
#include <cstring>
namespace cg = cooperative_groups;

#ifndef COOP
#define COOP 1
#endif

#define DI __device__ __forceinline__
#define LAS __attribute__((address_space(3)))
typedef unsigned short u16;
using bf16x8 = __attribute__((ext_vector_type(8))) short;
using s16x4  = __attribute__((ext_vector_type(4))) short;
using f32x16 = __attribute__((ext_vector_type(16))) float;
using f32x4  = __attribute__((ext_vector_type(4))) float;
typedef __bf16 bf2_t __attribute__((ext_vector_type(2)));
typedef float f2_t __attribute__((ext_vector_type(2)));
#define MFMA32(a, b, c) __builtin_amdgcn_mfma_f32_32x32x16_bf16((a), (b), (c), 0, 0, 0)

constexpr int S = 16384, NTOK = 32768, DFF = 2816, NPROJ = 3072;
constexpr int NTHR = 512, NWAVE = 8;
constexpr float LOG2E = 1.4426950408889634f;
constexpr float QSCALE_DIFF = 0.25503486164919736f;
constexpr float QSCALE_64   = 0.18033688011112042f;
constexpr float NEGBIG = -1e30f;
constexpr int LDS_BYTES = 131072;

__device__ const float ROPE_INV16[16] = {
1.000000000e+00f, 5.623413324e-01f, 3.162277639e-01f, 1.778279394e-01f, 1.000000015e-01f, 5.623413250e-02f, 3.162277490e-02f, 1.778279431e-02f, 9.999999776e-03f, 5.623413250e-03f, 3.162277630e-03f, 1.778279431e-03f, 1.000000047e-03f, 5.623413017e-04f, 3.162277571e-04f, 1.778279402e-04f};
__device__ const float ROPE_INV32[32] = {
1.000000000e+00f, 7.498942018e-01f, 5.623413324e-01f, 4.216965139e-01f, 3.162277639e-01f, 2.371373773e-01f, 1.778279394e-01f, 1.333521456e-01f, 1.000000015e-01f, 7.498942316e-02f, 5.623413250e-02f, 4.216964915e-02f, 3.162277490e-02f, 2.371373773e-02f, 1.778279431e-02f, 1.333521400e-02f, 9.999999776e-03f, 7.498942316e-03f, 5.623413250e-03f, 4.216964822e-03f, 3.162277630e-03f, 2.371373819e-03f, 1.778279431e-03f, 1.333521446e-03f, 1.000000047e-03f, 7.498941850e-04f, 5.623413017e-04f, 4.216965172e-04f, 3.162277571e-04f, 2.371373703e-04f, 1.778279402e-04f, 1.333521504e-04f};

struct Params {
  const float *x, *c, *w_ada, *b_ada, *g_attn, *w_in, *diff_lambda, *diff_subln, *na_rpb, *w_out, *g_ffn, *w_up, *conv_w, *conv_b, *w_down, *g_final;
  float* out;
  u16 *wt_in, *wt_out, *wt_up, *wt_down;
  float* mod;
  unsigned* kmax;
  unsigned* bar;
  u16 *h, *o, *proj, *act, *odil;
  float* lse;
  float lam_init[2];
  int ph_lo, ph_hi;
};

typedef const __attribute__((address_space(4))) Params& KP;
DI const __attribute__((address_space(4))) Params* kp_fresh() {
  const __attribute__((address_space(4))) Params* q = (const __attribute__((address_space(4))) Params*)__builtin_amdgcn_kernarg_segment_ptr();
  asm volatile("" : "+s"(q));
  return q;
}
DI unsigned pack2(float a, float b) { f2_t v = {a, b}; return __builtin_bit_cast(unsigned, __builtin_convertvector(v, bf2_t)); }
DI float bf2f(u16 v) { return __uint_as_float(((unsigned)v) << 16); }
DI float bflo(unsigned v) { return __uint_as_float(v << 16); }
DI float bfhi(unsigned v) { return __uint_as_float(v & 0xffff0000u); }
DI int crow(int i, int hh) { return (i & 3) + 8 * (i >> 2) + 4 * hh; }
DI float exp2_hw(float x) { return __builtin_amdgcn_exp2f(x); }
DI int otid() { int t = threadIdx.x; asm volatile("" : "+v"(t)); return t; }


#define XB_TMO      128
#define XB_XCNT(j)  (256  + 64 * (j))
#define XB_XSUB(j)  (1280 + 64 * (j))
#define XB_XGEN(j)  (2304 + 64 * (j))
#define XB_TOP      3328
#define XB_TOPGEN   3392
#define XCD_BAR_WORDS 3456
#define XB_SPIN_CAP (1u << 21)
DI unsigned xb_ld(unsigned* p)              { return __hip_atomic_load(p, __ATOMIC_RELAXED, __HIP_MEMORY_SCOPE_AGENT); }
DI unsigned xb_add(unsigned* p, unsigned v) { return __hip_atomic_fetch_add(p, v, __ATOMIC_RELAXED, __HIP_MEMORY_SCOPE_AGENT); }
DI unsigned xb_xcc_id() { return (unsigned)__builtin_amdgcn_s_getreg((3 << 11) | 20) & 0xFu; }
#define XB_SPIN(cond, bar) do { unsigned _sp = 0; while (cond) { __builtin_amdgcn_s_sleep(1); \
    if ((++_sp & 255u) == 0u) { if (xb_ld(&(bar)[XB_TMO])) break; if (_sp > XB_SPIN_CAP) { atomicAdd(&(bar)[XB_TMO], 1u); break; } } } } while (0)
struct XcdBarrier { unsigned* bar; unsigned x; volatile LAS unsigned* st; };
DI XcdBarrier xcd_barrier_post(unsigned* bar, volatile LAS unsigned* st) {
  XcdBarrier b; b.bar = bar; b.x = xb_xcc_id(); b.st = st;
  if (threadIdx.x == 0) (void)xb_add(&bar[XB_XCNT(b.x)], 1u);
  return b;
}
DI void xcd_barrier_complete(unsigned* bar, unsigned x, unsigned& nloc, unsigned& nx) {
  const unsigned G = gridDim.x * gridDim.y * gridDim.z;
  unsigned sum, cnt, mine, sp = 0u;
  for (;;) {
    sum = 0u; cnt = 0u; mine = 0u;
#pragma unroll
    for (unsigned j = 0; j < 16; ++j) { const unsigned c = xb_ld(&bar[XB_XCNT(j)]); sum += c; cnt += (c > 0u) ? 1u : 0u; mine = (j == x) ? c : mine; }
    if (sum == G) break;
    __builtin_amdgcn_s_sleep(1);
    if ((++sp & 255u) == 0u) { if (xb_ld(&bar[XB_TMO])) break; if (sp > XB_SPIN_CAP) { atomicAdd(&bar[XB_TMO], 1u); break; } }
  }
  nloc = mine > 0u ? mine : 1u; nx = cnt > 0u ? cnt : 1u;
}
DI void xcd_barrier(const XcdBarrier& b) {
  asm volatile("s_waitcnt vmcnt(0)" ::: "memory");
  __syncthreads();
  if (threadIdx.x == 0) {
    unsigned* bar = b.bar;
    __builtin_amdgcn_s_waitcnt(0);
    unsigned nloc = b.st[0], nx = b.st[1];
    if (nloc == 0u) { xcd_barrier_complete(bar, b.x, nloc, nx); b.st[0] = nloc; b.st[1] = nx; }
    const unsigned old = xb_add(&bar[XB_XSUB(b.x)], 1u);
    const unsigned gen = old / nloc;
    if (old + 1u == (gen + 1u) * nloc) {
      __builtin_amdgcn_fence(__ATOMIC_RELEASE, "agent");
      asm volatile("s_waitcnt vmcnt(0)" ::: "memory");
      const unsigned og = xb_add(&bar[XB_TOP], 1u);
      const unsigned tg = og / nx;
      if (og + 1u == (tg + 1u) * nx) xb_add(&bar[XB_TOPGEN], 1u);
      else XB_SPIN(xb_ld(&bar[XB_TOPGEN]) == tg, bar);
      __builtin_amdgcn_fence(__ATOMIC_ACQUIRE, "agent");
      xb_add(&bar[XB_XGEN(b.x)], 1u);
      asm volatile("s_waitcnt vmcnt(0)" ::: "memory");
    } else {
      XB_SPIN(xb_ld(&bar[XB_XGEN(b.x)]) == gen, bar);
      __builtin_amdgcn_fence(__ATOMIC_ACQUIRE, "agent");
      asm volatile("s_waitcnt vmcnt(0)" ::: "memory");
    }
  }
  __syncthreads();
}

DI int wmap_in(int np) {
  if (np >= 768 && np < 1536) { const int hb = np & ~63, w = np & 63, g = w >> 5, n = (w >> 4) & 1, i = w & 15; return hb + 16 * g + i + 32 * n; }
  return np;
}
DI int wmap_up(int np) {
  const int pn = np >> 8, w = np & 255, bj = w >> 7, q = w & 127;
  return bj ? (DFF + 128 * pn + q) : (128 * pn + q);
}

DI void phase_prep(KP p, float* smf) {
  const int tid = otid();
  if (blockIdx.x == 0 && tid < 64) p.kmax[tid] = 0u;
  constexpr int N_ADA = 192;
  constexpr int T_IN = 16 * 24, T_OUT = 16 * 8, T_UP = 16 * 44, T_DOWN = 44 * 8;
  constexpr int T_LAYER = T_IN + T_OUT + T_UP + T_DOWN;
  const int total = N_ADA + 2 * T_LAYER;
  for (int it = blockIdx.x; it < total; it += gridDim.x) {
    if (it < N_ADA) {
      const int l = it / 96, cgp = it % 96;
      float* sc = smf;
      float* red = smf + 2048;
      for (int i = tid; i < 2048; i += NTHR) { float v = p.c[i]; sc[i] = v / (1.f + __expf(-v)); }
      __syncthreads();
      const int kq = tid >> 6, cc = tid & 63, col = cgp * 64 + cc;
      const float* wp = p.w_ada + ((size_t)l * 1024 + kq * 128) * 6144 + col;
      float a0 = 0.f, a1 = 0.f;
#pragma unroll 8
      for (int k = 0; k < 128; ++k) { float w = wp[(size_t)k * 6144]; a0 += sc[kq * 128 + k] * w; a1 += sc[1024 + kq * 128 + k] * w; }
      red[(kq * 2 + 0) * 64 + cc] = a0; red[(kq * 2 + 1) * 64 + cc] = a1;
      __syncthreads();
      if (tid < 128) {
        const int b = tid >> 6, c2 = tid & 63;
        float s = 0.f;
#pragma unroll
        for (int q = 0; q < 8; ++q) s += red[(q * 2 + b) * 64 + c2];
        p.mod[(l * 2 + b) * 6144 + cgp * 64 + c2] = s + p.b_ada[l * 6144 + cgp * 64 + c2];
      }
    } else {
      int idx = it - N_ADA; const int l = idx / T_LAYER; int j = idx % T_LAYER;
      const float* W; u16* dst; int Kd, N, tk, tn, kind;
      if (j < T_IN) { W = p.w_in + (size_t)l * 1024 * 3072; dst = p.wt_in + (size_t)l * 3072 * 1024; Kd = 1024; N = 3072; tk = j / 24; tn = j % 24; kind = 0; }
      else if (j < T_IN + T_OUT) { j -= T_IN; W = p.w_out + (size_t)l * 1024 * 1024; dst = p.wt_out + (size_t)l * 1024 * 1024; Kd = 1024; N = 1024; tk = j / 8; tn = j % 8; kind = 1; }
      else if (j < T_IN + T_OUT + T_UP) { j -= T_IN + T_OUT; W = p.w_up + (size_t)l * 1024 * 5632; dst = p.wt_up + (size_t)l * 5632 * 1024; Kd = 1024; N = 5632; tk = j / 44; tn = j % 44; kind = 2; }
      else { j -= T_IN + T_OUT + T_UP; W = p.w_down + (size_t)l * 2816 * 1024; dst = p.wt_down + (size_t)l * 1024 * 2816; Kd = 2816; N = 1024; tk = j / 8; tn = j % 8; kind = 3; }
      const int hb = tid >> 8, t = tid & 255;
      const int k0 = tk * 64, n0 = (tn * 2 + hb) * 64;
      float* tile = smf + hb * (64 * 65);
      const int nn = t & 63;
      const int np = n0 + nn;
      const int srccol = (kind == 0) ? wmap_in(np) : (kind == 2) ? wmap_up(np) : np;
#pragma unroll 4
      for (int i = 0; i < 16; ++i) { const int kk = i * 4 + (t >> 6); tile[kk * 65 + nn] = W[(size_t)(k0 + kk) * N + srccol]; }
      __syncthreads();
      const int nrow = t >> 2, kc = (t & 3) * 16;
      unsigned pk[8];
#pragma unroll
      for (int q = 0; q < 8; ++q) pk[q] = pack2(tile[(kc + 2 * q) * 65 + nrow], tile[(kc + 2 * q + 1) * 65 + nrow]);
      uint4* dp = (uint4*)(dst + (size_t)(n0 + nrow) * Kd + k0 + kc);
      dp[0] = make_uint4(pk[0], pk[1], pk[2], pk[3]);
      dp[1] = make_uint4(pk[4], pk[5], pk[6], pk[7]);
    }
    __syncthreads();
  }
}

DI float wave_sum(float v) {
#pragma unroll
  for (int o = 32; o >= 1; o >>= 1) v += __shfl_xor(v, o);
  return v;
}

template <int MODE>
DI void phase_norm(const float* xin, const float* g, const float* modl, int sh_off, int sc_off, u16* hout, float* fout) {
  const int tid = otid(); const int lane = tid & 63, w = tid >> 6;
  for (int row = blockIdx.x * NWAVE + w; row < NTOK; row += gridDim.x * NWAVE) {
    const int b = row >> 14;
    const float4* xr = (const float4*)(xin + (size_t)row * 1024);
    float4 v[4];
#pragma unroll
    for (int i = 0; i < 4; ++i) v[i] = xr[lane + i * 64];
    float ss = 0.f;
#pragma unroll
    for (int i = 0; i < 4; ++i) ss += v[i].x * v[i].x + v[i].y * v[i].y + v[i].z * v[i].z + v[i].w * v[i].w;
    ss = wave_sum(ss);
    const float inv = rsqrtf(ss * (1.f / 1024.f) + 1e-6f);
#pragma unroll
    for (int i = 0; i < 4; ++i) {
      const int col = (lane + i * 64) * 4;
      const float4 g4 = *(const float4*)(g + col);
      if (MODE == 0) {
        const float4 sc4 = *(const float4*)(modl + b * 6144 + sc_off + col);
        const float4 sh4 = *(const float4*)(modl + b * 6144 + sh_off + col);
        float y0 = v[i].x * inv * g4.x * (1.f + sc4.x) + sh4.x;
        float y1 = v[i].y * inv * g4.y * (1.f + sc4.y) + sh4.y;
        float y2 = v[i].z * inv * g4.z * (1.f + sc4.z) + sh4.z;
        float y3 = v[i].w * inv * g4.w * (1.f + sc4.w) + sh4.w;
        *(uint2*)(hout + (size_t)row * 1024 + col) = make_uint2(pack2(y0, y1), pack2(y2, y3));
      } else {
        float4 y; y.x = v[i].x * inv * g4.x; y.y = v[i].y * inv * g4.y; y.z = v[i].z * inv * g4.z; y.w = v[i].w * inv * g4.w;
        *(float4*)(fout + (size_t)row * 1024 + col) = y;
      }
    }
  }
}

namespace pg8 {
constexpr int BM = 256, BK = 64, HALF = 128, HTB = HALF * BK * 2, NXCD = 8, WGM = 8;
DI int lds_byte(int r, int c) { const int st = (r >> 4) * 2 + (c >> 5), rr = r & 15, cc = c & 31, ob = rr * 64 + cc * 2; return st * 1024 + (ob ^ (((ob >> 9) & 1) << 5)); }
DI void stage_rc(int b, int& R, int& C) { const int st = b / 1024, sb = b % 1024, swz = sb ^ (((sb >> 9) & 1) << 5); R = (st >> 1) * 16 + swz / 64; C = (st & 1) * 32 + (swz % 64) / 2; }
struct Unit { int pm, pn; };
struct StaticOrder {
  int nM, nN, nwg, G, c;
  DI void init(int nM_, int nN_, int G_, int c_) { nM = nM_; nN = nN_; nwg = nM * nN; G = G_; c = c_; }
  DI bool next(int i, Unit& u) const {
    const long L = (long)i * G + c; if (L >= nwg) return false;
    int wgid = (int)L; { const int q = nwg / NXCD, r = nwg % NXCD, xcd = wgid % NXCD, off = wgid / NXCD; wgid = (xcd < r ? xcd * (q + 1) : r * (q + 1) + (xcd - r) * q) + off; }
    const int nig = WGM * nN, gid = wgid / nig, fm = gid * WGM, gsz = (nM - fm) < WGM ? (nM - fm) : WGM;
    u.pm = fm + ((wgid % nig) % gsz); u.pn = (wgid % nig) / gsz; return true;
  }
};
struct AMapPlain { static constexpr int HALF_ROWS = 128; static DI int row(int R) { return R; } static DI long tile_row0(int pm) { return (long)pm * 256; } };
struct AMapHalo  { static constexpr int HALF_ROWS = 124; static DI int row(int R) { return 62 * (R >> 6) + (R & 63); } static DI long tile_row0(int pm) { const int b = pm / 67, ti = pm % 67; return (long)b * S + 248 * ti - 1; } };

template <class AMap, class Epi>
DI void gemm_phase(LAS unsigned char* lds, const u16* Aptr, const u16* Btptr, int K, const StaticOrder& SO, const Epi& E) {
  const int tid = otid(), wid = __builtin_amdgcn_readfirstlane(tid >> 6), lane = tid & 63, wr = wid >> 2, wc = wid & 3, fr = lane & 15, fq = lane >> 4;
  const int nt = K / BK;
  unsigned voffA[2], voffB[2];
#pragma unroll
  for (int i = 0; i < 2; ++i) { int R, C; stage_rc(tid * 16 + i * 8192, R, C);
    voffA[i] = (unsigned)(AMap::row(R) * K + C) * 2u; voffB[i] = (unsigned)(R * K + C) * 2u; }
  const size_t kstep = (size_t)(BK * 2);
  const size_t hstepA = (size_t)AMap::HALF_ROWS * K * 2, hstepB = (size_t)HALF * K * 2;
  const size_t tstepB = 2 * hstepB;
  const size_t rowB = (size_t)K * 2;
  const unsigned ldsw = (unsigned)wid * 1024u;
  const int aoff = lds_byte(wr * 64 + fr, fq * 8), boff = lds_byte(wc * 32 + fr, fq * 8);
#define PG8_SA(b, h) (((b) * 2 + (h)) * HTB)
#define PG8_SB(b, h) ((4 + (b) * 2 + (h)) * HTB)
#define PG8_STAGE(bufoff, gbase, voff) do { _Pragma("unroll") for (int _i = 0; _i < 2; ++_i) \
        __builtin_amdgcn_global_load_lds((const unsigned*)((const char*)(gbase) + (voff)[_i]), (LAS unsigned*)(lds + (bufoff) + ldsw + _i * 8192), 16, 0, 0); } while (0)
#define PG8_LDA(dst, b, h) do { _Pragma("unroll") for (int m = 0; m < 4; ++m) _Pragma("unroll") for (int k = 0; k < 2; ++k) dst[m][k] = *(const LAS bf16x8*)(lds + PG8_SA(b, h) + aoff + m * 2048 + k * 1024); } while (0)
#define PG8_LDB(dst, b, h) do { _Pragma("unroll") for (int n = 0; n < 2; ++n) _Pragma("unroll") for (int k = 0; k < 2; ++k) dst[n][k] = *(const LAS bf16x8*)(lds + PG8_SB(b, h) + boff + n * 2048 + k * 1024); } while (0)
#define PG8_MMA(ai, bj, At, Bt) do { __builtin_amdgcn_s_setprio(1); _Pragma("unroll") for (int m = 0; m < 4; ++m) _Pragma("unroll") for (int n = 0; n < 2; ++n) _Pragma("unroll") for (int k = 0; k < 2; ++k) \
        acc[ai][bj][m][n] = __builtin_amdgcn_mfma_f32_16x16x32_bf16(Bt[n][k], At[m][k], acc[ai][bj][m][n], 0, 0, 0); __builtin_amdgcn_s_setprio(0); } while (0)
#define PG8_WAIT_V(n) asm volatile("s_waitcnt vmcnt(" #n ")" ::: "memory")
#define PG8_WAIT_L(n) asm volatile("s_waitcnt lgkmcnt(" #n ")" ::: "memory")
#define PG8_BAR __builtin_amdgcn_s_barrier()
#define PG8_SCHED __builtin_amdgcn_sched_barrier(0)
  Unit cur, nxt; int ui = 0;
  if (!SO.next(0, cur)) return;
  f32x4 acc[2][2][4][2];
#pragma unroll
  for (int a = 0; a < 2; ++a)
#pragma unroll
    for (int b = 0; b < 2; ++b)
#pragma unroll
      for (int m = 0; m < 4; ++m)
#pragma unroll
        for (int n = 0; n < 2; ++n) acc[a][b][m][n] = (f32x4){0.f, 0.f, 0.f, 0.f};
  bf16x8 At[4][2], B0[2][2], B1[2][2];
  const char* cA = (const char*)Aptr + AMap::tile_row0(cur.pm) * (long)rowB; const char* cB = (const char*)Btptr + (size_t)cur.pn * tstepB;
  PG8_STAGE(PG8_SB(0, 0), cB, voffB); PG8_STAGE(PG8_SA(0, 0), cA, voffA); PG8_STAGE(PG8_SB(0, 1), cB + hstepB, voffB); PG8_STAGE(PG8_SA(0, 1), cA + hstepA, voffA);
  if (wr == 1) PG8_BAR;
  PG8_WAIT_V(4); PG8_BAR;
  PG8_STAGE(PG8_SB(1, 0), cB + kstep, voffB); PG8_STAGE(PG8_SA(1, 0), cA + kstep, voffA); PG8_STAGE(PG8_SB(1, 1), cB + hstepB + kstep, voffB);
  PG8_WAIT_V(6); PG8_BAR;
  for (;;) {
    const bool has_next = SO.next(ui + 1, nxt);
    const char* nA = has_next ? (const char*)Aptr + AMap::tile_row0(nxt.pm) * (long)rowB : cA; const char* nB = has_next ? (const char*)Btptr + (size_t)nxt.pn * tstepB : cB;
    for (int t = 0; t < nt; t += 2) {
      const bool last = (t == nt - 2);
      const char* a1 = cA + (size_t)(t + 1) * kstep;
      const char* a2 = last ? nA : cA + (size_t)(t + 2) * kstep; const char* b2 = last ? nB : cB + (size_t)(t + 2) * kstep;
      const char* a3 = a2 + kstep; const char* b3 = b2 + kstep;
      PG8_LDB(B0, 0, 0); PG8_SCHED; PG8_LDA(At, 0, 0); PG8_STAGE(PG8_SA(1, 1), a1 + hstepA, voffA);
      PG8_WAIT_L(8); PG8_BAR; PG8_WAIT_L(0); PG8_MMA(0, 0, At, B0); PG8_BAR; PG8_SCHED;
      PG8_LDB(B1, 0, 1); PG8_STAGE(PG8_SB(0, 0), b2, voffB);
      PG8_BAR; PG8_WAIT_L(0); PG8_MMA(0, 1, At, B1); PG8_BAR;
      PG8_LDA(At, 0, 1); PG8_STAGE(PG8_SA(0, 0), a2, voffA);
      PG8_BAR; PG8_WAIT_L(0); PG8_MMA(1, 0, At, B0); PG8_BAR; PG8_SCHED;
      PG8_STAGE(PG8_SB(0, 1), b2 + hstepB, voffB);
      PG8_WAIT_V(6); PG8_BAR; PG8_MMA(1, 1, At, B1); PG8_BAR;
      PG8_LDB(B0, 1, 0); PG8_SCHED; PG8_LDA(At, 1, 0); PG8_STAGE(PG8_SA(0, 1), a2 + hstepA, voffA);
      PG8_WAIT_L(8); PG8_BAR; PG8_WAIT_L(0); PG8_MMA(0, 0, At, B0); PG8_BAR; PG8_SCHED;
      PG8_LDB(B1, 1, 1); PG8_STAGE(PG8_SB(1, 0), b3, voffB);
      PG8_BAR; PG8_WAIT_L(0); PG8_MMA(0, 1, At, B1); PG8_BAR;
      PG8_LDA(At, 1, 1); PG8_STAGE(PG8_SA(1, 0), a3, voffA);
      PG8_BAR; PG8_WAIT_L(0); PG8_MMA(1, 0, At, B0); PG8_BAR; PG8_SCHED;
      PG8_STAGE(PG8_SB(1, 1), b3 + hstepB, voffB);
      PG8_WAIT_V(6); PG8_BAR; PG8_MMA(1, 1, At, B1); PG8_BAR;
    }
    E(acc, cur, wr, wc, fr, fq);
    if (!has_next) break;
#pragma unroll
    for (int a = 0; a < 2; ++a)
#pragma unroll
      for (int b = 0; b < 2; ++b)
#pragma unroll
        for (int m = 0; m < 4; ++m)
#pragma unroll
          for (int n = 0; n < 2; ++n) acc[a][b][m][n] = (f32x4){0.f, 0.f, 0.f, 0.f};
    cur = nxt; cA = nA; cB = nB; ++ui;
  }
  PG8_WAIT_V(0);
  if (wr == 0) PG8_BAR;
  PG8_BAR;
#undef PG8_SA
#undef PG8_SB
#undef PG8_STAGE
#undef PG8_LDA
#undef PG8_LDB
#undef PG8_MMA
#undef PG8_WAIT_V
#undef PG8_WAIT_L
#undef PG8_BAR
#undef PG8_SCHED
}
}

DI void sincos_big(float ang, float& sn, float& cs) {
  const float c_hi = 1.591549367e-01f, c_lo = 6.420638243e-09f;
  const float rh = ang * c_hi;
  const float e = __builtin_fmaf(ang, c_hi, -rh);
  const float fr = rh - floorf(rh);
  const float rev = fr + (e + ang * c_lo);
  sn = __builtin_amdgcn_sinf(rev);
  cs = __builtin_amdgcn_cosf(rev);
}

struct EpiProj {
  u16* proj;
  DI void operator()(const f32x4 (&acc)[2][2][4][2], const pg8::Unit& u, int wr, int wc, int fr, int fq) const {
    const f32x4 i16 = *(const f32x4*)(ROPE_INV16 + 4 * fq);
    const f32x4 i32v = *(const f32x4*)(ROPE_INV32 + 16 * (wc & 1) + 4 * fq);
#pragma unroll
    for (int bj = 0; bj < 2; ++bj) {
      const int gcol0 = u.pn * 256 + bj * 128 + wc * 32;
      int mode; float scale = 1.f;
      if (gcol0 < 256) { mode = 1; scale = QSCALE_DIFF; }
      else if (gcol0 < 512) { mode = 1; }
      else if (gcol0 < 768) { mode = 0; }
      else if (gcol0 < 1152) { mode = 2; scale = QSCALE_64; }
      else if (gcol0 < 1536) { mode = 2; }
      else if (gcol0 < 1920) { mode = 0; }
      else if (gcol0 < 2304) { mode = 0; scale = QSCALE_64; }
      else { mode = 0; }
      f32x4 invv;
#pragma unroll
      for (int e = 0; e < 4; ++e) invv[e] = (mode == 1) ? i16[e] : i32v[e];
      int c1, c2;
      if (mode == 2) { const int hb = gcol0 & ~63, g = wc & 1; c1 = hb + 16 * g + 4 * fq; c2 = c1 + 32; }
      else { c1 = gcol0 + 4 * fq; c2 = c1 + 16; }
#pragma unroll
      for (int ai = 0; ai < 2; ++ai)
#pragma unroll
        for (int m = 0; m < 4; ++m) {
          const int row = u.pm * 256 + ai * 128 + wr * 64 + m * 16 + fr;
          f32x4 x1 = acc[ai][bj][m][0], x2 = acc[ai][bj][m][1];
          if (mode != 0) {
            const float pos = (float)(row & (S - 1));
#pragma unroll
            for (int e = 0; e < 4; ++e) {
              const float ang = __fmul_rn(pos, invv[e]);
              float sn, cs; sincos_big(ang, sn, cs);
              const float y1 = x1[e] * cs - x2[e] * sn, y2 = x2[e] * cs + x1[e] * sn;
              x1[e] = y1; x2[e] = y2;
            }
          }
          u16* dp = proj + (size_t)row * NPROJ;
          *(uint2*)(dp + c1) = make_uint2(pack2(x1[0] * scale, x1[1] * scale), pack2(x1[2] * scale, x1[3] * scale));
          *(uint2*)(dp + c2) = make_uint2(pack2(x2[0] * scale, x2[1] * scale), pack2(x2[2] * scale, x2[3] * scale));
        }
    }
  }
};

struct EpiResid {
  const float* xold; float* xnew; const float* gate;
  DI void operator()(const f32x4 (&acc)[2][2][4][2], const pg8::Unit& u, int wr, int wc, int fr, int fq) const {
    const int b = (u.pm * 256) >> 14;
    const int col0 = u.pn * 256 + wc * 32 + 4 * fq;
    f32x4 gv[2][2];
#pragma unroll
    for (int bj = 0; bj < 2; ++bj)
#pragma unroll
      for (int n = 0; n < 2; ++n) gv[bj][n] = *(const f32x4*)(gate + b * 6144 + col0 + bj * 128 + n * 16);
#pragma unroll
    for (int ai = 0; ai < 2; ++ai)
#pragma unroll
      for (int m = 0; m < 4; ++m) {
        const size_t off = (size_t)(u.pm * 256 + ai * 128 + wr * 64 + m * 16 + fr) * 1024 + col0;
        f32x4 xo[2][2];
#pragma unroll
        for (int bj = 0; bj < 2; ++bj)
#pragma unroll
          for (int n = 0; n < 2; ++n) xo[bj][n] = *(const f32x4*)(xold + off + bj * 128 + n * 16);
#pragma unroll
        for (int bj = 0; bj < 2; ++bj)
#pragma unroll
          for (int n = 0; n < 2; ++n) *(f32x4*)(xnew + off + bj * 128 + n * 16) = xo[bj][n] + gv[bj][n] * acc[ai][bj][m][n];
        asm volatile("" ::: "memory");
      }
  }
};

DI float dpp_ror1(float v)  { return __builtin_bit_cast(float, __builtin_amdgcn_update_dpp(0, __builtin_bit_cast(int, v), 0x121, 0xf, 0xf, false)); }
DI float dpp_ror15(float v) { return __builtin_bit_cast(float, __builtin_amdgcn_update_dpp(0, __builtin_bit_cast(int, v), 0x12F, 0xf, 0xf, false)); }
struct EpiUp {
  u16* act; const float* cw; const float* cb;
  DI void operator()(const f32x4 (&acc)[2][2][4][2], const pg8::Unit& u, int wr, int wc, int fr, int fq) const {
    const int b = u.pm / 67, ti = u.pm % 67;
#pragma unroll
    for (int n = 0; n < 2; ++n) {
      const int col = u.pn * 128 + wc * 32 + n * 16 + 4 * fq;
      const f32x4 w0 = *(const f32x4*)(cw + col), w1 = *(const f32x4*)(cw + DFF + col), w2 = *(const f32x4*)(cw + 2 * DFF + col), bb = *(const f32x4*)(cb + col);
#pragma unroll
      for (int ai = 0; ai < 2; ++ai) {
        const int tokb = 248 * ti - 1 + 62 * (2 * ai + wr);
        f32x4 g[4];
        if (tokb >= 0 && tokb + 63 < S) {
#pragma unroll
          for (int m = 0; m < 4; ++m) g[m] = acc[ai][0][m][n];
        } else {
#pragma unroll
          for (int m = 0; m < 4; ++m) {
            const int tok = tokb + 16 * m + fr;
            const bool ok = (tok >= 0) && (tok < S);
#pragma unroll
            for (int e = 0; e < 4; ++e) g[m][e] = ok ? acc[ai][0][m][n][e] : 0.f;
          }
        }
#pragma unroll
        for (int m = 0; m < 4; ++m) {
          const int q = 16 * m + fr, tok = tokb + q;
          f32x4 r;
#pragma unroll
          for (int e = 0; e < 4; ++e) {
            const float srcm = (fr == 15 && m > 0) ? g[m > 0 ? m - 1 : 0][e] : g[m][e];
            const float srcp = (fr == 0 && m < 3) ? g[m < 3 ? m + 1 : 3][e] : g[m][e];
            const float gm = dpp_ror1(srcm), gp = dpp_ror15(srcp);
            const float cv = bb[e] + w0[e] * gm + w1[e] * g[m][e] + w2[e] * gp;
            r[e] = cv * __builtin_amdgcn_rcpf(1.f + exp2_hw(-LOG2E * cv)) * acc[ai][1][m][n][e];
          }
          if (q >= 1 && q <= 62 && tok < S)
            *(uint2*)(act + (size_t)(b * S + tok) * DFF + col) = make_uint2(pack2(r[0], r[1]), pack2(r[2], r[3]));
        }
      }
    }
  }
};

constexpr int VROW = 96;
constexpr int VT_WAVE = 64 * VROW;
DI bf16x8 v_frag_tr(const u16* Vb, int kb0, int mb, int sp, int lane) {
  const int i16 = lane & 15, q = i16 >> 2, pp = i16 & 3, blk = (lane >> 4) & 1, hh = lane >> 5;
  const u16* a0 = Vb + (kb0 + 16 * sp + 4 * hh + q) * VROW + (mb * 2 + blk) * 16 + 4 * pp;
  const s16x4 lo = __builtin_amdgcn_ds_read_tr16_b64_v4i16((LAS s16x4*)a0);
  const s16x4 hi = __builtin_amdgcn_ds_read_tr16_b64_v4i16((LAS s16x4*)(a0 + 8 * VROW));
  return __builtin_shufflevector(lo, hi, 0, 1, 2, 3, 4, 5, 6, 7);
}

DI void local_softmax_step(float (&sv)[2][16], float& m_run, float& l_run, f32x16 (&O)[2], bf16x8 (&pk)[2][2]) {
  float tmax = NEGBIG;
#pragma unroll
  for (int h2 = 0; h2 < 2; ++h2)
#pragma unroll
    for (int i = 0; i < 16; ++i) tmax = fmaxf(tmax, sv[h2][i]);
  tmax = fmaxf(tmax, __shfl_xor(tmax, 32));
  const float m_new = fmaxf(m_run, tmax);
  if (__builtin_amdgcn_ballot_w64(m_new > m_run) != 0ull) {
    const float alpha = exp2_hw(m_run - m_new);
    m_run = m_new; l_run *= alpha;
#pragma unroll
    for (int mb = 0; mb < 2; ++mb)
#pragma unroll
      for (int i = 0; i < 16; ++i) O[mb][i] *= alpha;
  }
#pragma unroll
  for (int h2 = 0; h2 < 2; ++h2)
#pragma unroll
    for (int sp = 0; sp < 2; ++sp) {
      unsigned q4[4];
#pragma unroll
      for (int q = 0; q < 4; ++q) {
        const float s0 = sv[h2][8 * sp + 2 * q], s1 = sv[h2][8 * sp + 2 * q + 1];
        const float p0 = exp2_hw(s0 - m_run), p1 = exp2_hw(s1 - m_run);
        l_run += p0; l_run += p1;
        q4[q] = pack2(p0, p1);
      }
      pk[h2][sp] = __builtin_bit_cast(bf16x8, make_uint4(q4[0], q4[1], q4[2], q4[3]));
    }
}
DI void local_store_out(const f32x16 (&O)[2], float l_run, u16* op, int hh) {
  const float l = l_run + __shfl_xor(l_run, 32);
  const float il = 1.f / l;
#pragma unroll
  for (int mb = 0; mb < 2; ++mb)
#pragma unroll
    for (int g = 0; g < 4; ++g) {
      const int d = mb * 32 + 8 * g + 4 * hh;
      *(uint2*)(op + d) = make_uint2(pack2(O[mb][4 * g] * il, O[mb][4 * g + 1] * il), pack2(O[mb][4 * g + 2] * il, O[mb][4 * g + 3] * il));
    }
}

constexpr int KS_STRIDE = 72;
constexpr int KS_BUF = 64 * KS_STRIDE, VS_BUF = 64 * VROW;
DI void swin_attn_item(KP p, int item, u16* sm) {
  const int tid = otid(), lane = tid & 63, w = __builtin_amdgcn_readfirstlane(tid >> 6), r = lane & 31, hh = lane >> 5;
  u16* Ks = sm; u16* Vs = sm + 2 * KS_BUF;
  const int bhp = item >> 6, sub = item & 63;
  const int pat = bhp % 3, bh = bhp / 3, head = bh % 6, b = bh / 6;
  const int sh = 2 * pat, L = S >> sh;
  const int cls = sub >> (6 - sh), pb = sub & ((64 >> sh) - 1);
  const int P = pb * 256;
  const int qp = P + 32 * w + r, tq = cls + (qp << sh);
  const u16* prow = p.proj + (size_t)b * S * NPROJ;
  bf16x8 qf[4];
#pragma unroll
  for (int s = 0; s < 4; ++s) qf[s] = *(const bf16x8*)(prow + (size_t)tq * NPROJ + 768 + head * 64 + s * 16 + 8 * hh);
  f32x16 O[2];
#pragma unroll
  for (int mb = 0; mb < 2; ++mb)
#pragma unroll
    for (int i = 0; i < 16; ++i) O[mb][i] = 0.f;
  float m_run = -1e20f, l_run = 0.f;
  const int key0 = tid >> 3, ch = tid & 7;
  const u16* kg = prow + 1152 + head * 64 + ch * 8;
  auto gk = [&](int j) __attribute__((always_inline)) -> const u16* {
    int kp = P - 64 + 64 * j + key0; kp = kp < 0 ? 0 : (kp > L - 1 ? L - 1 : kp);
    return kg + (size_t)(cls + (kp << sh)) * NPROJ;
  };
  const uint4 k0 = *(const uint4*)gk(0), v0 = *(const uint4*)(gk(0) + 384), k1 = *(const uint4*)gk(1), v1 = *(const uint4*)(gk(1) + 384);
  const uint4 k2 = *(const uint4*)gk(2), v2 = *(const uint4*)(gk(2) + 384), k3 = *(const uint4*)gk(3), v3 = *(const uint4*)(gk(3) + 384);
  const uint4 k4 = *(const uint4*)gk(4), v4 = *(const uint4*)(gk(4) + 384), k5 = *(const uint4*)gk(5), v5 = *(const uint4*)(gk(5) + 384);
  auto lstore = [&](int buf, const uint4& kr, const uint4& vr) __attribute__((always_inline)) {
    *(uint4*)(Ks + buf * KS_BUF + key0 * KS_STRIDE + ch * 8) = kr;
    *(uint4*)(Vs + buf * VS_BUF + key0 * VROW + ch * 8) = vr;
  };
  lstore(0, k0, v0);
  __syncthreads();
  const int jlo = w >> 1;
#pragma unroll
  for (int j = 0; j < 6; ++j) {
    const int buf = j & 1;
    if (j >= jlo && j <= jlo + 2) {
      f32x16 Sc[2];
#pragma unroll
      for (int i = 0; i < 16; ++i) { Sc[0][i] = 0.f; Sc[1][i] = 0.f; }
#pragma unroll
      for (int s = 0; s < 4; ++s)
#pragma unroll
        for (int h2 = 0; h2 < 2; ++h2) {
          const bf16x8 kf = *(const bf16x8*)(Ks + buf * KS_BUF + (h2 * 32 + r) * KS_STRIDE + s * 16 + 8 * hh);
          Sc[h2] = MFMA32(kf, qf[s], Sc[h2]);
        }
      const int dbase = (64 * j - 32 * w) + 4 * hh - r;
      const int kbase = P - 64 + 64 * j + 4 * hh;
      float sv[2][16];
#pragma unroll
      for (int h2 = 0; h2 < 2; ++h2)
#pragma unroll
        for (int i = 0; i < 16; ++i) {
          const int c = h2 * 32 + (i & 3) + 8 * (i >> 2);
          const bool valid = ((unsigned)(dbase + c) <= 128u) && ((unsigned)(kbase + c) < (unsigned)L);
          sv[h2][i] = valid ? Sc[h2][i] : NEGBIG;
        }
      bf16x8 pk[2][2];
      local_softmax_step(sv, m_run, l_run, O, pk);
#pragma unroll
      for (int h2 = 0; h2 < 2; ++h2)
#pragma unroll
        for (int sp = 0; sp < 2; ++sp)
#pragma unroll
          for (int mb = 0; mb < 2; ++mb) {
            const bf16x8 vf = v_frag_tr(Vs + buf * VS_BUF, h2 * 32, mb, sp, lane);
            O[mb] = MFMA32(vf, pk[h2][sp], O[mb]);
          }
    }
    if (j == 0) lstore(1, k1, v1);
    if (j == 1) lstore(0, k2, v2);
    if (j == 2) lstore(1, k3, v3);
    if (j == 3) lstore(0, k4, v4);
    if (j == 4) lstore(1, k5, v5);
    __syncthreads();
  }
  const size_t orow = (size_t)pat * NTOK + (size_t)b * S + tq;
  const float l = l_run + __shfl_xor(l_run, 32);
  if (hh == 0) p.lse[orow * 6 + head] = m_run + __log2f(l);
  local_store_out(O, l_run, p.odil + orow * 384 + head * 64, hh);
}

DI void combine_dil(KP p) {
  const int tid = otid();
  for (int tc = blockIdx.x; tc < 256; tc += gridDim.x) {
#pragma unroll 1
    for (int idx = tid; idx < 128 * 48; idx += NTHR) {
      const int tok = tc * 128 + idx / 48, c8 = idx % 48, head = c8 >> 3;
      float ls[3], wgt[3];
#pragma unroll
      for (int q = 0; q < 3; ++q) ls[q] = p.lse[((size_t)q * NTOK + tok) * 6 + head];
      const float mx = fmaxf(ls[0], fmaxf(ls[1], ls[2]));
      float sum = 0.f;
#pragma unroll
      for (int q = 0; q < 3; ++q) { wgt[q] = exp2_hw(ls[q] - mx); sum += wgt[q]; }
      const float isum = 1.f / sum;
      float acc[8];
#pragma unroll
      for (int e = 0; e < 8; ++e) acc[e] = 0.f;
#pragma unroll
      for (int q = 0; q < 3; ++q) {
        const uint4 v = *(const uint4*)(p.odil + ((size_t)q * NTOK + tok) * 384 + c8 * 8);
        const float wq = wgt[q] * isum;
        acc[0] += wq * bflo(v.x); acc[1] += wq * bfhi(v.x); acc[2] += wq * bflo(v.y); acc[3] += wq * bfhi(v.y);
        acc[4] += wq * bflo(v.z); acc[5] += wq * bfhi(v.z); acc[6] += wq * bflo(v.w); acc[7] += wq * bfhi(v.w);
      }
      *(uint4*)(p.o + (size_t)tok * 1024 + 256 + c8 * 8) = make_uint4(pack2(acc[0], acc[1]), pack2(acc[2], acc[3]), pack2(acc[4], acc[5]), pack2(acc[6], acc[7]));
    }
  }
}

constexpr int RPB_PAD = 48, RPB_LDS = 15 * 31 + 2 * RPB_PAD;
DI void na_attn_item(KP p, int layer, int item, u16* sm) {
  const int tid = otid(), lane = tid & 63, w = __builtin_amdgcn_readfirstlane(tid >> 6), r = lane & 31, hh = lane >> 5;
  u16* Ks = sm; u16* Vs = sm + 2 * KS_BUF;
  const int b = item / (6 * 64), rem = item % (6 * 64), head = rem / 64, g = rem % 64;
  const int rr = 4 * g + (w >> 1), half = w & 1;
  const int tq = rr * 64 + half * 32 + r, qc = half * 32 + r;
  auto rstart = [](int x) { int v = x - 4; return v < 0 ? 0 : (v > 248 ? 248 : v); };
  const int my_rs = rstart(rr), rs_lo = rstart(4 * g), rs_hi = rstart(4 * g + 3) + 7;
  const u16* prow = p.proj + (size_t)b * S * NPROJ;
  const float* rpb = p.na_rpb + ((size_t)layer * 6 + head) * 15 * 31;
  bf16x8 qf[4];
#pragma unroll
  for (int s = 0; s < 4; ++s) qf[s] = *(const bf16x8*)(prow + (size_t)tq * NPROJ + 1920 + head * 64 + s * 16 + 8 * hh);
  int cs = qc - 8; cs = cs < 0 ? 0 : (cs > 48 ? 48 : cs);
  float* rtab = (float*)(sm + 2 * KS_BUF + 2 * VS_BUF);
  for (int i = tid; i < RPB_LDS; i += NTHR) { const int j = i - RPB_PAD; rtab[i] = (j >= 0 && j < 15 * 31) ? rpb[j] * LOG2E : 0.f; }
  const int vbase = 4 * hh - cs;
  f32x16 O[2];
#pragma unroll
  for (int mb = 0; mb < 2; ++mb)
#pragma unroll
    for (int i = 0; i < 16; ++i) O[mb][i] = 0.f;
  float m_run = -1e20f, l_run = 0.f;
  uint4 kr, vr, kr2, vr2, kr3, vr3;
  const int key0 = tid >> 3, ch = tid & 7;
  const u16* kg = prow + (size_t)key0 * NPROJ + 2304 + head * 64 + ch * 8;
  auto gload = [&](int krow, uint4& kd, uint4& vd) __attribute__((always_inline)) {
    const u16* src = kg + (size_t)((krow > 255 ? 255 : krow) * 64) * NPROJ;
    kd = *(const uint4*)src; vd = *(const uint4*)(src + 384);
  };
  auto lstore = [&](int buf) __attribute__((always_inline)) {
    *(uint4*)(Ks + buf * KS_BUF + key0 * KS_STRIDE + ch * 8) = kr;
    *(uint4*)(Vs + buf * VS_BUF + key0 * VROW + ch * 8) = vr;
  };
  gload(rs_lo, kr, vr); lstore(0);
  gload(rs_lo + 1, kr, vr); gload(rs_lo + 2, kr2, vr2);
  __syncthreads();
  for (int krow = rs_lo; krow <= rs_hi; ++krow) {
    const int buf = (krow - rs_lo) & 1;
    gload(krow + 3, kr3, vr3);
    if (krow >= my_rs && krow < my_rs + 8) {
      f32x16 Sc[2];
#pragma unroll
      for (int i = 0; i < 16; ++i) { Sc[0][i] = 0.f; Sc[1][i] = 0.f; }
#pragma unroll
      for (int s = 0; s < 4; ++s)
#pragma unroll
        for (int h2 = 0; h2 < 2; ++h2) {
          const bf16x8 kf = *(const bf16x8*)(Ks + buf * KS_BUF + (h2 * 32 + r) * KS_STRIDE + s * 16 + 8 * hh);
          Sc[h2] = MFMA32(kf, qf[s], Sc[h2]);
        }
      const float* rowp = rtab + RPB_PAD + (krow - rr + 7) * 31 + 15 + 4 * hh - qc;
      float sv[2][16];
#pragma unroll
      for (int h2 = 0; h2 < 2; ++h2)
#pragma unroll
        for (int i = 0; i < 16; ++i) {
          const int c = h2 * 32 + (i & 3) + 8 * (i >> 2);
          const bool valid = (unsigned)(vbase + c) < 16u;
          sv[h2][i] = valid ? (Sc[h2][i] + rowp[c]) : NEGBIG;
        }
      bf16x8 pk[2][2];
      local_softmax_step(sv, m_run, l_run, O, pk);
#pragma unroll
      for (int h2 = 0; h2 < 2; ++h2)
#pragma unroll
        for (int sp = 0; sp < 2; ++sp)
#pragma unroll
          for (int mb = 0; mb < 2; ++mb) {
            const bf16x8 vf = v_frag_tr(Vs + buf * VS_BUF, h2 * 32, mb, sp, lane);
            O[mb] = MFMA32(vf, pk[h2][sp], O[mb]);
          }
    }
    lstore(buf ^ 1);
    kr = kr2; vr = vr2; kr2 = kr3; vr2 = vr3;
    __syncthreads();
  }
  local_store_out(O, l_run, p.o + (size_t)(b * S + tq) * 1024 + 640 + head * 64, hh);
}

DI void kmax_item(KP p, int layer, int kidx) {
  const int tid = otid(); const int gid = kidx * NTHR + tid;
  const int row = gid >> 2, head = gid & 3, b = row >> 14;
  const uint4* kp = (const uint4*)(p.proj + (size_t)row * NPROJ + 256 + head * 64);
  float n0 = 0.f, n1 = 0.f;
#pragma unroll
  for (int c = 0; c < 8; ++c) {
    const uint4 v = kp[c];
    const unsigned e[4] = {v.x, v.y, v.z, v.w};
    float s = 0.f;
#pragma unroll
    for (int q = 0; q < 4; ++q) { const float a = bflo(e[q]), bq = bfhi(e[q]); s += a * a + bq * bq; }
    if (c >= 4) n1 += s; else n0 += s;
  }
#pragma unroll
  for (int o = 4; o <= 32; o <<= 1) { n0 = fmaxf(n0, __shfl_xor(n0, o)); n1 = fmaxf(n1, __shfl_xor(n1, o)); }
  if ((tid & 63) < 4) {
    unsigned* km = p.kmax + layer * 16 + (b * 4 + head) * 2;
    atomicMax(km, __float_as_uint(n0)); atomicMax(km + 1, __float_as_uint(n1));
  }
}

DI void phase_local(KP p, int layer, u16* sm) {
  constexpr int N_DIL = 2304, N_NA = 768, N_KM = 256;
  for (int it = blockIdx.x; it < N_DIL + N_NA + N_KM; it += gridDim.x) {
    __syncthreads();
    if (it < N_DIL) swin_attn_item(p, it, sm);
    else if (it < N_DIL + N_NA) na_attn_item(p, layer, it - N_DIL, sm);
    else kmax_item(p, layer, it - N_DIL - N_NA);
  }
}

DI void phase_diff(KP p, int layer, u16* sm) {
  combine_dil(p);
  const int tid = otid(), lane = tid & 63, w = __builtin_amdgcn_readfirstlane(tid >> 6), r = lane & 31, hh = lane >> 5;
  u16* Ks = sm; u16* Vs = sm + 2 * KS_BUF;
  float lam;
  {
    const float* dl = p.diff_lambda + layer * 128;
    float a = 0.f, c2 = 0.f;
    if (lane < 32) { a = dl[lane] * dl[32 + lane]; c2 = dl[64 + lane] * dl[96 + lane]; }
    a = wave_sum(a); c2 = wave_sum(c2);
    lam = __expf(a) - __expf(c2) + p.lam_init[layer];
  }
  const float lam_init = p.lam_init[layer];
  const float* sg = p.diff_subln + layer * 64;
  for (int it = blockIdx.x; it < 512; it += gridDim.x) {
    const int bh = it >> 6, qb = it & 63, b = bh >> 2, head = bh & 3;
    const u16* prow = p.proj + (size_t)b * S * NPROJ;
    const int tq = qb * 256 + w * 32 + r;
    bf16x8 qf[2][2];
    float qn[2];
#pragma unroll
    for (int m = 0; m < 2; ++m) {
      qn[m] = 0.f;
#pragma unroll
      for (int s = 0; s < 2; ++s) {
        qf[m][s] = *(const bf16x8*)(prow + (size_t)tq * NPROJ + head * 64 + m * 32 + s * 16 + 8 * hh);
#pragma unroll
        for (int j = 0; j < 8; ++j) { const float v = bf2f((u16)qf[m][s][j]); qn[m] += v * v; }
      }
      qn[m] += __shfl_xor(qn[m], 32);
    }
    float mbnd[2];
#pragma unroll
    for (int m = 0; m < 2; ++m) {
      const float km = __uint_as_float(p.kmax[layer * 16 + bh * 2 + m]);
      mbnd[m] = fmaxf(sqrtf(qn[m] * km) - 100.f, 0.f);
    }
    const bool noshift = __builtin_amdgcn_ballot_w64(mbnd[0] == 0.f && mbnd[1] == 0.f) == ~0ull;
    f32x16 O[2][2];
#pragma unroll
    for (int m = 0; m < 2; ++m)
#pragma unroll
      for (int mb = 0; mb < 2; ++mb)
#pragma unroll
        for (int i = 0; i < 16; ++i) O[m][mb][i] = 0.f;
    float lsum[2] = {0.f, 0.f};
    uint4 kr, vr, kr2, vr2, kr3, vr3;
    const int key0 = tid >> 3, ch = tid & 7;
    const u16* kg = prow + (size_t)key0 * NPROJ + 256 + head * 64 + ch * 8;
    auto gload = [&](int kt, uint4& kd, uint4& vd) __attribute__((always_inline)) {
      const u16* src = kg + (size_t)((kt & 255) * 64) * NPROJ;
      kd = *(const uint4*)src; vd = *(const uint4*)(src + 256);
    };
    auto lstore = [&](int buf) __attribute__((always_inline)) {
      *(uint4*)(Ks + buf * KS_BUF + key0 * KS_STRIDE + ch * 8) = kr;
      *(uint4*)(Vs + buf * VS_BUF + key0 * VROW + ch * 8) = vr;
    };
    gload(0, kr, vr); lstore(0);
    gload(1, kr, vr); gload(2, kr2, vr2);
    __syncthreads();
    if (w >= 4) __builtin_amdgcn_s_setprio(1);
    if (noshift) {
    for (int kt = 0; kt < 256; ++kt) {
      const int buf = kt & 1;
      gload(kt + 3, kr3, vr3);
#pragma unroll
      for (int sub = 0; sub < 2; ++sub) {
#pragma unroll
        for (int m = 0; m < 2; ++m) {
          f32x16 Sc;
#pragma unroll
          for (int i = 0; i < 16; ++i) Sc[i] = 0.f;
#pragma unroll
          for (int s = 0; s < 2; ++s) {
            const bf16x8 kf = *(const bf16x8*)(Ks + buf * KS_BUF + (sub * 32 + r) * KS_STRIDE + m * 32 + s * 16 + 8 * hh);
            Sc = MFMA32(kf, qf[m][s], Sc);
          }
          bf16x8 pk[2];
#pragma unroll
          for (int sp = 0; sp < 2; ++sp) {
            unsigned q4[4];
#pragma unroll
            for (int q = 0; q < 4; ++q) {
              const float p0 = exp2_hw(Sc[8 * sp + 2 * q]), p1 = exp2_hw(Sc[8 * sp + 2 * q + 1]);
              lsum[m] += p0; lsum[m] += p1;
              q4[q] = pack2(p0, p1);
            }
            pk[sp] = __builtin_bit_cast(bf16x8, make_uint4(q4[0], q4[1], q4[2], q4[3]));
          }
#pragma unroll
          for (int sp = 0; sp < 2; ++sp)
#pragma unroll
            for (int mb = 0; mb < 2; ++mb) {
              const bf16x8 vf = v_frag_tr(Vs + buf * VS_BUF, sub * 32, mb, sp, lane);
              O[m][mb] = MFMA32(vf, pk[sp], O[m][mb]);
            }
        }
        __builtin_amdgcn_sched_barrier(0);
      }
      lstore(buf ^ 1);
      kr = kr2; vr = vr2; kr2 = kr3; vr2 = vr3;
      __syncthreads();
    }
    } else {
    for (int kt = 0; kt < 256; ++kt) {
      const int buf = kt & 1;
      gload(kt + 3, kr3, vr3);
#pragma unroll
      for (int sub = 0; sub < 2; ++sub) {
#pragma unroll
        for (int m = 0; m < 2; ++m) {
          f32x16 Sc;
#pragma unroll
          for (int i = 0; i < 16; ++i) Sc[i] = 0.f;
#pragma unroll
          for (int s = 0; s < 2; ++s) {
            const bf16x8 kf = *(const bf16x8*)(Ks + buf * KS_BUF + (sub * 32 + r) * KS_STRIDE + m * 32 + s * 16 + 8 * hh);
            Sc = MFMA32(kf, qf[m][s], Sc);
          }
          bf16x8 pk[2];
#pragma unroll
          for (int sp = 0; sp < 2; ++sp) {
            unsigned q4[4];
#pragma unroll
            for (int q = 0; q < 4; ++q) {
              const float p0 = exp2_hw(Sc[8 * sp + 2 * q] - mbnd[m]), p1 = exp2_hw(Sc[8 * sp + 2 * q + 1] - mbnd[m]);
              lsum[m] += p0; lsum[m] += p1;
              q4[q] = pack2(p0, p1);
            }
            pk[sp] = __builtin_bit_cast(bf16x8, make_uint4(q4[0], q4[1], q4[2], q4[3]));
          }
#pragma unroll
          for (int sp = 0; sp < 2; ++sp)
#pragma unroll
            for (int mb = 0; mb < 2; ++mb) {
              const bf16x8 vf = v_frag_tr(Vs + buf * VS_BUF, sub * 32, mb, sp, lane);
              O[m][mb] = MFMA32(vf, pk[sp], O[m][mb]);
            }
        }
        __builtin_amdgcn_sched_barrier(0);
      }
      lstore(buf ^ 1);
      kr = kr2; vr = vr2; kr2 = kr3; vr2 = vr3;
      __syncthreads();
    }
    }
    __builtin_amdgcn_s_setprio(0);
    const float l0 = lsum[0] + __shfl_xor(lsum[0], 32);
    const float l1 = lsum[1] + __shfl_xor(lsum[1], 32);
    const float i0 = 1.f / l0, i1 = lam / l1;
    float ss = 0.f;
#pragma unroll
    for (int mb = 0; mb < 2; ++mb)
#pragma unroll
      for (int i = 0; i < 16; ++i) { const float v = O[0][mb][i] * i0 - O[1][mb][i] * i1; O[0][mb][i] = v; ss += v * v; }
    ss += __shfl_xor(ss, 32);
    const float inv = rsqrtf(ss * (1.f / 64.f) + 1e-6f) * (1.f - lam_init);
    u16* op = p.o + (size_t)(b * S + tq) * 1024 + head * 64;
#pragma unroll
    for (int mb = 0; mb < 2; ++mb)
#pragma unroll
      for (int g = 0; g < 4; ++g) {
        const int d = mb * 32 + 8 * g + 4 * hh;
        const float4 g4 = *(const float4*)(sg + d);
        *(uint2*)(op + d) = make_uint2(pack2(O[0][mb][4 * g] * inv * g4.x, O[0][mb][4 * g + 1] * inv * g4.y),
                                       pack2(O[0][mb][4 * g + 2] * inv * g4.z, O[0][mb][4 * g + 3] * inv * g4.w));
      }
  }
}

DI void phase_proj(KP p, int layer, LAS unsigned char* lds) {
  pg8::StaticOrder so; so.init(128, 12, gridDim.x, blockIdx.x);
  EpiProj e; e.proj = p.proj;
  pg8::gemm_phase<pg8::AMapPlain>(lds, p.h, p.wt_in + (size_t)layer * 3072 * 1024, 1024, so, e);
}
DI void phase_resid(const u16* A, int K, const u16* Bt, const float* xold, float* xnew, const float* gate, LAS unsigned char* lds) {
  pg8::StaticOrder so; so.init(128, 4, gridDim.x, blockIdx.x);
  EpiResid e; e.xold = xold; e.xnew = xnew; e.gate = gate;
  pg8::gemm_phase<pg8::AMapPlain>(lds, A, Bt, K, so, e);
}
DI void phase_up(KP p, int layer, LAS unsigned char* lds) {
  pg8::StaticOrder so; so.init(134, 22, gridDim.x, blockIdx.x);
  EpiUp e; e.act = p.act; e.cw = p.conv_w + (size_t)layer * 3 * DFF; e.cb = p.conv_b + (size_t)layer * DFF;
  pg8::gemm_phase<pg8::AMapHalo>(lds, p.h, p.wt_up + (size_t)layer * 5632 * 1024, 1024, so, e);
}

constexpr int N_PHASES = 18;

DI void run_phase(KP p, int ph, unsigned char* smraw) {
  u16* sm = (u16*)smraw;
  LAS unsigned char* lds = (LAS unsigned char*)smraw;
  if (ph == 0) { phase_prep(p, (float*)smraw); return; }
  if (ph == 17) { phase_norm<1>(p.out, p.g_final, nullptr, 0, 0, nullptr, p.out); return; }
  const int layer = (ph - 1) >> 3, sub = (ph - 1) & 7;
  const float* modl = p.mod + layer * 2 * 6144;
  const float* xcur = (layer == 0) ? p.x : p.out;
  switch (sub) {
    case 0: phase_norm<0>(xcur, p.g_attn + layer * 1024, modl, 0, 1024, p.h, nullptr); break;
    case 1: phase_proj(p, layer, lds); break;
    case 2: phase_local(p, layer, sm); break;
    case 3: phase_diff(p, layer, sm); break;
    case 4: phase_resid(p.o, 1024, p.wt_out + (size_t)layer * 1024 * 1024, xcur, p.out, modl + 2048, lds); break;
    case 5: phase_norm<0>(p.out, p.g_ffn + layer * 1024, modl, 3072, 4096, p.h, nullptr); break;
    case 6: phase_up(p, layer, lds); break;
    case 7: phase_resid(p.act, DFF, p.wt_down + (size_t)layer * 1024 * DFF, p.out, p.out, modl + 5120, lds); break;
  }
}

__global__ void __launch_bounds__(NTHR, 2) mega_kernel(Params p) {
  extern __shared__ __attribute__((aligned(16))) unsigned char smraw[];
#if COOP
  cg::grid_group grid = cg::this_grid();
  u16* sm = (u16*)smraw;
  LAS unsigned char* lds = (LAS unsigned char*)smraw;
  if (threadIdx.x == 0) *(uint4*)(smraw + LDS_BYTES) = make_uint4(0u, 0u, 0u, 0u);
  __syncthreads();
  const XcdBarrier xb = xcd_barrier_post(kp_fresh()->bar, (volatile LAS unsigned*)(smraw + LDS_BYTES));
  phase_prep(*kp_fresh(), (float*)smraw);
  grid.sync();
#pragma unroll 1
  for (int layer = 0; layer < 2; ++layer) {
    { KP q = *kp_fresh(); phase_norm<0>((layer == 0) ? q.x : q.out, q.g_attn + layer * 1024, q.mod + layer * 2 * 6144, 0, 1024, q.h, nullptr); } xcd_barrier(xb);
    phase_proj(*kp_fresh(), layer, lds); xcd_barrier(xb);
    phase_local(*kp_fresh(), layer, sm); xcd_barrier(xb);
    phase_diff(*kp_fresh(), layer, sm); xcd_barrier(xb);
    { KP q = *kp_fresh(); phase_resid(q.o, 1024, q.wt_out + (size_t)layer * 1024 * 1024, (layer == 0) ? q.x : q.out, q.out, q.mod + layer * 2 * 6144 + 2048, lds); } xcd_barrier(xb);
    { KP q = *kp_fresh(); phase_norm<0>(q.out, q.g_ffn + layer * 1024, q.mod + layer * 2 * 6144, 3072, 4096, q.h, nullptr); } xcd_barrier(xb);
    phase_up(*kp_fresh(), layer, lds); xcd_barrier(xb);
    { KP q = *kp_fresh(); phase_resid(q.act, DFF, q.wt_down + (size_t)layer * 1024 * DFF, q.out, q.out, q.mod + layer * 2 * 6144 + 5120, lds); } xcd_barrier(xb);
  }
  { KP q = *kp_fresh(); phase_norm<1>(q.out, q.g_final, nullptr, 0, 0, nullptr, q.out); }
#else
  { KP q = *kp_fresh(); for (int ph = q.ph_lo; ph < q.ph_hi; ++ph) run_phase(q, ph, smraw); }
#endif
}

extern "C" void kernel_launch(void* const* d_in, const int* in_sizes, int n_in, void* d_out, int out_size, void* d_ws, size_t ws_size, hipStream_t stream) {
  (void)in_sizes; (void)n_in; (void)out_size;
  Params p;
  memset(&p, 0, sizeof(p));
  p.x = (const float*)d_in[0]; p.c = (const float*)d_in[1]; p.w_ada = (const float*)d_in[2]; p.b_ada = (const float*)d_in[3];
  p.g_attn = (const float*)d_in[4]; p.w_in = (const float*)d_in[5]; p.diff_lambda = (const float*)d_in[6]; p.diff_subln = (const float*)d_in[7];
  p.na_rpb = (const float*)d_in[8]; p.w_out = (const float*)d_in[9]; p.g_ffn = (const float*)d_in[10]; p.w_up = (const float*)d_in[11];
  p.conv_w = (const float*)d_in[12]; p.conv_b = (const float*)d_in[13]; p.w_down = (const float*)d_in[14]; p.g_final = (const float*)d_in[15];
  p.out = (float*)d_out;
  char* ws = (char*)d_ws; size_t off = 0;
  auto take = [&](size_t bytes) { char* q = ws + off; off += (bytes + 255) & ~(size_t)255; return q; };
  p.wt_in = (u16*)take((size_t)2 * 3072 * 1024 * 2);
  p.wt_out = (u16*)take((size_t)2 * 1024 * 1024 * 2);
  p.wt_up = (u16*)take((size_t)2 * 5632 * 1024 * 2);
  p.wt_down = (u16*)take((size_t)2 * 1024 * 2816 * 2);
  p.mod = (float*)take((size_t)2 * 2 * 6144 * 4);
  p.kmax = (unsigned*)take(256);
  p.bar = (unsigned*)take((size_t)XCD_BAR_WORDS * 4);
  (void)take(4096);
  p.h = (u16*)take((size_t)NTOK * 1024 * 2);
  p.o = (u16*)take((size_t)NTOK * 1024 * 2);
  p.proj = (u16*)take((size_t)NTOK * NPROJ * 2);
  p.odil = (u16*)take((size_t)3 * NTOK * 384 * 2);
  p.lse = (float*)take((size_t)3 * NTOK * 6 * 4);
  p.act = p.proj;
  if (off > ws_size) { fprintf(stderr, "workspace too small: need %zu have %zu\n", off, ws_size); return; }
  p.lam_init[0] = 0.2f; p.lam_init[1] = 0.35550906759096934f;
  static int grid_blocks = 0;
  if (!grid_blocks) {
    int dev = 0, cus = 0, per_cu = 0;
    (void)hipGetDevice(&dev);
    (void)hipDeviceGetAttribute(&cus, hipDeviceAttributeMultiprocessorCount, dev);
    (void)hipFuncSetAttribute((const void*)mega_kernel, hipFuncAttributeMaxDynamicSharedMemorySize, LDS_BYTES + 16);
    (void)hipOccupancyMaxActiveBlocksPerMultiprocessor(&per_cu, mega_kernel, NTHR, LDS_BYTES + 16);
    if (per_cu > 1) per_cu = 1;
    if (per_cu < 1) per_cu = 1;
    grid_blocks = cus * per_cu;
  }
#if COOP
  p.ph_lo = 0; p.ph_hi = N_PHASES;
  (void)hipMemsetAsync(p.bar, 0, (size_t)XCD_BAR_WORDS * 4, stream);
  void* args[] = {&p};
  hipError_t e = hipLaunchCooperativeKernel((void*)mega_kernel, dim3(grid_blocks), dim3(NTHR), args, LDS_BYTES + 16, stream);
  if (e != hipSuccess) fprintf(stderr, "cooperative launch failed: %s (grid %d)\n", hipGetErrorString(e), grid_blocks);
#else
  for (int ph = 0; ph < N_PHASES; ++ph) {
    p.ph_lo = ph; p.ph_hi = ph + 1;
    hipLaunchKernelGGL(mega_kernel, dim3(grid_blocks), dim3(NTHR), LDS_BYTES + 16, stream, p);
  }
#endif
}
```

```cpp
#include <hip/hip_runtime.h>
#include <hip/hip_cooperative_groups.h>
#include <cstdio>
#include <cstring>
#include <type_traits>
namespace cg = cooperative_groups;

#ifndef COOP
#define COOP 1
#endif

#define DI __device__ __forceinline__
#define LAS __attribute__((address_space(3)))
typedef unsigned short u16;
using bf16x8 = __attribute__((ext_vector_type(8))) short;
using s16x4  = __attribute__((ext_vector_type(4))) short;
using f32x16 = __attribute__((ext_vector_type(16))) float;
using f32x4  = __attribute__((ext_vector_type(4))) float;
typedef int v8i_t __attribute__((ext_vector_type(8)));
typedef __bf16 bf2_t __attribute__((ext_vector_type(2)));
typedef float f2_t __attribute__((ext_vector_type(2)));
#define MFMA32(a, b, c) __builtin_amdgcn_mfma_f32_32x32x16_bf16((a), (b), (c), 0, 0, 0)

constexpr int S = 16384, NTOK = 32768, DFF = 2816, NPROJ = 3072;
constexpr int NTHR = 512, NWAVE = 8;
constexpr float LOG2E = 1.4426950408889634f;
constexpr float QSCALE_DIFF = 0.25503486164919736f;
constexpr float QSCALE_64   = 0.18033688011112042f;
constexpr float NEGBIG = -1e30f;
constexpr int LDS_BYTES = 131072;

__device__ const float ROPE_INV16[16] = {
1.000000000e+00f, 5.623413324e-01f, 3.162277639e-01f, 1.778279394e-01f, 1.000000015e-01f, 5.623413250e-02f, 3.162277490e-02f, 1.778279431e-02f, 9.999999776e-03f, 5.623413250e-03f, 3.162277630e-03f, 1.778279431e-03f, 1.000000047e-03f, 5.623413017e-04f, 3.162277571e-04f, 1.778279402e-04f};
__device__ const float ROPE_INV32[32] = {
1.000000000e+00f, 7.498942018e-01f, 5.623413324e-01f, 4.216965139e-01f, 3.162277639e-01f, 2.371373773e-01f, 1.778279394e-01f, 1.333521456e-01f, 1.000000015e-01f, 7.498942316e-02f, 5.623413250e-02f, 4.216964915e-02f, 3.162277490e-02f, 2.371373773e-02f, 1.778279431e-02f, 1.333521400e-02f, 9.999999776e-03f, 7.498942316e-03f, 5.623413250e-03f, 4.216964822e-03f, 3.162277630e-03f, 2.371373819e-03f, 1.778279431e-03f, 1.333521446e-03f, 1.000000047e-03f, 7.498941850e-04f, 5.623413017e-04f, 4.216965172e-04f, 3.162277571e-04f, 2.371373703e-04f, 1.778279402e-04f, 1.333521504e-04f};

struct Params {
  const float *x, *c, *w_ada, *b_ada, *g_attn, *w_in, *diff_lambda, *diff_subln, *na_rpb, *w_out, *g_ffn, *w_up, *conv_w, *conv_b, *w_down, *g_final;
  float* out;
  u16 *wt_in, *wt_out, *wt_up, *wt_down;
  float* mod;
  unsigned* kmax;
  unsigned* bar;
  u16 *h, *o, *proj, *act, *odil;
  unsigned char* vt8;
  float* lse;
  float lam_init[2];
  int ph_lo, ph_hi;
};

typedef const __attribute__((address_space(4))) Params& KP;
DI const __attribute__((address_space(4))) Params* kp_fresh() {
  const __attribute__((address_space(4))) Params* q = (const __attribute__((address_space(4))) Params*)__builtin_amdgcn_kernarg_segment_ptr();
  asm volatile("" : "+s"(q));
  return q;
}
DI unsigned pack2(float a, float b) { f2_t v = {a, b}; return __builtin_bit_cast(unsigned, __builtin_convertvector(v, bf2_t)); }
DI float bf2f(u16 v) { return __uint_as_float(((unsigned)v) << 16); }
DI float bflo(unsigned v) { return __uint_as_float(v << 16); }
DI float bfhi(unsigned v) { return __uint_as_float(v & 0xffff0000u); }
DI int crow(int i, int hh) { return (i & 3) + 8 * (i >> 2) + 4 * hh; }
DI float exp2_hw(float x) { return __builtin_amdgcn_exp2f(x); }
DI int otid() { int t = threadIdx.x; asm volatile("" : "+v"(t)); return t; }


#define XB_TMO      128
#define XB_XCNT(j)  (256  + 64 * (j))
#define XB_XSUB(j)  (1280 + 64 * (j))
#define XB_XGEN(j)  (2304 + 64 * (j))
#define XB_TOP      3328
#define XB_TOPGEN   3392
#define XCD_BAR_WORDS 3456
#define XB_SPIN_CAP (1u << 21)
DI unsigned xb_ld(unsigned* p)              { return __hip_atomic_load(p, __ATOMIC_RELAXED, __HIP_MEMORY_SCOPE_AGENT); }
DI unsigned xb_add(unsigned* p, unsigned v) { return __hip_atomic_fetch_add(p, v, __ATOMIC_RELAXED, __HIP_MEMORY_SCOPE_AGENT); }
DI unsigned xb_xcc_id() { return (unsigned)__builtin_amdgcn_s_getreg((3 << 11) | 20) & 0xFu; }
#define XB_SPIN(cond, bar) do { unsigned _sp = 0; while (cond) { __builtin_amdgcn_s_sleep(1); \
    if ((++_sp & 255u) == 0u) { if (xb_ld(&(bar)[XB_TMO])) break; if (_sp > XB_SPIN_CAP) { atomicAdd(&(bar)[XB_TMO], 1u); break; } } } } while (0)
struct XcdBarrier { unsigned* bar; unsigned x; volatile LAS unsigned* st; };
DI XcdBarrier xcd_barrier_post(unsigned* bar, volatile LAS unsigned* st) {
  XcdBarrier b; b.bar = bar; b.x = xb_xcc_id(); b.st = st;
  if (threadIdx.x == 0) (void)xb_add(&bar[XB_XCNT(b.x)], 1u);
  return b;
}
DI void xcd_barrier_complete(unsigned* bar, unsigned x, unsigned& nloc, unsigned& nx) {
  const unsigned G = gridDim.x * gridDim.y * gridDim.z;
  unsigned sum, cnt, mine, sp = 0u;
  for (;;) {
    sum = 0u; cnt = 0u; mine = 0u;
#pragma unroll
    for (unsigned j = 0; j < 16; ++j) { const unsigned c = xb_ld(&bar[XB_XCNT(j)]); sum += c; cnt += (c > 0u) ? 1u : 0u; mine = (j == x) ? c : mine; }
    if (sum == G) break;
    __builtin_amdgcn_s_sleep(1);
    if ((++sp & 255u) == 0u) { if (xb_ld(&bar[XB_TMO])) break; if (sp > XB_SPIN_CAP) { atomicAdd(&bar[XB_TMO], 1u); break; } }
  }
  nloc = mine > 0u ? mine : 1u; nx = cnt > 0u ? cnt : 1u;
}
DI void xcd_barrier(const XcdBarrier& b) {
  asm volatile("s_waitcnt vmcnt(0)" ::: "memory");
  __syncthreads();
  if (threadIdx.x == 0) {
    unsigned* bar = b.bar;
    __builtin_amdgcn_s_waitcnt(0);
    unsigned nloc = b.st[0], nx = b.st[1];
    if (nloc == 0u) { xcd_barrier_complete(bar, b.x, nloc, nx); b.st[0] = nloc; b.st[1] = nx; }
    const unsigned old = xb_add(&bar[XB_XSUB(b.x)], 1u);
    const unsigned gen = old / nloc;
    if (old + 1u == (gen + 1u) * nloc) {
      __builtin_amdgcn_fence(__ATOMIC_RELEASE, "agent");
      asm volatile("s_waitcnt vmcnt(0)" ::: "memory");
      const unsigned og = xb_add(&bar[XB_TOP], 1u);
      const unsigned tg = og / nx;
      if (og + 1u == (tg + 1u) * nx) xb_add(&bar[XB_TOPGEN], 1u);
      else XB_SPIN(xb_ld(&bar[XB_TOPGEN]) == tg, bar);
      __builtin_amdgcn_fence(__ATOMIC_ACQUIRE, "agent");
      xb_add(&bar[XB_XGEN(b.x)], 1u);
      asm volatile("s_waitcnt vmcnt(0)" ::: "memory");
    } else {
      XB_SPIN(xb_ld(&bar[XB_XGEN(b.x)]) == gen, bar);
      __builtin_amdgcn_fence(__ATOMIC_ACQUIRE, "agent");
      asm volatile("s_waitcnt vmcnt(0)" ::: "memory");
    }
  }
  __syncthreads();
}

DI int wmap_in(int np) {
  if (np >= 768 && np < 1536) { const int hb = np & ~63, w = np & 63, g = w >> 5, n = (w >> 4) & 1, i = w & 15; return hb + 16 * g + i + 32 * n; }
  return np;
}
DI int wmap_up(int np) {
  const int pn = np >> 8, w = np & 255, bj = w >> 7, q = w & 127;
  return bj ? (DFF + 128 * pn + q) : (128 * pn + q);
}

DI void phase_prep(KP p, float* smf) {
  const int tid = otid();
  if (blockIdx.x == 0 && tid < 64) p.kmax[tid] = 0u;
  constexpr int N_ADA = 192;
  constexpr int T_IN = 16 * 24, T_OUT = 16 * 8, T_UP = 16 * 44, T_DOWN = 44 * 8;
  constexpr int T_LAYER = T_IN + T_OUT + T_UP + T_DOWN;
  const int total = N_ADA + 2 * T_LAYER;
  for (int it = blockIdx.x; it < total; it += gridDim.x) {
    if (it < N_ADA) {
      const int l = it / 96, cgp = it % 96;
      float* sc = smf;
      float* red = smf + 2048;
      for (int i = tid; i < 2048; i += NTHR) { float v = p.c[i]; sc[i] = v / (1.f + __expf(-v)); }
      __syncthreads();
      const int kq = tid >> 6, cc = tid & 63, col = cgp * 64 + cc;
      const float* wp = p.w_ada + ((size_t)l * 1024 + kq * 128) * 6144 + col;
      float a0 = 0.f, a1 = 0.f;
#pragma unroll 8
      for (int k = 0; k < 128; ++k) { float w = wp[(size_t)k * 6144]; a0 += sc[kq * 128 + k] * w; a1 += sc[1024 + kq * 128 + k] * w; }
      red[(kq * 2 + 0) * 64 + cc] = a0; red[(kq * 2 + 1) * 64 + cc] = a1;
      __syncthreads();
      if (tid < 128) {
        const int b = tid >> 6, c2 = tid & 63;
        float s = 0.f;
#pragma unroll
        for (int q = 0; q < 8; ++q) s += red[(q * 2 + b) * 64 + c2];
        p.mod[(l * 2 + b) * 6144 + cgp * 64 + c2] = s + p.b_ada[l * 6144 + cgp * 64 + c2];
      }
    } else {
      int idx = it - N_ADA; const int l = idx / T_LAYER; int j = idx % T_LAYER;
      const float* W; u16* dst; int Kd, N, tk, tn, kind;
      if (j < T_IN) { W = p.w_in + (size_t)l * 1024 * 3072; dst = p.wt_in + (size_t)l * 3072 * 1024; Kd = 1024; N = 3072; tk = j / 24; tn = j % 24; kind = 0; }
      else if (j < T_IN + T_OUT) { j -= T_IN; W = p.w_out + (size_t)l * 1024 * 1024; dst = p.wt_out + (size_t)l * 1024 * 1024; Kd = 1024; N = 1024; tk = j / 8; tn = j % 8; kind = 1; }
      else if (j < T_IN + T_OUT + T_UP) { j -= T_IN + T_OUT; W = p.w_up + (size_t)l * 1024 * 5632; dst = p.wt_up + (size_t)l * 5632 * 1024; Kd = 1024; N = 5632; tk = j / 44; tn = j % 44; kind = 2; }
      else { j -= T_IN + T_OUT + T_UP; W = p.w_down + (size_t)l * 2816 * 1024; dst = p.wt_down + (size_t)l * 1024 * 2816; Kd = 2816; N = 1024; tk = j / 8; tn = j % 8; kind = 3; }
      const int hb = tid >> 8, t = tid & 255;
      const int k0 = tk * 64, n0 = (tn * 2 + hb) * 64;
      float* tile = smf + hb * (64 * 65);
      const int nn = t & 63;
      const int np = n0 + nn;
      const int srccol = (kind == 0) ? wmap_in(np) : (kind == 2) ? wmap_up(np) : np;
#pragma unroll 4
      for (int i = 0; i < 16; ++i) { const int kk = i * 4 + (t >> 6); tile[kk * 65 + nn] = W[(size_t)(k0 + kk) * N + srccol]; }
      __syncthreads();
      const int nrow = t >> 2, kc = (t & 3) * 16;
      unsigned pk[8];
#pragma unroll
      for (int q = 0; q < 8; ++q) pk[q] = pack2(tile[(kc + 2 * q) * 65 + nrow], tile[(kc + 2 * q + 1) * 65 + nrow]);
      uint4* dp = (uint4*)(dst + (size_t)(n0 + nrow) * Kd + k0 + kc);
      dp[0] = make_uint4(pk[0], pk[1], pk[2], pk[3]);
      dp[1] = make_uint4(pk[4], pk[5], pk[6], pk[7]);
    }
    __syncthreads();
  }
}

DI float wave_sum(float v) {
#pragma unroll
  for (int o = 32; o >= 1; o >>= 1) v += __shfl_xor(v, o);
  return v;
}

template <int MODE>
DI void phase_norm(const float* xin, const float* g, const float* modl, int sh_off, int sc_off, u16* hout, float* fout) {
  const int tid = otid(); const int lane = tid & 63, w = tid >> 6;
  for (int row = blockIdx.x * NWAVE + w; row < NTOK; row += gridDim.x * NWAVE) {
    const int b = row >> 14;
    const float4* xr = (const float4*)(xin + (size_t)row * 1024);
    float4 v[4];
#pragma unroll
    for (int i = 0; i < 4; ++i) v[i] = xr[lane + i * 64];
    float ss = 0.f;
#pragma unroll
    for (int i = 0; i < 4; ++i) ss += v[i].x * v[i].x + v[i].y * v[i].y + v[i].z * v[i].z + v[i].w * v[i].w;
    ss = wave_sum(ss);
    const float inv = rsqrtf(ss * (1.f / 1024.f) + 1e-6f);
#pragma unroll
    for (int i = 0; i < 4; ++i) {
      const int col = (lane + i * 64) * 4;
      const float4 g4 = *(const float4*)(g + col);
      if (MODE == 0) {
        const float4 sc4 = *(const float4*)(modl + b * 6144 + sc_off + col);
        const float4 sh4 = *(const float4*)(modl + b * 6144 + sh_off + col);
        float y0 = v[i].x * inv * g4.x * (1.f + sc4.x) + sh4.x;
        float y1 = v[i].y * inv * g4.y * (1.f + sc4.y) + sh4.y;
        float y2 = v[i].z * inv * g4.z * (1.f + sc4.z) + sh4.z;
        float y3 = v[i].w * inv * g4.w * (1.f + sc4.w) + sh4.w;
        *(uint2*)(hout + (size_t)row * 1024 + col) = make_uint2(pack2(y0, y1), pack2(y2, y3));
      } else {
        float4 y; y.x = v[i].x * inv * g4.x; y.y = v[i].y * inv * g4.y; y.z = v[i].z * inv * g4.z; y.w = v[i].w * inv * g4.w;
        *(float4*)(fout + (size_t)row * 1024 + col) = y;
      }
    }
  }
}

namespace pg8 {
constexpr int BM = 256, BK = 64, HALF = 128, HTB = HALF * BK * 2, NXCD = 8, WGM = 8;
DI int lds_byte(int r, int c) { const int st = (r >> 4) * 2 + (c >> 5), rr = r & 15, cc = c & 31, ob = rr * 64 + cc * 2; return st * 1024 + (ob ^ (((ob >> 9) & 1) << 5)); }
DI void stage_rc(int b, int& R, int& C) { const int st = b / 1024, sb = b % 1024, swz = sb ^ (((sb >> 9) & 1) << 5); R = (st >> 1) * 16 + swz / 64; C = (st & 1) * 32 + (swz % 64) / 2; }
struct Unit { int pm, pn; };
struct StaticOrder {
  int nM, nN, nwg, G, c;
  DI void init(int nM_, int nN_, int G_, int c_) { nM = nM_; nN = nN_; nwg = nM * nN; G = G_; c = c_; }
  DI bool next(int i, Unit& u) const {
    const long L = (long)i * G + c; if (L >= nwg) return false;
    int wgid = (int)L; { const int q = nwg / NXCD, r = nwg % NXCD, xcd = wgid % NXCD, off = wgid / NXCD; wgid = (xcd < r ? xcd * (q + 1) : r * (q + 1) + (xcd - r) * q) + off; }
    const int nig = WGM * nN, gid = wgid / nig, fm = gid * WGM, gsz = (nM - fm) < WGM ? (nM - fm) : WGM;
    u.pm = fm + ((wgid % nig) % gsz); u.pn = (wgid % nig) / gsz; return true;
  }
};
struct AMapPlain { static constexpr int HALF_ROWS = 128; static DI int row(int R) { return R; } static DI long tile_row0(int pm) { return (long)pm * 256; } };
struct AMapHalo  { static constexpr int HALF_ROWS = 124; static DI int row(int R) { return 62 * (R >> 6) + (R & 63); } static DI long tile_row0(int pm) { const int b = pm / 67, ti = pm % 67; return (long)b * S + 248 * ti - 1; } };

template <class AMap, class Epi>
DI void gemm_phase(LAS unsigned char* lds, const u16* Aptr, const u16* Btptr, int K, const StaticOrder& SO, const Epi& E) {
  const int tid = otid(), wid = __builtin_amdgcn_readfirstlane(tid >> 6), lane = tid & 63, wr = wid >> 2, wc = wid & 3, fr = lane & 15, fq = lane >> 4;
  const int nt = K / BK;
  unsigned voffA[2], voffB[2];
#pragma unroll
  for (int i = 0; i < 2; ++i) { int R, C; stage_rc(tid * 16 + i * 8192, R, C);
    voffA[i] = (unsigned)(AMap::row(R) * K + C) * 2u; voffB[i] = (unsigned)(R * K + C) * 2u; }
  const size_t kstep = (size_t)(BK * 2);
  const size_t hstepA = (size_t)AMap::HALF_ROWS * K * 2, hstepB = (size_t)HALF * K * 2;
  const size_t tstepB = 2 * hstepB;
  const size_t rowB = (size_t)K * 2;
  const unsigned ldsw = (unsigned)wid * 1024u;
  const int aoff = lds_byte(wr * 64 + fr, fq * 8), boff = lds_byte(wc * 32 + fr, fq * 8);
#define PG8_SA(b, h) (((b) * 2 + (h)) * HTB)
#define PG8_SB(b, h) ((4 + (b) * 2 + (h)) * HTB)
#define PG8_STAGE(bufoff, gbase, voff) do { _Pragma("unroll") for (int _i = 0; _i < 2; ++_i) \
        __builtin_amdgcn_global_load_lds((const unsigned*)((const char*)(gbase) + (voff)[_i]), (LAS unsigned*)(lds + (bufoff) + ldsw + _i * 8192), 16, 0, 0); } while (0)
#define PG8_LDA(dst, b, h) do { _Pragma("unroll") for (int m = 0; m < 4; ++m) _Pragma("unroll") for (int k = 0; k < 2; ++k) dst[m][k] = *(const LAS bf16x8*)(lds + PG8_SA(b, h) + aoff + m * 2048 + k * 1024); } while (0)
#define PG8_LDB(dst, b, h) do { _Pragma("unroll") for (int n = 0; n < 2; ++n) _Pragma("unroll") for (int k = 0; k < 2; ++k) dst[n][k] = *(const LAS bf16x8*)(lds + PG8_SB(b, h) + boff + n * 2048 + k * 1024); } while (0)
#define PG8_MMA(ai, bj, At, Bt) do { __builtin_amdgcn_s_setprio(1); _Pragma("unroll") for (int m = 0; m < 4; ++m) _Pragma("unroll") for (int n = 0; n < 2; ++n) _Pragma("unroll") for (int k = 0; k < 2; ++k) \
        acc[ai][bj][m][n] = __builtin_amdgcn_mfma_f32_16x16x32_bf16(Bt[n][k], At[m][k], acc[ai][bj][m][n], 0, 0, 0); __builtin_amdgcn_s_setprio(0); } while (0)
#define PG8_WAIT_V(n) asm volatile("s_waitcnt vmcnt(" #n ")" ::: "memory")
#define PG8_WAIT_L(n) asm volatile("s_waitcnt lgkmcnt(" #n ")" ::: "memory")
#define PG8_BAR __builtin_amdgcn_s_barrier()
#define PG8_SCHED __builtin_amdgcn_sched_barrier(0)
  Unit cur, nxt; int ui = 0;
  if (!SO.next(0, cur)) return;
  f32x4 acc[2][2][4][2];
#pragma unroll
  for (int a = 0; a < 2; ++a)
#pragma unroll
    for (int b = 0; b < 2; ++b)
#pragma unroll
      for (int m = 0; m < 4; ++m)
#pragma unroll
        for (int n = 0; n < 2; ++n) acc[a][b][m][n] = (f32x4){0.f, 0.f, 0.f, 0.f};
  bf16x8 At[4][2], B0[2][2], B1[2][2];
  const char* cA = (const char*)Aptr + AMap::tile_row0(cur.pm) * (long)rowB; const char* cB = (const char*)Btptr + (size_t)cur.pn * tstepB;
  PG8_STAGE(PG8_SB(0, 0), cB, voffB); PG8_STAGE(PG8_SA(0, 0), cA, voffA); PG8_STAGE(PG8_SB(0, 1), cB + hstepB, voffB); PG8_STAGE(PG8_SA(0, 1), cA + hstepA, voffA);
  if (wr == 1) PG8_BAR;
  PG8_WAIT_V(4); PG8_BAR;
  PG8_STAGE(PG8_SB(1, 0), cB + kstep, voffB); PG8_STAGE(PG8_SA(1, 0), cA + kstep, voffA); PG8_STAGE(PG8_SB(1, 1), cB + hstepB + kstep, voffB);
  PG8_WAIT_V(6); PG8_BAR;
  for (;;) {
    const bool has_next = SO.next(ui + 1, nxt);
    const char* nA = has_next ? (const char*)Aptr + AMap::tile_row0(nxt.pm) * (long)rowB : cA; const char* nB = has_next ? (const char*)Btptr + (size_t)nxt.pn * tstepB : cB;
    for (int t = 0; t < nt; t += 2) {
      const bool last = (t == nt - 2);
      const char* a1 = cA + (size_t)(t + 1) * kstep;
      const char* a2 = last ? nA : cA + (size_t)(t + 2) * kstep; const char* b2 = last ? nB : cB + (size_t)(t + 2) * kstep;
      const char* a3 = a2 + kstep; const char* b3 = b2 + kstep;
      PG8_LDB(B0, 0, 0); PG8_SCHED; PG8_LDA(At, 0, 0); PG8_STAGE(PG8_SA(1, 1), a1 + hstepA, voffA);
      PG8_WAIT_L(8); PG8_BAR; PG8_WAIT_L(0); PG8_MMA(0, 0, At, B0); PG8_BAR; PG8_SCHED;
      PG8_LDB(B1, 0, 1); PG8_STAGE(PG8_SB(0, 0), b2, voffB);
      PG8_BAR; PG8_WAIT_L(0); PG8_MMA(0, 1, At, B1); PG8_BAR;
      PG8_LDA(At, 0, 1); PG8_STAGE(PG8_SA(0, 0), a2, voffA);
      PG8_BAR; PG8_WAIT_L(0); PG8_MMA(1, 0, At, B0); PG8_BAR; PG8_SCHED;
      PG8_STAGE(PG8_SB(0, 1), b2 + hstepB, voffB);
      PG8_WAIT_V(6); PG8_BAR; PG8_MMA(1, 1, At, B1); PG8_BAR;
      PG8_LDB(B0, 1, 0); PG8_SCHED; PG8_LDA(At, 1, 0); PG8_STAGE(PG8_SA(0, 1), a2 + hstepA, voffA);
      PG8_WAIT_L(8); PG8_BAR; PG8_WAIT_L(0); PG8_MMA(0, 0, At, B0); PG8_BAR; PG8_SCHED;
      PG8_LDB(B1, 1, 1); PG8_STAGE(PG8_SB(1, 0), b3, voffB);
      PG8_BAR; PG8_WAIT_L(0); PG8_MMA(0, 1, At, B1); PG8_BAR;
      PG8_LDA(At, 1, 1); PG8_STAGE(PG8_SA(1, 0), a3, voffA);
      PG8_BAR; PG8_WAIT_L(0); PG8_MMA(1, 0, At, B0); PG8_BAR; PG8_SCHED;
      PG8_STAGE(PG8_SB(1, 1), b3 + hstepB, voffB);
      PG8_WAIT_V(6); PG8_BAR; PG8_MMA(1, 1, At, B1); PG8_BAR;
    }
    E(acc, cur, wr, wc, fr, fq);
    if (!has_next) break;
#pragma unroll
    for (int a = 0; a < 2; ++a)
#pragma unroll
      for (int b = 0; b < 2; ++b)
#pragma unroll
        for (int m = 0; m < 4; ++m)
#pragma unroll
          for (int n = 0; n < 2; ++n) acc[a][b][m][n] = (f32x4){0.f, 0.f, 0.f, 0.f};
    cur = nxt; cA = nA; cB = nB; ++ui;
  }
  PG8_WAIT_V(0);
  if (wr == 0) PG8_BAR;
  PG8_BAR;
#undef PG8_SA
#undef PG8_SB
#undef PG8_STAGE
#undef PG8_LDA
#undef PG8_LDB
#undef PG8_MMA
#undef PG8_WAIT_V
#undef PG8_WAIT_L
#undef PG8_BAR
#undef PG8_SCHED
}
}

DI void sincos_big(float ang, float& sn, float& cs) {
  const float c_hi = 1.591549367e-01f, c_lo = 6.420638243e-09f;
  const float rh = ang * c_hi;
  const float e = __builtin_fmaf(ang, c_hi, -rh);
  const float fr = rh - floorf(rh);
  const float rev = fr + (e + ang * c_lo);
  sn = __builtin_amdgcn_sinf(rev);
  cs = __builtin_amdgcn_cosf(rev);
}

struct EpiProj {
  u16* proj; unsigned char* vt8;
  DI void operator()(const f32x4 (&acc)[2][2][4][2], const pg8::Unit& u, int wr, int wc, int fr, int fq) const {
    const f32x4 i16 = *(const f32x4*)(ROPE_INV16 + 4 * fq);
    const f32x4 i32v = *(const f32x4*)(ROPE_INV32 + 16 * (wc & 1) + 4 * fq);
#pragma unroll
    for (int bj = 0; bj < 2; ++bj) {
      const int gcol0 = u.pn * 256 + bj * 128 + wc * 32;
      int mode; float scale = 1.f;
      if (gcol0 < 256) { mode = 1; scale = QSCALE_DIFF; }
      else if (gcol0 < 512) { mode = 1; }
      else if (gcol0 < 768) { mode = 0; }
      else if (gcol0 < 1152) { mode = 2; scale = QSCALE_64; }
      else if (gcol0 < 1536) { mode = 2; }
      else if (gcol0 < 1920) { mode = 0; }
      else if (gcol0 < 2304) { mode = 0; scale = QSCALE_64; }
      else { mode = 0; }
      f32x4 invv;
#pragma unroll
      for (int e = 0; e < 4; ++e) invv[e] = (mode == 1) ? i16[e] : i32v[e];
      int c1, c2;
      if (mode == 2) { const int hb = gcol0 & ~63, g = wc & 1; c1 = hb + 16 * g + 4 * fq; c2 = c1 + 32; }
      else { c1 = gcol0 + 4 * fq; c2 = c1 + 16; }
#pragma unroll
      for (int ai = 0; ai < 2; ++ai)
#pragma unroll
        for (int m = 0; m < 4; ++m) {
          const int row = u.pm * 256 + ai * 128 + wr * 64 + m * 16 + fr;
          f32x4 x1 = acc[ai][bj][m][0], x2 = acc[ai][bj][m][1];
          if (mode != 0) {
            const float pos = (float)(row & (S - 1));
#pragma unroll
            for (int e = 0; e < 4; ++e) {
              const float ang = __fmul_rn(pos, invv[e]);
              float sn, cs; sincos_big(ang, sn, cs);
              const float y1 = x1[e] * cs - x2[e] * sn, y2 = x2[e] * cs + x1[e] * sn;
              x1[e] = y1; x2[e] = y2;
            }
          }
          u16* dp = proj + (size_t)row * NPROJ;
          *(uint2*)(dp + c1) = make_uint2(pack2(x1[0] * scale, x1[1] * scale), pack2(x1[2] * scale, x1[3] * scale));
          *(uint2*)(dp + c2) = make_uint2(pack2(x2[0] * scale, x2[1] * scale), pack2(x2[2] * scale, x2[3] * scale));
          if (gcol0 >= 512 && gcol0 < 768) {
            const int hd = (gcol0 - 512) >> 6, d0 = (gcol0 & 63) + 4 * fq;
            unsigned char* vp = vt8 + ((size_t)((row >> 14) * 4 + hd) * 64 + d0) * S + (row & (S - 1));
            const int w1a = __builtin_amdgcn_cvt_pk_fp8_f32(x1[0], x1[1], 0, false), w1b = __builtin_amdgcn_cvt_pk_fp8_f32(x1[2], x1[3], 0, false);
            const int w2a = __builtin_amdgcn_cvt_pk_fp8_f32(x2[0], x2[1], 0, false), w2b = __builtin_amdgcn_cvt_pk_fp8_f32(x2[2], x2[3], 0, false);
            vp[0] = (unsigned char)(w1a & 0xff); vp[(size_t)S] = (unsigned char)((w1a >> 8) & 0xff); vp[(size_t)2 * S] = (unsigned char)(w1b & 0xff); vp[(size_t)3 * S] = (unsigned char)((w1b >> 8) & 0xff);
            unsigned char* vq = vp + (size_t)16 * S;
            vq[0] = (unsigned char)(w2a & 0xff); vq[(size_t)S] = (unsigned char)((w2a >> 8) & 0xff); vq[(size_t)2 * S] = (unsigned char)(w2b & 0xff); vq[(size_t)3 * S] = (unsigned char)((w2b >> 8) & 0xff);
          }
        }
    }
  }
};

struct EpiResid {
  const float* xold; float* xnew; const float* gate;
  DI void operator()(const f32x4 (&acc)[2][2][4][2], const pg8::Unit& u, int wr, int wc, int fr, int fq) const {
    const int b = (u.pm * 256) >> 14;
    const int col0 = u.pn * 256 + wc * 32 + 4 * fq;
    f32x4 gv[2][2];
#pragma unroll
    for (int bj = 0; bj < 2; ++bj)
#pragma unroll
      for (int n = 0; n < 2; ++n) gv[bj][n] = *(const f32x4*)(gate + b * 6144 + col0 + bj * 128 + n * 16);
#pragma unroll
    for (int ai = 0; ai < 2; ++ai)
#pragma unroll
      for (int m = 0; m < 4; ++m) {
        const size_t off = (size_t)(u.pm * 256 + ai * 128 + wr * 64 + m * 16 + fr) * 1024 + col0;
        f32x4 xo[2][2];
#pragma unroll
        for (int bj = 0; bj < 2; ++bj)
#pragma unroll
          for (int n = 0; n < 2; ++n) xo[bj][n] = *(const f32x4*)(xold + off + bj * 128 + n * 16);
#pragma unroll
        for (int bj = 0; bj < 2; ++bj)
#pragma unroll
          for (int n = 0; n < 2; ++n) *(f32x4*)(xnew + off + bj * 128 + n * 16) = xo[bj][n] + gv[bj][n] * acc[ai][bj][m][n];
        asm volatile("" ::: "memory");
      }
  }
};

DI float dpp_ror1(float v)  { return __builtin_bit_cast(float, __builtin_amdgcn_update_dpp(0, __builtin_bit_cast(int, v), 0x121, 0xf, 0xf, false)); }
DI float dpp_ror15(float v) { return __builtin_bit_cast(float, __builtin_amdgcn_update_dpp(0, __builtin_bit_cast(int, v), 0x12F, 0xf, 0xf, false)); }
struct EpiUp {
  u16* act; const float* cw; const float* cb;
  DI void operator()(const f32x4 (&acc)[2][2][4][2], const pg8::Unit& u, int wr, int wc, int fr, int fq) const {
    const int b = u.pm / 67, ti = u.pm % 67;
#pragma unroll
    for (int n = 0; n < 2; ++n) {
      const int col = u.pn * 128 + wc * 32 + n * 16 + 4 * fq;
      const f32x4 w0 = *(const f32x4*)(cw + col), w1 = *(const f32x4*)(cw + DFF + col), w2 = *(const f32x4*)(cw + 2 * DFF + col), bb = *(const f32x4*)(cb + col);
#pragma unroll
      for (int ai = 0; ai < 2; ++ai) {
        const int tokb = 248 * ti - 1 + 62 * (2 * ai + wr);
        f32x4 g[4];
        if (tokb >= 0 && tokb + 63 < S) {
#pragma unroll
          for (int m = 0; m < 4; ++m) g[m] = acc[ai][0][m][n];
        } else {
#pragma unroll
          for (int m = 0; m < 4; ++m) {
            const int tok = tokb + 16 * m + fr;
            const bool ok = (tok >= 0) && (tok < S);
#pragma unroll
            for (int e = 0; e < 4; ++e) g[m][e] = ok ? acc[ai][0][m][n][e] : 0.f;
          }
        }
#pragma unroll
        for (int m = 0; m < 4; ++m) {
          const int q = 16 * m + fr, tok = tokb + q;
          f32x4 r;
#pragma unroll
          for (int e = 0; e < 4; ++e) {
            const float srcm = (fr == 15 && m > 0) ? g[m > 0 ? m - 1 : 0][e] : g[m][e];
            const float srcp = (fr == 0 && m < 3) ? g[m < 3 ? m + 1 : 3][e] : g[m][e];
            const float gm = dpp_ror1(srcm), gp = dpp_ror15(srcp);
            const float cv = bb[e] + w0[e] * gm + w1[e] * g[m][e] + w2[e] * gp;
            r[e] = cv * __builtin_amdgcn_rcpf(1.f + exp2_hw(-LOG2E * cv)) * acc[ai][1][m][n][e];
          }
          if (q >= 1 && q <= 62 && tok < S)
            *(uint2*)(act + (size_t)(b * S + tok) * DFF + col) = make_uint2(pack2(r[0], r[1]), pack2(r[2], r[3]));
        }
      }
    }
  }
};

constexpr int VROW = 96;
constexpr int VT_WAVE = 64 * VROW;
DI bf16x8 v_frag_tr(const u16* Vb, int kb0, int mb, int sp, int lane) {
  const int i16 = lane & 15, q = i16 >> 2, pp = i16 & 3, blk = (lane >> 4) & 1, hh = lane >> 5;
  const u16* a0 = Vb + (kb0 + 16 * sp + 4 * hh + q) * VROW + (mb * 2 + blk) * 16 + 4 * pp;
  const s16x4 lo = __builtin_amdgcn_ds_read_tr16_b64_v4i16((LAS s16x4*)a0);
  const s16x4 hi = __builtin_amdgcn_ds_read_tr16_b64_v4i16((LAS s16x4*)(a0 + 8 * VROW));
  return __builtin_shufflevector(lo, hi, 0, 1, 2, 3, 4, 5, 6, 7);
}

DI void local_softmax_step(float (&sv)[2][16], float& m_run, float& l_run, f32x16 (&O)[2], bf16x8 (&pk)[2][2]) {
  float tmax = NEGBIG;
#pragma unroll
  for (int h2 = 0; h2 < 2; ++h2)
#pragma unroll
    for (int i = 0; i < 16; ++i) tmax = fmaxf(tmax, sv[h2][i]);
  tmax = fmaxf(tmax, __shfl_xor(tmax, 32));
  const float m_new = fmaxf(m_run, tmax);
  if (__builtin_amdgcn_ballot_w64(m_new > m_run) != 0ull) {
    const float alpha = exp2_hw(m_run - m_new);
    m_run = m_new; l_run *= alpha;
#pragma unroll
    for (int mb = 0; mb < 2; ++mb)
#pragma unroll
      for (int i = 0; i < 16; ++i) O[mb][i] *= alpha;
  }
#pragma unroll
  for (int h2 = 0; h2 < 2; ++h2)
#pragma unroll
    for (int sp = 0; sp < 2; ++sp) {
      unsigned q4[4];
#pragma unroll
      for (int q = 0; q < 4; ++q) {
        const float s0 = sv[h2][8 * sp + 2 * q], s1 = sv[h2][8 * sp + 2 * q + 1];
        const float p0 = exp2_hw(s0 - m_run), p1 = exp2_hw(s1 - m_run);
        l_run += p0; l_run += p1;
        q4[q] = pack2(p0, p1);
      }
      pk[h2][sp] = __builtin_bit_cast(bf16x8, make_uint4(q4[0], q4[1], q4[2], q4[3]));
    }
}
DI void local_store_out(const f32x16 (&O)[2], float l_run, u16* op, int hh) {
  const float l = l_run + __shfl_xor(l_run, 32);
  const float il = 1.f / l;
#pragma unroll
  for (int mb = 0; mb < 2; ++mb)
#pragma unroll
    for (int g = 0; g < 4; ++g) {
      const int d = mb * 32 + 8 * g + 4 * hh;
      *(uint2*)(op + d) = make_uint2(pack2(O[mb][4 * g] * il, O[mb][4 * g + 1] * il), pack2(O[mb][4 * g + 2] * il, O[mb][4 * g + 3] * il));
    }
}

constexpr int KS_STRIDE = 72;
constexpr int KS_BUF = 64 * KS_STRIDE, VS_BUF = 64 * VROW;
DI void swin_attn_item(KP p, int item, u16* sm) {
  const int tid = otid(), lane = tid & 63, w = __builtin_amdgcn_readfirstlane(tid >> 6), r = lane & 31, hh = lane >> 5;
  u16* Ks = sm; u16* Vs = sm + 2 * KS_BUF;
  const int bhp = item >> 6, sub = item & 63;
  const int pat = bhp % 3, bh = bhp / 3, head = bh % 6, b = bh / 6;
  const int sh = 2 * pat, L = S >> sh;
  const int cls = sub >> (6 - sh), pb = sub & ((64 >> sh) - 1);
  const int P = pb * 256;
  const int qp = P + 32 * w + r, tq = cls + (qp << sh);
  const u16* prow = p.proj + (size_t)b * S * NPROJ;
  bf16x8 qf[4];
#pragma unroll
  for (int s = 0; s < 4; ++s) qf[s] = *(const bf16x8*)(prow + (size_t)tq * NPROJ + 768 + head * 64 + s * 16 + 8 * hh);
  f32x16 O[2];
#pragma unroll
  for (int mb = 0; mb < 2; ++mb)
#pragma unroll
    for (int i = 0; i < 16; ++i) O[mb][i] = 0.f;
  float m_run = -1e20f, l_run = 0.f;
  const int key0 = tid >> 3, ch = tid & 7;
  const u16* kg = prow + 1152 + head * 64 + ch * 8;
  auto gk = [&](int j) __attribute__((always_inline)) -> const u16* {
    int kp = P - 64 + 64 * j + key0; kp = kp < 0 ? 0 : (kp > L - 1 ? L - 1 : kp);
    return kg + (size_t)(cls + (kp << sh)) * NPROJ;
  };
  const uint4 k0 = *(const uint4*)gk(0), v0 = *(const uint4*)(gk(0) + 384), k1 = *(const uint4*)gk(1), v1 = *(const uint4*)(gk(1) + 384);
  const uint4 k2 = *(const uint4*)gk(2), v2 = *(const uint4*)(gk(2) + 384), k3 = *(const uint4*)gk(3), v3 = *(const uint4*)(gk(3) + 384);
  const uint4 k4 = *(const uint4*)gk(4), v4 = *(const uint4*)(gk(4) + 384), k5 = *(const uint4*)gk(5), v5 = *(const uint4*)(gk(5) + 384);
  auto lstore = [&](int buf, const uint4& kr, const uint4& vr) __attribute__((always_inline)) {
    *(uint4*)(Ks + buf * KS_BUF + key0 * KS_STRIDE + ch * 8) = kr;
    *(uint4*)(Vs + buf * VS_BUF + key0 * VROW + ch * 8) = vr;
  };
  lstore(0, k0, v0);
  __syncthreads();
  const int jlo = w >> 1;
#pragma unroll
  for (int j = 0; j < 6; ++j) {
    const int buf = j & 1;
    if (j >= jlo && j <= jlo + 2) {
      f32x16 Sc[2];
#pragma unroll
      for (int i = 0; i < 16; ++i) { Sc[0][i] = 0.f; Sc[1][i] = 0.f; }
#pragma unroll
      for (int s = 0; s < 4; ++s)
#pragma unroll
        for (int h2 = 0; h2 < 2; ++h2) {
          const bf16x8 kf = *(const bf16x8*)(Ks + buf * KS_BUF + (h2 * 32 + r) * KS_STRIDE + s * 16 + 8 * hh);
          Sc[h2] = MFMA32(kf, qf[s], Sc[h2]);
        }
      const int dbase = (64 * j - 32 * w) + 4 * hh - r;
      const int kbase = P - 64 + 64 * j + 4 * hh;
      float sv[2][16];
#pragma unroll
      for (int h2 = 0; h2 < 2; ++h2)
#pragma unroll
        for (int i = 0; i < 16; ++i) {
          const int c = h2 * 32 + (i & 3) + 8 * (i >> 2);
          const bool valid = ((unsigned)(dbase + c) <= 128u) && ((unsigned)(kbase + c) < (unsigned)L);
          sv[h2][i] = valid ? Sc[h2][i] : NEGBIG;
        }
      bf16x8 pk[2][2];
      local_softmax_step(sv, m_run, l_run, O, pk);
#pragma unroll
      for (int h2 = 0; h2 < 2; ++h2)
#pragma unroll
        for (int sp = 0; sp < 2; ++sp)
#pragma unroll
          for (int mb = 0; mb < 2; ++mb) {
            const bf16x8 vf = v_frag_tr(Vs + buf * VS_BUF, h2 * 32, mb, sp, lane);
            O[mb] = MFMA32(vf, pk[h2][sp], O[mb]);
          }
    }
    if (j == 0) lstore(1, k1, v1);
    if (j == 1) lstore(0, k2, v2);
    if (j == 2) lstore(1, k3, v3);
    if (j == 3) lstore(0, k4, v4);
    if (j == 4) lstore(1, k5, v5);
    __syncthreads();
  }
  const size_t orow = (size_t)pat * NTOK + (size_t)b * S + tq;
  const float l = l_run + __shfl_xor(l_run, 32);
  if (hh == 0) p.lse[orow * 6 + head] = m_run + __log2f(l);
  local_store_out(O, l_run, p.odil + orow * 384 + head * 64, hh);
}

DI void combine_dil(KP p) {
  const int tid = otid();
  for (int tc = blockIdx.x; tc < 256; tc += gridDim.x) {
#pragma unroll 1
    for (int idx = tid; idx < 128 * 48; idx += NTHR) {
      const int tok = tc * 128 + idx / 48, c8 = idx % 48, head = c8 >> 3;
      float ls[3], wgt[3];
#pragma unroll
      for (int q = 0; q < 3; ++q) ls[q] = p.lse[((size_t)q * NTOK + tok) * 6 + head];
      const float mx = fmaxf(ls[0], fmaxf(ls[1], ls[2]));
      float sum = 0.f;
#pragma unroll
      for (int q = 0; q < 3; ++q) { wgt[q] = exp2_hw(ls[q] - mx); sum += wgt[q]; }
      const float isum = 1.f / sum;
      float acc[8];
#pragma unroll
      for (int e = 0; e < 8; ++e) acc[e] = 0.f;
#pragma unroll
      for (int q = 0; q < 3; ++q) {
        const uint4 v = *(const uint4*)(p.odil + ((size_t)q * NTOK + tok) * 384 + c8 * 8);
        const float wq = wgt[q] * isum;
        acc[0] += wq * bflo(v.x); acc[1] += wq * bfhi(v.x); acc[2] += wq * bflo(v.y); acc[3] += wq * bfhi(v.y);
        acc[4] += wq * bflo(v.z); acc[5] += wq * bfhi(v.z); acc[6] += wq * bflo(v.w); acc[7] += wq * bfhi(v.w);
      }
      *(uint4*)(p.o + (size_t)tok * 1024 + 256 + c8 * 8) = make_uint4(pack2(acc[0], acc[1]), pack2(acc[2], acc[3]), pack2(acc[4], acc[5]), pack2(acc[6], acc[7]));
    }
  }
}

constexpr int RPB_PAD = 48, RPB_LDS = 15 * 31 + 2 * RPB_PAD;
DI void na_attn_item(KP p, int layer, int item, u16* sm) {
  const int tid = otid(), lane = tid & 63, w = __builtin_amdgcn_readfirstlane(tid >> 6), r = lane & 31, hh = lane >> 5;
  u16* Ks = sm; u16* Vs = sm + 2 * KS_BUF;
  const int b = item / (6 * 64), rem = item % (6 * 64), head = rem / 64, g = rem % 64;
  const int rr = 4 * g + (w >> 1), half = w & 1;
  const int tq = rr * 64 + half * 32 + r, qc = half * 32 + r;
  auto rstart = [](int x) { int v = x - 4; return v < 0 ? 0 : (v > 248 ? 248 : v); };
  const int my_rs = rstart(rr), rs_lo = rstart(4 * g), rs_hi = rstart(4 * g + 3) + 7;
  const u16* prow = p.proj + (size_t)b * S * NPROJ;
  const float* rpb = p.na_rpb + ((size_t)layer * 6 + head) * 15 * 31;
  bf16x8 qf[4];
#pragma unroll
  for (int s = 0; s < 4; ++s) qf[s] = *(const bf16x8*)(prow + (size_t)tq * NPROJ + 1920 + head * 64 + s * 16 + 8 * hh);
  int cs = qc - 8; cs = cs < 0 ? 0 : (cs > 48 ? 48 : cs);
  float* rtab = (float*)(sm + 2 * KS_BUF + 2 * VS_BUF);
  for (int i = tid; i < RPB_LDS; i += NTHR) { const int j = i - RPB_PAD; rtab[i] = (j >= 0 && j < 15 * 31) ? rpb[j] * LOG2E : 0.f; }
  const int vbase = 4 * hh - cs;
  f32x16 O[2];
#pragma unroll
  for (int mb = 0; mb < 2; ++mb)
#pragma unroll
    for (int i = 0; i < 16; ++i) O[mb][i] = 0.f;
  float m_run = -1e20f, l_run = 0.f;
  uint4 kr, vr, kr2, vr2, kr3, vr3;
  const int key0 = tid >> 3, ch = tid & 7;
  const u16* kg = prow + (size_t)key0 * NPROJ + 2304 + head * 64 + ch * 8;
  auto gload = [&](int krow, uint4& kd, uint4& vd) __attribute__((always_inline)) {
    const u16* src = kg + (size_t)((krow > 255 ? 255 : krow) * 64) * NPROJ;
    kd = *(const uint4*)src; vd = *(const uint4*)(src + 384);
  };
  auto lstore = [&](int buf) __attribute__((always_inline)) {
    *(uint4*)(Ks + buf * KS_BUF + key0 * KS_STRIDE + ch * 8) = kr;
    *(uint4*)(Vs + buf * VS_BUF + key0 * VROW + ch * 8) = vr;
  };
  gload(rs_lo, kr, vr); lstore(0);
  gload(rs_lo + 1, kr, vr); gload(rs_lo + 2, kr2, vr2);
  __syncthreads();
  for (int krow = rs_lo; krow <= rs_hi; ++krow) {
    const int buf = (krow - rs_lo) & 1;
    gload(krow + 3, kr3, vr3);
    if (krow >= my_rs && krow < my_rs + 8) {
      f32x16 Sc[2];
#pragma unroll
      for (int i = 0; i < 16; ++i) { Sc[0][i] = 0.f; Sc[1][i] = 0.f; }
#pragma unroll
      for (int s = 0; s < 4; ++s)
#pragma unroll
        for (int h2 = 0; h2 < 2; ++h2) {
          const bf16x8 kf = *(const bf16x8*)(Ks + buf * KS_BUF + (h2 * 32 + r) * KS_STRIDE + s * 16 + 8 * hh);
          Sc[h2] = MFMA32(kf, qf[s], Sc[h2]);
        }
      const float* rowp = rtab + RPB_PAD + (krow - rr + 7) * 31 + 15 + 4 * hh - qc;
      float sv[2][16];
#pragma unroll
      for (int h2 = 0; h2 < 2; ++h2)
#pragma unroll
        for (int i = 0; i < 16; ++i) {
          const int c = h2 * 32 + (i & 3) + 8 * (i >> 2);
          const bool valid = (unsigned)(vbase + c) < 16u;
          sv[h2][i] = valid ? (Sc[h2][i] + rowp[c]) : NEGBIG;
        }
      bf16x8 pk[2][2];
      local_softmax_step(sv, m_run, l_run, O, pk);
#pragma unroll
      for (int h2 = 0; h2 < 2; ++h2)
#pragma unroll
        for (int sp = 0; sp < 2; ++sp)
#pragma unroll
          for (int mb = 0; mb < 2; ++mb) {
            const bf16x8 vf = v_frag_tr(Vs + buf * VS_BUF, h2 * 32, mb, sp, lane);
            O[mb] = MFMA32(vf, pk[h2][sp], O[mb]);
          }
    }
    lstore(buf ^ 1);
    kr = kr2; vr = vr2; kr2 = kr3; vr2 = vr3;
    __syncthreads();
  }
  local_store_out(O, l_run, p.o + (size_t)(b * S + tq) * 1024 + 640 + head * 64, hh);
}

DI void kmax_item(KP p, int layer, int kidx) {
  const int tid = otid(); const int gid = kidx * NTHR + tid;
  const int row = gid >> 2, head = gid & 3, b = row >> 14;
  const uint4* kp = (const uint4*)(p.proj + (size_t)row * NPROJ + 256 + head * 64);
  float n0 = 0.f, n1 = 0.f;
#pragma unroll
  for (int c = 0; c < 8; ++c) {
    const uint4 v = kp[c];
    const unsigned e[4] = {v.x, v.y, v.z, v.w};
    float s = 0.f;
#pragma unroll
    for (int q = 0; q < 4; ++q) { const float a = bflo(e[q]), bq = bfhi(e[q]); s += a * a + bq * bq; }
    if (c >= 4) n1 += s; else n0 += s;
  }
#pragma unroll
  for (int o = 4; o <= 32; o <<= 1) { n0 = fmaxf(n0, __shfl_xor(n0, o)); n1 = fmaxf(n1, __shfl_xor(n1, o)); }
  if ((tid & 63) < 4) {
    unsigned* km = p.kmax + layer * 16 + (b * 4 + head) * 2;
    atomicMax(km, __float_as_uint(n0)); atomicMax(km + 1, __float_as_uint(n1));
  }
}

DI void phase_local(KP p, int layer, u16* sm) {
  constexpr int N_DIL = 2304, N_NA = 768, N_KM = 256;
  for (int it = blockIdx.x; it < N_DIL + N_NA + N_KM; it += gridDim.x) {
    __syncthreads();
    if (it < N_DIL) swin_attn_item(p, it, sm);
    else if (it < N_DIL + N_NA) na_attn_item(p, layer, it - N_DIL, sm);
    else kmax_item(p, layer, it - N_DIL - N_NA);
  }
}

constexpr int VL_STRIDE = 80;
constexpr int VL_BUF = 64 * VL_STRIDE;
DI void phase_diff(KP p, int layer, u16* sm) {
  combine_dil(p);
  const int tid = otid(), lane = tid & 63, w = __builtin_amdgcn_readfirstlane(tid >> 6), r = lane & 31, hh = lane >> 5;
  u16* Ks = sm; unsigned char* Vl = (unsigned char*)(sm + 2 * KS_BUF);
  float lam;
  {
    const float* dl = p.diff_lambda + layer * 128;
    float a = 0.f, c2 = 0.f;
    if (lane < 32) { a = dl[lane] * dl[32 + lane]; c2 = dl[64 + lane] * dl[96 + lane]; }
    a = wave_sum(a); c2 = wave_sum(c2);
    lam = __expf(a) - __expf(c2) + p.lam_init[layer];
  }
  const float lam_init = p.lam_init[layer];
  const float* sg = p.diff_subln + layer * 64;
  for (int it = blockIdx.x; it < 512; it += gridDim.x) {
    const int bh = it >> 6, qb = it & 63, b = bh >> 2, head = bh & 3;
    const u16* prow = p.proj + (size_t)b * S * NPROJ;
    const int tq = qb * 256 + w * 32 + r;
    bf16x8 qf[2][2];
    float qn[2];
#pragma unroll
    for (int m = 0; m < 2; ++m) {
      qn[m] = 0.f;
#pragma unroll
      for (int s = 0; s < 2; ++s) {
        qf[m][s] = *(const bf16x8*)(prow + (size_t)tq * NPROJ + head * 64 + m * 32 + s * 16 + 8 * hh);
#pragma unroll
        for (int j = 0; j < 8; ++j) { const float v = bf2f((u16)qf[m][s][j]); qn[m] += v * v; }
      }
      qn[m] += __shfl_xor(qn[m], 32);
    }
    float mbnd[2];
#pragma unroll
    for (int m = 0; m < 2; ++m) {
      const float km = __uint_as_float(p.kmax[layer * 16 + bh * 2 + m]);
      mbnd[m] = fmaxf(sqrtf(qn[m] * km) - 15.f, 0.f);
    }
    const bool noshift = __builtin_amdgcn_ballot_w64(mbnd[0] == 0.f && mbnd[1] == 0.f) == ~0ull;
    f32x16 O[2][2];
#pragma unroll
    for (int m = 0; m < 2; ++m)
#pragma unroll
      for (int mb = 0; mb < 2; ++mb)
#pragma unroll
        for (int i = 0; i < 16; ++i) O[m][mb][i] = 0.f;
    f32x16 L[2];
#pragma unroll
    for (int m = 0; m < 2; ++m)
#pragma unroll
      for (int i = 0; i < 16; ++i) L[m][i] = 0.f;
    v8i_t ones8;
#pragma unroll
    for (int v = 0; v < 8; ++v) ones8[v] = 0x38383838;
    uint4 kr, kr2, kr3; uint2 vr, vr2, vr3;
    const int key0 = tid >> 3, ch = tid & 7;
    const u16* kg = prow + (size_t)key0 * NPROJ + 256 + head * 64 + ch * 8;
    const unsigned char* vg = p.vt8 + ((size_t)bh * 64 + key0) * S + ch * 8;
    auto gload = [&](int kt, uint4& kd, uint2& vd) __attribute__((always_inline)) {
      kd = *(const uint4*)(kg + (size_t)((kt & 255) * 64) * NPROJ);
      vd = *(const uint2*)(vg + (kt & 255) * 64);
    };
    auto lstore = [&](int buf) __attribute__((always_inline)) {
      *(uint4*)(Ks + buf * KS_BUF + key0 * KS_STRIDE + ch * 8) = kr;
      unsigned char* vd = Vl + buf * VL_BUF + key0 * VL_STRIDE + 4 * ch;
      *(unsigned*)vd = vr.x; *(unsigned*)(vd + 32) = vr.y;
    };
    gload(0, kr, vr); lstore(0);
    gload(1, kr, vr); gload(2, kr2, vr2);
    __syncthreads();
    if (w >= 4) __builtin_amdgcn_s_setprio(1);
    auto tile_loop = [&](auto shifted) __attribute__((always_inline)) {
      constexpr bool SH = decltype(shifted)::value;
      for (int kt = 0; kt < 256; ++kt) {
        const int buf = kt & 1;
        gload(kt + 3, kr3, vr3);
        f32x16 Sc[2][2];
#pragma unroll
        for (int sub = 0; sub < 2; ++sub)
#pragma unroll
          for (int m = 0; m < 2; ++m) {
#pragma unroll
            for (int i = 0; i < 16; ++i) Sc[sub][m][i] = 0.f;
#pragma unroll
            for (int s = 0; s < 2; ++s) {
              const bf16x8 kf = *(const bf16x8*)(Ks + buf * KS_BUF + (sub * 32 + r) * KS_STRIDE + m * 32 + s * 16 + 8 * hh);
              Sc[sub][m] = MFMA32(kf, qf[m][s], Sc[sub][m]);
            }
          }
        v8i_t pf[2];
#pragma unroll
        for (int sub = 0; sub < 2; ++sub)
#pragma unroll
          for (int m = 0; m < 2; ++m)
#pragma unroll
            for (int g = 0; g < 4; ++g) {
              float pv[4];
#pragma unroll
              for (int e = 0; e < 4; ++e) pv[e] = exp2_hw(SH ? (Sc[sub][m][4 * g + e] - mbnd[m]) : Sc[sub][m][4 * g + e]);
              int wd = __builtin_amdgcn_cvt_pk_bf8_f32(pv[0], pv[1], 0, false);
              wd = __builtin_amdgcn_cvt_pk_bf8_f32(pv[2], pv[3], wd, true);
              pf[m][4 * sub + g] = wd;
            }
#pragma unroll
        for (int mb = 0; mb < 2; ++mb) {
          const v8i_t vf = *(const v8i_t*)(Vl + buf * VL_BUF + (mb * 32 + r) * VL_STRIDE + 32 * hh);
          O[0][mb] = __builtin_amdgcn_mfma_scale_f32_32x32x64_f8f6f4(vf, pf[0], O[0][mb], 0, 1, 0, 0x7F7F7F7F, 0, 0x7F7F7F7F);
          O[1][mb] = __builtin_amdgcn_mfma_scale_f32_32x32x64_f8f6f4(vf, pf[1], O[1][mb], 0, 1, 0, 0x7F7F7F7F, 0, 0x7F7F7F7F);
        }
        L[0] = __builtin_amdgcn_mfma_scale_f32_32x32x64_f8f6f4(ones8, pf[0], L[0], 0, 1, 0, 0x7F7F7F7F, 0, 0x7F7F7F7F);
        L[1] = __builtin_amdgcn_mfma_scale_f32_32x32x64_f8f6f4(ones8, pf[1], L[1], 0, 1, 0, 0x7F7F7F7F, 0, 0x7F7F7F7F);
        lstore(buf ^ 1);
        kr = kr2; vr = vr2; kr2 = kr3; vr2 = vr3;
        __syncthreads();
      }
    };
    if (noshift) tile_loop(std::false_type{}); else tile_loop(std::true_type{});
    __builtin_amdgcn_s_setprio(0);
    const float l0 = L[0][0], l1 = L[1][0];
    const float i0 = 1.f / l0, i1 = lam / l1;
    float ss = 0.f;
#pragma unroll
    for (int mb = 0; mb < 2; ++mb)
#pragma unroll
      for (int i = 0; i < 16; ++i) { const float v = O[0][mb][i] * i0 - O[1][mb][i] * i1; O[0][mb][i] = v; ss += v * v; }
    ss += __shfl_xor(ss, 32);
    const float inv = rsqrtf(ss * (1.f / 64.f) + 1e-6f) * (1.f - lam_init);
    u16* op = p.o + (size_t)(b * S + tq) * 1024 + head * 64;
#pragma unroll
    for (int mb = 0; mb < 2; ++mb)
#pragma unroll
      for (int g = 0; g < 4; ++g) {
        const int d = mb * 32 + 8 * g + 4 * hh;
        const float4 g4 = *(const float4*)(sg + d);
        *(uint2*)(op + d) = make_uint2(pack2(O[0][mb][4 * g] * inv * g4.x, O[0][mb][4 * g + 1] * inv * g4.y),
                                       pack2(O[0][mb][4 * g + 2] * inv * g4.z, O[0][mb][4 * g + 3] * inv * g4.w));
      }
  }
}

DI void phase_proj(KP p, int layer, LAS unsigned char* lds) {
  pg8::StaticOrder so; so.init(128, 12, gridDim.x, blockIdx.x);
  EpiProj e; e.proj = p.proj; e.vt8 = p.vt8;
  pg8::gemm_phase<pg8::AMapPlain>(lds, p.h, p.wt_in + (size_t)layer * 3072 * 1024, 1024, so, e);
}
DI void phase_resid(const u16* A, int K, const u16* Bt, const float* xold, float* xnew, const float* gate, LAS unsigned char* lds) {
  pg8::StaticOrder so; so.init(128, 4, gridDim.x, blockIdx.x);
  EpiResid e; e.xold = xold; e.xnew = xnew; e.gate = gate;
  pg8::gemm_phase<pg8::AMapPlain>(lds, A, Bt, K, so, e);
}
DI void phase_up(KP p, int layer, LAS unsigned char* lds) {
  pg8::StaticOrder so; so.init(134, 22, gridDim.x, blockIdx.x);
  EpiUp e; e.act = p.act; e.cw = p.conv_w + (size_t)layer * 3 * DFF; e.cb = p.conv_b + (size_t)layer * DFF;
  pg8::gemm_phase<pg8::AMapHalo>(lds, p.h, p.wt_up + (size_t)layer * 5632 * 1024, 1024, so, e);
}

constexpr int N_PHASES = 18;

DI void run_phase(KP p, int ph, unsigned char* smraw) {
  u16* sm = (u16*)smraw;
  LAS unsigned char* lds = (LAS unsigned char*)smraw;
  if (ph == 0) { phase_prep(p, (float*)smraw); return; }
  if (ph == 17) { phase_norm<1>(p.out, p.g_final, nullptr, 0, 0, nullptr, p.out); return; }
  const int layer = (ph - 1) >> 3, sub = (ph - 1) & 7;
  const float* modl = p.mod + layer * 2 * 6144;
  const float* xcur = (layer == 0) ? p.x : p.out;
  switch (sub) {
    case 0: phase_norm<0>(xcur, p.g_attn + layer * 1024, modl, 0, 1024, p.h, nullptr); break;
    case 1: phase_proj(p, layer, lds); break;
    case 2: phase_local(p, layer, sm); break;
    case 3: phase_diff(p, layer, sm); break;
    case 4: phase_resid(p.o, 1024, p.wt_out + (size_t)layer * 1024 * 1024, xcur, p.out, modl + 2048, lds); break;
    case 5: phase_norm<0>(p.out, p.g_ffn + layer * 1024, modl, 3072, 4096, p.h, nullptr); break;
    case 6: phase_up(p, layer, lds); break;
    case 7: phase_resid(p.act, DFF, p.wt_down + (size_t)layer * 1024 * DFF, p.out, p.out, modl + 5120, lds); break;
  }
}

__global__ void __launch_bounds__(NTHR, 2) mega_kernel(Params p) {
  extern __shared__ __attribute__((aligned(16))) unsigned char smraw[];
#if COOP
  cg::grid_group grid = cg::this_grid();
  u16* sm = (u16*)smraw;
  LAS unsigned char* lds = (LAS unsigned char*)smraw;
  if (threadIdx.x == 0) *(uint4*)(smraw + LDS_BYTES) = make_uint4(0u, 0u, 0u, 0u);
  __syncthreads();
  const XcdBarrier xb = xcd_barrier_post(kp_fresh()->bar, (volatile LAS unsigned*)(smraw + LDS_BYTES));
  phase_prep(*kp_fresh(), (float*)smraw);
  grid.sync();
#pragma unroll 1
  for (int layer = 0; layer < 2; ++layer) {
    { KP q = *kp_fresh(); phase_norm<0>((layer == 0) ? q.x : q.out, q.g_attn + layer * 1024, q.mod + layer * 2 * 6144, 0, 1024, q.h, nullptr); } xcd_barrier(xb);
    phase_proj(*kp_fresh(), layer, lds); xcd_barrier(xb);
    phase_local(*kp_fresh(), layer, sm); xcd_barrier(xb);
    phase_diff(*kp_fresh(), layer, sm); xcd_barrier(xb);
    { KP q = *kp_fresh(); phase_resid(q.o, 1024, q.wt_out + (size_t)layer * 1024 * 1024, (layer == 0) ? q.x : q.out, q.out, q.mod + layer * 2 * 6144 + 2048, lds); } xcd_barrier(xb);
    { KP q = *kp_fresh(); phase_norm<0>(q.out, q.g_ffn + layer * 1024, q.mod + layer * 2 * 6144, 3072, 4096, q.h, nullptr); } xcd_barrier(xb);
    phase_up(*kp_fresh(), layer, lds); xcd_barrier(xb);
    { KP q = *kp_fresh(); phase_resid(q.act, DFF, q.wt_down + (size_t)layer * 1024 * DFF, q.out, q.out, q.mod + layer * 2 * 6144 + 5120, lds); } xcd_barrier(xb);
  }
  { KP q = *kp_fresh(); phase_norm<1>(q.out, q.g_final, nullptr, 0, 0, nullptr, q.out); }
#else
  { KP q = *kp_fresh(); for (int ph = q.ph_lo; ph < q.ph_hi; ++ph) run_phase(q, ph, smraw); }
#endif
}

extern "C" void kernel_launch(void* const* d_in, const int* in_sizes, int n_in, void* d_out, int out_size, void* d_ws, size_t ws_size, hipStream_t stream) {
  (void)in_sizes; (void)n_in; (void)out_size;
  Params p;
  memset(&p, 0, sizeof(p));
  p.x = (const float*)d_in[0]; p.c = (const float*)d_in[1]; p.w_ada = (const float*)d_in[2]; p.b_ada = (const float*)d_in[3];
  p.g_attn = (const float*)d_in[4]; p.w_in = (const float*)d_in[5]; p.diff_lambda = (const float*)d_in[6]; p.diff_subln = (const float*)d_in[7];
  p.na_rpb = (const float*)d_in[8]; p.w_out = (const float*)d_in[9]; p.g_ffn = (const float*)d_in[10]; p.w_up = (const float*)d_in[11];
  p.conv_w = (const float*)d_in[12]; p.conv_b = (const float*)d_in[13]; p.w_down = (const float*)d_in[14]; p.g_final = (const float*)d_in[15];
  p.out = (float*)d_out;
  char* ws = (char*)d_ws; size_t off = 0;
  auto take = [&](size_t bytes) { char* q = ws + off; off += (bytes + 255) & ~(size_t)255; return q; };
  p.wt_in = (u16*)take((size_t)2 * 3072 * 1024 * 2);
  p.wt_out = (u16*)take((size_t)2 * 1024 * 1024 * 2);
  p.wt_up = (u16*)take((size_t)2 * 5632 * 1024 * 2);
  p.wt_down = (u16*)take((size_t)2 * 1024 * 2816 * 2);
  p.mod = (float*)take((size_t)2 * 2 * 6144 * 4);
  p.kmax = (unsigned*)take(256);
  p.bar = (unsigned*)take((size_t)XCD_BAR_WORDS * 4);
  (void)take(4096);
  p.h = (u16*)take((size_t)NTOK * 1024 * 2);
  p.o = (u16*)take((size_t)NTOK * 1024 * 2);
  p.proj = (u16*)take((size_t)NTOK * NPROJ * 2);
  p.odil = (u16*)take((size_t)3 * NTOK * 384 * 2);
  p.lse = (float*)take((size_t)3 * NTOK * 6 * 4);
  p.vt8 = (unsigned char*)take((size_t)2 * 4 * 64 * S);
  p.act = p.proj;
  if (off > ws_size) { fprintf(stderr, "workspace too small: need %zu have %zu\n", off, ws_size); return; }
  p.lam_init[0] = 0.2f; p.lam_init[1] = 0.35550906759096934f;
  static int grid_blocks = 0;
  if (!grid_blocks) {
    int dev = 0, cus = 0, per_cu = 0;
    (void)hipGetDevice(&dev);
    (void)hipDeviceGetAttribute(&cus, hipDeviceAttributeMultiprocessorCount, dev);
    (void)hipFuncSetAttribute((const void*)mega_kernel, hipFuncAttributeMaxDynamicSharedMemorySize, LDS_BYTES + 16);
    (void)hipOccupancyMaxActiveBlocksPerMultiprocessor(&per_cu, mega_kernel, NTHR, LDS_BYTES + 16);
    if (per_cu > 1) per_cu = 1;
    if (per_cu < 1) per_cu = 1;
    grid_blocks = cus * per_cu;
  }
#if COOP
  p.ph_lo = 0; p.ph_hi = N_PHASES;
  (void)hipMemsetAsync(p.bar, 0, (size_t)XCD_BAR_WORDS * 4, stream);
  void* args[] = {&p};
  hipError_t e = hipLaunchCooperativeKernel((void*)mega_kernel, dim3(grid_blocks), dim3(NTHR), args, LDS_BYTES + 16, stream);
  if (e != hipSuccess) fprintf(stderr, "cooperative launch failed: %s (grid %d)\n", hipGetErrorString(e), grid_blocks);
#else
  for (int ph = 0; ph < N_PHASES; ++ph) {
    p.ph_lo = ph; p.ph_hi = ph + 1;
    hipLaunchKernelGGL(mega_kernel, dim3(grid_blocks), dim3(NTHR), LDS_BYTES + 16, stream, p);
  }
#endif
}
```

```cpp
#include <hip/hip_runtime.h>
#include <hip/hip_cooperative_groups.h>
#include <cstdio>
#include <cstring>
#include <type_traits>
namespace cg = cooperative_groups;

#ifndef COOP
#define COOP 1
#endif

#define DI __device__ __forceinline__
#define LAS __attribute__((address_space(3)))
typedef unsigned short u16;
using bf16x8 = __attribute__((ext_vector_type(8))) short;
using s16x4  = __attribute__((ext_vector_type(4))) short;
using f32x16 = __attribute__((ext_vector_type(16))) float;
using f32x4  = __attribute__((ext_vector_type(4))) float;
typedef int v8i_t __attribute__((ext_vector_type(8)));
typedef __bf16 bf2_t __attribute__((ext_vector_type(2)));
typedef float f2_t __attribute__((ext_vector_type(2)));
#define MFMA32(a, b, c) __builtin_amdgcn_mfma_f32_32x32x16_bf16((a), (b), (c), 0, 0, 0)

constexpr int S = 16384, NTOK = 32768, DFF = 2816, NPROJ = 3072;
constexpr int NTHR = 512, NWAVE = 8;
constexpr float LOG2E = 1.4426950408889634f;
constexpr float QSCALE_DIFF = 0.25503486164919736f;
constexpr float QSCALE_64   = 0.18033688011112042f;
constexpr float NEGBIG = -1e30f;
constexpr int LDS_BYTES = 131072;

__device__ const float ROPE_INV16[16] = {
1.000000000e+00f, 5.623413324e-01f, 3.162277639e-01f, 1.778279394e-01f, 1.000000015e-01f, 5.623413250e-02f, 3.162277490e-02f, 1.778279431e-02f, 9.999999776e-03f, 5.623413250e-03f, 3.162277630e-03f, 1.778279431e-03f, 1.000000047e-03f, 5.623413017e-04f, 3.162277571e-04f, 1.778279402e-04f};
__device__ const float ROPE_INV32[32] = {
1.000000000e+00f, 7.498942018e-01f, 5.623413324e-01f, 4.216965139e-01f, 3.162277639e-01f, 2.371373773e-01f, 1.778279394e-01f, 1.333521456e-01f, 1.000000015e-01f, 7.498942316e-02f, 5.623413250e-02f, 4.216964915e-02f, 3.162277490e-02f, 2.371373773e-02f, 1.778279431e-02f, 1.333521400e-02f, 9.999999776e-03f, 7.498942316e-03f, 5.623413250e-03f, 4.216964822e-03f, 3.162277630e-03f, 2.371373819e-03f, 1.778279431e-03f, 1.333521446e-03f, 1.000000047e-03f, 7.498941850e-04f, 5.623413017e-04f, 4.216965172e-04f, 3.162277571e-04f, 2.371373703e-04f, 1.778279402e-04f, 1.333521504e-04f};

struct Params {
  const float *x, *c, *w_ada, *b_ada, *g_attn, *w_in, *diff_lambda, *diff_subln, *na_rpb, *w_out, *g_ffn, *w_up, *conv_w, *conv_b, *w_down, *g_final;
  float* out;
  u16 *wt_in, *wt_out, *wt_up, *wt_down;
  float* mod;
  unsigned* kmax;
  unsigned* bar;
  u16 *h, *o, *proj, *act, *odil;
  unsigned char* vt8;
  float* lse;
  float lam_init[2];
  int ph_lo, ph_hi;
};

typedef const __attribute__((address_space(4))) Params& KP;
DI const __attribute__((address_space(4))) Params* kp_fresh() {
  const __attribute__((address_space(4))) Params* q = (const __attribute__((address_space(4))) Params*)__builtin_amdgcn_kernarg_segment_ptr();
  asm volatile("" : "+s"(q));
  return q;
}
DI unsigned pack2(float a, float b) { f2_t v = {a, b}; return __builtin_bit_cast(unsigned, __builtin_convertvector(v, bf2_t)); }
DI float bf2f(u16 v) { return __uint_as_float(((unsigned)v) << 16); }
DI float bflo(unsigned v) { return __uint_as_float(v << 16); }
DI float bfhi(unsigned v) { return __uint_as_float(v & 0xffff0000u); }
DI int crow(int i, int hh) { return (i & 3) + 8 * (i >> 2) + 4 * hh; }
DI float exp2_hw(float x) { return __builtin_amdgcn_exp2f(x); }
DI int otid() { int t = threadIdx.x; asm volatile("" : "+v"(t)); return t; }


#define XB_TMO      128
#define XB_XCNT(j)  (256  + 64 * (j))
#define XB_XSUB(j)  (1280 + 64 * (j))
#define XB_XGEN(j)  (2304 + 64 * (j))
#define XB_TOP      3328
#define XB_TOPGEN   3392
#define XCD_BAR_WORDS 3456
#define XB_SPIN_CAP (1u << 21)
DI unsigned xb_ld(unsigned* p)              { return __hip_atomic_load(p, __ATOMIC_RELAXED, __HIP_MEMORY_SCOPE_AGENT); }
DI unsigned xb_add(unsigned* p, unsigned v) { return __hip_atomic_fetch_add(p, v, __ATOMIC_RELAXED, __HIP_MEMORY_SCOPE_AGENT); }
DI unsigned xb_xcc_id() { return (unsigned)__builtin_amdgcn_s_getreg((3 << 11) | 20) & 0xFu; }
#define XB_SPIN(cond, bar) do { unsigned _sp = 0; while (cond) { __builtin_amdgcn_s_sleep(1); \
    if ((++_sp & 255u) == 0u) { if (xb_ld(&(bar)[XB_TMO])) break; if (_sp > XB_SPIN_CAP) { atomicAdd(&(bar)[XB_TMO], 1u); break; } } } } while (0)
struct XcdBarrier { unsigned* bar; unsigned x; volatile LAS unsigned* st; };
DI XcdBarrier xcd_barrier_post(unsigned* bar, volatile LAS unsigned* st) {
  XcdBarrier b; b.bar = bar; b.x = xb_xcc_id(); b.st = st;
  if (threadIdx.x == 0) (void)xb_add(&bar[XB_XCNT(b.x)], 1u);
  return b;
}
DI void xcd_barrier_complete(unsigned* bar, unsigned x, unsigned& nloc, unsigned& nx) {
  const unsigned G = gridDim.x * gridDim.y * gridDim.z;
  unsigned sum, cnt, mine, sp = 0u;
  for (;;) {
    sum = 0u; cnt = 0u; mine = 0u;
#pragma unroll
    for (unsigned j = 0; j < 16; ++j) { const unsigned c = xb_ld(&bar[XB_XCNT(j)]); sum += c; cnt += (c > 0u) ? 1u : 0u; mine = (j == x) ? c : mine; }
    if (sum == G) break;
    __builtin_amdgcn_s_sleep(1);
    if ((++sp & 255u) == 0u) { if (xb_ld(&bar[XB_TMO])) break; if (sp > XB_SPIN_CAP) { atomicAdd(&bar[XB_TMO], 1u); break; } }
  }
  nloc = mine > 0u ? mine : 1u; nx = cnt > 0u ? cnt : 1u;
}
DI void xcd_barrier(const XcdBarrier& b) {
  asm volatile("s_waitcnt vmcnt(0)" ::: "memory");
  __syncthreads();
  if (threadIdx.x == 0) {
    unsigned* bar = b.bar;
    __builtin_amdgcn_s_waitcnt(0);
    unsigned nloc = b.st[0], nx = b.st[1];
    if (nloc == 0u) { xcd_barrier_complete(bar, b.x, nloc, nx); b.st[0] = nloc; b.st[1] = nx; }
    const unsigned old = xb_add(&bar[XB_XSUB(b.x)], 1u);
    const unsigned gen = old / nloc;
    if (old + 1u == (gen + 1u) * nloc) {
      __builtin_amdgcn_fence(__ATOMIC_RELEASE, "agent");
      asm volatile("s_waitcnt vmcnt(0)" ::: "memory");
      const unsigned og = xb_add(&bar[XB_TOP], 1u);
      const unsigned tg = og / nx;
      if (og + 1u == (tg + 1u) * nx) xb_add(&bar[XB_TOPGEN], 1u);
      else XB_SPIN(xb_ld(&bar[XB_TOPGEN]) == tg, bar);
      __builtin_amdgcn_fence(__ATOMIC_ACQUIRE, "agent");
      xb_add(&bar[XB_XGEN(b.x)], 1u);
      asm volatile("s_waitcnt vmcnt(0)" ::: "memory");
    } else {
      XB_SPIN(xb_ld(&bar[XB_XGEN(b.x)]) == gen, bar);
      __builtin_amdgcn_fence(__ATOMIC_ACQUIRE, "agent");
      asm volatile("s_waitcnt vmcnt(0)" ::: "memory");
    }
  }
  __syncthreads();
}

DI int wmap_in(int np) {
  if (np >= 768 && np < 1536) { const int hb = np & ~63, w = np & 63, g = w >> 5, n = (w >> 4) & 1, i = w & 15; return hb + 16 * g + i + 32 * n; }
  return np;
}
DI int wmap_up(int np) {
  const int pn = np >> 8, w = np & 255, bj = w >> 7, q = w & 127;
  return bj ? (DFF + 128 * pn + q) : (128 * pn + q);
}

DI void phase_prep(KP p, float* smf) {
  const int tid = otid();
  if (blockIdx.x == 0 && tid < 64) p.kmax[tid] = 0u;
  constexpr int N_ADA = 192;
  constexpr int T_IN = 16 * 24, T_OUT = 16 * 8, T_UP = 16 * 44, T_DOWN = 44 * 8;
  constexpr int T_LAYER = T_IN + T_OUT + T_UP + T_DOWN;
  const int total = N_ADA + 2 * T_LAYER;
  for (int it = blockIdx.x; it < total; it += gridDim.x) {
    if (it < N_ADA) {
      const int l = it / 96, cgp = it % 96;
      float* sc = smf;
      float* red = smf + 2048;
      for (int i = tid; i < 2048; i += NTHR) { float v = p.c[i]; sc[i] = v / (1.f + __expf(-v)); }
      __syncthreads();
      const int kq = tid >> 6, cc = tid & 63, col = cgp * 64 + cc;
      const float* wp = p.w_ada + ((size_t)l * 1024 + kq * 128) * 6144 + col;
      float a0 = 0.f, a1 = 0.f;
#pragma unroll 8
      for (int k = 0; k < 128; ++k) { float w = wp[(size_t)k * 6144]; a0 += sc[kq * 128 + k] * w; a1 += sc[1024 + kq * 128 + k] * w; }
      red[(kq * 2 + 0) * 64 + cc] = a0; red[(kq * 2 + 1) * 64 + cc] = a1;
      __syncthreads();
      if (tid < 128) {
        const int b = tid >> 6, c2 = tid & 63;
        float s = 0.f;
#pragma unroll
        for (int q = 0; q < 8; ++q) s += red[(q * 2 + b) * 64 + c2];
        p.mod[(l * 2 + b) * 6144 + cgp * 64 + c2] = s + p.b_ada[l * 6144 + cgp * 64 + c2];
      }
    } else {
      int idx = it - N_ADA; const int l = idx / T_LAYER; int j = idx % T_LAYER;
      const float* W; u16* dst; int Kd, N, tk, tn, kind;
      if (j < T_IN) { W = p.w_in + (size_t)l * 1024 * 3072; dst = p.wt_in + (size_t)l * 3072 * 1024; Kd = 1024; N = 3072; tk = j / 24; tn = j % 24; kind = 0; }
      else if (j < T_IN + T_OUT) { j -= T_IN; W = p.w_out + (size_t)l * 1024 * 1024; dst = p.wt_out + (size_t)l * 1024 * 1024; Kd = 1024; N = 1024; tk = j / 8; tn = j % 8; kind = 1; }
      else if (j < T_IN + T_OUT + T_UP) { j -= T_IN + T_OUT; W = p.w_up + (size_t)l * 1024 * 5632; dst = p.wt_up + (size_t)l * 5632 * 1024; Kd = 1024; N = 5632; tk = j / 44; tn = j % 44; kind = 2; }
      else { j -= T_IN + T_OUT + T_UP; W = p.w_down + (size_t)l * 2816 * 1024; dst = p.wt_down + (size_t)l * 1024 * 2816; Kd = 2816; N = 1024; tk = j / 8; tn = j % 8; kind = 3; }
      const int hb = tid >> 8, t = tid & 255;
      const int k0 = tk * 64, n0 = (tn * 2 + hb) * 64;
      float* tile = smf + hb * (64 * 65);
      const int nn = t & 63;
      const int np = n0 + nn;
      const int srccol = (kind == 0) ? wmap_in(np) : (kind == 2) ? wmap_up(np) : np;
#pragma unroll 4
      for (int i = 0; i < 16; ++i) { const int kk = i * 4 + (t >> 6); tile[kk * 65 + nn] = W[(size_t)(k0 + kk) * N + srccol]; }
      __syncthreads();
      const int nrow = t >> 2, kc = (t & 3) * 16;
      unsigned pk[8];
#pragma unroll
      for (int q = 0; q < 8; ++q) pk[q] = pack2(tile[(kc + 2 * q) * 65 + nrow], tile[(kc + 2 * q + 1) * 65 + nrow]);
      uint4* dp = (uint4*)(dst + (size_t)(n0 + nrow) * Kd + k0 + kc);
      dp[0] = make_uint4(pk[0], pk[1], pk[2], pk[3]);
      dp[1] = make_uint4(pk[4], pk[5], pk[6], pk[7]);
    }
    __syncthreads();
  }
}

DI float wave_sum(float v) {
#pragma unroll
  for (int o = 32; o >= 1; o >>= 1) v += __shfl_xor(v, o);
  return v;
}

template <int MODE>
DI void phase_norm(const float* xin, const float* g, const float* modl, int sh_off, int sc_off, u16* hout, float* fout) {
  const int tid = otid(); const int lane = tid & 63, w = tid >> 6;
  for (int row = blockIdx.x * NWAVE + w; row < NTOK; row += gridDim.x * NWAVE) {
    const int b = row >> 14;
    const float4* xr = (const float4*)(xin + (size_t)row * 1024);
    float4 v[4];
#pragma unroll
    for (int i = 0; i < 4; ++i) v[i] = xr[lane + i * 64];
    float ss = 0.f;
#pragma unroll
    for (int i = 0; i < 4; ++i) ss += v[i].x * v[i].x + v[i].y * v[i].y + v[i].z * v[i].z + v[i].w * v[i].w;
    ss = wave_sum(ss);
    const float inv = rsqrtf(ss * (1.f / 1024.f) + 1e-6f);
#pragma unroll
    for (int i = 0; i < 4; ++i) {
      const int col = (lane + i * 64) * 4;
      const float4 g4 = *(const float4*)(g + col);
      if (MODE == 0) {
        const float4 sc4 = *(const float4*)(modl + b * 6144 + sc_off + col);
        const float4 sh4 = *(const float4*)(modl + b * 6144 + sh_off + col);
        float y0 = v[i].x * inv * g4.x * (1.f + sc4.x) + sh4.x;
        float y1 = v[i].y * inv * g4.y * (1.f + sc4.y) + sh4.y;
        float y2 = v[i].z * inv * g4.z * (1.f + sc4.z) + sh4.z;
        float y3 = v[i].w * inv * g4.w * (1.f + sc4.w) + sh4.w;
        *(uint2*)(hout + (size_t)row * 1024 + col) = make_uint2(pack2(y0, y1), pack2(y2, y3));
      } else {
        float4 y; y.x = v[i].x * inv * g4.x; y.y = v[i].y * inv * g4.y; y.z = v[i].z * inv * g4.z; y.w = v[i].w * inv * g4.w;
        *(float4*)(fout + (size_t)row * 1024 + col) = y;
      }
    }
  }
}

namespace pg8 {
constexpr int BM = 256, BK = 64, HALF = 128, HTB = HALF * BK * 2, NXCD = 8, WGM = 8;
DI int lds_byte(int r, int c) { const int st = (r >> 4) * 2 + (c >> 5), rr = r & 15, cc = c & 31, ob = rr * 64 + cc * 2; return st * 1024 + (ob ^ (((ob >> 9) & 1) << 5)); }
DI void stage_rc(int b, int& R, int& C) { const int st = b / 1024, sb = b % 1024, swz = sb ^ (((sb >> 9) & 1) << 5); R = (st >> 1) * 16 + swz / 64; C = (st & 1) * 32 + (swz % 64) / 2; }
struct Unit { int pm, pn; };
struct StaticOrder {
  int nM, nN, nwg, G, c;
  DI void init(int nM_, int nN_, int G_, int c_) { nM = nM_; nN = nN_; nwg = nM * nN; G = G_; c = c_; }
  DI bool next(int i, Unit& u) const {
    const long L = (long)i * G + c; if (L >= nwg) return false;
    int wgid = (int)L; { const int q = nwg / NXCD, r = nwg % NXCD, xcd = wgid % NXCD, off = wgid / NXCD; wgid = (xcd < r ? xcd * (q + 1) : r * (q + 1) + (xcd - r) * q) + off; }
    const int nig = WGM * nN, gid = wgid / nig, fm = gid * WGM, gsz = (nM - fm) < WGM ? (nM - fm) : WGM;
    u.pm = fm + ((wgid % nig) % gsz); u.pn = (wgid % nig) / gsz; return true;
  }
};
struct AMapPlain { static constexpr int HALF_ROWS = 128; static DI int row(int R) { return R; } static DI long tile_row0(int pm) { return (long)pm * 256; } };
struct AMapHalo  { static constexpr int HALF_ROWS = 124; static DI int row(int R) { return 62 * (R >> 6) + (R & 63); } static DI long tile_row0(int pm) { const int b = pm / 67, ti = pm % 67; return (long)b * S + 248 * ti - 1; } };

template <class AMap, class Epi>
DI void gemm_phase(LAS unsigned char* lds, const u16* Aptr, const u16* Btptr, int K, const StaticOrder& SO, const Epi& E) {
  const int tid = otid(), wid = __builtin_amdgcn_readfirstlane(tid >> 6), lane = tid & 63, wr = wid >> 2, wc = wid & 3, fr = lane & 15, fq = lane >> 4;
  const int nt = K / BK;
  unsigned voffA[2], voffB[2];
#pragma unroll
  for (int i = 0; i < 2; ++i) { int R, C; stage_rc(tid * 16 + i * 8192, R, C);
    voffA[i] = (unsigned)(AMap::row(R) * K + C) * 2u; voffB[i] = (unsigned)(R * K + C) * 2u; }
  const size_t kstep = (size_t)(BK * 2);
  const size_t hstepA = (size_t)AMap::HALF_ROWS * K * 2, hstepB = (size_t)HALF * K * 2;
  const size_t tstepB = 2 * hstepB;
  const size_t rowB = (size_t)K * 2;
  const unsigned ldsw = (unsigned)wid * 1024u;
  const int aoff = lds_byte(wr * 64 + fr, fq * 8), boff = lds_byte(wc * 32 + fr, fq * 8);
#define PG8_SA(b, h) (((b) * 2 + (h)) * HTB)
#define PG8_SB(b, h) ((4 + (b) * 2 + (h)) * HTB)
#define PG8_STAGE(bufoff, gbase, voff) do { _Pragma("unroll") for (int _i = 0; _i < 2; ++_i) \
        __builtin_amdgcn_global_load_lds((const unsigned*)((const char*)(gbase) + (voff)[_i]), (LAS unsigned*)(lds + (bufoff) + ldsw + _i * 8192), 16, 0, 0); } while (0)
#define PG8_LDA(dst, b, h) do { _Pragma("unroll") for (int m = 0; m < 4; ++m) _Pragma("unroll") for (int k = 0; k < 2; ++k) dst[m][k] = *(const LAS bf16x8*)(lds + PG8_SA(b, h) + aoff + m * 2048 + k * 1024); } while (0)
#define PG8_LDB(dst, b, h) do { _Pragma("unroll") for (int n = 0; n < 2; ++n) _Pragma("unroll") for (int k = 0; k < 2; ++k) dst[n][k] = *(const LAS bf16x8*)(lds + PG8_SB(b, h) + boff + n * 2048 + k * 1024); } while (0)
#define PG8_MMA(ai, bj, At, Bt) do { __builtin_amdgcn_s_setprio(1); _Pragma("unroll") for (int m = 0; m < 4; ++m) _Pragma("unroll") for (int n = 0; n < 2; ++n) _Pragma("unroll") for (int k = 0; k < 2; ++k) \
        acc[ai][bj][m][n] = __builtin_amdgcn_mfma_f32_16x16x32_bf16(Bt[n][k], At[m][k], acc[ai][bj][m][n], 0, 0, 0); __builtin_amdgcn_s_setprio(0); } while (0)
#define PG8_WAIT_V(n) asm volatile("s_waitcnt vmcnt(" #n ")" ::: "memory")
#define PG8_WAIT_L(n) asm volatile("s_waitcnt lgkmcnt(" #n ")" ::: "memory")
#define PG8_BAR __builtin_amdgcn_s_barrier()
#define PG8_SCHED __builtin_amdgcn_sched_barrier(0)
  Unit cur, nxt; int ui = 0;
  if (!SO.next(0, cur)) return;
  f32x4 acc[2][2][4][2];
#pragma unroll
  for (int a = 0; a < 2; ++a)
#pragma unroll
    for (int b = 0; b < 2; ++b)
#pragma unroll
      for (int m = 0; m < 4; ++m)
#pragma unroll
        for (int n = 0; n < 2; ++n) acc[a][b][m][n] = (f32x4){0.f, 0.f, 0.f, 0.f};
  bf16x8 At[4][2], B0[2][2], B1[2][2];
  const char* cA = (const char*)Aptr + AMap::tile_row0(cur.pm) * (long)rowB; const char* cB = (const char*)Btptr + (size_t)cur.pn * tstepB;
  PG8_STAGE(PG8_SB(0, 0), cB, voffB); PG8_STAGE(PG8_SA(0, 0), cA, voffA); PG8_STAGE(PG8_SB(0, 1), cB + hstepB, voffB); PG8_STAGE(PG8_SA(0, 1), cA + hstepA, voffA);
  if (wr == 1) PG8_BAR;
  PG8_WAIT_V(4); PG8_BAR;
  PG8_STAGE(PG8_SB(1, 0), cB + kstep, voffB); PG8_STAGE(PG8_SA(1, 0), cA + kstep, voffA); PG8_STAGE(PG8_SB(1, 1), cB + hstepB + kstep, voffB);
  PG8_WAIT_V(6); PG8_BAR;
  for (;;) {
    const bool has_next = SO.next(ui + 1, nxt);
    const char* nA = has_next ? (const char*)Aptr + AMap::tile_row0(nxt.pm) * (long)rowB : cA; const char* nB = has_next ? (const char*)Btptr + (size_t)nxt.pn * tstepB : cB;
    for (int t = 0; t < nt; t += 2) {
      const bool last = (t == nt - 2);
      const char* a1 = cA + (size_t)(t + 1) * kstep;
      const char* a2 = last ? nA : cA + (size_t)(t + 2) * kstep; const char* b2 = last ? nB : cB + (size_t)(t + 2) * kstep;
      const char* a3 = a2 + kstep; const char* b3 = b2 + kstep;
      PG8_LDB(B0, 0, 0); PG8_SCHED; PG8_LDA(At, 0, 0); PG8_STAGE(PG8_SA(1, 1), a1 + hstepA, voffA);
      PG8_WAIT_L(8); PG8_BAR; PG8_WAIT_L(0); PG8_MMA(0, 0, At, B0); PG8_BAR; PG8_SCHED;
      PG8_LDB(B1, 0, 1); PG8_STAGE(PG8_SB(0, 0), b2, voffB);
      PG8_BAR; PG8_WAIT_L(0); PG8_MMA(0, 1, At, B1); PG8_BAR;
      PG8_LDA(At, 0, 1); PG8_STAGE(PG8_SA(0, 0), a2, voffA);
      PG8_BAR; PG8_WAIT_L(0); PG8_MMA(1, 0, At, B0); PG8_BAR; PG8_SCHED;
      PG8_STAGE(PG8_SB(0, 1), b2 + hstepB, voffB);
      PG8_WAIT_V(6); PG8_BAR; PG8_MMA(1, 1, At, B1); PG8_BAR;
      PG8_LDB(B0, 1, 0); PG8_SCHED; PG8_LDA(At, 1, 0); PG8_STAGE(PG8_SA(0, 1), a2 + hstepA, voffA);
      PG8_WAIT_L(8); PG8_BAR; PG8_WAIT_L(0); PG8_MMA(0, 0, At, B0); PG8_BAR; PG8_SCHED;
      PG8_LDB(B1, 1, 1); PG8_STAGE(PG8_SB(1, 0), b3, voffB);
      PG8_BAR; PG8_WAIT_L(0); PG8_MMA(0, 1, At, B1); PG8_BAR;
      PG8_LDA(At, 1, 1); PG8_STAGE(PG8_SA(1, 0), a3, voffA);
      PG8_BAR; PG8_WAIT_L(0); PG8_MMA(1, 0, At, B0); PG8_BAR; PG8_SCHED;
      PG8_STAGE(PG8_SB(1, 1), b3 + hstepB, voffB);
      PG8_WAIT_V(6); PG8_BAR; PG8_MMA(1, 1, At, B1); PG8_BAR;
    }
    E(acc, cur, wr, wc, fr, fq);
    if (!has_next) break;
#pragma unroll
    for (int a = 0; a < 2; ++a)
#pragma unroll
      for (int b = 0; b < 2; ++b)
#pragma unroll
        for (int m = 0; m < 4; ++m)
#pragma unroll
          for (int n = 0; n < 2; ++n) acc[a][b][m][n] = (f32x4){0.f, 0.f, 0.f, 0.f};
    cur = nxt; cA = nA; cB = nB; ++ui;
  }
  PG8_WAIT_V(0);
  if (wr == 0) PG8_BAR;
  PG8_BAR;
#undef PG8_SA
#undef PG8_SB
#undef PG8_STAGE
#undef PG8_LDA
#undef PG8_LDB
#undef PG8_MMA
#undef PG8_WAIT_V
#undef PG8_WAIT_L
#undef PG8_BAR
#undef PG8_SCHED
}
}

DI void sincos_big(float ang, float& sn, float& cs) {
  const float c_hi = 1.591549367e-01f, c_lo = 6.420638243e-09f;
  const float rh = ang * c_hi;
  const float e = __builtin_fmaf(ang, c_hi, -rh);
  const float fr = rh - floorf(rh);
  const float rev = fr + (e + ang * c_lo);
  sn = __builtin_amdgcn_sinf(rev);
  cs = __builtin_amdgcn_cosf(rev);
}

struct EpiProj {
  u16* proj; unsigned char* vt8;
  DI void operator()(const f32x4 (&acc)[2][2][4][2], const pg8::Unit& u, int wr, int wc, int fr, int fq) const {
    const f32x4 i16 = *(const f32x4*)(ROPE_INV16 + 4 * fq);
    const f32x4 i32v = *(const f32x4*)(ROPE_INV32 + 16 * (wc & 1) + 4 * fq);
#pragma unroll
    for (int bj = 0; bj < 2; ++bj) {
      const int gcol0 = u.pn * 256 + bj * 128 + wc * 32;
      int mode; float scale = 1.f;
      if (gcol0 < 256) { mode = 1; scale = QSCALE_DIFF; }
      else if (gcol0 < 512) { mode = 1; }
      else if (gcol0 < 768) { mode = 0; }
      else if (gcol0 < 1152) { mode = 2; scale = QSCALE_64; }
      else if (gcol0 < 1536) { mode = 2; }
      else if (gcol0 < 1920) { mode = 0; }
      else if (gcol0 < 2304) { mode = 0; scale = QSCALE_64; }
      else { mode = 0; }
      f32x4 invv;
#pragma unroll
      for (int e = 0; e < 4; ++e) invv[e] = (mode == 1) ? i16[e] : i32v[e];
      int c1, c2;
      if (mode == 2) { const int hb = gcol0 & ~63, g = wc & 1; c1 = hb + 16 * g + 4 * fq; c2 = c1 + 32; }
      else { c1 = gcol0 + 4 * fq; c2 = c1 + 16; }
#pragma unroll
      for (int ai = 0; ai < 2; ++ai)
#pragma unroll
        for (int m = 0; m < 4; ++m) {
          const int row = u.pm * 256 + ai * 128 + wr * 64 + m * 16 + fr;
          f32x4 x1 = acc[ai][bj][m][0], x2 = acc[ai][bj][m][1];
          if (mode != 0) {
            const float pos = (float)(row & (S - 1));
#pragma unroll
            for (int e = 0; e < 4; ++e) {
              const float ang = __fmul_rn(pos, invv[e]);
              float sn, cs; sincos_big(ang, sn, cs);
              const float y1 = x1[e] * cs - x2[e] * sn, y2 = x2[e] * cs + x1[e] * sn;
              x1[e] = y1; x2[e] = y2;
            }
          }
          u16* dp = proj + (size_t)row * NPROJ;
          *(uint2*)(dp + c1) = make_uint2(pack2(x1[0] * scale, x1[1] * scale), pack2(x1[2] * scale, x1[3] * scale));
          *(uint2*)(dp + c2) = make_uint2(pack2(x2[0] * scale, x2[1] * scale), pack2(x2[2] * scale, x2[3] * scale));
          if (gcol0 >= 512 && gcol0 < 768) {
            const int hd = (gcol0 - 512) >> 6, d0 = (gcol0 & 63) + 4 * fq;
            unsigned char* vp = vt8 + ((size_t)((row >> 14) * 4 + hd) * 64 + d0) * S + (row & (S - 1));
            const int w1a = __builtin_amdgcn_cvt_pk_fp8_f32(x1[0], x1[1], 0, false), w1b = __builtin_amdgcn_cvt_pk_fp8_f32(x1[2], x1[3], 0, false);
            const int w2a = __builtin_amdgcn_cvt_pk_fp8_f32(x2[0], x2[1], 0, false), w2b = __builtin_amdgcn_cvt_pk_fp8_f32(x2[2], x2[3], 0, false);
            vp[0] = (unsigned char)(w1a & 0xff); vp[(size_t)S] = (unsigned char)((w1a >> 8) & 0xff); vp[(size_t)2 * S] = (unsigned char)(w1b & 0xff); vp[(size_t)3 * S] = (unsigned char)((w1b >> 8) & 0xff);
            unsigned char* vq = vp + (size_t)16 * S;
            vq[0] = (unsigned char)(w2a & 0xff); vq[(size_t)S] = (unsigned char)((w2a >> 8) & 0xff); vq[(size_t)2 * S] = (unsigned char)(w2b & 0xff); vq[(size_t)3 * S] = (unsigned char)((w2b >> 8) & 0xff);
          }
        }
    }
  }
};

struct EpiResid {
  const float* xold; float* xnew; const float* gate;
  DI void operator()(const f32x4 (&acc)[2][2][4][2], const pg8::Unit& u, int wr, int wc, int fr, int fq) const {
    const int b = (u.pm * 256) >> 14;
    const int col0 = u.pn * 256 + wc * 32 + 4 * fq;
    f32x4 gv[2][2];
#pragma unroll
    for (int bj = 0; bj < 2; ++bj)
#pragma unroll
      for (int n = 0; n < 2; ++n) gv[bj][n] = *(const f32x4*)(gate + b * 6144 + col0 + bj * 128 + n * 16);
#pragma unroll
    for (int ai = 0; ai < 2; ++ai)
#pragma unroll
      for (int m = 0; m < 4; ++m) {
        const size_t off = (size_t)(u.pm * 256 + ai * 128 + wr * 64 + m * 16 + fr) * 1024 + col0;
        f32x4 xo[2][2];
#pragma unroll
        for (int bj = 0; bj < 2; ++bj)
#pragma unroll
          for (int n = 0; n < 2; ++n) xo[bj][n] = *(const f32x4*)(xold + off + bj * 128 + n * 16);
#pragma unroll
        for (int bj = 0; bj < 2; ++bj)
#pragma unroll
          for (int n = 0; n < 2; ++n) *(f32x4*)(xnew + off + bj * 128 + n * 16) = xo[bj][n] + gv[bj][n] * acc[ai][bj][m][n];
        asm volatile("" ::: "memory");
      }
  }
};

DI float dpp_ror1(float v)  { return __builtin_bit_cast(float, __builtin_amdgcn_update_dpp(0, __builtin_bit_cast(int, v), 0x121, 0xf, 0xf, false)); }
DI float dpp_ror15(float v) { return __builtin_bit_cast(float, __builtin_amdgcn_update_dpp(0, __builtin_bit_cast(int, v), 0x12F, 0xf, 0xf, false)); }
struct EpiUp {
  u16* act; const float* cw; const float* cb;
  DI void operator()(const f32x4 (&acc)[2][2][4][2], const pg8::Unit& u, int wr, int wc, int fr, int fq) const {
    const int b = u.pm / 67, ti = u.pm % 67;
#pragma unroll
    for (int n = 0; n < 2; ++n) {
      const int col = u.pn * 128 + wc * 32 + n * 16 + 4 * fq;
      const f32x4 w0 = *(const f32x4*)(cw + col), w1 = *(const f32x4*)(cw + DFF + col), w2 = *(const f32x4*)(cw + 2 * DFF + col), bb = *(const f32x4*)(cb + col);
#pragma unroll
      for (int ai = 0; ai < 2; ++ai) {
        const int tokb = 248 * ti - 1 + 62 * (2 * ai + wr);
        f32x4 g[4];
        if (tokb >= 0 && tokb + 63 < S) {
#pragma unroll
          for (int m = 0; m < 4; ++m) g[m] = acc[ai][0][m][n];
        } else {
#pragma unroll
          for (int m = 0; m < 4; ++m) {
            const int tok = tokb + 16 * m + fr;
            const bool ok = (tok >= 0) && (tok < S);
#pragma unroll
            for (int e = 0; e < 4; ++e) g[m][e] = ok ? acc[ai][0][m][n][e] : 0.f;
          }
        }
#pragma unroll
        for (int m = 0; m < 4; ++m) {
          const int q = 16 * m + fr, tok = tokb + q;
          f32x4 r;
#pragma unroll
          for (int e = 0; e < 4; ++e) {
            const float srcm = (fr == 15 && m > 0) ? g[m > 0 ? m - 1 : 0][e] : g[m][e];
            const float srcp = (fr == 0 && m < 3) ? g[m < 3 ? m + 1 : 3][e] : g[m][e];
            const float gm = dpp_ror1(srcm), gp = dpp_ror15(srcp);
            const float cv = bb[e] + w0[e] * gm + w1[e] * g[m][e] + w2[e] * gp;
            r[e] = cv * __builtin_amdgcn_rcpf(1.f + exp2_hw(-LOG2E * cv)) * acc[ai][1][m][n][e];
          }
          if (q >= 1 && q <= 62 && tok < S)
            *(uint2*)(act + (size_t)(b * S + tok) * DFF + col) = make_uint2(pack2(r[0], r[1]), pack2(r[2], r[3]));
        }
      }
    }
  }
};

constexpr int VROW = 96;
constexpr int VT_WAVE = 64 * VROW;
DI bf16x8 v_frag_tr(const u16* Vb, int kb0, int mb, int sp, int lane) {
  const int i16 = lane & 15, q = i16 >> 2, pp = i16 & 3, blk = (lane >> 4) & 1, hh = lane >> 5;
  const u16* a0 = Vb + (kb0 + 16 * sp + 4 * hh + q) * VROW + (mb * 2 + blk) * 16 + 4 * pp;
  const s16x4 lo = __builtin_amdgcn_ds_read_tr16_b64_v4i16((LAS s16x4*)a0);
  const s16x4 hi = __builtin_amdgcn_ds_read_tr16_b64_v4i16((LAS s16x4*)(a0 + 8 * VROW));
  return __builtin_shufflevector(lo, hi, 0, 1, 2, 3, 4, 5, 6, 7);
}

DI void local_softmax_step(float (&sv)[2][16], float& m_run, float& l_run, f32x16 (&O)[2], bf16x8 (&pk)[2][2]) {
  float tmax = NEGBIG;
#pragma unroll
  for (int h2 = 0; h2 < 2; ++h2)
#pragma unroll
    for (int i = 0; i < 16; ++i) tmax = fmaxf(tmax, sv[h2][i]);
  tmax = fmaxf(tmax, __shfl_xor(tmax, 32));
  const float m_new = fmaxf(m_run, tmax);
  if (__builtin_amdgcn_ballot_w64(m_new > m_run) != 0ull) {
    const float alpha = exp2_hw(m_run - m_new);
    m_run = m_new; l_run *= alpha;
#pragma unroll
    for (int mb = 0; mb < 2; ++mb)
#pragma unroll
      for (int i = 0; i < 16; ++i) O[mb][i] *= alpha;
  }
#pragma unroll
  for (int h2 = 0; h2 < 2; ++h2)
#pragma unroll
    for (int sp = 0; sp < 2; ++sp) {
      unsigned q4[4];
#pragma unroll
      for (int q = 0; q < 4; ++q) {
        const float s0 = sv[h2][8 * sp + 2 * q], s1 = sv[h2][8 * sp + 2 * q + 1];
        const float p0 = exp2_hw(s0 - m_run), p1 = exp2_hw(s1 - m_run);
        l_run += p0; l_run += p1;
        q4[q] = pack2(p0, p1);
      }
      pk[h2][sp] = __builtin_bit_cast(bf16x8, make_uint4(q4[0], q4[1], q4[2], q4[3]));
    }
}
DI void local_softmax_step1(float (&sv)[16], float& m_run, float& l_run, f32x16 (&O)[2], bf16x8 (&pk)[2]) {
  float tmax = NEGBIG;
#pragma unroll
  for (int i = 0; i < 16; ++i) tmax = fmaxf(tmax, sv[i]);
  tmax = fmaxf(tmax, __shfl_xor(tmax, 32));
  const float m_new = fmaxf(m_run, tmax);
  if (__builtin_amdgcn_ballot_w64(m_new > m_run) != 0ull) {
    const float alpha = exp2_hw(m_run - m_new);
    m_run = m_new; l_run *= alpha;
#pragma unroll
    for (int mb = 0; mb < 2; ++mb)
#pragma unroll
      for (int i = 0; i < 16; ++i) O[mb][i] *= alpha;
  }
#pragma unroll
  for (int sp = 0; sp < 2; ++sp) {
    unsigned q4[4];
#pragma unroll
    for (int q = 0; q < 4; ++q) {
      const float p0 = exp2_hw(sv[8 * sp + 2 * q] - m_run), p1 = exp2_hw(sv[8 * sp + 2 * q + 1] - m_run);
      l_run += p0; l_run += p1;
      q4[q] = pack2(p0, p1);
    }
    pk[sp] = __builtin_bit_cast(bf16x8, make_uint4(q4[0], q4[1], q4[2], q4[3]));
  }
}
DI void local_store_out(const f32x16 (&O)[2], float l_run, u16* op, int hh) {
  const float l = l_run + __shfl_xor(l_run, 32);
  const float il = 1.f / l;
#pragma unroll
  for (int mb = 0; mb < 2; ++mb)
#pragma unroll
    for (int g = 0; g < 4; ++g) {
      const int d = mb * 32 + 8 * g + 4 * hh;
      *(uint2*)(op + d) = make_uint2(pack2(O[mb][4 * g] * il, O[mb][4 * g + 1] * il), pack2(O[mb][4 * g + 2] * il, O[mb][4 * g + 3] * il));
    }
}

constexpr int KS_STRIDE = 72;
constexpr int KS_BUF = 64 * KS_STRIDE, VS_BUF = 64 * VROW;
DI void swin_attn_item(KP p, int item, u16* sm) {
  const int tid = otid(), lane = tid & 63, w = __builtin_amdgcn_readfirstlane(tid >> 6), r = lane & 31, hh = lane >> 5;
  u16* Ks = sm; u16* Vs = sm + 2 * KS_BUF;
  const int bhp = item >> 6, sub = item & 63;
  const int pat = bhp % 3, bh = bhp / 3, head = bh % 6, b = bh / 6;
  const int sh = 2 * pat, L = S >> sh;
  const int cls = sub >> (6 - sh), pb = sub & ((64 >> sh) - 1);
  const int P = pb * 256;
  const int qp = P + 32 * w + r, tq = cls + (qp << sh);
  const u16* prow = p.proj + (size_t)b * S * NPROJ;
  bf16x8 qf[4];
#pragma unroll
  for (int s = 0; s < 4; ++s) qf[s] = *(const bf16x8*)(prow + (size_t)tq * NPROJ + 768 + head * 64 + s * 16 + 8 * hh);
  f32x16 O[2];
#pragma unroll
  for (int mb = 0; mb < 2; ++mb)
#pragma unroll
    for (int i = 0; i < 16; ++i) O[mb][i] = 0.f;
  float m_run = -1e20f, l_run = 0.f;
  const int key0 = tid >> 3, ch = tid & 7;
  const u16* kg = prow + 1152 + head * 64 + ch * 8;
  auto gk = [&](int j) __attribute__((always_inline)) -> const u16* {
    int kp = P - 64 + 64 * j + key0; kp = kp < 0 ? 0 : (kp > L - 1 ? L - 1 : kp);
    return kg + (size_t)(cls + (kp << sh)) * NPROJ;
  };
  const uint4 k0 = *(const uint4*)gk(0), v0 = *(const uint4*)(gk(0) + 384), k1 = *(const uint4*)gk(1), v1 = *(const uint4*)(gk(1) + 384);
  const uint4 k2 = *(const uint4*)gk(2), v2 = *(const uint4*)(gk(2) + 384), k3 = *(const uint4*)gk(3), v3 = *(const uint4*)(gk(3) + 384);
  const uint4 k4 = *(const uint4*)gk(4), v4 = *(const uint4*)(gk(4) + 384), k5 = *(const uint4*)gk(5), v5 = *(const uint4*)(gk(5) + 384);
  auto lstore = [&](int buf, const uint4& kr, const uint4& vr) __attribute__((always_inline)) {
    *(uint4*)(Ks + buf * KS_BUF + key0 * KS_STRIDE + ch * 8) = kr;
    *(uint4*)(Vs + buf * VS_BUF + key0 * VROW + ch * 8) = vr;
  };
  lstore(0, k0, v0);
  __syncthreads();
  const int jlo = w >> 1;
#pragma unroll
  for (int j = 0; j < 6; ++j) {
    const int buf = j & 1;
    if (j >= jlo && j <= jlo + 2) {
      f32x16 Sc[2];
#pragma unroll
      for (int i = 0; i < 16; ++i) { Sc[0][i] = 0.f; Sc[1][i] = 0.f; }
#pragma unroll
      for (int s = 0; s < 4; ++s)
#pragma unroll
        for (int h2 = 0; h2 < 2; ++h2) {
          const bf16x8 kf = *(const bf16x8*)(Ks + buf * KS_BUF + (h2 * 32 + r) * KS_STRIDE + s * 16 + 8 * hh);
          Sc[h2] = MFMA32(kf, qf[s], Sc[h2]);
        }
      const int dbase = (64 * j - 32 * w) + 4 * hh - r;
      const int kbase = P - 64 + 64 * j + 4 * hh;
      float sv[2][16];
#pragma unroll
      for (int h2 = 0; h2 < 2; ++h2)
#pragma unroll
        for (int i = 0; i < 16; ++i) {
          const int c = h2 * 32 + (i & 3) + 8 * (i >> 2);
          const bool valid = ((unsigned)(dbase + c) <= 128u) && ((unsigned)(kbase + c) < (unsigned)L);
          sv[h2][i] = valid ? Sc[h2][i] : NEGBIG;
        }
      bf16x8 pk[2][2];
      local_softmax_step(sv, m_run, l_run, O, pk);
#pragma unroll
      for (int h2 = 0; h2 < 2; ++h2)
#pragma unroll
        for (int sp = 0; sp < 2; ++sp)
#pragma unroll
          for (int mb = 0; mb < 2; ++mb) {
            const bf16x8 vf = v_frag_tr(Vs + buf * VS_BUF, h2 * 32, mb, sp, lane);
            O[mb] = MFMA32(vf, pk[h2][sp], O[mb]);
          }
    }
    if (j == 0) lstore(1, k1, v1);
    if (j == 1) lstore(0, k2, v2);
    if (j == 2) lstore(1, k3, v3);
    if (j == 3) lstore(0, k4, v4);
    if (j == 4) lstore(1, k5, v5);
    __syncthreads();
  }
  const size_t orow = (size_t)pat * NTOK + (size_t)b * S + tq;
  const float l = l_run + __shfl_xor(l_run, 32);
  if (hh == 0) p.lse[orow * 6 + head] = m_run + __log2f(l);
  local_store_out(O, l_run, p.odil + orow * 384 + head * 64, hh);
}

DI void combine_dil(KP p) {
  const int tid = otid();
  for (int tc = blockIdx.x; tc < 256; tc += gridDim.x) {
#pragma unroll 1
    for (int idx = tid; idx < 128 * 48; idx += NTHR) {
      const int tok = tc * 128 + idx / 48, c8 = idx % 48, head = c8 >> 3;
      float ls[3], wgt[3];
#pragma unroll
      for (int q = 0; q < 3; ++q) ls[q] = p.lse[((size_t)q * NTOK + tok) * 6 + head];
      const float mx = fmaxf(ls[0], fmaxf(ls[1], ls[2]));
      float sum = 0.f;
#pragma unroll
      for (int q = 0; q < 3; ++q) { wgt[q] = exp2_hw(ls[q] - mx); sum += wgt[q]; }
      const float isum = 1.f / sum;
      float acc[8];
#pragma unroll
      for (int e = 0; e < 8; ++e) acc[e] = 0.f;
#pragma unroll
      for (int q = 0; q < 3; ++q) {
        const uint4 v = *(const uint4*)(p.odil + ((size_t)q * NTOK + tok) * 384 + c8 * 8);
        const float wq = wgt[q] * isum;
        acc[0] += wq * bflo(v.x); acc[1] += wq * bfhi(v.x); acc[2] += wq * bflo(v.y); acc[3] += wq * bfhi(v.y);
        acc[4] += wq * bflo(v.z); acc[5] += wq * bfhi(v.z); acc[6] += wq * bflo(v.w); acc[7] += wq * bfhi(v.w);
      }
      *(uint4*)(p.o + (size_t)tok * 1024 + 256 + c8 * 8) = make_uint4(pack2(acc[0], acc[1]), pack2(acc[2], acc[3]), pack2(acc[4], acc[5]), pack2(acc[6], acc[7]));
    }
  }
}

constexpr int RPB_PAD = 48, RPB_LDS = 15 * 31 + 2 * RPB_PAD;
DI void na_attn_item(KP p, int layer, int item, u16* sm) {
  const int tid = otid(), lane = tid & 63, w = __builtin_amdgcn_readfirstlane(tid >> 6), r = lane & 31, hh = lane >> 5;
  u16* Ks = sm; u16* Vs = sm + 2 * KS_BUF;
  const int b = item / (6 * 64), rem = item % (6 * 64), head = rem / 64, g = rem % 64;
  auto rstart = [](int x) { int v = x - 4; return v < 0 ? 0 : (v > 248 ? 248 : v); };
  const int qra = 4 * g + 2 * (w >> 2), cgp = w & 3;
  const int qr = qra + (r >> 4), qc = 16 * cgp + (r & 15), tq = qr * 64 + qc;
  int kc0 = 16 * cgp - 8; kc0 = kc0 < 0 ? 0 : (kc0 > 32 ? 32 : kc0);
  const int wlo = rstart(qra), whi = rstart(qra + 1) + 8;
  const int rs_q = rstart(qr);
  const int rs_lo = rstart(4 * g), rs_hi = rstart(4 * g + 3) + 7;
  const u16* prow = p.proj + (size_t)b * S * NPROJ;
  const float* rpb = p.na_rpb + ((size_t)layer * 6 + head) * 15 * 31;
  bf16x8 qf[4];
#pragma unroll
  for (int s = 0; s < 4; ++s) qf[s] = *(const bf16x8*)(prow + (size_t)tq * NPROJ + 1920 + head * 64 + s * 16 + 8 * hh);
  int cs = qc - 8; cs = cs < 0 ? 0 : (cs > 48 ? 48 : cs);
  float* rtab = (float*)(sm + 2 * KS_BUF + 2 * VS_BUF);
  for (int i = tid; i < RPB_LDS; i += NTHR) { const int j = i - RPB_PAD; rtab[i] = (j >= 0 && j < 15 * 31) ? rpb[j] * LOG2E : 0.f; }
  const int vbase = kc0 + 4 * hh - cs;
  f32x16 O[2];
#pragma unroll
  for (int mb = 0; mb < 2; ++mb)
#pragma unroll
    for (int i = 0; i < 16; ++i) O[mb][i] = 0.f;
  float m_run = -1e20f, l_run = 0.f;
  uint4 kr, vr, kr2, vr2, kr3, vr3;
  const int key0 = tid >> 3, ch = tid & 7;
  const u16* kg = prow + (size_t)key0 * NPROJ + 2304 + head * 64 + ch * 8;
  auto gload = [&](int krow, uint4& kd, uint4& vd) __attribute__((always_inline)) {
    const u16* src = kg + (size_t)((krow > 255 ? 255 : krow) * 64) * NPROJ;
    kd = *(const uint4*)src; vd = *(const uint4*)(src + 384);
  };
  auto lstore = [&](int buf) __attribute__((always_inline)) {
    *(uint4*)(Ks + buf * KS_BUF + key0 * KS_STRIDE + ch * 8) = kr;
    *(uint4*)(Vs + buf * VS_BUF + key0 * VROW + ch * 8) = vr;
  };
  gload(rs_lo, kr, vr); lstore(0);
  gload(rs_lo + 1, kr, vr); gload(rs_lo + 2, kr2, vr2);
  __syncthreads();
  for (int krow = rs_lo; krow <= rs_hi; ++krow) {
    const int buf = (krow - rs_lo) & 1;
    gload(krow + 3, kr3, vr3);
    if (krow >= wlo && krow < whi) {
      f32x16 Sc;
#pragma unroll
      for (int i = 0; i < 16; ++i) Sc[i] = 0.f;
#pragma unroll
      for (int s = 0; s < 4; ++s) {
        const bf16x8 kf = *(const bf16x8*)(Ks + buf * KS_BUF + (kc0 + r) * KS_STRIDE + s * 16 + 8 * hh);
        Sc = MFMA32(kf, qf[s], Sc);
      }
      const float* rowp = rtab + RPB_PAD + (krow - qr + 7) * 31 + 15 + kc0 + 4 * hh - qc;
      const bool rowok = (unsigned)(krow - rs_q) < 8u;
      float sv[16];
#pragma unroll
      for (int i = 0; i < 16; ++i) {
        const int c = (i & 3) + 8 * (i >> 2);
        const bool valid = rowok && ((unsigned)(vbase + c) < 16u);
        sv[i] = valid ? (Sc[i] + rowp[c]) : NEGBIG;
      }
      bf16x8 pk[2];
      local_softmax_step1(sv, m_run, l_run, O, pk);
#pragma unroll
      for (int sp = 0; sp < 2; ++sp)
#pragma unroll
        for (int mb = 0; mb < 2; ++mb) {
          const bf16x8 vf = v_frag_tr(Vs + buf * VS_BUF, kc0, mb, sp, lane);
          O[mb] = MFMA32(vf, pk[sp], O[mb]);
        }
    }
    lstore(buf ^ 1);
    kr = kr2; vr = vr2; kr2 = kr3; vr2 = vr3;
    __syncthreads();
  }
  local_store_out(O, l_run, p.o + (size_t)(b * S + tq) * 1024 + 640 + head * 64, hh);
}

DI void kmax_item(KP p, int layer, int kidx) {
  const int tid = otid(); const int gid = kidx * NTHR + tid;
  const int row = gid >> 2, head = gid & 3, b = row >> 14;
  const uint4* kp = (const uint4*)(p.proj + (size_t)row * NPROJ + 256 + head * 64);
  float n0 = 0.f, n1 = 0.f;
#pragma unroll
  for (int c = 0; c < 8; ++c) {
    const uint4 v = kp[c];
    const unsigned e[4] = {v.x, v.y, v.z, v.w};
    float s = 0.f;
#pragma unroll
    for (int q = 0; q < 4; ++q) { const float a = bflo(e[q]), bq = bfhi(e[q]); s += a * a + bq * bq; }
    if (c >= 4) n1 += s; else n0 += s;
  }
#pragma unroll
  for (int o = 4; o <= 32; o <<= 1) { n0 = fmaxf(n0, __shfl_xor(n0, o)); n1 = fmaxf(n1, __shfl_xor(n1, o)); }
  if ((tid & 63) < 4) {
    unsigned* km = p.kmax + layer * 16 + (b * 4 + head) * 2;
    atomicMax(km, __float_as_uint(n0)); atomicMax(km + 1, __float_as_uint(n1));
  }
}

DI void phase_local(KP p, int layer, u16* sm) {
  constexpr int N_DIL = 2304, N_NA = 768, N_KM = 256;
  for (int it = blockIdx.x; it < N_DIL + N_NA + N_KM; it += gridDim.x) {
    __syncthreads();
    if (it < N_DIL) swin_attn_item(p, it, sm);
    else if (it < N_DIL + N_NA) na_attn_item(p, layer, it - N_DIL, sm);
    else kmax_item(p, layer, it - N_DIL - N_NA);
  }
}

constexpr int VL_STRIDE = 80;
constexpr int VL_BUF = 64 * VL_STRIDE;
DI void phase_diff(KP p, int layer, u16* sm) {
  combine_dil(p);
  const int tid = otid(), lane = tid & 63, w = __builtin_amdgcn_readfirstlane(tid >> 6), r = lane & 31, hh = lane >> 5;
  u16* Ks = sm; unsigned char* Vl = (unsigned char*)(sm + 2 * KS_BUF);
  float lam;
  {
    const float* dl = p.diff_lambda + layer * 128;
    float a = 0.f, c2 = 0.f;
    if (lane < 32) { a = dl[lane] * dl[32 + lane]; c2 = dl[64 + lane] * dl[96 + lane]; }
    a = wave_sum(a); c2 = wave_sum(c2);
    lam = __expf(a) - __expf(c2) + p.lam_init[layer];
  }
  const float lam_init = p.lam_init[layer];
  const float* sg = p.diff_subln + layer * 64;
  for (int it = blockIdx.x; it < 512; it += gridDim.x) {
    const int bh = it >> 6, qb = it & 63, b = bh >> 2, head = bh & 3;
    const u16* prow = p.proj + (size_t)b * S * NPROJ;
    const int tq = qb * 256 + w * 32 + r;
    bf16x8 qf[2][2];
    float qn[2];
#pragma unroll
    for (int m = 0; m < 2; ++m) {
      qn[m] = 0.f;
#pragma unroll
      for (int s = 0; s < 2; ++s) {
        qf[m][s] = *(const bf16x8*)(prow + (size_t)tq * NPROJ + head * 64 + m * 32 + s * 16 + 8 * hh);
#pragma unroll
        for (int j = 0; j < 8; ++j) { const float v = bf2f((u16)qf[m][s][j]); qn[m] += v * v; }
      }
      qn[m] += __shfl_xor(qn[m], 32);
    }
    float mbnd[2];
#pragma unroll
    for (int m = 0; m < 2; ++m) {
      const float km = __uint_as_float(p.kmax[layer * 16 + bh * 2 + m]);
      mbnd[m] = fmaxf(sqrtf(qn[m] * km) - 15.f, 0.f);
    }
    const bool noshift = __builtin_amdgcn_ballot_w64(mbnd[0] == 0.f && mbnd[1] == 0.f) == ~0ull;
    f32x16 O[2][2];
#pragma unroll
    for (int m = 0; m < 2; ++m)
#pragma unroll
      for (int mb = 0; mb < 2; ++mb)
#pragma unroll
        for (int i = 0; i < 16; ++i) O[m][mb][i] = 0.f;
    f32x16 L[2];
#pragma unroll
    for (int m = 0; m < 2; ++m)
#pragma unroll
      for (int i = 0; i < 16; ++i) L[m][i] = 0.f;
    v8i_t ones8;
#pragma unroll
    for (int v = 0; v < 8; ++v) ones8[v] = 0x38383838;
    uint4 kr, kr2, kr3; uint2 vr, vr2, vr3;
    const int key0 = tid >> 3, ch = tid & 7;
    const u16* kg = prow + (size_t)key0 * NPROJ + 256 + head * 64 + ch * 8;
    const unsigned char* vg = p.vt8 + ((size_t)bh * 64 + key0) * S + ch * 8;
    auto gload = [&](int kt, uint4& kd, uint2& vd) __attribute__((always_inline)) {
      kd = *(const uint4*)(kg + (size_t)((kt & 255) * 64) * NPROJ);
      vd = *(const uint2*)(vg + (kt & 255) * 64);
    };
    auto lstore = [&](int buf) __attribute__((always_inline)) {
      *(uint4*)(Ks + buf * KS_BUF + key0 * KS_STRIDE + ch * 8) = kr;
      unsigned char* vd = Vl + buf * VL_BUF + key0 * VL_STRIDE + 4 * ch;
      *(unsigned*)vd = vr.x; *(unsigned*)(vd + 32) = vr.y;
    };
    gload(0, kr, vr); lstore(0);
    gload(1, kr, vr); gload(2, kr2, vr2);
    __syncthreads();
    if (w >= 4) __builtin_amdgcn_s_setprio(1);
    auto tile_loop = [&](auto shifted) __attribute__((always_inline)) {
      constexpr bool SH = decltype(shifted)::value;
      for (int kt = 0; kt < 256; ++kt) {
        const int buf = kt & 1;
        gload(kt + 3, kr3, vr3);
        f32x16 Sc[2][2];
#pragma unroll
        for (int sub = 0; sub < 2; ++sub)
#pragma unroll
          for (int m = 0; m < 2; ++m) {
#pragma unroll
            for (int i = 0; i < 16; ++i) Sc[sub][m][i] = 0.f;
#pragma unroll
            for (int s = 0; s < 2; ++s) {
              const bf16x8 kf = *(const bf16x8*)(Ks + buf * KS_BUF + (sub * 32 + r) * KS_STRIDE + m * 32 + s * 16 + 8 * hh);
              Sc[sub][m] = MFMA32(kf, qf[m][s], Sc[sub][m]);
            }
          }
        v8i_t pf[2];
#pragma unroll
        for (int sub = 0; sub < 2; ++sub)
#pragma unroll
          for (int m = 0; m < 2; ++m)
#pragma unroll
            for (int g = 0; g < 4; ++g) {
              float pv[4];
#pragma unroll
              for (int e = 0; e < 4; ++e) pv[e] = exp2_hw(SH ? (Sc[sub][m][4 * g + e] - mbnd[m]) : Sc[sub][m][4 * g + e]);
              int wd = __builtin_amdgcn_cvt_pk_bf8_f32(pv[0], pv[1], 0, false);
              wd = __builtin_amdgcn_cvt_pk_bf8_f32(pv[2], pv[3], wd, true);
              pf[m][4 * sub + g] = wd;
            }
#pragma unroll
        for (int mb = 0; mb < 2; ++mb) {
          const v8i_t vf = *(const v8i_t*)(Vl + buf * VL_BUF + (mb * 32 + r) * VL_STRIDE + 32 * hh);
          O[0][mb] = __builtin_amdgcn_mfma_scale_f32_32x32x64_f8f6f4(vf, pf[0], O[0][mb], 0, 1, 0, 0x7F7F7F7F, 0, 0x7F7F7F7F);
          O[1][mb] = __builtin_amdgcn_mfma_scale_f32_32x32x64_f8f6f4(vf, pf[1], O[1][mb], 0, 1, 0, 0x7F7F7F7F, 0, 0x7F7F7F7F);
        }
        L[0] = __builtin_amdgcn_mfma_scale_f32_32x32x64_f8f6f4(ones8, pf[0], L[0], 0, 1, 0, 0x7F7F7F7F, 0, 0x7F7F7F7F);
        L[1] = __builtin_amdgcn_mfma_scale_f32_32x32x64_f8f6f4(ones8, pf[1], L[1], 0, 1, 0, 0x7F7F7F7F, 0, 0x7F7F7F7F);
        lstore(buf ^ 1);
        kr = kr2; vr = vr2; kr2 = kr3; vr2 = vr3;
        __syncthreads();
      }
    };
    if (noshift) tile_loop(std::false_type{}); else tile_loop(std::true_type{});
    __builtin_amdgcn_s_setprio(0);
    const float l0 = L[0][0], l1 = L[1][0];
    const float i0 = 1.f / l0, i1 = lam / l1;
    float ss = 0.f;
#pragma unroll
    for (int mb = 0; mb < 2; ++mb)
#pragma unroll
      for (int i = 0; i < 16; ++i) { const float v = O[0][mb][i] * i0 - O[1][mb][i] * i1; O[0][mb][i] = v; ss += v * v; }
    ss += __shfl_xor(ss, 32);
    const float inv = rsqrtf(ss * (1.f / 64.f) + 1e-6f) * (1.f - lam_init);
    u16* op = p.o + (size_t)(b * S + tq) * 1024 + head * 64;
#pragma unroll
    for (int mb = 0; mb < 2; ++mb)
#pragma unroll
      for (int g = 0; g < 4; ++g) {
        const int d = mb * 32 + 8 * g + 4 * hh;
        const float4 g4 = *(const float4*)(sg + d);
        *(uint2*)(op + d) = make_uint2(pack2(O[0][mb][4 * g] * inv * g4.x, O[0][mb][4 * g + 1] * inv * g4.y),
                                       pack2(O[0][mb][4 * g + 2] * inv * g4.z, O[0][mb][4 * g + 3] * inv * g4.w));
      }
  }
}

DI void phase_proj(KP p, int layer, LAS unsigned char* lds) {
  pg8::StaticOrder so; so.init(128, 12, gridDim.x, blockIdx.x);
  EpiProj e; e.proj = p.proj; e.vt8 = p.vt8;
  pg8::gemm_phase<pg8::AMapPlain>(lds, p.h, p.wt_in + (size_t)layer * 3072 * 1024, 1024, so, e);
}
DI void phase_resid(const u16* A, int K, const u16* Bt, const float* xold, float* xnew, const float* gate, LAS unsigned char* lds) {
  pg8::StaticOrder so; so.init(128, 4, gridDim.x, blockIdx.x);
  EpiResid e; e.xold = xold; e.xnew = xnew; e.gate = gate;
  pg8::gemm_phase<pg8::AMapPlain>(lds, A, Bt, K, so, e);
}
DI void phase_up(KP p, int layer, LAS unsigned char* lds) {
  pg8::StaticOrder so; so.init(134, 22, gridDim.x, blockIdx.x);
  EpiUp e; e.act = p.act; e.cw = p.conv_w + (size_t)layer * 3 * DFF; e.cb = p.conv_b + (size_t)layer * DFF;
  pg8::gemm_phase<pg8::AMapHalo>(lds, p.h, p.wt_up + (size_t)layer * 5632 * 1024, 1024, so, e);
}

constexpr int N_PHASES = 18;

DI void run_phase(KP p, int ph, unsigned char* smraw) {
  u16* sm = (u16*)smraw;
  LAS unsigned char* lds = (LAS unsigned char*)smraw;
  if (ph == 0) { phase_prep(p, (float*)smraw); return; }
  if (ph == 17) { phase_norm<1>(p.out, p.g_final, nullptr, 0, 0, nullptr, p.out); return; }
  const int layer = (ph - 1) >> 3, sub = (ph - 1) & 7;
  const float* modl = p.mod + layer * 2 * 6144;
  const float* xcur = (layer == 0) ? p.x : p.out;
  switch (sub) {
    case 0: phase_norm<0>(xcur, p.g_attn + layer * 1024, modl, 0, 1024, p.h, nullptr); break;
    case 1: phase_proj(p, layer, lds); break;
    case 2: phase_local(p, layer, sm); break;
    case 3: phase_diff(p, layer, sm); break;
    case 4: phase_resid(p.o, 1024, p.wt_out + (size_t)layer * 1024 * 1024, xcur, p.out, modl + 2048, lds); break;
    case 5: phase_norm<0>(p.out, p.g_ffn + layer * 1024, modl, 3072, 4096, p.h, nullptr); break;
    case 6: phase_up(p, layer, lds); break;
    case 7: phase_resid(p.act, DFF, p.wt_down + (size_t)layer * 1024 * DFF, p.out, p.out, modl + 5120, lds); break;
  }
}

__global__ void __launch_bounds__(NTHR, 2) mega_kernel(Params p) {
  extern __shared__ __attribute__((aligned(16))) unsigned char smraw[];
#if COOP
  cg::grid_group grid = cg::this_grid();
  u16* sm = (u16*)smraw;
  LAS unsigned char* lds = (LAS unsigned char*)smraw;
  if (threadIdx.x == 0) *(uint4*)(smraw + LDS_BYTES) = make_uint4(0u, 0u, 0u, 0u);
  __syncthreads();
  const XcdBarrier xb = xcd_barrier_post(kp_fresh()->bar, (volatile LAS unsigned*)(smraw + LDS_BYTES));
  phase_prep(*kp_fresh(), (float*)smraw);
  grid.sync();
#pragma unroll 1
  for (int layer = 0; layer < 2; ++layer) {
    { KP q = *kp_fresh(); phase_norm<0>((layer == 0) ? q.x : q.out, q.g_attn + layer * 1024, q.mod + layer * 2 * 6144, 0, 1024, q.h, nullptr); } xcd_barrier(xb);
    phase_proj(*kp_fresh(), layer, lds); xcd_barrier(xb);
    phase_local(*kp_fresh(), layer, sm); xcd_barrier(xb);
    phase_diff(*kp_fresh(), layer, sm); xcd_barrier(xb);
    { KP q = *kp_fresh(); phase_resid(q.o, 1024, q.wt_out + (size_t)layer * 1024 * 1024, (layer == 0) ? q.x : q.out, q.out, q.mod + layer * 2 * 6144 + 2048, lds); } xcd_barrier(xb);
    { KP q = *kp_fresh(); phase_norm<0>(q.out, q.g_ffn + layer * 1024, q.mod + layer * 2 * 6144, 3072, 4096, q.h, nullptr); } xcd_barrier(xb);
    phase_up(*kp_fresh(), layer, lds); xcd_barrier(xb);
    { KP q = *kp_fresh(); phase_resid(q.act, DFF, q.wt_down + (size_t)layer * 1024 * DFF, q.out, q.out, q.mod + layer * 2 * 6144 + 5120, lds); } xcd_barrier(xb);
  }
  { KP q = *kp_fresh(); phase_norm<1>(q.out, q.g_final, nullptr, 0, 0, nullptr, q.out); }
#else
  { KP q = *kp_fresh(); for (int ph = q.ph_lo; ph < q.ph_hi; ++ph) run_phase(q, ph, smraw); }
#endif
}

extern "C" void kernel_launch(void* const* d_in, const int* in_sizes, int n_in, void* d_out, int out_size, void* d_ws, size_t ws_size, hipStream_t stream) {
  (void)in_sizes; (void)n_in; (void)out_size;
  Params p;
  memset(&p, 0, sizeof(p));
  p.x = (const float*)d_in[0]; p.c = (const float*)d_in[1]; p.w_ada = (const float*)d_in[2]; p.b_ada = (const float*)d_in[3];
  p.g_attn = (const float*)d_in[4]; p.w_in = (const float*)d_in[5]; p.diff_lambda = (const float*)d_in[6]; p.diff_subln = (const float*)d_in[7];
  p.na_rpb = (const float*)d_in[8]; p.w_out = (const float*)d_in[9]; p.g_ffn = (const float*)d_in[10]; p.w_up = (const float*)d_in[11];
  p.conv_w = (const float*)d_in[12]; p.conv_b = (const float*)d_in[13]; p.w_down = (const float*)d_in[14]; p.g_final = (const float*)d_in[15];
  p.out = (float*)d_out;
  char* ws = (char*)d_ws; size_t off = 0;
  auto take = [&](size_t bytes) { char* q = ws + off; off += (bytes + 255) & ~(size_t)255; return q; };
  p.wt_in = (u16*)take((size_t)2 * 3072 * 1024 * 2);
  p.wt_out = (u16*)take((size_t)2 * 1024 * 1024 * 2);
  p.wt_up = (u16*)take((size_t)2 * 5632 * 1024 * 2);
  p.wt_down = (u16*)take((size_t)2 * 1024 * 2816 * 2);
  p.mod = (float*)take((size_t)2 * 2 * 6144 * 4);
  p.kmax = (unsigned*)take(256);
  p.bar = (unsigned*)take((size_t)XCD_BAR_WORDS * 4);
  (void)take(4096);
  p.h = (u16*)take((size_t)NTOK * 1024 * 2);
  p.o = (u16*)take((size_t)NTOK * 1024 * 2);
  p.proj = (u16*)take((size_t)NTOK * NPROJ * 2);
  p.odil = (u16*)take((size_t)3 * NTOK * 384 * 2);
  p.lse = (float*)take((size_t)3 * NTOK * 6 * 4);
  p.vt8 = (unsigned char*)take((size_t)2 * 4 * 64 * S);
  p.act = p.proj;
  if (off > ws_size) { fprintf(stderr, "workspace too small: need %zu have %zu\n", off, ws_size); return; }
  p.lam_init[0] = 0.2f; p.lam_init[1] = 0.35550906759096934f;
  static int grid_blocks = 0;
  if (!grid_blocks) {
    int dev = 0, cus = 0, per_cu = 0;
    (void)hipGetDevice(&dev);
    (void)hipDeviceGetAttribute(&cus, hipDeviceAttributeMultiprocessorCount, dev);
    (void)hipFuncSetAttribute((const void*)mega_kernel, hipFuncAttributeMaxDynamicSharedMemorySize, LDS_BYTES + 16);
    (void)hipOccupancyMaxActiveBlocksPerMultiprocessor(&per_cu, mega_kernel, NTHR, LDS_BYTES + 16);
    if (per_cu > 1) per_cu = 1;
    if (per_cu < 1) per_cu = 1;
    grid_blocks = cus * per_cu;
  }
#if COOP
  p.ph_lo = 0; p.ph_hi = N_PHASES;
  (void)hipMemsetAsync(p.bar, 0, (size_t)XCD_BAR_WORDS * 4, stream);
  void* args[] = {&p};
  hipError_t e = hipLaunchCooperativeKernel((void*)mega_kernel, dim3(grid_blocks), dim3(NTHR), args, LDS_BYTES + 16, stream);
  if (e != hipSuccess) fprintf(stderr, "cooperative launch failed: %s (grid %d)\n", hipGetErrorString(e), grid_blocks);
#else
  for (int ph = 0; ph < N_PHASES; ++ph) {
    p.ph_lo = ph; p.ph_hi = ph + 1;
    hipLaunchKernelGGL(mega_kernel, dim3(grid_blocks), dim3(NTHR), LDS_BYTES + 16, stream, p);
  }
#endif
}
```

```cpp
#include <hip/hip_runtime.h>
#include <hip/hip_cooperative_groups.h>
#include <cstdio>
#include <cstring>
#include <type_traits>
namespace cg = cooperative_groups;

#ifndef COOP
#define COOP 1
#endif

#define DI __device__ __forceinline__
#define LAS __attribute__((address_space(3)))
typedef unsigned short u16;
using bf16x8 = __attribute__((ext_vector_type(8))) short;
using s16x4  = __attribute__((ext_vector_type(4))) short;
using f32x16 = __attribute__((ext_vector_type(16))) float;
using f32x4  = __attribute__((ext_vector_type(4))) float;
typedef int v8i_t __attribute__((ext_vector_type(8)));
typedef __bf16 bf2_t __attribute__((ext_vector_type(2)));
typedef float f2_t __attribute__((ext_vector_type(2)));
#define MFMA32(a, b, c) __builtin_amdgcn_mfma_f32_32x32x16_bf16((a), (b), (c), 0, 0, 0)

constexpr int S = 16384, NTOK = 32768, DFF = 2816, NPROJ = 3072;
constexpr int NTHR = 512, NWAVE = 8;
constexpr float LOG2E = 1.4426950408889634f;
constexpr float QSCALE_DIFF = 0.25503486164919736f;
constexpr float QSCALE_64   = 0.18033688011112042f;
constexpr float NEGBIG = -1e30f;
constexpr int LDS_BYTES = 131072;

__device__ const float ROPE_INV16[16] = {
1.000000000e+00f, 5.623413324e-01f, 3.162277639e-01f, 1.778279394e-01f, 1.000000015e-01f, 5.623413250e-02f, 3.162277490e-02f, 1.778279431e-02f, 9.999999776e-03f, 5.623413250e-03f, 3.162277630e-03f, 1.778279431e-03f, 1.000000047e-03f, 5.623413017e-04f, 3.162277571e-04f, 1.778279402e-04f};
__device__ const float ROPE_INV32[32] = {
1.000000000e+00f, 7.498942018e-01f, 5.623413324e-01f, 4.216965139e-01f, 3.162277639e-01f, 2.371373773e-01f, 1.778279394e-01f, 1.333521456e-01f, 1.000000015e-01f, 7.498942316e-02f, 5.623413250e-02f, 4.216964915e-02f, 3.162277490e-02f, 2.371373773e-02f, 1.778279431e-02f, 1.333521400e-02f, 9.999999776e-03f, 7.498942316e-03f, 5.623413250e-03f, 4.216964822e-03f, 3.162277630e-03f, 2.371373819e-03f, 1.778279431e-03f, 1.333521446e-03f, 1.000000047e-03f, 7.498941850e-04f, 5.623413017e-04f, 4.216965172e-04f, 3.162277571e-04f, 2.371373703e-04f, 1.778279402e-04f, 1.333521504e-04f};

struct Params {
  const float *x, *c, *w_ada, *b_ada, *g_attn, *w_in, *diff_lambda, *diff_subln, *na_rpb, *w_out, *g_ffn, *w_up, *conv_w, *conv_b, *w_down, *g_final;
  float* out;
  u16 *wt_in, *wt_out, *wt_up, *wt_down;
  float* mod;
  unsigned* kmax;
  unsigned* bar;
  u16 *h, *o, *proj, *act, *odil;
  unsigned char* vt8;
  float* lse;
  float lam_init[2];
  int ph_lo, ph_hi;
};

typedef const __attribute__((address_space(4))) Params& KP;
DI const __attribute__((address_space(4))) Params* kp_fresh() {
  const __attribute__((address_space(4))) Params* q = (const __attribute__((address_space(4))) Params*)__builtin_amdgcn_kernarg_segment_ptr();
  asm volatile("" : "+s"(q));
  return q;
}
DI unsigned pack2(float a, float b) { f2_t v = {a, b}; return __builtin_bit_cast(unsigned, __builtin_convertvector(v, bf2_t)); }
DI float bf2f(u16 v) { return __uint_as_float(((unsigned)v) << 16); }
DI float bflo(unsigned v) { return __uint_as_float(v << 16); }
DI float bfhi(unsigned v) { return __uint_as_float(v & 0xffff0000u); }
DI int crow(int i, int hh) { return (i & 3) + 8 * (i >> 2) + 4 * hh; }
DI float exp2_hw(float x) { return __builtin_amdgcn_exp2f(x); }
DI int otid() { int t = threadIdx.x; asm volatile("" : "+v"(t)); return t; }


#define XB_TMO      128
#define XB_XCNT(j)  (256  + 64 * (j))
#define XB_XSUB(j)  (1280 + 64 * (j))
#define XB_XGEN(j)  (2304 + 64 * (j))
#define XB_TOP      3328
#define XB_TOPGEN   3392
#define XCD_BAR_WORDS 3456
#define XB_SPIN_CAP (1u << 21)
DI unsigned xb_ld(unsigned* p)              { return __hip_atomic_load(p, __ATOMIC_RELAXED, __HIP_MEMORY_SCOPE_AGENT); }
DI unsigned xb_add(unsigned* p, unsigned v) { return __hip_atomic_fetch_add(p, v, __ATOMIC_RELAXED, __HIP_MEMORY_SCOPE_AGENT); }
DI unsigned xb_xcc_id() { return (unsigned)__builtin_amdgcn_s_getreg((3 << 11) | 20) & 0xFu; }
#define XB_SPIN(cond, bar) do { unsigned _sp = 0; while (cond) { __builtin_amdgcn_s_sleep(1); \
    if ((++_sp & 255u) == 0u) { if (xb_ld(&(bar)[XB_TMO])) break; if (_sp > XB_SPIN_CAP) { atomicAdd(&(bar)[XB_TMO], 1u); break; } } } } while (0)
struct XcdBarrier { unsigned* bar; unsigned x; volatile LAS unsigned* st; };
DI XcdBarrier xcd_barrier_post(unsigned* bar, volatile LAS unsigned* st) {
  XcdBarrier b; b.bar = bar; b.x = xb_xcc_id(); b.st = st;
  if (threadIdx.x == 0) (void)xb_add(&bar[XB_XCNT(b.x)], 1u);
  return b;
}
DI void xcd_barrier_complete(unsigned* bar, unsigned x, unsigned& nloc, unsigned& nx) {
  const unsigned G = gridDim.x * gridDim.y * gridDim.z;
  unsigned sum, cnt, mine, sp = 0u;
  for (;;) {
    sum = 0u; cnt = 0u; mine = 0u;
#pragma unroll
    for (unsigned j = 0; j < 16; ++j) { const unsigned c = xb_ld(&bar[XB_XCNT(j)]); sum += c; cnt += (c > 0u) ? 1u : 0u; mine = (j == x) ? c : mine; }
    if (sum == G) break;
    __builtin_amdgcn_s_sleep(1);
    if ((++sp & 255u) == 0u) { if (xb_ld(&bar[XB_TMO])) break; if (sp > XB_SPIN_CAP) { atomicAdd(&bar[XB_TMO], 1u); break; } }
  }
  nloc = mine > 0u ? mine : 1u; nx = cnt > 0u ? cnt : 1u;
}
DI void xcd_barrier(const XcdBarrier& b) {
  asm volatile("s_waitcnt vmcnt(0)" ::: "memory");
  __syncthreads();
  if (threadIdx.x == 0) {
    unsigned* bar = b.bar;
    __builtin_amdgcn_s_waitcnt(0);
    unsigned nloc = b.st[0], nx = b.st[1];
    if (nloc == 0u) { xcd_barrier_complete(bar, b.x, nloc, nx); b.st[0] = nloc; b.st[1] = nx; }
    const unsigned old = xb_add(&bar[XB_XSUB(b.x)], 1u);
    const unsigned gen = old / nloc;
    if (old + 1u == (gen + 1u) * nloc) {
      __builtin_amdgcn_fence(__ATOMIC_RELEASE, "agent");
      asm volatile("s_waitcnt vmcnt(0)" ::: "memory");
      const unsigned og = xb_add(&bar[XB_TOP], 1u);
      const unsigned tg = og / nx;
      if (og + 1u == (tg + 1u) * nx) xb_add(&bar[XB_TOPGEN], 1u);
      else XB_SPIN(xb_ld(&bar[XB_TOPGEN]) == tg, bar);
      __builtin_amdgcn_fence(__ATOMIC_ACQUIRE, "agent");
      xb_add(&bar[XB_XGEN(b.x)], 1u);
      asm volatile("s_waitcnt vmcnt(0)" ::: "memory");
    } else {
      XB_SPIN(xb_ld(&bar[XB_XGEN(b.x)]) == gen, bar);
      __builtin_amdgcn_fence(__ATOMIC_ACQUIRE, "agent");
      asm volatile("s_waitcnt vmcnt(0)" ::: "memory");
    }
  }
  __syncthreads();
}

DI int wmap_in(int np) {
  if (np >= 768 && np < 1536) { const int hb = np & ~63, w = np & 63, g = w >> 5, n = (w >> 4) & 1, i = w & 15; return hb + 16 * g + i + 32 * n; }
  return np;
}
DI int wmap_up(int np) {
  const int pn = np >> 8, w = np & 255, bj = w >> 7, q = w & 127;
  return bj ? (DFF + 128 * pn + q) : (128 * pn + q);
}

DI void phase_prep(KP p, float* smf) {
  const int tid = otid();
  if (blockIdx.x == 0 && tid < 64) p.kmax[tid] = 0u;
  constexpr int N_ADA = 192;
  constexpr int T_IN = 16 * 24, T_OUT = 16 * 8, T_UP = 16 * 44, T_DOWN = 44 * 8;
  constexpr int T_LAYER = T_IN + T_OUT + T_UP + T_DOWN;
  const int total = N_ADA + 2 * T_LAYER;
  for (int it = blockIdx.x; it < total; it += gridDim.x) {
    if (it < N_ADA) {
      const int l = it / 96, cgp = it % 96;
      float* sc = smf;
      float* red = smf + 2048;
      for (int i = tid; i < 2048; i += NTHR) { float v = p.c[i]; sc[i] = v / (1.f + __expf(-v)); }
      __syncthreads();
      const int kq = tid >> 6, cc = tid & 63, col = cgp * 64 + cc;
      const float* wp = p.w_ada + ((size_t)l * 1024 + kq * 128) * 6144 + col;
      float a0 = 0.f, a1 = 0.f;
#pragma unroll 8
      for (int k = 0; k < 128; ++k) { float w = wp[(size_t)k * 6144]; a0 += sc[kq * 128 + k] * w; a1 += sc[1024 + kq * 128 + k] * w; }
      red[(kq * 2 + 0) * 64 + cc] = a0; red[(kq * 2 + 1) * 64 + cc] = a1;
      __syncthreads();
      if (tid < 128) {
        const int b = tid >> 6, c2 = tid & 63;
        float s = 0.f;
#pragma unroll
        for (int q = 0; q < 8; ++q) s += red[(q * 2 + b) * 64 + c2];
        p.mod[(l * 2 + b) * 6144 + cgp * 64 + c2] = s + p.b_ada[l * 6144 + cgp * 64 + c2];
      }
    } else {
      int idx = it - N_ADA; const int l = idx / T_LAYER; int j = idx % T_LAYER;
      const float* W; u16* dst; int Kd, N, tk, tn, kind;
      if (j < T_IN) { W = p.w_in + (size_t)l * 1024 * 3072; dst = p.wt_in + (size_t)l * 3072 * 1024; Kd = 1024; N = 3072; tk = j / 24; tn = j % 24; kind = 0; }
      else if (j < T_IN + T_OUT) { j -= T_IN; W = p.w_out + (size_t)l * 1024 * 1024; dst = p.wt_out + (size_t)l * 1024 * 1024; Kd = 1024; N = 1024; tk = j / 8; tn = j % 8; kind = 1; }
      else if (j < T_IN + T_OUT + T_UP) { j -= T_IN + T_OUT; W = p.w_up + (size_t)l * 1024 * 5632; dst = p.wt_up + (size_t)l * 5632 * 1024; Kd = 1024; N = 5632; tk = j / 44; tn = j % 44; kind = 2; }
      else { j -= T_IN + T_OUT + T_UP; W = p.w_down + (size_t)l * 2816 * 1024; dst = p.wt_down + (size_t)l * 1024 * 2816; Kd = 2816; N = 1024; tk = j / 8; tn = j % 8; kind = 3; }
      const int hb = tid >> 8, t = tid & 255;
      const int k0 = tk * 64, n0 = (tn * 2 + hb) * 64;
      float* tile = smf + hb * (64 * 65);
      const int nn = t & 63;
      const int np = n0 + nn;
      const int srccol = (kind == 0) ? wmap_in(np) : (kind == 2) ? wmap_up(np) : np;
#pragma unroll 4
      for (int i = 0; i < 16; ++i) { const int kk = i * 4 + (t >> 6); tile[kk * 65 + nn] = W[(size_t)(k0 + kk) * N + srccol]; }
      __syncthreads();
      const int nrow = t >> 2, kc = (t & 3) * 16;
      unsigned pk[8];
#pragma unroll
      for (int q = 0; q < 8; ++q) pk[q] = pack2(tile[(kc + 2 * q) * 65 + nrow], tile[(kc + 2 * q + 1) * 65 + nrow]);
      uint4* dp = (uint4*)(dst + (size_t)(n0 + nrow) * Kd + k0 + kc);
      dp[0] = make_uint4(pk[0], pk[1], pk[2], pk[3]);
      dp[1] = make_uint4(pk[4], pk[5], pk[6], pk[7]);
    }
    __syncthreads();
  }
}

DI float wave_sum(float v) {
#pragma unroll
  for (int o = 32; o >= 1; o >>= 1) v += __shfl_xor(v, o);
  return v;
}

template <int MODE>
DI void phase_norm(const float* xin, const float* g, const float* modl, int sh_off, int sc_off, u16* hout, float* fout) {
  const int tid = otid(); const int lane = tid & 63, w = tid >> 6;
  for (int row = blockIdx.x * NWAVE + w; row < NTOK; row += gridDim.x * NWAVE) {
    const int b = row >> 14;
    const float4* xr = (const float4*)(xin + (size_t)row * 1024);
    float4 v[4];
#pragma unroll
    for (int i = 0; i < 4; ++i) v[i] = xr[lane + i * 64];
    float ss = 0.f;
#pragma unroll
    for (int i = 0; i < 4; ++i) ss += v[i].x * v[i].x + v[i].y * v[i].y + v[i].z * v[i].z + v[i].w * v[i].w;
    ss = wave_sum(ss);
    const float inv = rsqrtf(ss * (1.f / 1024.f) + 1e-6f);
#pragma unroll
    for (int i = 0; i < 4; ++i) {
      const int col = (lane + i * 64) * 4;
      const float4 g4 = *(const float4*)(g + col);
      if (MODE == 0) {
        const float4 sc4 = *(const float4*)(modl + b * 6144 + sc_off + col);
        const float4 sh4 = *(const float4*)(modl + b * 6144 + sh_off + col);
        float y0 = v[i].x * inv * g4.x * (1.f + sc4.x) + sh4.x;
        float y1 = v[i].y * inv * g4.y * (1.f + sc4.y) + sh4.y;
        float y2 = v[i].z * inv * g4.z * (1.f + sc4.z) + sh4.z;
        float y3 = v[i].w * inv * g4.w * (1.f + sc4.w) + sh4.w;
        *(uint2*)(hout + (size_t)row * 1024 + col) = make_uint2(pack2(y0, y1), pack2(y2, y3));
      } else {
        float4 y; y.x = v[i].x * inv * g4.x; y.y = v[i].y * inv * g4.y; y.z = v[i].z * inv * g4.z; y.w = v[i].w * inv * g4.w;
        *(float4*)(fout + (size_t)row * 1024 + col) = y;
      }
    }
  }
}

namespace pg8 {
constexpr int BM = 256, BK = 64, HALF = 128, HTB = HALF * BK * 2, NXCD = 8, WGM = 8;
DI int lds_byte(int r, int c) { const int st = (r >> 4) * 2 + (c >> 5), rr = r & 15, cc = c & 31, ob = rr * 64 + cc * 2; return st * 1024 + (ob ^ (((ob >> 9) & 1) << 5)); }
DI void stage_rc(int b, int& R, int& C) { const int st = b / 1024, sb = b % 1024, swz = sb ^ (((sb >> 9) & 1) << 5); R = (st >> 1) * 16 + swz / 64; C = (st & 1) * 32 + (swz % 64) / 2; }
struct Unit { int pm, pn; };
struct StaticOrder {
  int nM, nN, nwg, G, c;
  DI void init(int nM_, int nN_, int G_, int c_) { nM = nM_; nN = nN_; nwg = nM * nN; G = G_; c = c_; }
  DI bool next(int i, Unit& u) const {
    const long L = (long)i * G + c; if (L >= nwg) return false;
    int wgid = (int)L; { const int q = nwg / NXCD, r = nwg % NXCD, xcd = wgid % NXCD, off = wgid / NXCD; wgid = (xcd < r ? xcd * (q + 1) : r * (q + 1) + (xcd - r) * q) + off; }
    const int nig = WGM * nN, gid = wgid / nig, fm = gid * WGM, gsz = (nM - fm) < WGM ? (nM - fm) : WGM;
    u.pm = fm + ((wgid % nig) % gsz); u.pn = (wgid % nig) / gsz; return true;
  }
};
struct AMapPlain { static constexpr int HALF_ROWS = 128; static DI int row(int R) { return R; } static DI long tile_row0(int pm) { return (long)pm * 256; } };
struct AMapHalo  { static constexpr int HALF_ROWS = 124; static DI int row(int R) { return 62 * (R >> 6) + (R & 63); } static DI long tile_row0(int pm) { const int b = pm / 67, ti = pm % 67; return (long)b * S + 248 * ti - 1; } };

template <class AMap, class Epi>
DI void gemm_phase(LAS unsigned char* lds, const u16* Aptr, const u16* Btptr, int K, const StaticOrder& SO, const Epi& E) {
  const int tid = otid(), wid = __builtin_amdgcn_readfirstlane(tid >> 6), lane = tid & 63, wr = wid >> 2, wc = wid & 3, fr = lane & 15, fq = lane >> 4;
  const int nt = K / BK;
  unsigned voffA[2], voffB[2];
#pragma unroll
  for (int i = 0; i < 2; ++i) { int R, C; stage_rc(tid * 16 + i * 8192, R, C);
    voffA[i] = (unsigned)(AMap::row(R) * K + C) * 2u; voffB[i] = (unsigned)(R * K + C) * 2u; }
  const size_t kstep = (size_t)(BK * 2);
  const size_t hstepA = (size_t)AMap::HALF_ROWS * K * 2, hstepB = (size_t)HALF * K * 2;
  const size_t tstepB = 2 * hstepB;
  const size_t rowB = (size_t)K * 2;
  const unsigned ldsw = (unsigned)wid * 1024u;
  const int aoff = lds_byte(wr * 64 + fr, fq * 8), boff = lds_byte(wc * 32 + fr, fq * 8);
#define PG8_SA(b, h) (((b) * 2 + (h)) * HTB)
#define PG8_SB(b, h) ((4 + (b) * 2 + (h)) * HTB)
#define PG8_STAGE(bufoff, gbase, voff) do { _Pragma("unroll") for (int _i = 0; _i < 2; ++_i) \
        __builtin_amdgcn_global_load_lds((const unsigned*)((const char*)(gbase) + (voff)[_i]), (LAS unsigned*)(lds + (bufoff) + ldsw + _i * 8192), 16, 0, 0); } while (0)
#define PG8_LDA(dst, b, h) do { _Pragma("unroll") for (int m = 0; m < 4; ++m) _Pragma("unroll") for (int k = 0; k < 2; ++k) dst[m][k] = *(const LAS bf16x8*)(lds + PG8_SA(b, h) + aoff + m * 2048 + k * 1024); } while (0)
#define PG8_LDB(dst, b, h) do { _Pragma("unroll") for (int n = 0; n < 2; ++n) _Pragma("unroll") for (int k = 0; k < 2; ++k) dst[n][k] = *(const LAS bf16x8*)(lds + PG8_SB(b, h) + boff + n * 2048 + k * 1024); } while (0)
#define PG8_MMA(ai, bj, At, Bt) do { __builtin_amdgcn_s_setprio(1); _Pragma("unroll") for (int m = 0; m < 4; ++m) _Pragma("unroll") for (int n = 0; n < 2; ++n) _Pragma("unroll") for (int k = 0; k < 2; ++k) \
        acc[ai][bj][m][n] = __builtin_amdgcn_mfma_f32_16x16x32_bf16(Bt[n][k], At[m][k], acc[ai][bj][m][n], 0, 0, 0); __builtin_amdgcn_s_setprio(0); } while (0)
#define PG8_WAIT_V(n) asm volatile("s_waitcnt vmcnt(" #n ")" ::: "memory")
#define PG8_WAIT_L(n) asm volatile("s_waitcnt lgkmcnt(" #n ")" ::: "memory")
#define PG8_BAR __builtin_amdgcn_s_barrier()
#define PG8_SCHED __builtin_amdgcn_sched_barrier(0)
  Unit cur, nxt; int ui = 0;
  if (!SO.next(0, cur)) return;
  f32x4 acc[2][2][4][2];
#pragma unroll
  for (int a = 0; a < 2; ++a)
#pragma unroll
    for (int b = 0; b < 2; ++b)
#pragma unroll
      for (int m = 0; m < 4; ++m)
#pragma unroll
        for (int n = 0; n < 2; ++n) acc[a][b][m][n] = (f32x4){0.f, 0.f, 0.f, 0.f};
  bf16x8 At[4][2], B0[2][2], B1[2][2];
  const char* cA = (const char*)Aptr + AMap::tile_row0(cur.pm) * (long)rowB; const char* cB = (const char*)Btptr + (size_t)cur.pn * tstepB;
  PG8_STAGE(PG8_SB(0, 0), cB, voffB); PG8_STAGE(PG8_SA(0, 0), cA, voffA); PG8_STAGE(PG8_SB(0, 1), cB + hstepB, voffB); PG8_STAGE(PG8_SA(0, 1), cA + hstepA, voffA);
  if (wr == 1) PG8_BAR;
  PG8_WAIT_V(4); PG8_BAR;
  PG8_STAGE(PG8_SB(1, 0), cB + kstep, voffB); PG8_STAGE(PG8_SA(1, 0), cA + kstep, voffA); PG8_STAGE(PG8_SB(1, 1), cB + hstepB + kstep, voffB);
  PG8_WAIT_V(6); PG8_BAR;
  for (;;) {
    const bool has_next = SO.next(ui + 1, nxt);
    const char* nA = has_next ? (const char*)Aptr + AMap::tile_row0(nxt.pm) * (long)rowB : cA; const char* nB = has_next ? (const char*)Btptr + (size_t)nxt.pn * tstepB : cB;
    for (int t = 0; t < nt; t += 2) {
      const bool last = (t == nt - 2);
      const char* a1 = cA + (size_t)(t + 1) * kstep;
      const char* a2 = last ? nA : cA + (size_t)(t + 2) * kstep; const char* b2 = last ? nB : cB + (size_t)(t + 2) * kstep;
      const char* a3 = a2 + kstep; const char* b3 = b2 + kstep;
      PG8_LDB(B0, 0, 0); PG8_SCHED; PG8_LDA(At, 0, 0); PG8_STAGE(PG8_SA(1, 1), a1 + hstepA, voffA);
      PG8_WAIT_L(8); PG8_BAR; PG8_WAIT_L(0); PG8_MMA(0, 0, At, B0); PG8_BAR; PG8_SCHED;
      PG8_LDB(B1, 0, 1); PG8_STAGE(PG8_SB(0, 0), b2, voffB);
      PG8_BAR; PG8_WAIT_L(0); PG8_MMA(0, 1, At, B1); PG8_BAR;
      PG8_LDA(At, 0, 1); PG8_STAGE(PG8_SA(0, 0), a2, voffA);
      PG8_BAR; PG8_WAIT_L(0); PG8_MMA(1, 0, At, B0); PG8_BAR; PG8_SCHED;
      PG8_STAGE(PG8_SB(0, 1), b2 + hstepB, voffB);
      PG8_WAIT_V(6); PG8_BAR; PG8_MMA(1, 1, At, B1); PG8_BAR;
      PG8_LDB(B0, 1, 0); PG8_SCHED; PG8_LDA(At, 1, 0); PG8_STAGE(PG8_SA(0, 1), a2 + hstepA, voffA);
      PG8_WAIT_L(8); PG8_BAR; PG8_WAIT_L(0); PG8_MMA(0, 0, At, B0); PG8_BAR; PG8_SCHED;
      PG8_LDB(B1, 1, 1); PG8_STAGE(PG8_SB(1, 0), b3, voffB);
      PG8_BAR; PG8_WAIT_L(0); PG8_MMA(0, 1, At, B1); PG8_BAR;
      PG8_LDA(At, 1, 1); PG8_STAGE(PG8_SA(1, 0), a3, voffA);
      PG8_BAR; PG8_WAIT_L(0); PG8_MMA(1, 0, At, B0); PG8_BAR; PG8_SCHED;
      PG8_STAGE(PG8_SB(1, 1), b3 + hstepB, voffB);
      PG8_WAIT_V(6); PG8_BAR; PG8_MMA(1, 1, At, B1); PG8_BAR;
    }
    E(acc, cur, wr, wc, fr, fq);
    if (!has_next) break;
#pragma unroll
    for (int a = 0; a < 2; ++a)
#pragma unroll
      for (int b = 0; b < 2; ++b)
#pragma unroll
        for (int m = 0; m < 4; ++m)
#pragma unroll
          for (int n = 0; n < 2; ++n) acc[a][b][m][n] = (f32x4){0.f, 0.f, 0.f, 0.f};
    cur = nxt; cA = nA; cB = nB; ++ui;
  }
  PG8_WAIT_V(0);
  if (wr == 0) PG8_BAR;
  PG8_BAR;
#undef PG8_SA
#undef PG8_SB
#undef PG8_STAGE
#undef PG8_LDA
#undef PG8_LDB
#undef PG8_MMA
#undef PG8_WAIT_V
#undef PG8_WAIT_L
#undef PG8_BAR
#undef PG8_SCHED
}
}

DI void sincos_big(float ang, float& sn, float& cs) {
  const float c_hi = 1.591549367e-01f, c_lo = 6.420638243e-09f;
  const float rh = ang * c_hi;
  const float e = __builtin_fmaf(ang, c_hi, -rh);
  const float fr = rh - floorf(rh);
  const float rev = fr + (e + ang * c_lo);
  sn = __builtin_amdgcn_sinf(rev);
  cs = __builtin_amdgcn_cosf(rev);
}

struct EpiProj {
  u16* proj; unsigned char* vt8;
  DI void operator()(const f32x4 (&acc)[2][2][4][2], const pg8::Unit& u, int wr, int wc, int fr, int fq) const {
    const f32x4 i16 = *(const f32x4*)(ROPE_INV16 + 4 * fq);
    const f32x4 i32v = *(const f32x4*)(ROPE_INV32 + 16 * (wc & 1) + 4 * fq);
#pragma unroll
    for (int bj = 0; bj < 2; ++bj) {
      const int gcol0 = u.pn * 256 + bj * 128 + wc * 32;
      int mode; float scale = 1.f;
      if (gcol0 < 256) { mode = 1; scale = QSCALE_DIFF; }
      else if (gcol0 < 512) { mode = 1; }
      else if (gcol0 < 768) { mode = 0; }
      else if (gcol0 < 1152) { mode = 2; scale = QSCALE_64; }
      else if (gcol0 < 1536) { mode = 2; }
      else if (gcol0 < 1920) { mode = 0; }
      else if (gcol0 < 2304) { mode = 0; scale = QSCALE_64; }
      else { mode = 0; }
      f32x4 invv;
#pragma unroll
      for (int e = 0; e < 4; ++e) invv[e] = (mode == 1) ? i16[e] : i32v[e];
      int c1, c2;
      if (mode == 2) { const int hb = gcol0 & ~63, g = wc & 1; c1 = hb + 16 * g + 4 * fq; c2 = c1 + 32; }
      else { c1 = gcol0 + 4 * fq; c2 = c1 + 16; }
#pragma unroll
      for (int ai = 0; ai < 2; ++ai)
#pragma unroll
        for (int m = 0; m < 4; ++m) {
          const int row = u.pm * 256 + ai * 128 + wr * 64 + m * 16 + fr;
          f32x4 x1 = acc[ai][bj][m][0], x2 = acc[ai][bj][m][1];
          if (mode != 0) {
            const float pos = (float)(row & (S - 1));
#pragma unroll
            for (int e = 0; e < 4; ++e) {
              const float ang = __fmul_rn(pos, invv[e]);
              float sn, cs; sincos_big(ang, sn, cs);
              const float y1 = x1[e] * cs - x2[e] * sn, y2 = x2[e] * cs + x1[e] * sn;
              x1[e] = y1; x2[e] = y2;
            }
          }
          u16* dp = proj + (size_t)row * NPROJ;
          *(uint2*)(dp + c1) = make_uint2(pack2(x1[0] * scale, x1[1] * scale), pack2(x1[2] * scale, x1[3] * scale));
          *(uint2*)(dp + c2) = make_uint2(pack2(x2[0] * scale, x2[1] * scale), pack2(x2[2] * scale, x2[3] * scale));
          if (gcol0 >= 512 && gcol0 < 768) {
            const int hd = (gcol0 - 512) >> 6, d0 = (gcol0 & 63) + 4 * fq;
            unsigned char* vp = vt8 + ((size_t)((row >> 14) * 4 + hd) * 64 + d0) * S + (row & (S - 1));
            const int w1a = __builtin_amdgcn_cvt_pk_fp8_f32(x1[0], x1[1], 0, false), w1b = __builtin_amdgcn_cvt_pk_fp8_f32(x1[2], x1[3], 0, false);
            const int w2a = __builtin_amdgcn_cvt_pk_fp8_f32(x2[0], x2[1], 0, false), w2b = __builtin_amdgcn_cvt_pk_fp8_f32(x2[2], x2[3], 0, false);
            vp[0] = (unsigned char)(w1a & 0xff); vp[(size_t)S] = (unsigned char)((w1a >> 8) & 0xff); vp[(size_t)2 * S] = (unsigned char)(w1b & 0xff); vp[(size_t)3 * S] = (unsigned char)((w1b >> 8) & 0xff);
            unsigned char* vq = vp + (size_t)16 * S;
            vq[0] = (unsigned char)(w2a & 0xff); vq[(size_t)S] = (unsigned char)((w2a >> 8) & 0xff); vq[(size_t)2 * S] = (unsigned char)(w2b & 0xff); vq[(size_t)3 * S] = (unsigned char)((w2b >> 8) & 0xff);
          }
        }
    }
  }
};

struct EpiResid {
  const float* xold; float* xnew; const float* gate;
  DI void operator()(const f32x4 (&acc)[2][2][4][2], const pg8::Unit& u, int wr, int wc, int fr, int fq) const {
    const int b = (u.pm * 256) >> 14;
    const int col0 = u.pn * 256 + wc * 32 + 4 * fq;
    f32x4 gv[2][2];
#pragma unroll
    for (int bj = 0; bj < 2; ++bj)
#pragma unroll
      for (int n = 0; n < 2; ++n) gv[bj][n] = *(const f32x4*)(gate + b * 6144 + col0 + bj * 128 + n * 16);
#pragma unroll
    for (int ai = 0; ai < 2; ++ai)
#pragma unroll
      for (int m = 0; m < 4; ++m) {
        const size_t off = (size_t)(u.pm * 256 + ai * 128 + wr * 64 + m * 16 + fr) * 1024 + col0;
        f32x4 xo[2][2];
#pragma unroll
        for (int bj = 0; bj < 2; ++bj)
#pragma unroll
          for (int n = 0; n < 2; ++n) xo[bj][n] = *(const f32x4*)(xold + off + bj * 128 + n * 16);
#pragma unroll
        for (int bj = 0; bj < 2; ++bj)
#pragma unroll
          for (int n = 0; n < 2; ++n) *(f32x4*)(xnew + off + bj * 128 + n * 16) = xo[bj][n] + gv[bj][n] * acc[ai][bj][m][n];
        asm volatile("" ::: "memory");
      }
  }
};

DI float dpp_ror1(float v)  { return __builtin_bit_cast(float, __builtin_amdgcn_update_dpp(0, __builtin_bit_cast(int, v), 0x121, 0xf, 0xf, false)); }
DI float dpp_ror15(float v) { return __builtin_bit_cast(float, __builtin_amdgcn_update_dpp(0, __builtin_bit_cast(int, v), 0x12F, 0xf, 0xf, false)); }
struct EpiUp {
  u16* act; const float* cw; const float* cb;
  DI void operator()(const f32x4 (&acc)[2][2][4][2], const pg8::Unit& u, int wr, int wc, int fr, int fq) const {
    const int b = u.pm / 67, ti = u.pm % 67;
#pragma unroll
    for (int n = 0; n < 2; ++n) {
      const int col = u.pn * 128 + wc * 32 + n * 16 + 4 * fq;
      const f32x4 w0 = *(const f32x4*)(cw + col), w1 = *(const f32x4*)(cw + DFF + col), w2 = *(const f32x4*)(cw + 2 * DFF + col), bb = *(const f32x4*)(cb + col);
#pragma unroll
      for (int ai = 0; ai < 2; ++ai) {
        const int tokb = 248 * ti - 1 + 62 * (2 * ai + wr);
        f32x4 g[4];
        if (tokb >= 0 && tokb + 63 < S) {
#pragma unroll
          for (int m = 0; m < 4; ++m) g[m] = acc[ai][0][m][n];
        } else {
#pragma unroll
          for (int m = 0; m < 4; ++m) {
            const int tok = tokb + 16 * m + fr;
            const bool ok = (tok >= 0) && (tok < S);
#pragma unroll
            for (int e = 0; e < 4; ++e) g[m][e] = ok ? acc[ai][0][m][n][e] : 0.f;
          }
        }
#pragma unroll
        for (int m = 0; m < 4; ++m) {
          const int q = 16 * m + fr, tok = tokb + q;
          f32x4 r;
#pragma unroll
          for (int e = 0; e < 4; ++e) {
            const float srcm = (fr == 15 && m > 0) ? g[m > 0 ? m - 1 : 0][e] : g[m][e];
            const float srcp = (fr == 0 && m < 3) ? g[m < 3 ? m + 1 : 3][e] : g[m][e];
            const float gm = dpp_ror1(srcm), gp = dpp_ror15(srcp);
            const float cv = bb[e] + w0[e] * gm + w1[e] * g[m][e] + w2[e] * gp;
            r[e] = cv * __builtin_amdgcn_rcpf(1.f + exp2_hw(-LOG2E * cv)) * acc[ai][1][m][n][e];
          }
          if (q >= 1 && q <= 62 && tok < S)
            *(uint2*)(act + (size_t)(b * S + tok) * DFF + col) = make_uint2(pack2(r[0], r[1]), pack2(r[2], r[3]));
        }
      }
    }
  }
};

constexpr int VROW = 96;
constexpr int VT_WAVE = 64 * VROW;
DI bf16x8 v_frag_tr(const u16* Vb, int kb0, int mb, int sp, int lane) {
  const int i16 = lane & 15, q = i16 >> 2, pp = i16 & 3, blk = (lane >> 4) & 1, hh = lane >> 5;
  const u16* a0 = Vb + (kb0 + 16 * sp + 4 * hh + q) * VROW + (mb * 2 + blk) * 16 + 4 * pp;
  const s16x4 lo = __builtin_amdgcn_ds_read_tr16_b64_v4i16((LAS s16x4*)a0);
  const s16x4 hi = __builtin_amdgcn_ds_read_tr16_b64_v4i16((LAS s16x4*)(a0 + 8 * VROW));
  return __builtin_shufflevector(lo, hi, 0, 1, 2, 3, 4, 5, 6, 7);
}

DI void local_softmax_step(float (&sv)[2][16], float& m_run, float& l_run, f32x16 (&O)[2], bf16x8 (&pk)[2][2]) {
  float tmax = NEGBIG;
#pragma unroll
  for (int h2 = 0; h2 < 2; ++h2)
#pragma unroll
    for (int i = 0; i < 16; ++i) tmax = fmaxf(tmax, sv[h2][i]);
  tmax = fmaxf(tmax, __shfl_xor(tmax, 32));
  const float m_new = fmaxf(m_run, tmax);
  if (__builtin_amdgcn_ballot_w64(m_new > m_run) != 0ull) {
    const float alpha = exp2_hw(m_run - m_new);
    m_run = m_new; l_run *= alpha;
#pragma unroll
    for (int mb = 0; mb < 2; ++mb)
#pragma unroll
      for (int i = 0; i < 16; ++i) O[mb][i] *= alpha;
  }
#pragma unroll
  for (int h2 = 0; h2 < 2; ++h2)
#pragma unroll
    for (int sp = 0; sp < 2; ++sp) {
      unsigned q4[4];
#pragma unroll
      for (int q = 0; q < 4; ++q) {
        const float s0 = sv[h2][8 * sp + 2 * q], s1 = sv[h2][8 * sp + 2 * q + 1];
        const float p0 = exp2_hw(s0 - m_run), p1 = exp2_hw(s1 - m_run);
        l_run += p0; l_run += p1;
        q4[q] = pack2(p0, p1);
      }
      pk[h2][sp] = __builtin_bit_cast(bf16x8, make_uint4(q4[0], q4[1], q4[2], q4[3]));
    }
}
DI void local_softmax_step1(float (&sv)[16], float& m_run, float& l_run, f32x16 (&O)[2], bf16x8 (&pk)[2]) {
  float tmax = NEGBIG;
#pragma unroll
  for (int i = 0; i < 16; ++i) tmax = fmaxf(tmax, sv[i]);
  tmax = fmaxf(tmax, __shfl_xor(tmax, 32));
  const float m_new = fmaxf(m_run, tmax);
  if (__builtin_amdgcn_ballot_w64(m_new > m_run) != 0ull) {
    const float alpha = exp2_hw(m_run - m_new);
    m_run = m_new; l_run *= alpha;
#pragma unroll
    for (int mb = 0; mb < 2; ++mb)
#pragma unroll
      for (int i = 0; i < 16; ++i) O[mb][i] *= alpha;
  }
#pragma unroll
  for (int sp = 0; sp < 2; ++sp) {
    unsigned q4[4];
#pragma unroll
    for (int q = 0; q < 4; ++q) {
      const float p0 = exp2_hw(sv[8 * sp + 2 * q] - m_run), p1 = exp2_hw(sv[8 * sp + 2 * q + 1] - m_run);
      l_run += p0; l_run += p1;
      q4[q] = pack2(p0, p1);
    }
    pk[sp] = __builtin_bit_cast(bf16x8, make_uint4(q4[0], q4[1], q4[2], q4[3]));
  }
}
DI void local_store_out(const f32x16 (&O)[2], float l_run, u16* op, int hh) {
  const float l = l_run + __shfl_xor(l_run, 32);
  const float il = 1.f / l;
#pragma unroll
  for (int mb = 0; mb < 2; ++mb)
#pragma unroll
    for (int g = 0; g < 4; ++g) {
      const int d = mb * 32 + 8 * g + 4 * hh;
      *(uint2*)(op + d) = make_uint2(pack2(O[mb][4 * g] * il, O[mb][4 * g + 1] * il), pack2(O[mb][4 * g + 2] * il, O[mb][4 * g + 3] * il));
    }
}

constexpr int KS_STRIDE = 72;
constexpr int KS_BUF = 64 * KS_STRIDE, VS_BUF = 64 * VROW;
DI void swin_attn_item(KP p, int item, u16* sm) {
  const int tid = otid(), lane = tid & 63, w = __builtin_amdgcn_readfirstlane(tid >> 6), r = lane & 31, hh = lane >> 5;
  u16* Ks = sm; u16* Vs = sm + 2 * KS_BUF;
  const int bhp = item >> 6, sub = item & 63;
  const int pat = bhp % 3, bh = bhp / 3, head = bh % 6, b = bh / 6;
  const int sh = 2 * pat, L = S >> sh;
  const int cls = sub >> (6 - sh), pb = sub & ((64 >> sh) - 1);
  const int P = pb * 256;
  const int qp = P + 32 * w + r, tq = cls + (qp << sh);
  const u16* prow = p.proj + (size_t)b * S * NPROJ;
  bf16x8 qf[4];
#pragma unroll
  for (int s = 0; s < 4; ++s) qf[s] = *(const bf16x8*)(prow + (size_t)tq * NPROJ + 768 + head * 64 + s * 16 + 8 * hh);
  f32x16 O[2];
#pragma unroll
  for (int mb = 0; mb < 2; ++mb)
#pragma unroll
    for (int i = 0; i < 16; ++i) O[mb][i] = 0.f;
  float m_run = -1e20f, l_run = 0.f;
  const int key0 = tid >> 3, ch = tid & 7;
  const u16* kg = prow + 1152 + head * 64 + ch * 8;
  auto gk = [&](int j) __attribute__((always_inline)) -> const u16* {
    int kp = P - 64 + 64 * j + key0; kp = kp < 0 ? 0 : (kp > L - 1 ? L - 1 : kp);
    return kg + (size_t)(cls + (kp << sh)) * NPROJ;
  };
  const uint4 k0 = *(const uint4*)gk(0), v0 = *(const uint4*)(gk(0) + 384), k1 = *(const uint4*)gk(1), v1 = *(const uint4*)(gk(1) + 384);
  const uint4 k2 = *(const uint4*)gk(2), v2 = *(const uint4*)(gk(2) + 384), k3 = *(const uint4*)gk(3), v3 = *(const uint4*)(gk(3) + 384);
  const uint4 k4 = *(const uint4*)gk(4), v4 = *(const uint4*)(gk(4) + 384), k5 = *(const uint4*)gk(5), v5 = *(const uint4*)(gk(5) + 384);
  auto lstore = [&](int buf, const uint4& kr, const uint4& vr) __attribute__((always_inline)) {
    *(uint4*)(Ks + buf * KS_BUF + key0 * KS_STRIDE + ch * 8) = kr;
    *(uint4*)(Vs + buf * VS_BUF + key0 * VROW + ch * 8) = vr;
  };
  lstore(0, k0, v0);
  __syncthreads();
  const int jlo = w >> 1;
#pragma unroll
  for (int j = 0; j < 6; ++j) {
    const int buf = j & 1;
    const bool half_only = (w & 1) ? (j == jlo) : (j == jlo + 2);
    if (j >= jlo && j <= jlo + 2 && !half_only) {
      f32x16 Sc[2];
#pragma unroll
      for (int i = 0; i < 16; ++i) { Sc[0][i] = 0.f; Sc[1][i] = 0.f; }
#pragma unroll
      for (int s = 0; s < 4; ++s)
#pragma unroll
        for (int h2 = 0; h2 < 2; ++h2) {
          const bf16x8 kf = *(const bf16x8*)(Ks + buf * KS_BUF + (h2 * 32 + r) * KS_STRIDE + s * 16 + 8 * hh);
          Sc[h2] = MFMA32(kf, qf[s], Sc[h2]);
        }
      const int dbase = (64 * j - 32 * w) + 4 * hh - r;
      const int kbase = P - 64 + 64 * j + 4 * hh;
      float sv[2][16];
#pragma unroll
      for (int h2 = 0; h2 < 2; ++h2)
#pragma unroll
        for (int i = 0; i < 16; ++i) {
          const int c = h2 * 32 + (i & 3) + 8 * (i >> 2);
          const bool valid = ((unsigned)(dbase + c) <= 128u) && ((unsigned)(kbase + c) < (unsigned)L);
          sv[h2][i] = valid ? Sc[h2][i] : NEGBIG;
        }
      bf16x8 pk[2][2];
      local_softmax_step(sv, m_run, l_run, O, pk);
#pragma unroll
      for (int h2 = 0; h2 < 2; ++h2)
#pragma unroll
        for (int sp = 0; sp < 2; ++sp)
#pragma unroll
          for (int mb = 0; mb < 2; ++mb) {
            const bf16x8 vf = v_frag_tr(Vs + buf * VS_BUF, h2 * 32, mb, sp, lane);
            O[mb] = MFMA32(vf, pk[h2][sp], O[mb]);
          }
    } else if (j >= jlo && j <= jlo + 2) {
      const int hs = (w & 1) * 32;
      f32x16 Sc;
#pragma unroll
      for (int i = 0; i < 16; ++i) Sc[i] = 0.f;
#pragma unroll
      for (int s = 0; s < 4; ++s) {
        const bf16x8 kf = *(const bf16x8*)(Ks + buf * KS_BUF + (hs + r) * KS_STRIDE + s * 16 + 8 * hh);
        Sc = MFMA32(kf, qf[s], Sc);
      }
      const int dbase = (64 * j - 32 * w) + hs + 4 * hh - r;
      const int kbase = P - 64 + 64 * j + hs + 4 * hh;
      float sv[16];
#pragma unroll
      for (int i = 0; i < 16; ++i) {
        const int c = (i & 3) + 8 * (i >> 2);
        const bool valid = ((unsigned)(dbase + c) <= 128u) && ((unsigned)(kbase + c) < (unsigned)L);
        sv[i] = valid ? Sc[i] : NEGBIG;
      }
      bf16x8 pk[2];
      local_softmax_step1(sv, m_run, l_run, O, pk);
#pragma unroll
      for (int sp = 0; sp < 2; ++sp)
#pragma unroll
        for (int mb = 0; mb < 2; ++mb) {
          const bf16x8 vf = v_frag_tr(Vs + buf * VS_BUF, hs, mb, sp, lane);
          O[mb] = MFMA32(vf, pk[sp], O[mb]);
        }
    }
    if (j == 0) lstore(1, k1, v1);
    if (j == 1) lstore(0, k2, v2);
    if (j == 2) lstore(1, k3, v3);
    if (j == 3) lstore(0, k4, v4);
    if (j == 4) lstore(1, k5, v5);
    __syncthreads();
  }
  const size_t orow = (size_t)pat * NTOK + (size_t)b * S + tq;
  const float l = l_run + __shfl_xor(l_run, 32);
  if (hh == 0) p.lse[orow * 6 + head] = m_run + __log2f(l);
  local_store_out(O, l_run, p.odil + orow * 384 + head * 64, hh);
}

DI void combine_dil(KP p) {
  const int tid = otid();
  for (int tc = blockIdx.x; tc < 256; tc += gridDim.x) {
#pragma unroll 1
    for (int idx = tid; idx < 128 * 48; idx += NTHR) {
      const int tok = tc * 128 + idx / 48, c8 = idx % 48, head = c8 >> 3;
      float ls[3], wgt[3];
#pragma unroll
      for (int q = 0; q < 3; ++q) ls[q] = p.lse[((size_t)q * NTOK + tok) * 6 + head];
      const float mx = fmaxf(ls[0], fmaxf(ls[1], ls[2]));
      float sum = 0.f;
#pragma unroll
      for (int q = 0; q < 3; ++q) { wgt[q] = exp2_hw(ls[q] - mx); sum += wgt[q]; }
      const float isum = 1.f / sum;
      float acc[8];
#pragma unroll
      for (int e = 0; e < 8; ++e) acc[e] = 0.f;
#pragma unroll
      for (int q = 0; q < 3; ++q) {
        const uint4 v = *(const uint4*)(p.odil + ((size_t)q * NTOK + tok) * 384 + c8 * 8);
        const float wq = wgt[q] * isum;
        acc[0] += wq * bflo(v.x); acc[1] += wq * bfhi(v.x); acc[2] += wq * bflo(v.y); acc[3] += wq * bfhi(v.y);
        acc[4] += wq * bflo(v.z); acc[5] += wq * bfhi(v.z); acc[6] += wq * bflo(v.w); acc[7] += wq * bfhi(v.w);
      }
      *(uint4*)(p.o + (size_t)tok * 1024 + 256 + c8 * 8) = make_uint4(pack2(acc[0], acc[1]), pack2(acc[2], acc[3]), pack2(acc[4], acc[5]), pack2(acc[6], acc[7]));
    }
  }
}

constexpr int RPB_PAD = 48, RPB_LDS = 15 * 31 + 2 * RPB_PAD;
DI void na_attn_item(KP p, int layer, int item, u16* sm) {
  const int tid = otid(), lane = tid & 63, w = __builtin_amdgcn_readfirstlane(tid >> 6), r = lane & 31, hh = lane >> 5;
  u16* Ks = sm; u16* Vs = sm + 2 * KS_BUF;
  const int b = item / (6 * 64), rem = item % (6 * 64), head = rem / 64, g = rem % 64;
  auto rstart = [](int x) { int v = x - 4; return v < 0 ? 0 : (v > 248 ? 248 : v); };
  const int qra = 4 * g + 2 * (w >> 2), cgp = w & 3;
  const int qr = qra + (r >> 4), qc = 16 * cgp + (r & 15), tq = qr * 64 + qc;
  int kc0 = 16 * cgp - 8; kc0 = kc0 < 0 ? 0 : (kc0 > 32 ? 32 : kc0);
  const int wlo = rstart(qra), whi = rstart(qra + 1) + 8;
  const int rs_q = rstart(qr);
  const int rs_lo = rstart(4 * g), rs_hi = rstart(4 * g + 3) + 7;
  const u16* prow = p.proj + (size_t)b * S * NPROJ;
  const float* rpb = p.na_rpb + ((size_t)layer * 6 + head) * 15 * 31;
  bf16x8 qf[4];
#pragma unroll
  for (int s = 0; s < 4; ++s) qf[s] = *(const bf16x8*)(prow + (size_t)tq * NPROJ + 1920 + head * 64 + s * 16 + 8 * hh);
  int cs = qc - 8; cs = cs < 0 ? 0 : (cs > 48 ? 48 : cs);
  float* rtab = (float*)(sm + 2 * KS_BUF + 2 * VS_BUF);
  for (int i = tid; i < RPB_LDS; i += NTHR) { const int j = i - RPB_PAD; rtab[i] = (j >= 0 && j < 15 * 31) ? rpb[j] * LOG2E : 0.f; }
  const int vbase = kc0 + 4 * hh - cs;
  f32x16 O[2];
#pragma unroll
  for (int mb = 0; mb < 2; ++mb)
#pragma unroll
    for (int i = 0; i < 16; ++i) O[mb][i] = 0.f;
  float m_run = -1e20f, l_run = 0.f;
  uint4 kr, vr, kr2, vr2, kr3, vr3;
  const int key0 = tid >> 3, ch = tid & 7;
  const u16* kg = prow + (size_t)key0 * NPROJ + 2304 + head * 64 + ch * 8;
  auto gload = [&](int krow, uint4& kd, uint4& vd) __attribute__((always_inline)) {
    const u16* src = kg + (size_t)((krow > 255 ? 255 : krow) * 64) * NPROJ;
    kd = *(const uint4*)src; vd = *(const uint4*)(src + 384);
  };
  auto lstore = [&](int buf) __attribute__((always_inline)) {
    *(uint4*)(Ks + buf * KS_BUF + key0 * KS_STRIDE + ch * 8) = kr;
    *(uint4*)(Vs + buf * VS_BUF + key0 * VROW + ch * 8) = vr;
  };
  gload(rs_lo, kr, vr); lstore(0);
  gload(rs_lo + 1, kr, vr); gload(rs_lo + 2, kr2, vr2);
  __syncthreads();
  for (int krow = rs_lo; krow <= rs_hi; ++krow) {
    const int buf = (krow - rs_lo) & 1;
    gload(krow + 3, kr3, vr3);
    if (krow >= wlo && krow < whi) {
      f32x16 Sc;
#pragma unroll
      for (int i = 0; i < 16; ++i) Sc[i] = 0.f;
#pragma unroll
      for (int s = 0; s < 4; ++s) {
        const bf16x8 kf = *(const bf16x8*)(Ks + buf * KS_BUF + (kc0 + r) * KS_STRIDE + s * 16 + 8 * hh);
        Sc = MFMA32(kf, qf[s], Sc);
      }
      const float* rowp = rtab + RPB_PAD + (krow - qr + 7) * 31 + 15 + kc0 + 4 * hh - qc;
      const bool rowok = (unsigned)(krow - rs_q) < 8u;
      float sv[16];
#pragma unroll
      for (int i = 0; i < 16; ++i) {
        const int c = (i & 3) + 8 * (i >> 2);
        const bool valid = rowok && ((unsigned)(vbase + c) < 16u);
        sv[i] = valid ? (Sc[i] + rowp[c]) : NEGBIG;
      }
      bf16x8 pk[2];
      local_softmax_step1(sv, m_run, l_run, O, pk);
#pragma unroll
      for (int sp = 0; sp < 2; ++sp)
#pragma unroll
        for (int mb = 0; mb < 2; ++mb) {
          const bf16x8 vf = v_frag_tr(Vs + buf * VS_BUF, kc0, mb, sp, lane);
          O[mb] = MFMA32(vf, pk[sp], O[mb]);
        }
    }
    lstore(buf ^ 1);
    kr = kr2; vr = vr2; kr2 = kr3; vr2 = vr3;
    __syncthreads();
  }
  local_store_out(O, l_run, p.o + (size_t)(b * S + tq) * 1024 + 640 + head * 64, hh);
}

DI void kmax_item(KP p, int layer, int kidx) {
  const int tid = otid(); const int gid = kidx * NTHR + tid;
  const int row = gid >> 2, head = gid & 3, b = row >> 14;
  const uint4* kp = (const uint4*)(p.proj + (size_t)row * NPROJ + 256 + head * 64);
  float n0 = 0.f, n1 = 0.f;
#pragma unroll
  for (int c = 0; c < 8; ++c) {
    const uint4 v = kp[c];
    const unsigned e[4] = {v.x, v.y, v.z, v.w};
    float s = 0.f;
#pragma unroll
    for (int q = 0; q < 4; ++q) { const float a = bflo(e[q]), bq = bfhi(e[q]); s += a * a + bq * bq; }
    if (c >= 4) n1 += s; else n0 += s;
  }
#pragma unroll
  for (int o = 4; o <= 32; o <<= 1) { n0 = fmaxf(n0, __shfl_xor(n0, o)); n1 = fmaxf(n1, __shfl_xor(n1, o)); }
  if ((tid & 63) < 4) {
    unsigned* km = p.kmax + layer * 16 + (b * 4 + head) * 2;
    atomicMax(km, __float_as_uint(n0)); atomicMax(km + 1, __float_as_uint(n1));
  }
}

DI void phase_local(KP p, int layer, u16* sm) {
  constexpr int N_DIL = 2304, N_NA = 768, N_KM = 256;
  for (int it = blockIdx.x; it < N_DIL + N_NA + N_KM; it += gridDim.x) {
    __syncthreads();
    if (it < N_DIL) swin_attn_item(p, it, sm);
    else if (it < N_DIL + N_NA) na_attn_item(p, layer, it - N_DIL, sm);
    else kmax_item(p, layer, it - N_DIL - N_NA);
  }
}

constexpr int VL_STRIDE = 80;
constexpr int VL_BUF = 64 * VL_STRIDE;
DI void phase_diff(KP p, int layer, u16* sm) {
  combine_dil(p);
  const int tid = otid(), lane = tid & 63, w = __builtin_amdgcn_readfirstlane(tid >> 6), r = lane & 31, hh = lane >> 5;
  u16* Ks = sm; unsigned char* Vl = (unsigned char*)(sm + 2 * KS_BUF);
  float lam;
  {
    const float* dl = p.diff_lambda + layer * 128;
    float a = 0.f, c2 = 0.f;
    if (lane < 32) { a = dl[lane] * dl[32 + lane]; c2 = dl[64 + lane] * dl[96 + lane]; }
    a = wave_sum(a); c2 = wave_sum(c2);
    lam = __expf(a) - __expf(c2) + p.lam_init[layer];
  }
  const float lam_init = p.lam_init[layer];
  const float* sg = p.diff_subln + layer * 64;
  for (int it = blockIdx.x; it < 512; it += gridDim.x) {
    const int bh = it >> 6, qb = it & 63, b = bh >> 2, head = bh & 3;
    const u16* prow = p.proj + (size_t)b * S * NPROJ;
    const int tq = qb * 256 + w * 32 + r;
    bf16x8 qf[2][2];
    float qn[2];
#pragma unroll
    for (int m = 0; m < 2; ++m) {
      qn[m] = 0.f;
#pragma unroll
      for (int s = 0; s < 2; ++s) {
        qf[m][s] = *(const bf16x8*)(prow + (size_t)tq * NPROJ + head * 64 + m * 32 + s * 16 + 8 * hh);
#pragma unroll
        for (int j = 0; j < 8; ++j) { const float v = bf2f((u16)qf[m][s][j]); qn[m] += v * v; }
      }
      qn[m] += __shfl_xor(qn[m], 32);
    }
    float mbnd[2];
#pragma unroll
    for (int m = 0; m < 2; ++m) {
      const float km = __uint_as_float(p.kmax[layer * 16 + bh * 2 + m]);
      mbnd[m] = fmaxf(sqrtf(qn[m] * km) - 15.f, 0.f);
    }
    const bool noshift = __builtin_amdgcn_ballot_w64(mbnd[0] == 0.f && mbnd[1] == 0.f) == ~0ull;
    f32x16 O[2][2];
#pragma unroll
    for (int m = 0; m < 2; ++m)
#pragma unroll
      for (int mb = 0; mb < 2; ++mb)
#pragma unroll
        for (int i = 0; i < 16; ++i) O[m][mb][i] = 0.f;
    f32x16 L[2];
#pragma unroll
    for (int m = 0; m < 2; ++m)
#pragma unroll
      for (int i = 0; i < 16; ++i) L[m][i] = 0.f;
    v8i_t ones8;
#pragma unroll
    for (int v = 0; v < 8; ++v) ones8[v] = 0x38383838;
    uint4 kr, kr2, kr3; uint2 vr, vr2, vr3;
    const int key0 = tid >> 3, ch = tid & 7;
    const u16* kg = prow + (size_t)key0 * NPROJ + 256 + head * 64 + ch * 8;
    const unsigned char* vg = p.vt8 + ((size_t)bh * 64 + key0) * S + ch * 8;
    auto gload = [&](int kt, uint4& kd, uint2& vd) __attribute__((always_inline)) {
      kd = *(const uint4*)(kg + (size_t)((kt & 255) * 64) * NPROJ);
      vd = *(const uint2*)(vg + (kt & 255) * 64);
    };
    auto lstore = [&](int buf) __attribute__((always_inline)) {
      *(uint4*)(Ks + buf * KS_BUF + key0 * KS_STRIDE + ch * 8) = kr;
      unsigned char* vd = Vl + buf * VL_BUF + key0 * VL_STRIDE + 4 * ch;
      *(unsigned*)vd = vr.x; *(unsigned*)(vd + 32) = vr.y;
    };
    gload(0, kr, vr); lstore(0);
    gload(1, kr, vr); gload(2, kr2, vr2);
    __syncthreads();
    if (w >= 4) __builtin_amdgcn_s_setprio(1);
    auto tile_loop = [&](auto shifted) __attribute__((always_inline)) {
      constexpr bool SH = decltype(shifted)::value;
      for (int kt = 0; kt < 256; ++kt) {
        const int buf = kt & 1;
        gload(kt + 3, kr3, vr3);
        f32x16 Sc[2][2];
#pragma unroll
        for (int sub = 0; sub < 2; ++sub)
#pragma unroll
          for (int m = 0; m < 2; ++m) {
#pragma unroll
            for (int i = 0; i < 16; ++i) Sc[sub][m][i] = 0.f;
#pragma unroll
            for (int s = 0; s < 2; ++s) {
              const bf16x8 kf = *(const bf16x8*)(Ks + buf * KS_BUF + (sub * 32 + r) * KS_STRIDE + m * 32 + s * 16 + 8 * hh);
              Sc[sub][m] = MFMA32(kf, qf[m][s], Sc[sub][m]);
            }
          }
        v8i_t pf[2];
#pragma unroll
        for (int sub = 0; sub < 2; ++sub)
#pragma unroll
          for (int m = 0; m < 2; ++m)
#pragma unroll
            for (int g = 0; g < 4; ++g) {
              float pv[4];
#pragma unroll
              for (int e = 0; e < 4; ++e) pv[e] = exp2_hw(SH ? (Sc[sub][m][4 * g + e] - mbnd[m]) : Sc[sub][m][4 * g + e]);
              int wd = __builtin_amdgcn_cvt_pk_bf8_f32(pv[0], pv[1], 0, false);
              wd = __builtin_amdgcn_cvt_pk_bf8_f32(pv[2], pv[3], wd, true);
              pf[m][4 * sub + g] = wd;
            }
#pragma unroll
        for (int mb = 0; mb < 2; ++mb) {
          const v8i_t vf = *(const v8i_t*)(Vl + buf * VL_BUF + (mb * 32 + r) * VL_STRIDE + 32 * hh);
          O[0][mb] = __builtin_amdgcn_mfma_scale_f32_32x32x64_f8f6f4(vf, pf[0], O[0][mb], 0, 1, 0, 0x7F7F7F7F, 0, 0x7F7F7F7F);
          O[1][mb] = __builtin_amdgcn_mfma_scale_f32_32x32x64_f8f6f4(vf, pf[1], O[1][mb], 0, 1, 0, 0x7F7F7F7F, 0, 0x7F7F7F7F);
        }
        L[0] = __builtin_amdgcn_mfma_scale_f32_32x32x64_f8f6f4(ones8, pf[0], L[0], 0, 1, 0, 0x7F7F7F7F, 0, 0x7F7F7F7F);
        L[1] = __builtin_amdgcn_mfma_scale_f32_32x32x64_f8f6f4(ones8, pf[1], L[1], 0, 1, 0, 0x7F7F7F7F, 0, 0x7F7F7F7F);
        lstore(buf ^ 1);
        kr = kr2; vr = vr2; kr2 = kr3; vr2 = vr3;
        __syncthreads();
      }
    };
    if (noshift) tile_loop(std::false_type{}); else tile_loop(std::true_type{});
    __builtin_amdgcn_s_setprio(0);
    const float l0 = L[0][0], l1 = L[1][0];
    const float i0 = 1.f / l0, i1 = lam / l1;
    float ss = 0.f;
#pragma unroll
    for (int mb = 0; mb < 2; ++mb)
#pragma unroll
      for (int i = 0; i < 16; ++i) { const float v = O[0][mb][i] * i0 - O[1][mb][i] * i1; O[0][mb][i] = v; ss += v * v; }
    ss += __shfl_xor(ss, 32);
    const float inv = rsqrtf(ss * (1.f / 64.f) + 1e-6f) * (1.f - lam_init);
    u16* op = p.o + (size_t)(b * S + tq) * 1024 + head * 64;
#pragma unroll
    for (int mb = 0; mb < 2; ++mb)
#pragma unroll
      for (int g = 0; g < 4; ++g) {
        const int d = mb * 32 + 8 * g + 4 * hh;
        const float4 g4 = *(const float4*)(sg + d);
        *(uint2*)(op + d) = make_uint2(pack2(O[0][mb][4 * g] * inv * g4.x, O[0][mb][4 * g + 1] * inv * g4.y),
                                       pack2(O[0][mb][4 * g + 2] * inv * g4.z, O[0][mb][4 * g + 3] * inv * g4.w));
      }
  }
}

DI void phase_proj(KP p, int layer, LAS unsigned char* lds) {
  pg8::StaticOrder so; so.init(128, 12, gridDim.x, blockIdx.x);
  EpiProj e; e.proj = p.proj; e.vt8 = p.vt8;
  pg8::gemm_phase<pg8::AMapPlain>(lds, p.h, p.wt_in + (size_t)layer * 3072 * 1024, 1024, so, e);
}
DI void phase_resid(const u16* A, int K, const u16* Bt, const float* xold, float* xnew, const float* gate, LAS unsigned char* lds) {
  pg8::StaticOrder so; so.init(128, 4, gridDim.x, blockIdx.x);
  EpiResid e; e.xold = xold; e.xnew = xnew; e.gate = gate;
  pg8::gemm_phase<pg8::AMapPlain>(lds, A, Bt, K, so, e);
}
DI void phase_up(KP p, int layer, LAS unsigned char* lds) {
  pg8::StaticOrder so; so.init(134, 22, gridDim.x, blockIdx.x);
  EpiUp e; e.act = p.act; e.cw = p.conv_w + (size_t)layer * 3 * DFF; e.cb = p.conv_b + (size_t)layer * DFF;
  pg8::gemm_phase<pg8::AMapHalo>(lds, p.h, p.wt_up + (size_t)layer * 5632 * 1024, 1024, so, e);
}

constexpr int N_PHASES = 18;

DI void run_phase(KP p, int ph, unsigned char* smraw) {
  u16* sm = (u16*)smraw;
  LAS unsigned char* lds = (LAS unsigned char*)smraw;
  if (ph == 0) { phase_prep(p, (float*)smraw); return; }
  if (ph == 17) { phase_norm<1>(p.out, p.g_final, nullptr, 0, 0, nullptr, p.out); return; }
  const int layer = (ph - 1) >> 3, sub = (ph - 1) & 7;
  const float* modl = p.mod + layer * 2 * 6144;
  const float* xcur = (layer == 0) ? p.x : p.out;
  switch (sub) {
    case 0: phase_norm<0>(xcur, p.g_attn + layer * 1024, modl, 0, 1024, p.h, nullptr); break;
    case 1: phase_proj(p, layer, lds); break;
    case 2: phase_local(p, layer, sm); break;
    case 3: phase_diff(p, layer, sm); break;
    case 4: phase_resid(p.o, 1024, p.wt_out + (size_t)layer * 1024 * 1024, xcur, p.out, modl + 2048, lds); break;
    case 5: phase_norm<0>(p.out, p.g_ffn + layer * 1024, modl, 3072, 4096, p.h, nullptr); break;
    case 6: phase_up(p, layer, lds); break;
    case 7: phase_resid(p.act, DFF, p.wt_down + (size_t)layer * 1024 * DFF, p.out, p.out, modl + 5120, lds); break;
  }
}

__global__ void __launch_bounds__(NTHR, 2) mega_kernel(Params p) {
  extern __shared__ __attribute__((aligned(16))) unsigned char smraw[];
#if COOP
  cg::grid_group grid = cg::this_grid();
  u16* sm = (u16*)smraw;
  LAS unsigned char* lds = (LAS unsigned char*)smraw;
  if (threadIdx.x == 0) *(uint4*)(smraw + LDS_BYTES) = make_uint4(0u, 0u, 0u, 0u);
  __syncthreads();
  const XcdBarrier xb = xcd_barrier_post(kp_fresh()->bar, (volatile LAS unsigned*)(smraw + LDS_BYTES));
  phase_prep(*kp_fresh(), (float*)smraw);
  grid.sync();
#pragma unroll 1
  for (int layer = 0; layer < 2; ++layer) {
    { KP q = *kp_fresh(); phase_norm<0>((layer == 0) ? q.x : q.out, q.g_attn + layer * 1024, q.mod + layer * 2 * 6144, 0, 1024, q.h, nullptr); } xcd_barrier(xb);
    phase_proj(*kp_fresh(), layer, lds); xcd_barrier(xb);
    phase_local(*kp_fresh(), layer, sm); xcd_barrier(xb);
    phase_diff(*kp_fresh(), layer, sm); xcd_barrier(xb);
    { KP q = *kp_fresh(); phase_resid(q.o, 1024, q.wt_out + (size_t)layer * 1024 * 1024, (layer == 0) ? q.x : q.out, q.out, q.mod + layer * 2 * 6144 + 2048, lds); } xcd_barrier(xb);
    { KP q = *kp_fresh(); phase_norm<0>(q.out, q.g_ffn + layer * 1024, q.mod + layer * 2 * 6144, 3072, 4096, q.h, nullptr); } xcd_barrier(xb);
    phase_up(*kp_fresh(), layer, lds); xcd_barrier(xb);
    { KP q = *kp_fresh(); phase_resid(q.act, DFF, q.wt_down + (size_t)layer * 1024 * DFF, q.out, q.out, q.mod + layer * 2 * 6144 + 5120, lds); } xcd_barrier(xb);
  }
  { KP q = *kp_fresh(); phase_norm<1>(q.out, q.g_final, nullptr, 0, 0, nullptr, q.out); }
#else
  { KP q = *kp_fresh(); for (int ph = q.ph_lo; ph < q.ph_hi; ++ph) run_phase(q, ph, smraw); }
#endif
}

extern "C" void kernel_launch(void* const* d_in, const int* in_sizes, int n_in, void* d_out, int out_size, void* d_ws, size_t ws_size, hipStream_t stream) {
  (void)in_sizes; (void)n_in; (void)out_size;
  Params p;
  memset(&p, 0, sizeof(p));
  p.x = (const float*)d_in[0]; p.c = (const float*)d_in[1]; p.w_ada = (const float*)d_in[2]; p.b_ada = (const float*)d_in[3];
  p.g_attn = (const float*)d_in[4]; p.w_in = (const float*)d_in[5]; p.diff_lambda = (const float*)d_in[6]; p.diff_subln = (const float*)d_in[7];
  p.na_rpb = (const float*)d_in[8]; p.w_out = (const float*)d_in[9]; p.g_ffn = (const float*)d_in[10]; p.w_up = (const float*)d_in[11];
  p.conv_w = (const float*)d_in[12]; p.conv_b = (const float*)d_in[13]; p.w_down = (const float*)d_in[14]; p.g_final = (const float*)d_in[15];
  p.out = (float*)d_out;
  char* ws = (char*)d_ws; size_t off = 0;
  auto take = [&](size_t bytes) { char* q = ws + off; off += (bytes + 255) & ~(size_t)255; return q; };
  p.wt_in = (u16*)take((size_t)2 * 3072 * 1024 * 2);
  p.wt_out = (u16*)take((size_t)2 * 1024 * 1024 * 2);
  p.wt_up = (u16*)take((size_t)2 * 5632 * 1024 * 2);
  p.wt_down = (u16*)take((size_t)2 * 1024 * 2816 * 2);
  p.mod = (float*)take((size_t)2 * 2 * 6144 * 4);
  p.kmax = (unsigned*)take(256);
  p.bar = (unsigned*)take((size_t)XCD_BAR_WORDS * 4);
  (void)take(4096);
  p.h = (u16*)take((size_t)NTOK * 1024 * 2);
  p.o = (u16*)take((size_t)NTOK * 1024 * 2);
  p.proj = (u16*)take((size_t)NTOK * NPROJ * 2);
  p.odil = (u16*)take((size_t)3 * NTOK * 384 * 2);
  p.lse = (float*)take((size_t)3 * NTOK * 6 * 4);
  p.vt8 = (unsigned char*)take((size_t)2 * 4 * 64 * S);
  p.act = p.proj;
  if (off > ws_size) { fprintf(stderr, "workspace too small: need %zu have %zu\n", off, ws_size); return; }
  p.lam_init[0] = 0.2f; p.lam_init[1] = 0.35550906759096934f;
  static int grid_blocks = 0;
  if (!grid_blocks) {
    int dev = 0, cus = 0, per_cu = 0;
    (void)hipGetDevice(&dev);
    (void)hipDeviceGetAttribute(&cus, hipDeviceAttributeMultiprocessorCount, dev);
    (void)hipFuncSetAttribute((const void*)mega_kernel, hipFuncAttributeMaxDynamicSharedMemorySize, LDS_BYTES + 16);
    (void)hipOccupancyMaxActiveBlocksPerMultiprocessor(&per_cu, mega_kernel, NTHR, LDS_BYTES + 16);
    if (per_cu > 1) per_cu = 1;
    if (per_cu < 1) per_cu = 1;
    grid_blocks = cus * per_cu;
  }
#if COOP
  p.ph_lo = 0; p.ph_hi = N_PHASES;
  (void)hipMemsetAsync(p.bar, 0, (size_t)XCD_BAR_WORDS * 4, stream);
  void* args[] = {&p};
  hipError_t e = hipLaunchCooperativeKernel((void*)mega_kernel, dim3(grid_blocks), dim3(NTHR), args, LDS_BYTES + 16, stream);
  if (e != hipSuccess) fprintf(stderr, "cooperative launch failed: %s (grid %d)\n", hipGetErrorString(e), grid_blocks);
#else
  for (int ph = 0; ph < N_PHASES; ++ph) {
    p.ph_lo = ph; p.ph_hi = ph + 1;
    hipLaunchKernelGGL(mega_kernel, dim3(grid_blocks), dim3(NTHR), LDS_BYTES + 16, stream, p);
  }
#endif
}
```

```cpp
#include <hip/hip_runtime.h>
#include <hip/hip_cooperative_groups.h>
#include <cstdio>
#include <cstring>
#include <type_traits>
namespace cg = cooperative_groups;

#ifndef COOP
#define COOP 1
#endif

#define DI __device__ __forceinline__
#define LAS __attribute__((address_space(3)))
typedef unsigned short u16;
using bf16x8 = __attribute__((ext_vector_type(8))) short;
using s16x4  = __attribute__((ext_vector_type(4))) short;
using f32x16 = __attribute__((ext_vector_type(16))) float;
using f32x4  = __attribute__((ext_vector_type(4))) float;
typedef int v8i_t __attribute__((ext_vector_type(8)));
typedef __bf16 bf2_t __attribute__((ext_vector_type(2)));
typedef float f2_t __attribute__((ext_vector_type(2)));
#define MFMA32(a, b, c) __builtin_amdgcn_mfma_f32_32x32x16_bf16((a), (b), (c), 0, 0, 0)

constexpr int S = 16384, NTOK = 32768, DFF = 2816, NPROJ = 3072;
constexpr int NTHR = 512, NWAVE = 8;
constexpr float LOG2E = 1.4426950408889634f;
constexpr float QSCALE_DIFF = 0.25503486164919736f;
constexpr float QSCALE_64   = 0.18033688011112042f;
constexpr float NEGBIG = -1e30f;
constexpr int LDS_BYTES = 131072;

__device__ const float ROPE_INV16[16] = {
1.000000000e+00f, 5.623413324e-01f, 3.162277639e-01f, 1.778279394e-01f, 1.000000015e-01f, 5.623413250e-02f, 3.162277490e-02f, 1.778279431e-02f, 9.999999776e-03f, 5.623413250e-03f, 3.162277630e-03f, 1.778279431e-03f, 1.000000047e-03f, 5.623413017e-04f, 3.162277571e-04f, 1.778279402e-04f};
__device__ const float ROPE_INV32[32] = {
1.000000000e+00f, 7.498942018e-01f, 5.623413324e-01f, 4.216965139e-01f, 3.162277639e-01f, 2.371373773e-01f, 1.778279394e-01f, 1.333521456e-01f, 1.000000015e-01f, 7.498942316e-02f, 5.623413250e-02f, 4.216964915e-02f, 3.162277490e-02f, 2.371373773e-02f, 1.778279431e-02f, 1.333521400e-02f, 9.999999776e-03f, 7.498942316e-03f, 5.623413250e-03f, 4.216964822e-03f, 3.162277630e-03f, 2.371373819e-03f, 1.778279431e-03f, 1.333521446e-03f, 1.000000047e-03f, 7.498941850e-04f, 5.623413017e-04f, 4.216965172e-04f, 3.162277571e-04f, 2.371373703e-04f, 1.778279402e-04f, 1.333521504e-04f};

struct Params {
  const float *x, *c, *w_ada, *b_ada, *g_attn, *w_in, *diff_lambda, *diff_subln, *na_rpb, *w_out, *g_ffn, *w_up, *conv_w, *conv_b, *w_down, *g_final;
  float* out;
  u16 *wt_in, *wt_out, *wt_up, *wt_down;
  float* mod;
  unsigned* kmax;
  unsigned* bar;
  u16 *h, *o, *proj, *act, *odil;
  unsigned char* vt8;
  float* lse;
  float lam_init[2];
  int ph_lo, ph_hi;
};

typedef const __attribute__((address_space(4))) Params& KP;
DI const __attribute__((address_space(4))) Params* kp_fresh() {
  const __attribute__((address_space(4))) Params* q = (const __attribute__((address_space(4))) Params*)__builtin_amdgcn_kernarg_segment_ptr();
  asm volatile("" : "+s"(q));
  return q;
}
DI unsigned pack2(float a, float b) { f2_t v = {a, b}; return __builtin_bit_cast(unsigned, __builtin_convertvector(v, bf2_t)); }
DI float bf2f(u16 v) { return __uint_as_float(((unsigned)v) << 16); }
DI float bflo(unsigned v) { return __uint_as_float(v << 16); }
DI float bfhi(unsigned v) { return __uint_as_float(v & 0xffff0000u); }
DI int crow(int i, int hh) { return (i & 3) + 8 * (i >> 2) + 4 * hh; }
DI float exp2_hw(float x) { return __builtin_amdgcn_exp2f(x); }
DI int otid() { int t = threadIdx.x; asm volatile("" : "+v"(t)); return t; }


#define XB_TMO      128
#define XB_XCNT(j)  (256  + 64 * (j))
#define XB_XSUB(j)  (1280 + 64 * (j))
#define XB_XGEN(j)  (2304 + 64 * (j))
#define XB_TOP      3328
#define XB_TOPGEN   3392
#define XCD_BAR_WORDS 3456
#define XB_SPIN_CAP (1u << 21)
DI unsigned xb_ld(unsigned* p)              { return __hip_atomic_load(p, __ATOMIC_RELAXED, __HIP_MEMORY_SCOPE_AGENT); }
DI unsigned xb_add(unsigned* p, unsigned v) { return __hip_atomic_fetch_add(p, v, __ATOMIC_RELAXED, __HIP_MEMORY_SCOPE_AGENT); }
DI unsigned xb_xcc_id() { return (unsigned)__builtin_amdgcn_s_getreg((3 << 11) | 20) & 0xFu; }
#define XB_SPIN(cond, bar) do { unsigned _sp = 0; while (cond) { __builtin_amdgcn_s_sleep(1); \
    if ((++_sp & 255u) == 0u) { if (xb_ld(&(bar)[XB_TMO])) break; if (_sp > XB_SPIN_CAP) { atomicAdd(&(bar)[XB_TMO], 1u); break; } } } } while (0)
struct XcdBarrier { unsigned* bar; unsigned x; volatile LAS unsigned* st; };
DI XcdBarrier xcd_barrier_post(unsigned* bar, volatile LAS unsigned* st) {
  XcdBarrier b; b.bar = bar; b.x = xb_xcc_id(); b.st = st;
  if (threadIdx.x == 0) (void)xb_add(&bar[XB_XCNT(b.x)], 1u);
  return b;
}
DI void xcd_barrier_complete(unsigned* bar, unsigned x, unsigned& nloc, unsigned& nx) {
  const unsigned G = gridDim.x * gridDim.y * gridDim.z;
  unsigned sum, cnt, mine, sp = 0u;
  for (;;) {
    sum = 0u; cnt = 0u; mine = 0u;
#pragma unroll
    for (unsigned j = 0; j < 16; ++j) { const unsigned c = xb_ld(&bar[XB_XCNT(j)]); sum += c; cnt += (c > 0u) ? 1u : 0u; mine = (j == x) ? c : mine; }
    if (sum == G) break;
    __builtin_amdgcn_s_sleep(1);
    if ((++sp & 255u) == 0u) { if (xb_ld(&bar[XB_TMO])) break; if (sp > XB_SPIN_CAP) { atomicAdd(&bar[XB_TMO], 1u); break; } }
  }
  nloc = mine > 0u ? mine : 1u; nx = cnt > 0u ? cnt : 1u;
}
DI void xcd_barrier(const XcdBarrier& b) {
  asm volatile("s_waitcnt vmcnt(0)" ::: "memory");
  __syncthreads();
  if (threadIdx.x == 0) {
    unsigned* bar = b.bar;
    __builtin_amdgcn_s_waitcnt(0);
    unsigned nloc = b.st[0], nx = b.st[1];
    if (nloc == 0u) { xcd_barrier_complete(bar, b.x, nloc, nx); b.st[0] = nloc; b.st[1] = nx; }
    const unsigned old = xb_add(&bar[XB_XSUB(b.x)], 1u);
    const unsigned gen = old / nloc;
    if (old + 1u == (gen + 1u) * nloc) {
      __builtin_amdgcn_fence(__ATOMIC_RELEASE, "agent");
      asm volatile("s_waitcnt vmcnt(0)" ::: "memory");
      const unsigned og = xb_add(&bar[XB_TOP], 1u);
      const unsigned tg = og / nx;
      if (og + 1u == (tg + 1u) * nx) xb_add(&bar[XB_TOPGEN], 1u);
      else XB_SPIN(xb_ld(&bar[XB_TOPGEN]) == tg, bar);
      __builtin_amdgcn_fence(__ATOMIC_ACQUIRE, "agent");
      xb_add(&bar[XB_XGEN(b.x)], 1u);
      asm volatile("s_waitcnt vmcnt(0)" ::: "memory");
    } else {
      XB_SPIN(xb_ld(&bar[XB_XGEN(b.x)]) == gen, bar);
      __builtin_amdgcn_fence(__ATOMIC_ACQUIRE, "agent");
      asm volatile("s_waitcnt vmcnt(0)" ::: "memory");
    }
  }
  __syncthreads();
}

DI int wmap_in(int np) {
  if (np >= 768 && np < 1536) { const int hb = np & ~63, w = np & 63, g = w >> 5, n = (w >> 4) & 1, i = w & 15; return hb + 16 * g + i + 32 * n; }
  return np;
}
DI int wmap_up(int np) {
  const int pn = np >> 8, w = np & 255, bj = w >> 7, q = w & 127;
  return bj ? (DFF + 128 * pn + q) : (128 * pn + q);
}

DI void phase_prep(KP p, float* smf) {
  const int tid = otid();
  if (blockIdx.x == 0 && tid < 64) p.kmax[tid] = 0u;
  constexpr int N_ADA = 192;
  constexpr int T_IN = 16 * 24, T_OUT = 16 * 8, T_UP = 16 * 44, T_DOWN = 44 * 8;
  constexpr int T_LAYER = T_IN + T_OUT + T_UP + T_DOWN;
  const int total = N_ADA + 2 * T_LAYER;
  for (int it = blockIdx.x; it < total; it += gridDim.x) {
    if (it < N_ADA) {
      const int l = it / 96, cgp = it % 96;
      float* sc = smf;
      float* red = smf + 2048;
      for (int i = tid; i < 2048; i += NTHR) { float v = p.c[i]; sc[i] = v / (1.f + __expf(-v)); }
      __syncthreads();
      const int kq = tid >> 6, cc = tid & 63, col = cgp * 64 + cc;
      const float* wp = p.w_ada + ((size_t)l * 1024 + kq * 128) * 6144 + col;
      float a0 = 0.f, a1 = 0.f;
#pragma unroll 32
      for (int k = 0; k < 128; ++k) { float w = wp[(size_t)k * 6144]; a0 += sc[kq * 128 + k] * w; a1 += sc[1024 + kq * 128 + k] * w; }
      red[(kq * 2 + 0) * 64 + cc] = a0; red[(kq * 2 + 1) * 64 + cc] = a1;
      __syncthreads();
      if (tid < 128) {
        const int b = tid >> 6, c2 = tid & 63;
        float s = 0.f;
#pragma unroll
        for (int q = 0; q < 8; ++q) s += red[(q * 2 + b) * 64 + c2];
        p.mod[(l * 2 + b) * 6144 + cgp * 64 + c2] = s + p.b_ada[l * 6144 + cgp * 64 + c2];
      }
    } else {
      int idx = it - N_ADA; const int l = idx / T_LAYER; int j = idx % T_LAYER;
      const float* W; u16* dst; int Kd, N, tk, tn, kind;
      if (j < T_IN) { W = p.w_in + (size_t)l * 1024 * 3072; dst = p.wt_in + (size_t)l * 3072 * 1024; Kd = 1024; N = 3072; tk = j / 24; tn = j % 24; kind = 0; }
      else if (j < T_IN + T_OUT) { j -= T_IN; W = p.w_out + (size_t)l * 1024 * 1024; dst = p.wt_out + (size_t)l * 1024 * 1024; Kd = 1024; N = 1024; tk = j / 8; tn = j % 8; kind = 1; }
      else if (j < T_IN + T_OUT + T_UP) { j -= T_IN + T_OUT; W = p.w_up + (size_t)l * 1024 * 5632; dst = p.wt_up + (size_t)l * 5632 * 1024; Kd = 1024; N = 5632; tk = j / 44; tn = j % 44; kind = 2; }
      else { j -= T_IN + T_OUT + T_UP; W = p.w_down + (size_t)l * 2816 * 1024; dst = p.wt_down + (size_t)l * 1024 * 2816; Kd = 2816; N = 1024; tk = j / 8; tn = j % 8; kind = 3; }
      const int hb = tid >> 8, t = tid & 255;
      const int k0 = tk * 64, n0 = (tn * 2 + hb) * 64;
      float* tile = smf + hb * (64 * 65);
      const int nn = t & 63;
      const int np = n0 + nn;
      const int srccol = (kind == 0) ? wmap_in(np) : (kind == 2) ? wmap_up(np) : np;
      float wv[16];
#pragma unroll
      for (int i = 0; i < 16; ++i) wv[i] = W[(size_t)(k0 + i * 4 + (t >> 6)) * N + srccol];
#pragma unroll
      for (int i = 0; i < 16; ++i) tile[(i * 4 + (t >> 6)) * 65 + nn] = wv[i];
      __syncthreads();
      const int nrow = t >> 2, kc = (t & 3) * 16;
      unsigned pk[8];
#pragma unroll
      for (int q = 0; q < 8; ++q) pk[q] = pack2(tile[(kc + 2 * q) * 65 + nrow], tile[(kc + 2 * q + 1) * 65 + nrow]);
      uint4* dp = (uint4*)(dst + (size_t)(n0 + nrow) * Kd + k0 + kc);
      dp[0] = make_uint4(pk[0], pk[1], pk[2], pk[3]);
      dp[1] = make_uint4(pk[4], pk[5], pk[6], pk[7]);
    }
    __syncthreads();
  }
}

DI float wave_sum(float v) {
#pragma unroll
  for (int o = 32; o >= 1; o >>= 1) v += __shfl_xor(v, o);
  return v;
}

template <int MODE>
DI void phase_norm(const float* xin, const float* g, const float* modl, int sh_off, int sc_off, u16* hout, float* fout) {
  const int tid = otid(); const int lane = tid & 63, w = tid >> 6;
  for (int row = blockIdx.x * NWAVE + w; row < NTOK; row += gridDim.x * NWAVE) {
    const int b = row >> 14;
    const float4* xr = (const float4*)(xin + (size_t)row * 1024);
    float4 v[4];
#pragma unroll
    for (int i = 0; i < 4; ++i) v[i] = xr[lane + i * 64];
    float ss = 0.f;
#pragma unroll
    for (int i = 0; i < 4; ++i) ss += v[i].x * v[i].x + v[i].y * v[i].y + v[i].z * v[i].z + v[i].w * v[i].w;
    ss = wave_sum(ss);
    const float inv = rsqrtf(ss * (1.f / 1024.f) + 1e-6f);
#pragma unroll
    for (int i = 0; i < 4; ++i) {
      const int col = (lane + i * 64) * 4;
      const float4 g4 = *(const float4*)(g + col);
      if (MODE == 0) {
        const float4 sc4 = *(const float4*)(modl + b * 6144 + sc_off + col);
        const float4 sh4 = *(const float4*)(modl + b * 6144 + sh_off + col);
        float y0 = v[i].x * inv * g4.x * (1.f + sc4.x) + sh4.x;
        float y1 = v[i].y * inv * g4.y * (1.f + sc4.y) + sh4.y;
        float y2 = v[i].z * inv * g4.z * (1.f + sc4.z) + sh4.z;
        float y3 = v[i].w * inv * g4.w * (1.f + sc4.w) + sh4.w;
        *(uint2*)(hout + (size_t)row * 1024 + col) = make_uint2(pack2(y0, y1), pack2(y2, y3));
      } else {
        float4 y; y.x = v[i].x * inv * g4.x; y.y = v[i].y * inv * g4.y; y.z = v[i].z * inv * g4.z; y.w = v[i].w * inv * g4.w;
        *(float4*)(fout + (size_t)row * 1024 + col) = y;
      }
    }
  }
}

namespace pg8 {
constexpr int BM = 256, BK = 64, HALF = 128, HTB = HALF * BK * 2, NXCD = 8, WGM = 8;
DI int lds_byte(int r, int c) { const int st = (r >> 4) * 2 + (c >> 5), rr = r & 15, cc = c & 31, ob = rr * 64 + cc * 2; return st * 1024 + (ob ^ (((ob >> 9) & 1) << 5)); }
DI void stage_rc(int b, int& R, int& C) { const int st = b / 1024, sb = b % 1024, swz = sb ^ (((sb >> 9) & 1) << 5); R = (st >> 1) * 16 + swz / 64; C = (st & 1) * 32 + (swz % 64) / 2; }
struct Unit { int pm, pn; };
struct StaticOrder {
  int nM, nN, nwg, G, c;
  DI void init(int nM_, int nN_, int G_, int c_) { nM = nM_; nN = nN_; nwg = nM * nN; G = G_; c = c_; }
  DI bool next(int i, Unit& u) const {
    const long L = (long)i * G + c; if (L >= nwg) return false;
    int wgid = (int)L; { const int q = nwg / NXCD, r = nwg % NXCD, xcd = wgid % NXCD, off = wgid / NXCD; wgid = (xcd < r ? xcd * (q + 1) : r * (q + 1) + (xcd - r) * q) + off; }
    const int nig = WGM * nN, gid = wgid / nig, fm = gid * WGM, gsz = (nM - fm) < WGM ? (nM - fm) : WGM;
    u.pm = fm + ((wgid % nig) % gsz); u.pn = (wgid % nig) / gsz; return true;
  }
};
struct AMapPlain { static constexpr int HALF_ROWS = 128; static DI int row(int R) { return R; } static DI long tile_row0(int pm) { return (long)pm * 256; } };
struct AMapHalo  { static constexpr int HALF_ROWS = 124; static DI int row(int R) { return 62 * (R >> 6) + (R & 63); } static DI long tile_row0(int pm) { const int b = pm / 67, ti = pm % 67; return (long)b * S + 248 * ti - 1; } };

template <class AMap, class Epi>
DI void gemm_phase(LAS unsigned char* lds, const u16* Aptr, const u16* Btptr, int K, const StaticOrder& SO, const Epi& E) {
  const int tid = otid(), wid = __builtin_amdgcn_readfirstlane(tid >> 6), lane = tid & 63, wr = wid >> 2, wc = wid & 3, fr = lane & 15, fq = lane >> 4;
  const int nt = K / BK;
  unsigned voffA[2], voffB[2];
#pragma unroll
  for (int i = 0; i < 2; ++i) { int R, C; stage_rc(tid * 16 + i * 8192, R, C);
    voffA[i] = (unsigned)(AMap::row(R) * K + C) * 2u; voffB[i] = (unsigned)(R * K + C) * 2u; }
  const size_t kstep = (size_t)(BK * 2);
  const size_t hstepA = (size_t)AMap::HALF_ROWS * K * 2, hstepB = (size_t)HALF * K * 2;
  const size_t tstepB = 2 * hstepB;
  const size_t rowB = (size_t)K * 2;
  const unsigned ldsw = (unsigned)wid * 1024u;
  const int aoff = lds_byte(wr * 64 + fr, fq * 8), boff = lds_byte(wc * 32 + fr, fq * 8);
#define PG8_SA(b, h) (((b) * 2 + (h)) * HTB)
#define PG8_SB(b, h) ((4 + (b) * 2 + (h)) * HTB)
#define PG8_STAGE(bufoff, gbase, voff) do { _Pragma("unroll") for (int _i = 0; _i < 2; ++_i) \
        __builtin_amdgcn_global_load_lds((const unsigned*)((const char*)(gbase) + (voff)[_i]), (LAS unsigned*)(lds + (bufoff) + ldsw + _i * 8192), 16, 0, 0); } while (0)
#define PG8_LDA(dst, b, h) do { _Pragma("unroll") for (int m = 0; m < 4; ++m) _Pragma("unroll") for (int k = 0; k < 2; ++k) dst[m][k] = *(const LAS bf16x8*)(lds + PG8_SA(b, h) + aoff + m * 2048 + k * 1024); } while (0)
#define PG8_LDB(dst, b, h) do { _Pragma("unroll") for (int n = 0; n < 2; ++n) _Pragma("unroll") for (int k = 0; k < 2; ++k) dst[n][k] = *(const LAS bf16x8*)(lds + PG8_SB(b, h) + boff + n * 2048 + k * 1024); } while (0)
#define PG8_MMA(ai, bj, At, Bt) do { __builtin_amdgcn_s_setprio(1); _Pragma("unroll") for (int m = 0; m < 4; ++m) _Pragma("unroll") for (int n = 0; n < 2; ++n) _Pragma("unroll") for (int k = 0; k < 2; ++k) \
        acc[ai][bj][m][n] = __builtin_amdgcn_mfma_f32_16x16x32_bf16(Bt[n][k], At[m][k], acc[ai][bj][m][n], 0, 0, 0); __builtin_amdgcn_s_setprio(0); } while (0)
#define PG8_WAIT_V(n) asm volatile("s_waitcnt vmcnt(" #n ")" ::: "memory")
#define PG8_WAIT_L(n) asm volatile("s_waitcnt lgkmcnt(" #n ")" ::: "memory")
#define PG8_BAR __builtin_amdgcn_s_barrier()
#define PG8_SCHED __builtin_amdgcn_sched_barrier(0)
  Unit cur, nxt; int ui = 0;
  if (!SO.next(0, cur)) return;
  f32x4 acc[2][2][4][2];
#pragma unroll
  for (int a = 0; a < 2; ++a)
#pragma unroll
    for (int b = 0; b < 2; ++b)
#pragma unroll
      for (int m = 0; m < 4; ++m)
#pragma unroll
        for (int n = 0; n < 2; ++n) acc[a][b][m][n] = (f32x4){0.f, 0.f, 0.f, 0.f};
  bf16x8 At[4][2], B0[2][2], B1[2][2];
  const char* cA = (const char*)Aptr + AMap::tile_row0(cur.pm) * (long)rowB; const char* cB = (const char*)Btptr + (size_t)cur.pn * tstepB;
  PG8_STAGE(PG8_SB(0, 0), cB, voffB); PG8_STAGE(PG8_SA(0, 0), cA, voffA); PG8_STAGE(PG8_SB(0, 1), cB + hstepB, voffB); PG8_STAGE(PG8_SA(0, 1), cA + hstepA, voffA);
  if (wr == 1) PG8_BAR;
  PG8_WAIT_V(4); PG8_BAR;
  PG8_STAGE(PG8_SB(1, 0), cB + kstep, voffB); PG8_STAGE(PG8_SA(1, 0), cA + kstep, voffA); PG8_STAGE(PG8_SB(1, 1), cB + hstepB + kstep, voffB);
  PG8_WAIT_V(6); PG8_BAR;
  for (;;) {
    const bool has_next = SO.next(ui + 1, nxt);
    const char* nA = has_next ? (const char*)Aptr + AMap::tile_row0(nxt.pm) * (long)rowB : cA; const char* nB = has_next ? (const char*)Btptr + (size_t)nxt.pn * tstepB : cB;
    for (int t = 0; t < nt; t += 2) {
      const bool last = (t == nt - 2);
      const char* a1 = cA + (size_t)(t + 1) * kstep;
      const char* a2 = last ? nA : cA + (size_t)(t + 2) * kstep; const char* b2 = last ? nB : cB + (size_t)(t + 2) * kstep;
      const char* a3 = a2 + kstep; const char* b3 = b2 + kstep;
      PG8_LDB(B0, 0, 0); PG8_SCHED; PG8_LDA(At, 0, 0); PG8_STAGE(PG8_SA(1, 1), a1 + hstepA, voffA);
      PG8_WAIT_L(8); PG8_BAR; PG8_WAIT_L(0); PG8_MMA(0, 0, At, B0); PG8_BAR; PG8_SCHED;
      PG8_LDB(B1, 0, 1); PG8_STAGE(PG8_SB(0, 0), b2, voffB);
      PG8_BAR; PG8_WAIT_L(0); PG8_MMA(0, 1, At, B1); PG8_BAR;
      PG8_LDA(At, 0, 1); PG8_STAGE(PG8_SA(0, 0), a2, voffA);
      PG8_BAR; PG8_WAIT_L(0); PG8_MMA(1, 0, At, B0); PG8_BAR; PG8_SCHED;
      PG8_STAGE(PG8_SB(0, 1), b2 + hstepB, voffB);
      PG8_WAIT_V(6); PG8_BAR; PG8_MMA(1, 1, At, B1); PG8_BAR;
      PG8_LDB(B0, 1, 0); PG8_SCHED; PG8_LDA(At, 1, 0); PG8_STAGE(PG8_SA(0, 1), a2 + hstepA, voffA);
      PG8_WAIT_L(8); PG8_BAR; PG8_WAIT_L(0); PG8_MMA(0, 0, At, B0); PG8_BAR; PG8_SCHED;
      PG8_LDB(B1, 1, 1); PG8_STAGE(PG8_SB(1, 0), b3, voffB);
      PG8_BAR; PG8_WAIT_L(0); PG8_MMA(0, 1, At, B1); PG8_BAR;
      PG8_LDA(At, 1, 1); PG8_STAGE(PG8_SA(1, 0), a3, voffA);
      PG8_BAR; PG8_WAIT_L(0); PG8_MMA(1, 0, At, B0); PG8_BAR; PG8_SCHED;
      PG8_STAGE(PG8_SB(1, 1), b3 + hstepB, voffB);
      PG8_WAIT_V(6); PG8_BAR; PG8_MMA(1, 1, At, B1); PG8_BAR;
    }
    E(acc, cur, wr, wc, fr, fq);
    if (!has_next) break;
#pragma unroll
    for (int a = 0; a < 2; ++a)
#pragma unroll
      for (int b = 0; b < 2; ++b)
#pragma unroll
        for (int m = 0; m < 4; ++m)
#pragma unroll
          for (int n = 0; n < 2; ++n) acc[a][b][m][n] = (f32x4){0.f, 0.f, 0.f, 0.f};
    cur = nxt; cA = nA; cB = nB; ++ui;
  }
  PG8_WAIT_V(0);
  if (wr == 0) PG8_BAR;
  PG8_BAR;
#undef PG8_SA
#undef PG8_SB
#undef PG8_STAGE
#undef PG8_LDA
#undef PG8_LDB
#undef PG8_MMA
#undef PG8_WAIT_V
#undef PG8_WAIT_L
#undef PG8_BAR
#undef PG8_SCHED
}
}

DI void sincos_big(float ang, float& sn, float& cs) {
  const float c_hi = 1.591549367e-01f, c_lo = 6.420638243e-09f;
  const float rh = ang * c_hi;
  const float e = __builtin_fmaf(ang, c_hi, -rh);
  const float fr = rh - floorf(rh);
  const float rev = fr + (e + ang * c_lo);
  sn = __builtin_amdgcn_sinf(rev);
  cs = __builtin_amdgcn_cosf(rev);
}

struct EpiProj {
  u16* proj; unsigned char* vt8;
  DI void operator()(const f32x4 (&acc)[2][2][4][2], const pg8::Unit& u, int wr, int wc, int fr, int fq) const {
    const f32x4 i16 = *(const f32x4*)(ROPE_INV16 + 4 * fq);
    const f32x4 i32v = *(const f32x4*)(ROPE_INV32 + 16 * (wc & 1) + 4 * fq);
#pragma unroll
    for (int bj = 0; bj < 2; ++bj) {
      const int gcol0 = u.pn * 256 + bj * 128 + wc * 32;
      int mode; float scale = 1.f;
      if (gcol0 < 256) { mode = 1; scale = QSCALE_DIFF; }
      else if (gcol0 < 512) { mode = 1; }
      else if (gcol0 < 768) { mode = 0; }
      else if (gcol0 < 1152) { mode = 2; scale = QSCALE_64; }
      else if (gcol0 < 1536) { mode = 2; }
      else if (gcol0 < 1920) { mode = 0; }
      else if (gcol0 < 2304) { mode = 0; scale = QSCALE_64; }
      else { mode = 0; }
      f32x4 invv;
#pragma unroll
      for (int e = 0; e < 4; ++e) invv[e] = (mode == 1) ? i16[e] : i32v[e];
      int c1, c2;
      if (mode == 2) { const int hb = gcol0 & ~63, g = wc & 1; c1 = hb + 16 * g + 4 * fq; c2 = c1 + 32; }
      else { c1 = gcol0 + 4 * fq; c2 = c1 + 16; }
#pragma unroll
      for (int ai = 0; ai < 2; ++ai)
#pragma unroll
        for (int m = 0; m < 4; ++m) {
          const int row = u.pm * 256 + ai * 128 + wr * 64 + m * 16 + fr;
          f32x4 x1 = acc[ai][bj][m][0], x2 = acc[ai][bj][m][1];
          if (mode != 0) {
            const float pos = (float)(row & (S - 1));
#pragma unroll
            for (int e = 0; e < 4; ++e) {
              const float ang = __fmul_rn(pos, invv[e]);
              float sn, cs; sincos_big(ang, sn, cs);
              const float y1 = x1[e] * cs - x2[e] * sn, y2 = x2[e] * cs + x1[e] * sn;
              x1[e] = y1; x2[e] = y2;
            }
          }
          u16* dp = proj + (size_t)row * NPROJ;
          if (!(gcol0 >= 512 && gcol0 < 768)) {
            *(uint2*)(dp + c1) = make_uint2(pack2(x1[0] * scale, x1[1] * scale), pack2(x1[2] * scale, x1[3] * scale));
            *(uint2*)(dp + c2) = make_uint2(pack2(x2[0] * scale, x2[1] * scale), pack2(x2[2] * scale, x2[3] * scale));
          }
          if (gcol0 >= 512 && gcol0 < 768) {
            const int hd = (gcol0 - 512) >> 6, d0 = (gcol0 & 63) + 4 * fq;
            unsigned char* vp = vt8 + ((size_t)((row >> 14) * 4 + hd) * 64 + d0) * S + (row & (S - 1));
            const int w1a = __builtin_amdgcn_cvt_pk_fp8_f32(x1[0], x1[1], 0, false), w1b = __builtin_amdgcn_cvt_pk_fp8_f32(x1[2], x1[3], 0, false);
            const int w2a = __builtin_amdgcn_cvt_pk_fp8_f32(x2[0], x2[1], 0, false), w2b = __builtin_amdgcn_cvt_pk_fp8_f32(x2[2], x2[3], 0, false);
            vp[0] = (unsigned char)(w1a & 0xff); vp[(size_t)S] = (unsigned char)((w1a >> 8) & 0xff); vp[(size_t)2 * S] = (unsigned char)(w1b & 0xff); vp[(size_t)3 * S] = (unsigned char)((w1b >> 8) & 0xff);
            unsigned char* vq = vp + (size_t)16 * S;
            vq[0] = (unsigned char)(w2a & 0xff); vq[(size_t)S] = (unsigned char)((w2a >> 8) & 0xff); vq[(size_t)2 * S] = (unsigned char)(w2b & 0xff); vq[(size_t)3 * S] = (unsigned char)((w2b >> 8) & 0xff);
          }
        }
    }
  }
};

struct EpiResid {
  const float* xold; float* xnew; const float* gate;
  DI void operator()(const f32x4 (&acc)[2][2][4][2], const pg8::Unit& u, int wr, int wc, int fr, int fq) const {
    const int b = (u.pm * 256) >> 14;
    const int col0 = u.pn * 256 + wc * 32 + 4 * fq;
    f32x4 gv[2][2];
#pragma unroll
    for (int bj = 0; bj < 2; ++bj)
#pragma unroll
      for (int n = 0; n < 2; ++n) gv[bj][n] = *(const f32x4*)(gate + b * 6144 + col0 + bj * 128 + n * 16);
#pragma unroll
    for (int ai = 0; ai < 2; ++ai)
#pragma unroll
      for (int m = 0; m < 4; ++m) {
        const size_t off = (size_t)(u.pm * 256 + ai * 128 + wr * 64 + m * 16 + fr) * 1024 + col0;
        f32x4 xo[2][2];
#pragma unroll
        for (int bj = 0; bj < 2; ++bj)
#pragma unroll
          for (int n = 0; n < 2; ++n) xo[bj][n] = *(const f32x4*)(xold + off + bj * 128 + n * 16);
#pragma unroll
        for (int bj = 0; bj < 2; ++bj)
#pragma unroll
          for (int n = 0; n < 2; ++n) *(f32x4*)(xnew + off + bj * 128 + n * 16) = xo[bj][n] + gv[bj][n] * acc[ai][bj][m][n];
        asm volatile("" ::: "memory");
      }
  }
};

DI float dpp_ror1(float v)  { return __builtin_bit_cast(float, __builtin_amdgcn_update_dpp(0, __builtin_bit_cast(int, v), 0x121, 0xf, 0xf, false)); }
DI float dpp_ror15(float v) { return __builtin_bit_cast(float, __builtin_amdgcn_update_dpp(0, __builtin_bit_cast(int, v), 0x12F, 0xf, 0xf, false)); }
struct EpiUp {
  u16* act; const float* cw; const float* cb;
  DI void operator()(const f32x4 (&acc)[2][2][4][2], const pg8::Unit& u, int wr, int wc, int fr, int fq) const {
    const int b = u.pm / 67, ti = u.pm % 67;
#pragma unroll
    for (int n = 0; n < 2; ++n) {
      const int col = u.pn * 128 + wc * 32 + n * 16 + 4 * fq;
      const f32x4 w0 = *(const f32x4*)(cw + col), w1 = *(const f32x4*)(cw + DFF + col), w2 = *(const f32x4*)(cw + 2 * DFF + col), bb = *(const f32x4*)(cb + col);
#pragma unroll
      for (int ai = 0; ai < 2; ++ai) {
        const int tokb = 248 * ti - 1 + 62 * (2 * ai + wr);
        f32x4 g[4];
        if (tokb >= 0 && tokb + 63 < S) {
#pragma unroll
          for (int m = 0; m < 4; ++m) g[m] = acc[ai][0][m][n];
        } else {
#pragma unroll
          for (int m = 0; m < 4; ++m) {
            const int tok = tokb + 16 * m + fr;
            const bool ok = (tok >= 0) && (tok < S);
#pragma unroll
            for (int e = 0; e < 4; ++e) g[m][e] = ok ? acc[ai][0][m][n][e] : 0.f;
          }
        }
#pragma unroll
        for (int m = 0; m < 4; ++m) {
          const int q = 16 * m + fr, tok = tokb + q;
          f32x4 r;
#pragma unroll
          for (int e = 0; e < 4; ++e) {
            const float srcm = (fr == 15 && m > 0) ? g[m > 0 ? m - 1 : 0][e] : g[m][e];
            const float srcp = (fr == 0 && m < 3) ? g[m < 3 ? m + 1 : 3][e] : g[m][e];
            const float gm = dpp_ror1(srcm), gp = dpp_ror15(srcp);
            const float cv = bb[e] + w0[e] * gm + w1[e] * g[m][e] + w2[e] * gp;
            r[e] = cv * __builtin_amdgcn_rcpf(1.f + exp2_hw(-LOG2E * cv)) * acc[ai][1][m][n][e];
          }
          if (q >= 1 && q <= 62 && tok < S)
            *(uint2*)(act + (size_t)(b * S + tok) * DFF + col) = make_uint2(pack2(r[0], r[1]), pack2(r[2], r[3]));
        }
      }
    }
  }
};

constexpr int VROW = 96;
constexpr int VT_WAVE = 64 * VROW;
DI bf16x8 v_frag_tr(const u16* Vb, int kb0, int mb, int sp, int lane) {
  const int i16 = lane & 15, q = i16 >> 2, pp = i16 & 3, blk = (lane >> 4) & 1, hh = lane >> 5;
  const u16* a0 = Vb + (kb0 + 16 * sp + 4 * hh + q) * VROW + (mb * 2 + blk) * 16 + 4 * pp;
  const s16x4 lo = __builtin_amdgcn_ds_read_tr16_b64_v4i16((LAS s16x4*)a0);
  const s16x4 hi = __builtin_amdgcn_ds_read_tr16_b64_v4i16((LAS s16x4*)(a0 + 8 * VROW));
  return __builtin_shufflevector(lo, hi, 0, 1, 2, 3, 4, 5, 6, 7);
}

DI void local_softmax_step(float (&sv)[2][16], float& m_run, float& l_run, f32x16 (&O)[2], bf16x8 (&pk)[2][2]) {
  float tmax = NEGBIG;
#pragma unroll
  for (int h2 = 0; h2 < 2; ++h2)
#pragma unroll
    for (int i = 0; i < 16; ++i) tmax = fmaxf(tmax, sv[h2][i]);
  tmax = fmaxf(tmax, __shfl_xor(tmax, 32));
  const float m_new = fmaxf(m_run, tmax);
  if (__builtin_amdgcn_ballot_w64(m_new > m_run) != 0ull) {
    const float alpha = exp2_hw(m_run - m_new);
    m_run = m_new; l_run *= alpha;
#pragma unroll
    for (int mb = 0; mb < 2; ++mb)
#pragma unroll
      for (int i = 0; i < 16; ++i) O[mb][i] *= alpha;
  }
#pragma unroll
  for (int h2 = 0; h2 < 2; ++h2)
#pragma unroll
    for (int sp = 0; sp < 2; ++sp) {
      unsigned q4[4];
#pragma unroll
      for (int q = 0; q < 4; ++q) {
        const float s0 = sv[h2][8 * sp + 2 * q], s1 = sv[h2][8 * sp + 2 * q + 1];
        const float p0 = exp2_hw(s0 - m_run), p1 = exp2_hw(s1 - m_run);
        l_run += p0; l_run += p1;
        q4[q] = pack2(p0, p1);
      }
      pk[h2][sp] = __builtin_bit_cast(bf16x8, make_uint4(q4[0], q4[1], q4[2], q4[3]));
    }
}
DI void local_softmax_step1(float (&sv)[16], float& m_run, float& l_run, f32x16 (&O)[2], bf16x8 (&pk)[2]) {
  float tmax = NEGBIG;
#pragma unroll
  for (int i = 0; i < 16; ++i) tmax = fmaxf(tmax, sv[i]);
  tmax = fmaxf(tmax, __shfl_xor(tmax, 32));
  const float m_new = fmaxf(m_run, tmax);
  if (__builtin_amdgcn_ballot_w64(m_new > m_run) != 0ull) {
    const float alpha = exp2_hw(m_run - m_new);
    m_run = m_new; l_run *= alpha;
#pragma unroll
    for (int mb = 0; mb < 2; ++mb)
#pragma unroll
      for (int i = 0; i < 16; ++i) O[mb][i] *= alpha;
  }
#pragma unroll
  for (int sp = 0; sp < 2; ++sp) {
    unsigned q4[4];
#pragma unroll
    for (int q = 0; q < 4; ++q) {
      const float p0 = exp2_hw(sv[8 * sp + 2 * q] - m_run), p1 = exp2_hw(sv[8 * sp + 2 * q + 1] - m_run);
      l_run += p0; l_run += p1;
      q4[q] = pack2(p0, p1);
    }
    pk[sp] = __builtin_bit_cast(bf16x8, make_uint4(q4[0], q4[1], q4[2], q4[3]));
  }
}
DI void local_store_out(const f32x16 (&O)[2], float l_run, u16* op, int hh) {
  const float l = l_run + __shfl_xor(l_run, 32);
  const float il = 1.f / l;
#pragma unroll
  for (int mb = 0; mb < 2; ++mb)
#pragma unroll
    for (int g = 0; g < 4; ++g) {
      const int d = mb * 32 + 8 * g + 4 * hh;
      *(uint2*)(op + d) = make_uint2(pack2(O[mb][4 * g] * il, O[mb][4 * g + 1] * il), pack2(O[mb][4 * g + 2] * il, O[mb][4 * g + 3] * il));
    }
}

constexpr int KS_STRIDE = 72;
constexpr int KS_BUF = 64 * KS_STRIDE, VS_BUF = 64 * VROW;
DI void swin_attn_item(KP p, int item, u16* sm) {
  const int tid = otid(), lane = tid & 63, w = __builtin_amdgcn_readfirstlane(tid >> 6), r = lane & 31, hh = lane >> 5;
  u16* Ks = sm; u16* Vs = sm + 4 * KS_BUF;
  const int bhp = item >> 6, sub = item & 63;
  const int pat = bhp % 3, bh = bhp / 3, head = bh % 6, b = bh / 6;
  const int sh = 2 * pat, L = S >> sh;
  const int cls = sub >> (6 - sh), pb = sub & ((64 >> sh) - 1);
  const int P = pb * 256;
  const int qp = P + 32 * w + r, tq = cls + (qp << sh);
  const u16* prow = p.proj + (size_t)b * S * NPROJ;
  bf16x8 qf[4];
#pragma unroll
  for (int s = 0; s < 4; ++s) qf[s] = *(const bf16x8*)(prow + (size_t)tq * NPROJ + 768 + head * 64 + s * 16 + 8 * hh);
  f32x16 O[2];
#pragma unroll
  for (int mb = 0; mb < 2; ++mb)
#pragma unroll
    for (int i = 0; i < 16; ++i) O[mb][i] = 0.f;
  float m_run = -1e20f, l_run = 0.f;
  const int key0 = tid >> 3, ch = tid & 7;
  const u16* kg = prow + 1152 + head * 64 + ch * 8;
  auto gk = [&](int j) __attribute__((always_inline)) -> const u16* {
    int kp = P - 64 + 64 * j + key0; kp = kp < 0 ? 0 : (kp > L - 1 ? L - 1 : kp);
    return kg + (size_t)(cls + (kp << sh)) * NPROJ;
  };
  const uint4 k0 = *(const uint4*)gk(0), v0 = *(const uint4*)(gk(0) + 384), k1 = *(const uint4*)gk(1), v1 = *(const uint4*)(gk(1) + 384);
  const uint4 k2 = *(const uint4*)gk(2), v2 = *(const uint4*)(gk(2) + 384), k3 = *(const uint4*)gk(3), v3 = *(const uint4*)(gk(3) + 384);
  const uint4 k4 = *(const uint4*)gk(4), v4 = *(const uint4*)(gk(4) + 384), k5 = *(const uint4*)gk(5), v5 = *(const uint4*)(gk(5) + 384);
  auto lstore = [&](int buf, const uint4& kr, const uint4& vr) __attribute__((always_inline)) {
    *(uint4*)(Ks + buf * KS_BUF + key0 * KS_STRIDE + ch * 8) = kr;
    *(uint4*)(Vs + buf * VS_BUF + key0 * VROW + ch * 8) = vr;
  };
  lstore(0, k0, v0); lstore(1, k1, v1);
  __syncthreads();
  const int jlo = w >> 1;
#pragma unroll
  for (int j = 0; j < 6; ++j) {
    const int buf = j & 3;
    const bool half_only = (w & 1) ? (j == jlo) : (j == jlo + 2);
    if (j >= jlo && j <= jlo + 2 && !half_only) {
      f32x16 Sc[2];
#pragma unroll
      for (int i = 0; i < 16; ++i) { Sc[0][i] = 0.f; Sc[1][i] = 0.f; }
#pragma unroll
      for (int s = 0; s < 4; ++s)
#pragma unroll
        for (int h2 = 0; h2 < 2; ++h2) {
          const bf16x8 kf = *(const bf16x8*)(Ks + buf * KS_BUF + (h2 * 32 + r) * KS_STRIDE + s * 16 + 8 * hh);
          Sc[h2] = MFMA32(kf, qf[s], Sc[h2]);
        }
      const int dbase = (64 * j - 32 * w) + 4 * hh - r;
      const int kbase = P - 64 + 64 * j + 4 * hh;
      float sv[2][16];
#pragma unroll
      for (int h2 = 0; h2 < 2; ++h2)
#pragma unroll
        for (int i = 0; i < 16; ++i) {
          const int c = h2 * 32 + (i & 3) + 8 * (i >> 2);
          const bool valid = ((unsigned)(dbase + c) <= 128u) && ((unsigned)(kbase + c) < (unsigned)L);
          sv[h2][i] = valid ? Sc[h2][i] : NEGBIG;
        }
      bf16x8 pk[2][2];
      local_softmax_step(sv, m_run, l_run, O, pk);
#pragma unroll
      for (int h2 = 0; h2 < 2; ++h2)
#pragma unroll
        for (int sp = 0; sp < 2; ++sp)
#pragma unroll
          for (int mb = 0; mb < 2; ++mb) {
            const bf16x8 vf = v_frag_tr(Vs + buf * VS_BUF, h2 * 32, mb, sp, lane);
            O[mb] = MFMA32(vf, pk[h2][sp], O[mb]);
          }
    } else if (j >= jlo && j <= jlo + 2) {
      const int hs = (w & 1) * 32;
      f32x16 Sc;
#pragma unroll
      for (int i = 0; i < 16; ++i) Sc[i] = 0.f;
#pragma unroll
      for (int s = 0; s < 4; ++s) {
        const bf16x8 kf = *(const bf16x8*)(Ks + buf * KS_BUF + (hs + r) * KS_STRIDE + s * 16 + 8 * hh);
        Sc = MFMA32(kf, qf[s], Sc);
      }
      const int dbase = (64 * j - 32 * w) + hs + 4 * hh - r;
      const int kbase = P - 64 + 64 * j + hs + 4 * hh;
      float sv[16];
#pragma unroll
      for (int i = 0; i < 16; ++i) {
        const int c = (i & 3) + 8 * (i >> 2);
        const bool valid = ((unsigned)(dbase + c) <= 128u) && ((unsigned)(kbase + c) < (unsigned)L);
        sv[i] = valid ? Sc[i] : NEGBIG;
      }
      bf16x8 pk[2];
      local_softmax_step1(sv, m_run, l_run, O, pk);
#pragma unroll
      for (int sp = 0; sp < 2; ++sp)
#pragma unroll
        for (int mb = 0; mb < 2; ++mb) {
          const bf16x8 vf = v_frag_tr(Vs + buf * VS_BUF, hs, mb, sp, lane);
          O[mb] = MFMA32(vf, pk[sp], O[mb]);
        }
    }
    if (j == 1) { lstore(2, k2, v2); lstore(3, k3, v3); __syncthreads(); }
    if (j == 3) { lstore(0, k4, v4); lstore(1, k5, v5); __syncthreads(); }
  }
  const size_t orow = (size_t)pat * NTOK + (size_t)b * S + tq;
  const float l = l_run + __shfl_xor(l_run, 32);
  if (hh == 0) p.lse[orow * 6 + head] = m_run + __log2f(l);
  local_store_out(O, l_run, p.odil + orow * 384 + head * 64, hh);
}

DI void combine_dil(KP p) {
  const int tid = otid();
  for (int tc = blockIdx.x; tc < 256; tc += gridDim.x) {
#pragma unroll 1
    for (int idx = tid; idx < 128 * 48; idx += NTHR) {
      const int tok = tc * 128 + idx / 48, c8 = idx % 48, head = c8 >> 3;
      float ls[3], wgt[3];
#pragma unroll
      for (int q = 0; q < 3; ++q) ls[q] = p.lse[((size_t)q * NTOK + tok) * 6 + head];
      const float mx = fmaxf(ls[0], fmaxf(ls[1], ls[2]));
      float sum = 0.f;
#pragma unroll
      for (int q = 0; q < 3; ++q) { wgt[q] = exp2_hw(ls[q] - mx); sum += wgt[q]; }
      const float isum = 1.f / sum;
      float acc[8];
#pragma unroll
      for (int e = 0; e < 8; ++e) acc[e] = 0.f;
#pragma unroll
      for (int q = 0; q < 3; ++q) {
        const uint4 v = *(const uint4*)(p.odil + ((size_t)q * NTOK + tok) * 384 + c8 * 8);
        const float wq = wgt[q] * isum;
        acc[0] += wq * bflo(v.x); acc[1] += wq * bfhi(v.x); acc[2] += wq * bflo(v.y); acc[3] += wq * bfhi(v.y);
        acc[4] += wq * bflo(v.z); acc[5] += wq * bfhi(v.z); acc[6] += wq * bflo(v.w); acc[7] += wq * bfhi(v.w);
      }
      *(uint4*)(p.o + (size_t)tok * 1024 + 256 + c8 * 8) = make_uint4(pack2(acc[0], acc[1]), pack2(acc[2], acc[3]), pack2(acc[4], acc[5]), pack2(acc[6], acc[7]));
    }
  }
}

constexpr int RPB_PAD = 48, RPB_LDS = 15 * 31 + 2 * RPB_PAD;
DI void na_attn_item(KP p, int layer, int item, u16* sm) {
  const int tid = otid(), lane = tid & 63, w = __builtin_amdgcn_readfirstlane(tid >> 6), r = lane & 31, hh = lane >> 5;
  u16* Ks = sm; u16* Vs = sm + 4 * KS_BUF;
  const int b = item / (6 * 64), rem = item % (6 * 64), head = rem / 64, g = rem % 64;
  auto rstart = [](int x) { int v = x - 4; return v < 0 ? 0 : (v > 248 ? 248 : v); };
  const int qra = 4 * g + 2 * (w >> 2), cgp = w & 3;
  const int qr = qra + (r >> 4), qc = 16 * cgp + (r & 15), tq = qr * 64 + qc;
  int kc0 = 16 * cgp - 8; kc0 = kc0 < 0 ? 0 : (kc0 > 32 ? 32 : kc0);
  const int wlo = rstart(qra), whi = rstart(qra + 1) + 8;
  const int rs_q = rstart(qr);
  const int rs_lo = rstart(4 * g), rs_hi = rstart(4 * g + 3) + 7;
  const u16* prow = p.proj + (size_t)b * S * NPROJ;
  const float* rpb = p.na_rpb + ((size_t)layer * 6 + head) * 15 * 31;
  bf16x8 qf[4];
#pragma unroll
  for (int s = 0; s < 4; ++s) qf[s] = *(const bf16x8*)(prow + (size_t)tq * NPROJ + 1920 + head * 64 + s * 16 + 8 * hh);
  int cs = qc - 8; cs = cs < 0 ? 0 : (cs > 48 ? 48 : cs);
  float* rtab = (float*)(sm + 4 * KS_BUF + 4 * VS_BUF);
  for (int i = tid; i < RPB_LDS; i += NTHR) { const int j = i - RPB_PAD; rtab[i] = (j >= 0 && j < 15 * 31) ? rpb[j] * LOG2E : 0.f; }
  const int vbase = kc0 + 4 * hh - cs;
  f32x16 O[2];
#pragma unroll
  for (int mb = 0; mb < 2; ++mb)
#pragma unroll
    for (int i = 0; i < 16; ++i) O[mb][i] = 0.f;
  float m_run = -1e20f, l_run = 0.f;
  uint4 kr, vr, kr2, vr2;
  const int key0 = tid >> 3, ch = tid & 7;
  const u16* kg = prow + (size_t)key0 * NPROJ + 2304 + head * 64 + ch * 8;
  auto gload = [&](int krow, uint4& kd, uint4& vd) __attribute__((always_inline)) {
    const u16* src = kg + (size_t)((krow > 255 ? 255 : krow) * 64) * NPROJ;
    kd = *(const uint4*)src; vd = *(const uint4*)(src + 384);
  };
  auto lstore = [&](int buf) __attribute__((always_inline)) {
    *(uint4*)(Ks + buf * KS_BUF + key0 * KS_STRIDE + ch * 8) = kr;
    *(uint4*)(Vs + buf * VS_BUF + key0 * VROW + ch * 8) = vr;
  };
  gload(rs_lo, kr, vr); lstore(0);
  gload(rs_lo + 1, kr, vr); lstore(1);
  gload(rs_lo + 2, kr, vr); gload(rs_lo + 3, kr2, vr2);
  __syncthreads();
  for (int krow = rs_lo; krow <= rs_hi; ++krow) {
    const int buf = (krow - rs_lo) & 3;
    if (krow >= wlo && krow < whi) {
      f32x16 Sc;
#pragma unroll
      for (int i = 0; i < 16; ++i) Sc[i] = 0.f;
#pragma unroll
      for (int s = 0; s < 4; ++s) {
        const bf16x8 kf = *(const bf16x8*)(Ks + buf * KS_BUF + (kc0 + r) * KS_STRIDE + s * 16 + 8 * hh);
        Sc = MFMA32(kf, qf[s], Sc);
      }
      const float* rowp = rtab + RPB_PAD + (krow - qr + 7) * 31 + 15 + kc0 + 4 * hh - qc;
      const bool rowok = (unsigned)(krow - rs_q) < 8u;
      float sv[16];
#pragma unroll
      for (int i = 0; i < 16; ++i) {
        const int c = (i & 3) + 8 * (i >> 2);
        const bool valid = rowok && ((unsigned)(vbase + c) < 16u);
        sv[i] = valid ? (Sc[i] + rowp[c]) : NEGBIG;
      }
      bf16x8 pk[2];
      local_softmax_step1(sv, m_run, l_run, O, pk);
#pragma unroll
      for (int sp = 0; sp < 2; ++sp)
#pragma unroll
        for (int mb = 0; mb < 2; ++mb) {
          const bf16x8 vf = v_frag_tr(Vs + buf * VS_BUF, kc0, mb, sp, lane);
          O[mb] = MFMA32(vf, pk[sp], O[mb]);
        }
    }
    if (buf & 1) {
      lstore((buf + 1) & 3);
      { const uint4 tk = kr, tv = vr; kr = kr2; vr = vr2; lstore((buf + 2) & 3); kr = tk; vr = tv; }
      gload(krow + 3, kr, vr); gload(krow + 4, kr2, vr2);
      __syncthreads();
    }
  }
  local_store_out(O, l_run, p.o + (size_t)(b * S + tq) * 1024 + 640 + head * 64, hh);
}

DI void kmax_item(KP p, int layer, int kidx) {
  const int tid = otid(); const int gid = kidx * NTHR + tid;
  const int row = gid >> 2, head = gid & 3, b = row >> 14;
  const uint4* kp = (const uint4*)(p.proj + (size_t)row * NPROJ + 256 + head * 64);
  float n0 = 0.f, n1 = 0.f;
#pragma unroll
  for (int c = 0; c < 8; ++c) {
    const uint4 v = kp[c];
    const unsigned e[4] = {v.x, v.y, v.z, v.w};
    float s = 0.f;
#pragma unroll
    for (int q = 0; q < 4; ++q) { const float a = bflo(e[q]), bq = bfhi(e[q]); s += a * a + bq * bq; }
    if (c >= 4) n1 += s; else n0 += s;
  }
#pragma unroll
  for (int o = 4; o <= 32; o <<= 1) { n0 = fmaxf(n0, __shfl_xor(n0, o)); n1 = fmaxf(n1, __shfl_xor(n1, o)); }
  if ((tid & 63) < 4) {
    unsigned* km = p.kmax + layer * 16 + (b * 4 + head) * 2;
    atomicMax(km, __float_as_uint(n0)); atomicMax(km + 1, __float_as_uint(n1));
  }
}

DI void phase_local(KP p, int layer, u16* sm) {
  constexpr int N_DIL = 2304, N_NA = 768, N_KM = 256;
  for (int it = blockIdx.x; it < N_DIL + N_NA + N_KM; it += gridDim.x) {
    __syncthreads();
    if (it < N_DIL) swin_attn_item(p, (it & 7) * (N_DIL / 8) + (it >> 3), sm);
    else if (it < N_DIL + N_NA) { const int j = it - N_DIL; na_attn_item(p, layer, (j & 7) * (N_NA / 8) + (j >> 3), sm); }
    else kmax_item(p, layer, it - N_DIL - N_NA);
  }
}

constexpr int VL_STRIDE = 80;
constexpr int VL_BUF = 64 * VL_STRIDE;
DI void phase_diff(KP p, int layer, u16* sm) {
  combine_dil(p);
  const int tid = otid(), lane = tid & 63, w = __builtin_amdgcn_readfirstlane(tid >> 6), r = lane & 31, hh = lane >> 5;
  u16* Ks = sm; unsigned char* Vl = (unsigned char*)(sm + 4 * KS_BUF);
  float lam;
  {
    const float* dl = p.diff_lambda + layer * 128;
    float a = 0.f, c2 = 0.f;
    if (lane < 32) { a = dl[lane] * dl[32 + lane]; c2 = dl[64 + lane] * dl[96 + lane]; }
    a = wave_sum(a); c2 = wave_sum(c2);
    lam = __expf(a) - __expf(c2) + p.lam_init[layer];
  }
  const float lam_init = p.lam_init[layer];
  const float* sg = p.diff_subln + layer * 64;
  for (int it = blockIdx.x; it < 512; it += gridDim.x) {
    const int bh = it >> 6, qb = it & 63, b = bh >> 2, head = bh & 3;
    const u16* prow = p.proj + (size_t)b * S * NPROJ;
    const int tq = qb * 256 + w * 32 + r;
    bf16x8 qf[2][2];
    float qn[2];
#pragma unroll
    for (int m = 0; m < 2; ++m) {
      qn[m] = 0.f;
#pragma unroll
      for (int s = 0; s < 2; ++s) {
        qf[m][s] = *(const bf16x8*)(prow + (size_t)tq * NPROJ + head * 64 + m * 32 + s * 16 + 8 * hh);
#pragma unroll
        for (int j = 0; j < 8; ++j) { const float v = bf2f((u16)qf[m][s][j]); qn[m] += v * v; }
      }
      qn[m] += __shfl_xor(qn[m], 32);
    }
    float mbnd[2];
#pragma unroll
    for (int m = 0; m < 2; ++m) {
      const float km = __uint_as_float(p.kmax[layer * 16 + bh * 2 + m]);
      mbnd[m] = fmaxf(sqrtf(qn[m] * km) - 15.f, 0.f);
    }
    const bool noshift = __builtin_amdgcn_ballot_w64(mbnd[0] == 0.f && mbnd[1] == 0.f) == ~0ull;
    f32x16 O[2][2];
#pragma unroll
    for (int m = 0; m < 2; ++m)
#pragma unroll
      for (int mb = 0; mb < 2; ++mb)
#pragma unroll
        for (int i = 0; i < 16; ++i) O[m][mb][i] = 0.f;
    f32x16 L[2];
#pragma unroll
    for (int m = 0; m < 2; ++m)
#pragma unroll
      for (int i = 0; i < 16; ++i) L[m][i] = 0.f;
    v8i_t ones8;
#pragma unroll
    for (int v = 0; v < 8; ++v) ones8[v] = 0x38383838;
    uint4 kra, krb; uint2 vra, vrb;
    const int key0 = tid >> 3, ch = tid & 7;
    const u16* kg = prow + (size_t)key0 * NPROJ + 256 + head * 64 + ch * 8;
    const unsigned char* vg = p.vt8 + ((size_t)bh * 64 + key0) * S + ch * 8;
    auto gload = [&](int st) __attribute__((always_inline)) {
      const int t0 = (st & 127) * 2;
      kra = *(const uint4*)(kg + (size_t)(t0 * 64) * NPROJ); krb = *(const uint4*)(kg + (size_t)(t0 * 64 + 64) * NPROJ);
      vra = *(const uint2*)(vg + t0 * 64); vrb = *(const uint2*)(vg + t0 * 64 + 64);
    };
    auto lstore = [&](int buf) __attribute__((always_inline)) {
      u16* kd = Ks + buf * (2 * KS_BUF) + key0 * KS_STRIDE + ch * 8;
      *(uint4*)kd = kra; *(uint4*)(kd + KS_BUF) = krb;
      unsigned char* vd = Vl + buf * (2 * VL_BUF) + key0 * VL_STRIDE + 4 * ch;
      *(unsigned*)vd = vra.x; *(unsigned*)(vd + 32) = vra.y;
      *(unsigned*)(vd + VL_BUF) = vrb.x; *(unsigned*)(vd + VL_BUF + 32) = vrb.y;
    };
    gload(0); lstore(0);
    __syncthreads();
    if (w >= 4) __builtin_amdgcn_s_setprio(1);
    auto tile_loop = [&](auto shifted) __attribute__((always_inline)) {
      constexpr bool SH = decltype(shifted)::value;
      for (int st = 0; st < 128; ++st) {
        const int buf = st & 1;
        gload(st + 1);
#pragma unroll
        for (int hf = 0; hf < 2; ++hf) {
          const u16* Kt = Ks + buf * (2 * KS_BUF) + hf * KS_BUF;
          const unsigned char* Vt = Vl + buf * (2 * VL_BUF) + hf * VL_BUF;
          f32x16 Sc[2][2];
#pragma unroll
          for (int sub = 0; sub < 2; ++sub)
#pragma unroll
            for (int m = 0; m < 2; ++m) {
#pragma unroll
              for (int i = 0; i < 16; ++i) Sc[sub][m][i] = 0.f;
#pragma unroll
              for (int s = 0; s < 2; ++s) {
                const bf16x8 kf = *(const bf16x8*)(Kt + (sub * 32 + r) * KS_STRIDE + m * 32 + s * 16 + 8 * hh);
                Sc[sub][m] = MFMA32(kf, qf[m][s], Sc[sub][m]);
              }
            }
          v8i_t pf[2];
#pragma unroll
          for (int sub = 0; sub < 2; ++sub)
#pragma unroll
            for (int m = 0; m < 2; ++m)
#pragma unroll
              for (int g = 0; g < 4; ++g) {
                float pv[4];
#pragma unroll
                for (int e = 0; e < 4; ++e) pv[e] = exp2_hw(SH ? (Sc[sub][m][4 * g + e] - mbnd[m]) : Sc[sub][m][4 * g + e]);
                const unsigned ha = __builtin_bit_cast(unsigned, __builtin_amdgcn_cvt_pkrtz(pv[0], pv[1]));
                const unsigned hb = __builtin_bit_cast(unsigned, __builtin_amdgcn_cvt_pkrtz(pv[2], pv[3]));
                pf[m][4 * sub + g] = (int)__builtin_amdgcn_perm(hb, ha, 0x07050301u);
              }
#pragma unroll
          for (int mb = 0; mb < 2; ++mb) {
            const v8i_t vf = *(const v8i_t*)(Vt + (mb * 32 + r) * VL_STRIDE + 32 * hh);
            O[0][mb] = __builtin_amdgcn_mfma_scale_f32_32x32x64_f8f6f4(vf, pf[0], O[0][mb], 0, 1, 0, 0x7F7F7F7F, 0, 0x7F7F7F7F);
            O[1][mb] = __builtin_amdgcn_mfma_scale_f32_32x32x64_f8f6f4(vf, pf[1], O[1][mb], 0, 1, 0, 0x7F7F7F7F, 0, 0x7F7F7F7F);
          }
          L[0] = __builtin_amdgcn_mfma_scale_f32_32x32x64_f8f6f4(ones8, pf[0], L[0], 0, 1, 0, 0x7F7F7F7F, 0, 0x7F7F7F7F);
          L[1] = __builtin_amdgcn_mfma_scale_f32_32x32x64_f8f6f4(ones8, pf[1], L[1], 0, 1, 0, 0x7F7F7F7F, 0, 0x7F7F7F7F);
        }
        lstore(buf ^ 1);
        __syncthreads();
      }
    };
    if (noshift) tile_loop(std::false_type{}); else tile_loop(std::true_type{});
    __builtin_amdgcn_s_setprio(0);
    const float l0 = L[0][0], l1 = L[1][0];
    const float i0 = 1.f / l0, i1 = lam / l1;
    float ss = 0.f;
#pragma unroll
    for (int mb = 0; mb < 2; ++mb)
#pragma unroll
      for (int i = 0; i < 16; ++i) { const float v = O[0][mb][i] * i0 - O[1][mb][i] * i1; O[0][mb][i] = v; ss += v * v; }
    ss += __shfl_xor(ss, 32);
    const float inv = rsqrtf(ss * (1.f / 64.f) + 1e-6f) * (1.f - lam_init);
    u16* op = p.o + (size_t)(b * S + tq) * 1024 + head * 64;
#pragma unroll
    for (int mb = 0; mb < 2; ++mb)
#pragma unroll
      for (int g = 0; g < 4; ++g) {
        const int d = mb * 32 + 8 * g + 4 * hh;
        const float4 g4 = *(const float4*)(sg + d);
        *(uint2*)(op + d) = make_uint2(pack2(O[0][mb][4 * g] * inv * g4.x, O[0][mb][4 * g + 1] * inv * g4.y),
                                       pack2(O[0][mb][4 * g + 2] * inv * g4.z, O[0][mb][4 * g + 3] * inv * g4.w));
      }
  }
}

DI void phase_proj(KP p, int layer, LAS unsigned char* lds) {
  pg8::StaticOrder so; so.init(128, 12, gridDim.x, blockIdx.x);
  EpiProj e; e.proj = p.proj; e.vt8 = p.vt8;
  pg8::gemm_phase<pg8::AMapPlain>(lds, p.h, p.wt_in + (size_t)layer * 3072 * 1024, 1024, so, e);
}
DI void phase_resid(const u16* A, int K, const u16* Bt, const float* xold, float* xnew, const float* gate, LAS unsigned char* lds) {
  pg8::StaticOrder so; so.init(128, 4, gridDim.x, blockIdx.x);
  EpiResid e; e.xold = xold; e.xnew = xnew; e.gate = gate;
  pg8::gemm_phase<pg8::AMapPlain>(lds, A, Bt, K, so, e);
}
DI void phase_up(KP p, int layer, LAS unsigned char* lds) {
  pg8::StaticOrder so; so.init(134, 22, gridDim.x, blockIdx.x);
  EpiUp e; e.act = p.act; e.cw = p.conv_w + (size_t)layer * 3 * DFF; e.cb = p.conv_b + (size_t)layer * DFF;
  pg8::gemm_phase<pg8::AMapHalo>(lds, p.h, p.wt_up + (size_t)layer * 5632 * 1024, 1024, so, e);
}

constexpr int N_PHASES = 18;

DI void run_phase(KP p, int ph, unsigned char* smraw) {
  u16* sm = (u16*)smraw;
  LAS unsigned char* lds = (LAS unsigned char*)smraw;
  if (ph == 0) { phase_prep(p, (float*)smraw); return; }
  if (ph == 17) { phase_norm<1>(p.out, p.g_final, nullptr, 0, 0, nullptr, p.out); return; }
  const int layer = (ph - 1) >> 3, sub = (ph - 1) & 7;
  const float* modl = p.mod + layer * 2 * 6144;
  const float* xcur = (layer == 0) ? p.x : p.out;
  switch (sub) {
    case 0: phase_norm<0>(xcur, p.g_attn + layer * 1024, modl, 0, 1024, p.h, nullptr); break;
    case 1: phase_proj(p, layer, lds); break;
    case 2: phase_local(p, layer, sm); break;
    case 3: phase_diff(p, layer, sm); break;
    case 4: phase_resid(p.o, 1024, p.wt_out + (size_t)layer * 1024 * 1024, xcur, p.out, modl + 2048, lds); break;
    case 5: phase_norm<0>(p.out, p.g_ffn + layer * 1024, modl, 3072, 4096, p.h, nullptr); break;
    case 6: phase_up(p, layer, lds); break;
    case 7: phase_resid(p.act, DFF, p.wt_down + (size_t)layer * 1024 * DFF, p.out, p.out, modl + 5120, lds); break;
  }
}

__global__ void __launch_bounds__(NTHR, 2) mega_kernel(Params p) {
  extern __shared__ __attribute__((aligned(16))) unsigned char smraw[];
#if COOP
  cg::grid_group grid = cg::this_grid();
  u16* sm = (u16*)smraw;
  LAS unsigned char* lds = (LAS unsigned char*)smraw;
  if (threadIdx.x == 0) *(uint4*)(smraw + LDS_BYTES) = make_uint4(0u, 0u, 0u, 0u);
  __syncthreads();
  const XcdBarrier xb = xcd_barrier_post(kp_fresh()->bar, (volatile LAS unsigned*)(smraw + LDS_BYTES));
  phase_prep(*kp_fresh(), (float*)smraw);
  grid.sync();
#pragma unroll 1
  for (int layer = 0; layer < 2; ++layer) {
    { KP q = *kp_fresh(); phase_norm<0>((layer == 0) ? q.x : q.out, q.g_attn + layer * 1024, q.mod + layer * 2 * 6144, 0, 1024, q.h, nullptr); } xcd_barrier(xb);
    phase_proj(*kp_fresh(), layer, lds); xcd_barrier(xb);
    phase_local(*kp_fresh(), layer, sm); xcd_barrier(xb);
    phase_diff(*kp_fresh(), layer, sm); xcd_barrier(xb);
    { KP q = *kp_fresh(); phase_resid(q.o, 1024, q.wt_out + (size_t)layer * 1024 * 1024, (layer == 0) ? q.x : q.out, q.out, q.mod + layer * 2 * 6144 + 2048, lds); } xcd_barrier(xb);
    { KP q = *kp_fresh(); phase_norm<0>(q.out, q.g_ffn + layer * 1024, q.mod + layer * 2 * 6144, 3072, 4096, q.h, nullptr); } xcd_barrier(xb);
    phase_up(*kp_fresh(), layer, lds); xcd_barrier(xb);
    { KP q = *kp_fresh(); phase_resid(q.act, DFF, q.wt_down + (size_t)layer * 1024 * DFF, q.out, q.out, q.mod + layer * 2 * 6144 + 5120, lds); } xcd_barrier(xb);
  }
  { KP q = *kp_fresh(); phase_norm<1>(q.out, q.g_final, nullptr, 0, 0, nullptr, q.out); }
#else
  { KP q = *kp_fresh(); for (int ph = q.ph_lo; ph < q.ph_hi; ++ph) run_phase(q, ph, smraw); }
#endif
}

extern "C" void kernel_launch(void* const* d_in, const int* in_sizes, int n_in, void* d_out, int out_size, void* d_ws, size_t ws_size, hipStream_t stream) {
  (void)in_sizes; (void)n_in; (void)out_size;
  Params p;
  memset(&p, 0, sizeof(p));
  p.x = (const float*)d_in[0]; p.c = (const float*)d_in[1]; p.w_ada = (const float*)d_in[2]; p.b_ada = (const float*)d_in[3];
  p.g_attn = (const float*)d_in[4]; p.w_in = (const float*)d_in[5]; p.diff_lambda = (const float*)d_in[6]; p.diff_subln = (const float*)d_in[7];
  p.na_rpb = (const float*)d_in[8]; p.w_out = (const float*)d_in[9]; p.g_ffn = (const float*)d_in[10]; p.w_up = (const float*)d_in[11];
  p.conv_w = (const float*)d_in[12]; p.conv_b = (const float*)d_in[13]; p.w_down = (const float*)d_in[14]; p.g_final = (const float*)d_in[15];
  p.out = (float*)d_out;
  char* ws = (char*)d_ws; size_t off = 0;
  auto take = [&](size_t bytes) { char* q = ws + off; off += (bytes + 255) & ~(size_t)255; return q; };
  p.wt_in = (u16*)take((size_t)2 * 3072 * 1024 * 2);
  p.wt_out = (u16*)take((size_t)2 * 1024 * 1024 * 2);
  p.wt_up = (u16*)take((size_t)2 * 5632 * 1024 * 2);
  p.wt_down = (u16*)take((size_t)2 * 1024 * 2816 * 2);
  p.mod = (float*)take((size_t)2 * 2 * 6144 * 4);
  p.kmax = (unsigned*)take(256);
  p.bar = (unsigned*)take((size_t)XCD_BAR_WORDS * 4);
  (void)take(4096);
  p.h = (u16*)take((size_t)NTOK * 1024 * 2);
  p.o = (u16*)take((size_t)NTOK * 1024 * 2);
  p.proj = (u16*)take((size_t)NTOK * NPROJ * 2);
  p.odil = (u16*)take((size_t)3 * NTOK * 384 * 2);
  p.lse = (float*)take((size_t)3 * NTOK * 6 * 4);
  p.vt8 = (unsigned char*)take((size_t)2 * 4 * 64 * S);
  p.act = p.proj;
  if (off > ws_size) { fprintf(stderr, "workspace too small: need %zu have %zu\n", off, ws_size); return; }
  p.lam_init[0] = 0.2f; p.lam_init[1] = 0.35550906759096934f;
  static int grid_blocks = 0;
  if (!grid_blocks) {
    int dev = 0, cus = 0, per_cu = 0;
    (void)hipGetDevice(&dev);
    (void)hipDeviceGetAttribute(&cus, hipDeviceAttributeMultiprocessorCount, dev);
    (void)hipFuncSetAttribute((const void*)mega_kernel, hipFuncAttributeMaxDynamicSharedMemorySize, LDS_BYTES + 16);
    (void)hipOccupancyMaxActiveBlocksPerMultiprocessor(&per_cu, mega_kernel, NTHR, LDS_BYTES + 16);
    if (per_cu > 1) per_cu = 1;
    if (per_cu < 1) per_cu = 1;
    grid_blocks = cus * per_cu;
  }
#if COOP
  p.ph_lo = 0; p.ph_hi = N_PHASES;
  (void)hipMemsetAsync(p.bar, 0, (size_t)XCD_BAR_WORDS * 4, stream);
  void* args[] = {&p};
  hipError_t e = hipLaunchCooperativeKernel((void*)mega_kernel, dim3(grid_blocks), dim3(NTHR), args, LDS_BYTES + 16, stream);
  if (e != hipSuccess) fprintf(stderr, "cooperative launch failed: %s (grid %d)\n", hipGetErrorString(e), grid_blocks);
#else
  for (int ph = 0; ph < N_PHASES; ++ph) {
    p.ph_lo = ph; p.ph_hi = ph + 1;
    hipLaunchKernelGGL(mega_kernel, dim3(grid_blocks), dim3(NTHR), LDS_BYTES + 16, stream, p);
  }
#endif
}
```

```cpp
#include <hip/hip_runtime.h>
#include <hip/hip_cooperative_groups.h>
#include <cstdio>
#include <cstring>
#include <type_traits>
namespace cg = cooperative_groups;

#ifndef COOP
#define COOP 1
#endif

#define DI __device__ __forceinline__
#define LAS __attribute__((address_space(3)))
typedef unsigned short u16;
using bf16x8 = __attribute__((ext_vector_type(8))) short;
using s16x4  = __attribute__((ext_vector_type(4))) short;
using f32x16 = __attribute__((ext_vector_type(16))) float;
using f32x4  = __attribute__((ext_vector_type(4))) float;
typedef int v8i_t __attribute__((ext_vector_type(8)));
typedef __bf16 bf2_t __attribute__((ext_vector_type(2)));
typedef float f2_t __attribute__((ext_vector_type(2)));
#define MFMA32(a, b, c) __builtin_amdgcn_mfma_f32_32x32x16_bf16((a), (b), (c), 0, 0, 0)

constexpr int S = 16384, NTOK = 32768, DFF = 2816, NPROJ = 3072;
constexpr int NTHR = 512, NWAVE = 8;
constexpr float LOG2E = 1.4426950408889634f;
constexpr float QSCALE_DIFF = 0.25503486164919736f;
constexpr float QSCALE_64   = 0.18033688011112042f;
constexpr float NEGBIG = -1e30f;
constexpr int LDS_BYTES = 131072;

__device__ const float ROPE_INV16[16] = {
1.000000000e+00f, 5.623413324e-01f, 3.162277639e-01f, 1.778279394e-01f, 1.000000015e-01f, 5.623413250e-02f, 3.162277490e-02f, 1.778279431e-02f, 9.999999776e-03f, 5.623413250e-03f, 3.162277630e-03f, 1.778279431e-03f, 1.000000047e-03f, 5.623413017e-04f, 3.162277571e-04f, 1.778279402e-04f};
__device__ const float ROPE_INV32[32] = {
1.000000000e+00f, 7.498942018e-01f, 5.623413324e-01f, 4.216965139e-01f, 3.162277639e-01f, 2.371373773e-01f, 1.778279394e-01f, 1.333521456e-01f, 1.000000015e-01f, 7.498942316e-02f, 5.623413250e-02f, 4.216964915e-02f, 3.162277490e-02f, 2.371373773e-02f, 1.778279431e-02f, 1.333521400e-02f, 9.999999776e-03f, 7.498942316e-03f, 5.623413250e-03f, 4.216964822e-03f, 3.162277630e-03f, 2.371373819e-03f, 1.778279431e-03f, 1.333521446e-03f, 1.000000047e-03f, 7.498941850e-04f, 5.623413017e-04f, 4.216965172e-04f, 3.162277571e-04f, 2.371373703e-04f, 1.778279402e-04f, 1.333521504e-04f};

struct Params {
  const float *x, *c, *w_ada, *b_ada, *g_attn, *w_in, *diff_lambda, *diff_subln, *na_rpb, *w_out, *g_ffn, *w_up, *conv_w, *conv_b, *w_down, *g_final;
  float* out;
  u16 *wt_in, *wt_out, *wt_up, *wt_down;
  float* mod;
  unsigned* kmax;
  unsigned* bar;
  u16 *h, *o, *proj, *act, *odil;
  unsigned char* vt8;
  float* lse;
  float lam_init[2];
  int ph_lo, ph_hi;
};

typedef const __attribute__((address_space(4))) Params& KP;
DI const __attribute__((address_space(4))) Params* kp_fresh() {
  const __attribute__((address_space(4))) Params* q = (const __attribute__((address_space(4))) Params*)__builtin_amdgcn_kernarg_segment_ptr();
  asm volatile("" : "+s"(q));
  return q;
}
DI unsigned pack2(float a, float b) { f2_t v = {a, b}; return __builtin_bit_cast(unsigned, __builtin_convertvector(v, bf2_t)); }
DI float bf2f(u16 v) { return __uint_as_float(((unsigned)v) << 16); }
DI float bflo(unsigned v) { return __uint_as_float(v << 16); }
DI float bfhi(unsigned v) { return __uint_as_float(v & 0xffff0000u); }
DI int crow(int i, int hh) { return (i & 3) + 8 * (i >> 2) + 4 * hh; }
DI float exp2_hw(float x) { return __builtin_amdgcn_exp2f(x); }
DI int otid() { int t = threadIdx.x; asm volatile("" : "+v"(t)); return t; }


#define XB_TMO      128
#define XB_XCNT(j)  (256  + 64 * (j))
#define XB_XSUB(j)  (1280 + 64 * (j))
#define XB_XGEN(j)  (2304 + 64 * (j))
#define XB_TOP      3328
#define XB_TOPGEN   3392
#define XCD_BAR_WORDS 3456
#define XB_SPIN_CAP (1u << 21)
DI unsigned xb_ld(unsigned* p)              { return __hip_atomic_load(p, __ATOMIC_RELAXED, __HIP_MEMORY_SCOPE_AGENT); }
DI unsigned xb_add(unsigned* p, unsigned v) { return __hip_atomic_fetch_add(p, v, __ATOMIC_RELAXED, __HIP_MEMORY_SCOPE_AGENT); }
DI unsigned xb_xcc_id() { return (unsigned)__builtin_amdgcn_s_getreg((3 << 11) | 20) & 0xFu; }
#define XB_SPIN(cond, bar) do { unsigned _sp = 0; while (cond) { __builtin_amdgcn_s_sleep(1); \
    if ((++_sp & 255u) == 0u) { if (xb_ld(&(bar)[XB_TMO])) break; if (_sp > XB_SPIN_CAP) { atomicAdd(&(bar)[XB_TMO], 1u); break; } } } } while (0)
struct XcdBarrier { unsigned* bar; unsigned x; volatile LAS unsigned* st; };
DI XcdBarrier xcd_barrier_post(unsigned* bar, volatile LAS unsigned* st) {
  XcdBarrier b; b.bar = bar; b.x = xb_xcc_id(); b.st = st;
  if (threadIdx.x == 0) (void)xb_add(&bar[XB_XCNT(b.x)], 1u);
  return b;
}
DI void xcd_barrier_complete(unsigned* bar, unsigned x, unsigned& nloc, unsigned& nx) {
  const unsigned G = gridDim.x * gridDim.y * gridDim.z;
  unsigned sum, cnt, mine, sp = 0u;
  for (;;) {
    sum = 0u; cnt = 0u; mine = 0u;
#pragma unroll
    for (unsigned j = 0; j < 16; ++j) { const unsigned c = xb_ld(&bar[XB_XCNT(j)]); sum += c; cnt += (c > 0u) ? 1u : 0u; mine = (j == x) ? c : mine; }
    if (sum == G) break;
    __builtin_amdgcn_s_sleep(1);
    if ((++sp & 255u) == 0u) { if (xb_ld(&bar[XB_TMO])) break; if (sp > XB_SPIN_CAP) { atomicAdd(&bar[XB_TMO], 1u); break; } }
  }
  nloc = mine > 0u ? mine : 1u; nx = cnt > 0u ? cnt : 1u;
}
DI void xcd_barrier(const XcdBarrier& b) {
  asm volatile("s_waitcnt vmcnt(0)" ::: "memory");
  __syncthreads();
  if (threadIdx.x == 0) {
    unsigned* bar = b.bar;
    __builtin_amdgcn_s_waitcnt(0);
    unsigned nloc = b.st[0], nx = b.st[1];
    if (nloc == 0u) { xcd_barrier_complete(bar, b.x, nloc, nx); b.st[0] = nloc; b.st[1] = nx; }
    const unsigned old = xb_add(&bar[XB_XSUB(b.x)], 1u);
    const unsigned gen = old / nloc;
    if (old + 1u == (gen + 1u) * nloc) {
      __builtin_amdgcn_fence(__ATOMIC_RELEASE, "agent");
      asm volatile("s_waitcnt vmcnt(0)" ::: "memory");
      const unsigned og = xb_add(&bar[XB_TOP], 1u);
      const unsigned tg = og / nx;
      if (og + 1u == (tg + 1u) * nx) xb_add(&bar[XB_TOPGEN], 1u);
      else XB_SPIN(xb_ld(&bar[XB_TOPGEN]) == tg, bar);
      __builtin_amdgcn_fence(__ATOMIC_ACQUIRE, "agent");
      xb_add(&bar[XB_XGEN(b.x)], 1u);
      asm volatile("s_waitcnt vmcnt(0)" ::: "memory");
    } else {
      XB_SPIN(xb_ld(&bar[XB_XGEN(b.x)]) == gen, bar);
      __builtin_amdgcn_fence(__ATOMIC_ACQUIRE, "agent");
      asm volatile("s_waitcnt vmcnt(0)" ::: "memory");
    }
  }
  __syncthreads();
}

DI int wmap_in(int np) {
  if (np >= 768 && np < 1536) { const int hb = np & ~63, w = np & 63, g = w >> 5, n = (w >> 4) & 1, i = w & 15; return hb + 16 * g + i + 32 * n; }
  return np;
}
DI int wmap_up(int np) {
  const int pn = np >> 8, w = np & 255, bj = w >> 7, q = w & 127;
  return bj ? (DFF + 128 * pn + q) : (128 * pn + q);
}

DI void phase_prep(KP p, float* smf) {
  const int tid = otid();
  if (blockIdx.x == 0 && tid < 64) p.kmax[tid] = 0u;
  constexpr int N_ADA = 192;
  constexpr int T_IN = 16 * 24, T_OUT = 16 * 8, T_UP = 16 * 44, T_DOWN = 44 * 8;
  constexpr int T_LAYER = T_IN + T_OUT + T_UP + T_DOWN;
  const int total = N_ADA + 2 * T_LAYER;
  for (int it = blockIdx.x; it < total; it += gridDim.x) {
    if (it < N_ADA) {
      const int l = it / 96, cgp = it % 96;
      float* sc = smf;
      float* red = smf + 2048;
      for (int i = tid; i < 2048; i += NTHR) { float v = p.c[i]; sc[i] = v / (1.f + __expf(-v)); }
      __syncthreads();
      const int kq = tid >> 6, cc = tid & 63, col = cgp * 64 + cc;
      const float* wp = p.w_ada + ((size_t)l * 1024 + kq * 128) * 6144 + col;
      float a0 = 0.f, a1 = 0.f;
#pragma unroll 32
      for (int k = 0; k < 128; ++k) { float w = wp[(size_t)k * 6144]; a0 += sc[kq * 128 + k] * w; a1 += sc[1024 + kq * 128 + k] * w; }
      red[(kq * 2 + 0) * 64 + cc] = a0; red[(kq * 2 + 1) * 64 + cc] = a1;
      __syncthreads();
      if (tid < 128) {
        const int b = tid >> 6, c2 = tid & 63;
        float s = 0.f;
#pragma unroll
        for (int q = 0; q < 8; ++q) s += red[(q * 2 + b) * 64 + c2];
        p.mod[(l * 2 + b) * 6144 + cgp * 64 + c2] = s + p.b_ada[l * 6144 + cgp * 64 + c2];
      }
    } else {
      int idx = it - N_ADA; const int l = idx / T_LAYER; int j = idx % T_LAYER;
      const float* W; u16* dst; int Kd, N, tk, tn, kind;
      if (j < T_IN) { W = p.w_in + (size_t)l * 1024 * 3072; dst = p.wt_in + (size_t)l * 3072 * 1024; Kd = 1024; N = 3072; tk = j / 24; tn = j % 24; kind = 0; }
      else if (j < T_IN + T_OUT) { j -= T_IN; W = p.w_out + (size_t)l * 1024 * 1024; dst = p.wt_out + (size_t)l * 1024 * 1024; Kd = 1024; N = 1024; tk = j / 8; tn = j % 8; kind = 1; }
      else if (j < T_IN + T_OUT + T_UP) { j -= T_IN + T_OUT; W = p.w_up + (size_t)l * 1024 * 5632; dst = p.wt_up + (size_t)l * 5632 * 1024; Kd = 1024; N = 5632; tk = j / 44; tn = j % 44; kind = 2; }
      else { j -= T_IN + T_OUT + T_UP; W = p.w_down + (size_t)l * 2816 * 1024; dst = p.wt_down + (size_t)l * 1024 * 2816; Kd = 2816; N = 1024; tk = j / 8; tn = j % 8; kind = 3; }
      const int hb = tid >> 8, t = tid & 255;
      const int k0 = tk * 64, n0 = (tn * 2 + hb) * 64;
      float* tile = smf + hb * (64 * 65);
      const int nn = t & 63;
      const int np = n0 + nn;
      const int srccol = (kind == 0) ? wmap_in(np) : (kind == 2) ? wmap_up(np) : np;
      float wv[16];
#pragma unroll
      for (int i = 0; i < 16; ++i) wv[i] = W[(size_t)(k0 + i * 4 + (t >> 6)) * N + srccol];
#pragma unroll
      for (int i = 0; i < 16; ++i) tile[(i * 4 + (t >> 6)) * 65 + nn] = wv[i];
      __syncthreads();
      const int nrow = t >> 2, kc = (t & 3) * 16;
      unsigned pk[8];
#pragma unroll
      for (int q = 0; q < 8; ++q) pk[q] = pack2(tile[(kc + 2 * q) * 65 + nrow], tile[(kc + 2 * q + 1) * 65 + nrow]);
      uint4* dp = (uint4*)(dst + (size_t)(n0 + nrow) * Kd + k0 + kc);
      dp[0] = make_uint4(pk[0], pk[1], pk[2], pk[3]);
      dp[1] = make_uint4(pk[4], pk[5], pk[6], pk[7]);
    }
    __syncthreads();
  }
}

DI float wave_sum(float v) {
#pragma unroll
  for (int o = 32; o >= 1; o >>= 1) v += __shfl_xor(v, o);
  return v;
}

template <int MODE>
DI void phase_norm(const float* xin, const float* g, const float* modl, int sh_off, int sc_off, u16* hout, float* fout) {
  const int tid = otid(); const int lane = tid & 63, w = tid >> 6;
  for (int row = blockIdx.x * NWAVE + w; row < NTOK; row += gridDim.x * NWAVE) {
    const int b = row >> 14;
    const float4* xr = (const float4*)(xin + (size_t)row * 1024);
    float4 v[4];
#pragma unroll
    for (int i = 0; i < 4; ++i) v[i] = xr[lane + i * 64];
    float ss = 0.f;
#pragma unroll
    for (int i = 0; i < 4; ++i) ss += v[i].x * v[i].x + v[i].y * v[i].y + v[i].z * v[i].z + v[i].w * v[i].w;
    ss = wave_sum(ss);
    const float inv = rsqrtf(ss * (1.f / 1024.f) + 1e-6f);
#pragma unroll
    for (int i = 0; i < 4; ++i) {
      const int col = (lane + i * 64) * 4;
      const float4 g4 = *(const float4*)(g + col);
      if (MODE == 0) {
        const float4 sc4 = *(const float4*)(modl + b * 6144 + sc_off + col);
        const float4 sh4 = *(const float4*)(modl + b * 6144 + sh_off + col);
        float y0 = v[i].x * inv * g4.x * (1.f + sc4.x) + sh4.x;
        float y1 = v[i].y * inv * g4.y * (1.f + sc4.y) + sh4.y;
        float y2 = v[i].z * inv * g4.z * (1.f + sc4.z) + sh4.z;
        float y3 = v[i].w * inv * g4.w * (1.f + sc4.w) + sh4.w;
        *(uint2*)(hout + (size_t)row * 1024 + col) = make_uint2(pack2(y0, y1), pack2(y2, y3));
      } else {
        float4 y; y.x = v[i].x * inv * g4.x; y.y = v[i].y * inv * g4.y; y.z = v[i].z * inv * g4.z; y.w = v[i].w * inv * g4.w;
        *(float4*)(fout + (size_t)row * 1024 + col) = y;
      }
    }
  }
}

namespace pg8 {
constexpr int BM = 256, BK = 64, HALF = 128, HTB = HALF * BK * 2, NXCD = 8, WGM = 8;
DI int lds_byte(int r, int c) { const int st = (r >> 4) * 2 + (c >> 5), rr = r & 15, cc = c & 31, ob = rr * 64 + cc * 2; return st * 1024 + (ob ^ (((ob >> 9) & 1) << 5)); }
DI void stage_rc(int b, int& R, int& C) { const int st = b / 1024, sb = b % 1024, swz = sb ^ (((sb >> 9) & 1) << 5); R = (st >> 1) * 16 + swz / 64; C = (st & 1) * 32 + (swz % 64) / 2; }
struct Unit { int pm, pn; };
struct StaticOrder {
  int nM, nN, nwg, G, c;
  DI void init(int nM_, int nN_, int G_, int c_) { nM = nM_; nN = nN_; nwg = nM * nN; G = G_; c = c_; }
  DI bool next(int i, Unit& u) const {
    const long L = (long)i * G + c; if (L >= nwg) return false;
    int wgid = (int)L; { const int q = nwg / NXCD, r = nwg % NXCD, xcd = wgid % NXCD, off = wgid / NXCD; wgid = (xcd < r ? xcd * (q + 1) : r * (q + 1) + (xcd - r) * q) + off; }
    const int nig = WGM * nN, gid = wgid / nig, fm = gid * WGM, gsz = (nM - fm) < WGM ? (nM - fm) : WGM;
    u.pm = fm + ((wgid % nig) % gsz); u.pn = (wgid % nig) / gsz; return true;
  }
};
struct AMapPlain { static constexpr int HALF_ROWS = 128; static DI int row(int R) { return R; } static DI long tile_row0(int pm) { return (long)pm * 256; } };
struct AMapHalo  { static constexpr int HALF_ROWS = 124; static DI int row(int R) { return 62 * (R >> 6) + (R & 63); } static DI long tile_row0(int pm) { const int b = pm / 67, ti = pm % 67; return (long)b * S + 248 * ti - 1; } };

template <class AMap, class Epi>
DI void gemm_phase(LAS unsigned char* lds, const u16* Aptr, const u16* Btptr, int K, const StaticOrder& SO, const Epi& E) {
  const int tid = otid(), wid = __builtin_amdgcn_readfirstlane(tid >> 6), lane = tid & 63, wr = wid >> 2, wc = wid & 3, fr = lane & 15, fq = lane >> 4;
  const int nt = K / BK;
  unsigned voffA[2], voffB[2];
#pragma unroll
  for (int i = 0; i < 2; ++i) { int R, C; stage_rc(tid * 16 + i * 8192, R, C);
    voffA[i] = (unsigned)(AMap::row(R) * K + C) * 2u; voffB[i] = (unsigned)(R * K + C) * 2u; }
  const size_t kstep = (size_t)(BK * 2);
  const size_t hstepA = (size_t)AMap::HALF_ROWS * K * 2, hstepB = (size_t)HALF * K * 2;
  const size_t tstepB = 2 * hstepB;
  const size_t rowB = (size_t)K * 2;
  const unsigned ldsw = (unsigned)wid * 1024u;
  const int aoff = lds_byte(wr * 64 + fr, fq * 8), boff = lds_byte(wc * 32 + fr, fq * 8);
#define PG8_SA(b, h) (((b) * 2 + (h)) * HTB)
#define PG8_SB(b, h) ((4 + (b) * 2 + (h)) * HTB)
#define PG8_STAGE(bufoff, gbase, voff) do { _Pragma("unroll") for (int _i = 0; _i < 2; ++_i) \
        __builtin_amdgcn_global_load_lds((const unsigned*)((const char*)(gbase) + (voff)[_i]), (LAS unsigned*)(lds + (bufoff) + ldsw + _i * 8192), 16, 0, 0); } while (0)
#define PG8_LDA(dst, b, h) do { _Pragma("unroll") for (int m = 0; m < 4; ++m) _Pragma("unroll") for (int k = 0; k < 2; ++k) dst[m][k] = *(const LAS bf16x8*)(lds + PG8_SA(b, h) + aoff + m * 2048 + k * 1024); } while (0)
#define PG8_LDB(dst, b, h) do { _Pragma("unroll") for (int n = 0; n < 2; ++n) _Pragma("unroll") for (int k = 0; k < 2; ++k) dst[n][k] = *(const LAS bf16x8*)(lds + PG8_SB(b, h) + boff + n * 2048 + k * 1024); } while (0)
#define PG8_MMA(ai, bj, At, Bt) do { __builtin_amdgcn_s_setprio(1); _Pragma("unroll") for (int m = 0; m < 4; ++m) _Pragma("unroll") for (int n = 0; n < 2; ++n) _Pragma("unroll") for (int k = 0; k < 2; ++k) \
        acc[ai][bj][m][n] = __builtin_amdgcn_mfma_f32_16x16x32_bf16(Bt[n][k], At[m][k], acc[ai][bj][m][n], 0, 0, 0); __builtin_amdgcn_s_setprio(0); } while (0)
#define PG8_WAIT_V(n) asm volatile("s_waitcnt vmcnt(" #n ")" ::: "memory")
#define PG8_WAIT_L(n) asm volatile("s_waitcnt lgkmcnt(" #n ")" ::: "memory")
#define PG8_BAR __builtin_amdgcn_s_barrier()
#define PG8_SCHED __builtin_amdgcn_sched_barrier(0)
  Unit cur, nxt; int ui = 0;
  if (!SO.next(0, cur)) return;
  f32x4 acc[2][2][4][2];
#pragma unroll
  for (int a = 0; a < 2; ++a)
#pragma unroll
    for (int b = 0; b < 2; ++b)
#pragma unroll
      for (int m = 0; m < 4; ++m)
#pragma unroll
        for (int n = 0; n < 2; ++n) acc[a][b][m][n] = (f32x4){0.f, 0.f, 0.f, 0.f};
  bf16x8 At[4][2], B0[2][2], B1[2][2];
  const char* cA = (const char*)Aptr + AMap::tile_row0(cur.pm) * (long)rowB; const char* cB = (const char*)Btptr + (size_t)cur.pn * tstepB;
  PG8_STAGE(PG8_SB(0, 0), cB, voffB); PG8_STAGE(PG8_SA(0, 0), cA, voffA); PG8_STAGE(PG8_SB(0, 1), cB + hstepB, voffB); PG8_STAGE(PG8_SA(0, 1), cA + hstepA, voffA);
  if (wr == 1) PG8_BAR;
  PG8_WAIT_V(4); PG8_BAR;
  PG8_STAGE(PG8_SB(1, 0), cB + kstep, voffB); PG8_STAGE(PG8_SA(1, 0), cA + kstep, voffA); PG8_STAGE(PG8_SB(1, 1), cB + hstepB + kstep, voffB);
  PG8_WAIT_V(6); PG8_BAR;
  for (;;) {
    const bool has_next = SO.next(ui + 1, nxt);
    const char* nA = has_next ? (const char*)Aptr + AMap::tile_row0(nxt.pm) * (long)rowB : cA; const char* nB = has_next ? (const char*)Btptr + (size_t)nxt.pn * tstepB : cB;
    for (int t = 0; t < nt; t += 2) {
      const bool last = (t == nt - 2);
      const char* a1 = cA + (size_t)(t + 1) * kstep;
      const char* a2 = last ? nA : cA + (size_t)(t + 2) * kstep; const char* b2 = last ? nB : cB + (size_t)(t + 2) * kstep;
      const char* a3 = a2 + kstep; const char* b3 = b2 + kstep;
      PG8_LDB(B0, 0, 0); PG8_SCHED; PG8_LDA(At, 0, 0); PG8_STAGE(PG8_SA(1, 1), a1 + hstepA, voffA);
      PG8_WAIT_L(8); PG8_BAR; PG8_WAIT_L(0); PG8_MMA(0, 0, At, B0); PG8_BAR; PG8_SCHED;
      PG8_LDB(B1, 0, 1); PG8_STAGE(PG8_SB(0, 0), b2, voffB);
      PG8_BAR; PG8_WAIT_L(0); PG8_MMA(0, 1, At, B1); PG8_BAR;
      PG8_LDA(At, 0, 1); PG8_STAGE(PG8_SA(0, 0), a2, voffA);
      PG8_BAR; PG8_WAIT_L(0); PG8_MMA(1, 0, At, B0); PG8_BAR; PG8_SCHED;
      PG8_STAGE(PG8_SB(0, 1), b2 + hstepB, voffB);
      PG8_WAIT_V(6); PG8_BAR; PG8_MMA(1, 1, At, B1); PG8_BAR;
      PG8_LDB(B0, 1, 0); PG8_SCHED; PG8_LDA(At, 1, 0); PG8_STAGE(PG8_SA(0, 1), a2 + hstepA, voffA);
      PG8_WAIT_L(8); PG8_BAR; PG8_WAIT_L(0); PG8_MMA(0, 0, At, B0); PG8_BAR; PG8_SCHED;
      PG8_LDB(B1, 1, 1); PG8_STAGE(PG8_SB(1, 0), b3, voffB);
      PG8_BAR; PG8_WAIT_L(0); PG8_MMA(0, 1, At, B1); PG8_BAR;
      PG8_LDA(At, 1, 1); PG8_STAGE(PG8_SA(1, 0), a3, voffA);
      PG8_BAR; PG8_WAIT_L(0); PG8_MMA(1, 0, At, B0); PG8_BAR; PG8_SCHED;
      PG8_STAGE(PG8_SB(1, 1), b3 + hstepB, voffB);
      PG8_WAIT_V(6); PG8_BAR; PG8_MMA(1, 1, At, B1); PG8_BAR;
    }
    E(acc, cur, wr, wc, fr, fq);
    if (!has_next) break;
#pragma unroll
    for (int a = 0; a < 2; ++a)
#pragma unroll
      for (int b = 0; b < 2; ++b)
#pragma unroll
        for (int m = 0; m < 4; ++m)
#pragma unroll
          for (int n = 0; n < 2; ++n) acc[a][b][m][n] = (f32x4){0.f, 0.f, 0.f, 0.f};
    cur = nxt; cA = nA; cB = nB; ++ui;
  }
  PG8_WAIT_V(0);
  if (wr == 0) PG8_BAR;
  PG8_BAR;
#undef PG8_SA
#undef PG8_SB
#undef PG8_STAGE
#undef PG8_LDA
#undef PG8_LDB
#undef PG8_MMA
#undef PG8_WAIT_V
#undef PG8_WAIT_L
#undef PG8_BAR
#undef PG8_SCHED
}
}

DI void sincos_big(float ang, float& sn, float& cs) {
  const float c_hi = 1.591549367e-01f, c_lo = 6.420638243e-09f;
  const float rh = ang * c_hi;
  const float e = __builtin_fmaf(ang, c_hi, -rh);
  const float fr = rh - floorf(rh);
  const float rev = fr + (e + ang * c_lo);
  sn = __builtin_amdgcn_sinf(rev);
  cs = __builtin_amdgcn_cosf(rev);
}

struct EpiProj {
  u16* proj; unsigned char* vt8;
  DI void operator()(const f32x4 (&acc)[2][2][4][2], const pg8::Unit& u, int wr, int wc, int fr, int fq) const {
    const f32x4 i16 = *(const f32x4*)(ROPE_INV16 + 4 * fq);
    const f32x4 i32v = *(const f32x4*)(ROPE_INV32 + 16 * (wc & 1) + 4 * fq);
#pragma unroll
    for (int bj = 0; bj < 2; ++bj) {
      const int gcol0 = u.pn * 256 + bj * 128 + wc * 32;
      int mode; float scale = 1.f;
      if (gcol0 < 256) { mode = 1; scale = QSCALE_DIFF; }
      else if (gcol0 < 512) { mode = 1; }
      else if (gcol0 < 768) { mode = 0; }
      else if (gcol0 < 1152) { mode = 2; scale = QSCALE_64; }
      else if (gcol0 < 1536) { mode = 2; }
      else if (gcol0 < 1920) { mode = 0; }
      else if (gcol0 < 2304) { mode = 0; scale = QSCALE_64; }
      else { mode = 0; }
      f32x4 invv;
#pragma unroll
      for (int e = 0; e < 4; ++e) invv[e] = (mode == 1) ? i16[e] : i32v[e];
      int c1, c2;
      if (mode == 2) { const int hb = gcol0 & ~63, g = wc & 1; c1 = hb + 16 * g + 4 * fq; c2 = c1 + 32; }
      else { c1 = gcol0 + 4 * fq; c2 = c1 + 16; }
#pragma unroll
      for (int ai = 0; ai < 2; ++ai)
#pragma unroll
        for (int m = 0; m < 4; ++m) {
          const int row = u.pm * 256 + ai * 128 + wr * 64 + m * 16 + fr;
          f32x4 x1 = acc[ai][bj][m][0], x2 = acc[ai][bj][m][1];
          if (mode != 0) {
            const float pos = (float)(row & (S - 1));
#pragma unroll
            for (int e = 0; e < 4; ++e) {
              const float ang = __fmul_rn(pos, invv[e]);
              float sn, cs; sincos_big(ang, sn, cs);
              const float y1 = x1[e] * cs - x2[e] * sn, y2 = x2[e] * cs + x1[e] * sn;
              x1[e] = y1; x2[e] = y2;
            }
          }
          u16* dp = proj + (size_t)row * NPROJ;
          *(uint2*)(dp + c1) = make_uint2(pack2(x1[0] * scale, x1[1] * scale), pack2(x1[2] * scale, x1[3] * scale));
          *(uint2*)(dp + c2) = make_uint2(pack2(x2[0] * scale, x2[1] * scale), pack2(x2[2] * scale, x2[3] * scale));
          if (gcol0 >= 512 && gcol0 < 768) {
            const int hd = (gcol0 - 512) >> 6, d0 = (gcol0 & 63) + 4 * fq;
            unsigned char* vp = vt8 + ((size_t)((row >> 14) * 4 + hd) * 64 + d0) * S + (row & (S - 1));
            const int w1a = __builtin_amdgcn_cvt_pk_fp8_f32(x1[0], x1[1], 0, false), w1b = __builtin_amdgcn_cvt_pk_fp8_f32(x1[2], x1[3], 0, false);
            const int w2a = __builtin_amdgcn_cvt_pk_fp8_f32(x2[0], x2[1], 0, false), w2b = __builtin_amdgcn_cvt_pk_fp8_f32(x2[2], x2[3], 0, false);
            vp[0] = (unsigned char)(w1a & 0xff); vp[(size_t)S] = (unsigned char)((w1a >> 8) & 0xff); vp[(size_t)2 * S] = (unsigned char)(w1b & 0xff); vp[(size_t)3 * S] = (unsigned char)((w1b >> 8) & 0xff);
            unsigned char* vq = vp + (size_t)16 * S;
            vq[0] = (unsigned char)(w2a & 0xff); vq[(size_t)S] = (unsigned char)((w2a >> 8) & 0xff); vq[(size_t)2 * S] = (unsigned char)(w2b & 0xff); vq[(size_t)3 * S] = (unsigned char)((w2b >> 8) & 0xff);
          }
        }
    }
  }
};

struct EpiResid {
  const float* xold; float* xnew; const float* gate;
  DI void operator()(const f32x4 (&acc)[2][2][4][2], const pg8::Unit& u, int wr, int wc, int fr, int fq) const {
    const int b = (u.pm * 256) >> 14;
    const int col0 = u.pn * 256 + wc * 32 + 4 * fq;
    f32x4 gv[2][2];
#pragma unroll
    for (int bj = 0; bj < 2; ++bj)
#pragma unroll
      for (int n = 0; n < 2; ++n) gv[bj][n] = *(const f32x4*)(gate + b * 6144 + col0 + bj * 128 + n * 16);
#pragma unroll
    for (int ai = 0; ai < 2; ++ai)
#pragma unroll
      for (int m = 0; m < 4; ++m) {
        const size_t off = (size_t)(u.pm * 256 + ai * 128 + wr * 64 + m * 16 + fr) * 1024 + col0;
        f32x4 xo[2][2];
#pragma unroll
        for (int bj = 0; bj < 2; ++bj)
#pragma unroll
          for (int n = 0; n < 2; ++n) xo[bj][n] = *(const f32x4*)(xold + off + bj * 128 + n * 16);
#pragma unroll
        for (int bj = 0; bj < 2; ++bj)
#pragma unroll
          for (int n = 0; n < 2; ++n) *(f32x4*)(xnew + off + bj * 128 + n * 16) = xo[bj][n] + gv[bj][n] * acc[ai][bj][m][n];
        asm volatile("" ::: "memory");
      }
  }
};

DI float dpp_ror1(float v)  { return __builtin_bit_cast(float, __builtin_amdgcn_update_dpp(0, __builtin_bit_cast(int, v), 0x121, 0xf, 0xf, false)); }
DI float dpp_ror15(float v) { return __builtin_bit_cast(float, __builtin_amdgcn_update_dpp(0, __builtin_bit_cast(int, v), 0x12F, 0xf, 0xf, false)); }
struct EpiUp {
  u16* act; const float* cw; const float* cb;
  DI void operator()(const f32x4 (&acc)[2][2][4][2], const pg8::Unit& u, int wr, int wc, int fr, int fq) const {
    const int b = u.pm / 67, ti = u.pm % 67;
#pragma unroll
    for (int n = 0; n < 2; ++n) {
      const int col = u.pn * 128 + wc * 32 + n * 16 + 4 * fq;
      const f32x4 w0 = *(const f32x4*)(cw + col), w1 = *(const f32x4*)(cw + DFF + col), w2 = *(const f32x4*)(cw + 2 * DFF + col), bb = *(const f32x4*)(cb + col);
#pragma unroll
      for (int ai = 0; ai < 2; ++ai) {
        const int tokb = 248 * ti - 1 + 62 * (2 * ai + wr);
        f32x4 g[4];
        if (tokb >= 0 && tokb + 63 < S) {
#pragma unroll
          for (int m = 0; m < 4; ++m) g[m] = acc[ai][0][m][n];
        } else {
#pragma unroll
          for (int m = 0; m < 4; ++m) {
            const int tok = tokb + 16 * m + fr;
            const bool ok = (tok >= 0) && (tok < S);
#pragma unroll
            for (int e = 0; e < 4; ++e) g[m][e] = ok ? acc[ai][0][m][n][e] : 0.f;
          }
        }
#pragma unroll
        for (int m = 0; m < 4; ++m) {
          const int q = 16 * m + fr, tok = tokb + q;
          f32x4 r;
#pragma unroll
          for (int e = 0; e < 4; ++e) {
            const float srcm = (fr == 15 && m > 0) ? g[m > 0 ? m - 1 : 0][e] : g[m][e];
            const float srcp = (fr == 0 && m < 3) ? g[m < 3 ? m + 1 : 3][e] : g[m][e];
            const float gm = dpp_ror1(srcm), gp = dpp_ror15(srcp);
            const float cv = bb[e] + w0[e] * gm + w1[e] * g[m][e] + w2[e] * gp;
            r[e] = cv * __builtin_amdgcn_rcpf(1.f + exp2_hw(-LOG2E * cv)) * acc[ai][1][m][n][e];
          }
          if (q >= 1 && q <= 62 && tok < S)
            *(uint2*)(act + (size_t)(b * S + tok) * DFF + col) = make_uint2(pack2(r[0], r[1]), pack2(r[2], r[3]));
        }
      }
    }
  }
};

constexpr int VROW = 96;
constexpr int VT_WAVE = 64 * VROW;
DI bf16x8 v_frag_tr(const u16* Vb, int kb0, int mb, int sp, int lane) {
  const int i16 = lane & 15, q = i16 >> 2, pp = i16 & 3, blk = (lane >> 4) & 1, hh = lane >> 5;
  const u16* a0 = Vb + (kb0 + 16 * sp + 4 * hh + q) * VROW + (mb * 2 + blk) * 16 + 4 * pp;
  const s16x4 lo = __builtin_amdgcn_ds_read_tr16_b64_v4i16((LAS s16x4*)a0);
  const s16x4 hi = __builtin_amdgcn_ds_read_tr16_b64_v4i16((LAS s16x4*)(a0 + 8 * VROW));
  return __builtin_shufflevector(lo, hi, 0, 1, 2, 3, 4, 5, 6, 7);
}

DI void local_softmax_step(float (&sv)[2][16], float& m_run, float& l_run, f32x16 (&O)[2], bf16x8 (&pk)[2][2]) {
  float tmax = NEGBIG;
#pragma unroll
  for (int h2 = 0; h2 < 2; ++h2)
#pragma unroll
    for (int i = 0; i < 16; ++i) tmax = fmaxf(tmax, sv[h2][i]);
  tmax = fmaxf(tmax, __shfl_xor(tmax, 32));
  const float m_new = fmaxf(m_run, tmax);
  if (__builtin_amdgcn_ballot_w64(m_new > m_run) != 0ull) {
    const float alpha = exp2_hw(m_run - m_new);
    m_run = m_new; l_run *= alpha;
#pragma unroll
    for (int mb = 0; mb < 2; ++mb)
#pragma unroll
      for (int i = 0; i < 16; ++i) O[mb][i] *= alpha;
  }
#pragma unroll
  for (int h2 = 0; h2 < 2; ++h2)
#pragma unroll
    for (int sp = 0; sp < 2; ++sp) {
      unsigned q4[4];
#pragma unroll
      for (int q = 0; q < 4; ++q) {
        const float s0 = sv[h2][8 * sp + 2 * q], s1 = sv[h2][8 * sp + 2 * q + 1];
        const float p0 = exp2_hw(s0 - m_run), p1 = exp2_hw(s1 - m_run);
        l_run += p0; l_run += p1;
        q4[q] = pack2(p0, p1);
      }
      pk[h2][sp] = __builtin_bit_cast(bf16x8, make_uint4(q4[0], q4[1], q4[2], q4[3]));
    }
}
DI void local_softmax_step1(float (&sv)[16], float& m_run, float& l_run, f32x16 (&O)[2], bf16x8 (&pk)[2]) {
  float tmax = NEGBIG;
#pragma unroll
  for (int i = 0; i < 16; ++i) tmax = fmaxf(tmax, sv[i]);
  tmax = fmaxf(tmax, __shfl_xor(tmax, 32));
  const float m_new = fmaxf(m_run, tmax);
  if (__builtin_amdgcn_ballot_w64(m_new > m_run) != 0ull) {
    const float alpha = exp2_hw(m_run - m_new);
    m_run = m_new; l_run *= alpha;
#pragma unroll
    for (int mb = 0; mb < 2; ++mb)
#pragma unroll
      for (int i = 0; i < 16; ++i) O[mb][i] *= alpha;
  }
#pragma unroll
  for (int sp = 0; sp < 2; ++sp) {
    unsigned q4[4];
#pragma unroll
    for (int q = 0; q < 4; ++q) {
      const float p0 = exp2_hw(sv[8 * sp + 2 * q] - m_run), p1 = exp2_hw(sv[8 * sp + 2 * q + 1] - m_run);
      l_run += p0; l_run += p1;
      q4[q] = pack2(p0, p1);
    }
    pk[sp] = __builtin_bit_cast(bf16x8, make_uint4(q4[0], q4[1], q4[2], q4[3]));
  }
}
DI void local_store_out(const f32x16 (&O)[2], float l_run, u16* op, int hh) {
  const float l = l_run + __shfl_xor(l_run, 32);
  const float il = 1.f / l;
#pragma unroll
  for (int mb = 0; mb < 2; ++mb)
#pragma unroll
    for (int g = 0; g < 4; ++g) {
      const int d = mb * 32 + 8 * g + 4 * hh;
      *(uint2*)(op + d) = make_uint2(pack2(O[mb][4 * g] * il, O[mb][4 * g + 1] * il), pack2(O[mb][4 * g + 2] * il, O[mb][4 * g + 3] * il));
    }
}

constexpr int KS_STRIDE = 72;
constexpr int KS_BUF = 64 * KS_STRIDE, VS_BUF = 64 * VROW;
DI void swin_attn_item(KP p, int item, u16* sm) {
  const int tid = otid(), lane = tid & 63, w = __builtin_amdgcn_readfirstlane(tid >> 6), r = lane & 31, hh = lane >> 5;
  u16* Ks = sm; u16* Vs = sm + 4 * KS_BUF;
  const int bhp = item >> 6, sub = item & 63;
  const int pat = bhp % 3, bh = bhp / 3, head = bh % 6, b = bh / 6;
  const int sh = 2 * pat, L = S >> sh;
  const int cls = sub >> (6 - sh), pb = sub & ((64 >> sh) - 1);
  const int P = pb * 256;
  const int qp = P + 32 * w + r, tq = cls + (qp << sh);
  const u16* prow = p.proj + (size_t)b * S * NPROJ;
  bf16x8 qf[4];
#pragma unroll
  for (int s = 0; s < 4; ++s) qf[s] = *(const bf16x8*)(prow + (size_t)tq * NPROJ + 768 + head * 64 + s * 16 + 8 * hh);
  f32x16 O[2];
#pragma unroll
  for (int mb = 0; mb < 2; ++mb)
#pragma unroll
    for (int i = 0; i < 16; ++i) O[mb][i] = 0.f;
  float m_run = -1e20f, l_run = 0.f;
  const int key0 = tid >> 3, ch = tid & 7;
  const u16* kg = prow + 1152 + head * 64 + ch * 8;
  auto gk = [&](int j) __attribute__((always_inline)) -> const u16* {
    int kp = P - 64 + 64 * j + key0; kp = kp < 0 ? 0 : (kp > L - 1 ? L - 1 : kp);
    return kg + (size_t)(cls + (kp << sh)) * NPROJ;
  };
  const uint4 k0 = *(const uint4*)gk(0), v0 = *(const uint4*)(gk(0) + 384), k1 = *(const uint4*)gk(1), v1 = *(const uint4*)(gk(1) + 384);
  const uint4 k2 = *(const uint4*)gk(2), v2 = *(const uint4*)(gk(2) + 384), k3 = *(const uint4*)gk(3), v3 = *(const uint4*)(gk(3) + 384);
  const uint4 k4 = *(const uint4*)gk(4), v4 = *(const uint4*)(gk(4) + 384), k5 = *(const uint4*)gk(5), v5 = *(const uint4*)(gk(5) + 384);
  auto lstore = [&](int buf, const uint4& kr, const uint4& vr) __attribute__((always_inline)) {
    *(uint4*)(Ks + buf * KS_BUF + key0 * KS_STRIDE + ch * 8) = kr;
    *(uint4*)(Vs + buf * VS_BUF + key0 * VROW + ch * 8) = vr;
  };
  lstore(0, k0, v0); lstore(1, k1, v1);
  __syncthreads();
  const int jlo = w >> 1;
#pragma unroll
  for (int j = 0; j < 6; ++j) {
    const int buf = j & 3;
    const bool half_only = (w & 1) ? (j == jlo) : (j == jlo + 2);
    if (j >= jlo && j <= jlo + 2 && !half_only) {
      f32x16 Sc[2];
#pragma unroll
      for (int i = 0; i < 16; ++i) { Sc[0][i] = 0.f; Sc[1][i] = 0.f; }
#pragma unroll
      for (int s = 0; s < 4; ++s)
#pragma unroll
        for (int h2 = 0; h2 < 2; ++h2) {
          const bf16x8 kf = *(const bf16x8*)(Ks + buf * KS_BUF + (h2 * 32 + r) * KS_STRIDE + s * 16 + 8 * hh);
          Sc[h2] = MFMA32(kf, qf[s], Sc[h2]);
        }
      const int dbase = (64 * j - 32 * w) + 4 * hh - r;
      const int kbase = P - 64 + 64 * j + 4 * hh;
      float sv[2][16];
#pragma unroll
      for (int h2 = 0; h2 < 2; ++h2)
#pragma unroll
        for (int i = 0; i < 16; ++i) {
          const int c = h2 * 32 + (i & 3) + 8 * (i >> 2);
          const bool valid = ((unsigned)(dbase + c) <= 128u) && ((unsigned)(kbase + c) < (unsigned)L);
          sv[h2][i] = valid ? Sc[h2][i] : NEGBIG;
        }
      bf16x8 pk[2][2];
      local_softmax_step(sv, m_run, l_run, O, pk);
#pragma unroll
      for (int h2 = 0; h2 < 2; ++h2)
#pragma unroll
        for (int sp = 0; sp < 2; ++sp)
#pragma unroll
          for (int mb = 0; mb < 2; ++mb) {
            const bf16x8 vf = v_frag_tr(Vs + buf * VS_BUF, h2 * 32, mb, sp, lane);
            O[mb] = MFMA32(vf, pk[h2][sp], O[mb]);
          }
    } else if (j >= jlo && j <= jlo + 2) {
      const int hs = (w & 1) * 32;
      f32x16 Sc;
#pragma unroll
      for (int i = 0; i < 16; ++i) Sc[i] = 0.f;
#pragma unroll
      for (int s = 0; s < 4; ++s) {
        const bf16x8 kf = *(const bf16x8*)(Ks + buf * KS_BUF + (hs + r) * KS_STRIDE + s * 16 + 8 * hh);
        Sc = MFMA32(kf, qf[s], Sc);
      }
      const int dbase = (64 * j - 32 * w) + hs + 4 * hh - r;
      const int kbase = P - 64 + 64 * j + hs + 4 * hh;
      float sv[16];
#pragma unroll
      for (int i = 0; i < 16; ++i) {
        const int c = (i & 3) + 8 * (i >> 2);
        const bool valid = ((unsigned)(dbase + c) <= 128u) && ((unsigned)(kbase + c) < (unsigned)L);
        sv[i] = valid ? Sc[i] : NEGBIG;
      }
      bf16x8 pk[2];
      local_softmax_step1(sv, m_run, l_run, O, pk);
#pragma unroll
      for (int sp = 0; sp < 2; ++sp)
#pragma unroll
        for (int mb = 0; mb < 2; ++mb) {
          const bf16x8 vf = v_frag_tr(Vs + buf * VS_BUF, hs, mb, sp, lane);
          O[mb] = MFMA32(vf, pk[sp], O[mb]);
        }
    }
    if (j == 1) { lstore(2, k2, v2); lstore(3, k3, v3); __syncthreads(); }
    if (j == 3) { lstore(0, k4, v4); lstore(1, k5, v5); __syncthreads(); }
  }
  const size_t orow = (size_t)pat * NTOK + (size_t)b * S + tq;
  const float l = l_run + __shfl_xor(l_run, 32);
  if (hh == 0) p.lse[orow * 6 + head] = m_run + __log2f(l);
  local_store_out(O, l_run, p.odil + orow * 384 + head * 64, hh);
}

DI void combine_dil(KP p) {
  const int tid = otid();
  for (int tc = blockIdx.x; tc < 256; tc += gridDim.x) {
#pragma unroll 1
    for (int idx = tid; idx < 128 * 48; idx += NTHR) {
      const int tok = tc * 128 + idx / 48, c8 = idx % 48, head = c8 >> 3;
      float ls[3], wgt[3];
#pragma unroll
      for (int q = 0; q < 3; ++q) ls[q] = p.lse[((size_t)q * NTOK + tok) * 6 + head];
      const float mx = fmaxf(ls[0], fmaxf(ls[1], ls[2]));
      float sum = 0.f;
#pragma unroll
      for (int q = 0; q < 3; ++q) { wgt[q] = exp2_hw(ls[q] - mx); sum += wgt[q]; }
      const float isum = 1.f / sum;
      float acc[8];
#pragma unroll
      for (int e = 0; e < 8; ++e) acc[e] = 0.f;
#pragma unroll
      for (int q = 0; q < 3; ++q) {
        const uint4 v = *(const uint4*)(p.odil + ((size_t)q * NTOK + tok) * 384 + c8 * 8);
        const float wq = wgt[q] * isum;
        acc[0] += wq * bflo(v.x); acc[1] += wq * bfhi(v.x); acc[2] += wq * bflo(v.y); acc[3] += wq * bfhi(v.y);
        acc[4] += wq * bflo(v.z); acc[5] += wq * bfhi(v.z); acc[6] += wq * bflo(v.w); acc[7] += wq * bfhi(v.w);
      }
      *(uint4*)(p.o + (size_t)tok * 1024 + 256 + c8 * 8) = make_uint4(pack2(acc[0], acc[1]), pack2(acc[2], acc[3]), pack2(acc[4], acc[5]), pack2(acc[6], acc[7]));
    }
  }
}

constexpr int RPB_PAD = 48, RPB_LDS = 15 * 31 + 2 * RPB_PAD;
DI void na_attn_item(KP p, int layer, int item, u16* sm) {
  const int tid = otid(), lane = tid & 63, w = __builtin_amdgcn_readfirstlane(tid >> 6), r = lane & 31, hh = lane >> 5;
  u16* Ks = sm; u16* Vs = sm + 4 * KS_BUF;
  const int b = item / (6 * 64), rem = item % (6 * 64), head = rem / 64, g = rem % 64;
  auto rstart = [](int x) { int v = x - 4; return v < 0 ? 0 : (v > 248 ? 248 : v); };
  const int qra = 4 * g + 2 * (w >> 2), cgp = w & 3;
  const int qr = qra + (r >> 4), qc = 16 * cgp + (r & 15), tq = qr * 64 + qc;
  int kc0 = 16 * cgp - 8; kc0 = kc0 < 0 ? 0 : (kc0 > 32 ? 32 : kc0);
  const int wlo = rstart(qra), whi = rstart(qra + 1) + 8;
  const int rs_q = rstart(qr);
  const int rs_lo = rstart(4 * g), rs_hi = rstart(4 * g + 3) + 7;
  const u16* prow = p.proj + (size_t)b * S * NPROJ;
  const float* rpb = p.na_rpb + ((size_t)layer * 6 + head) * 15 * 31;
  bf16x8 qf[4];
#pragma unroll
  for (int s = 0; s < 4; ++s) qf[s] = *(const bf16x8*)(prow + (size_t)tq * NPROJ + 1920 + head * 64 + s * 16 + 8 * hh);
  int cs = qc - 8; cs = cs < 0 ? 0 : (cs > 48 ? 48 : cs);
  float* rtab = (float*)(sm + 4 * KS_BUF + 4 * VS_BUF);
  for (int i = tid; i < RPB_LDS; i += NTHR) { const int j = i - RPB_PAD; rtab[i] = (j >= 0 && j < 15 * 31) ? rpb[j] * LOG2E : 0.f; }
  const int vbase = kc0 + 4 * hh - cs;
  f32x16 O[2];
#pragma unroll
  for (int mb = 0; mb < 2; ++mb)
#pragma unroll
    for (int i = 0; i < 16; ++i) O[mb][i] = 0.f;
  float m_run = -1e20f, l_run = 0.f;
  uint4 kr, vr, kr2, vr2;
  const int key0 = tid >> 3, ch = tid & 7;
  const u16* kg = prow + (size_t)key0 * NPROJ + 2304 + head * 64 + ch * 8;
  auto gload = [&](int krow, uint4& kd, uint4& vd) __attribute__((always_inline)) {
    const u16* src = kg + (size_t)((krow > 255 ? 255 : krow) * 64) * NPROJ;
    kd = *(const uint4*)src; vd = *(const uint4*)(src + 384);
  };
  auto lstore = [&](int buf) __attribute__((always_inline)) {
    *(uint4*)(Ks + buf * KS_BUF + key0 * KS_STRIDE + ch * 8) = kr;
    *(uint4*)(Vs + buf * VS_BUF + key0 * VROW + ch * 8) = vr;
  };
  gload(rs_lo, kr, vr); lstore(0);
  gload(rs_lo + 1, kr, vr); lstore(1);
  gload(rs_lo + 2, kr, vr); gload(rs_lo + 3, kr2, vr2);
  __syncthreads();
  for (int krow = rs_lo; krow <= rs_hi; ++krow) {
    const int buf = (krow - rs_lo) & 3;
    if (krow >= wlo && krow < whi) {
      f32x16 Sc;
#pragma unroll
      for (int i = 0; i < 16; ++i) Sc[i] = 0.f;
#pragma unroll
      for (int s = 0; s < 4; ++s) {
        const bf16x8 kf = *(const bf16x8*)(Ks + buf * KS_BUF + (kc0 + r) * KS_STRIDE + s * 16 + 8 * hh);
        Sc = MFMA32(kf, qf[s], Sc);
      }
      const float* rowp = rtab + RPB_PAD + (krow - qr + 7) * 31 + 15 + kc0 + 4 * hh - qc;
      const bool rowok = (unsigned)(krow - rs_q) < 8u;
      float sv[16];
#pragma unroll
      for (int i = 0; i < 16; ++i) {
        const int c = (i & 3) + 8 * (i >> 2);
        const bool valid = rowok && ((unsigned)(vbase + c) < 16u);
        sv[i] = valid ? (Sc[i] + rowp[c]) : NEGBIG;
      }
      bf16x8 pk[2];
      local_softmax_step1(sv, m_run, l_run, O, pk);
#pragma unroll
      for (int sp = 0; sp < 2; ++sp)
#pragma unroll
        for (int mb = 0; mb < 2; ++mb) {
          const bf16x8 vf = v_frag_tr(Vs + buf * VS_BUF, kc0, mb, sp, lane);
          O[mb] = MFMA32(vf, pk[sp], O[mb]);
        }
    }
    if (buf & 1) {
      lstore((buf + 1) & 3);
      { const uint4 tk = kr, tv = vr; kr = kr2; vr = vr2; lstore((buf + 2) & 3); kr = tk; vr = tv; }
      gload(krow + 3, kr, vr); gload(krow + 4, kr2, vr2);
      __syncthreads();
    }
  }
  local_store_out(O, l_run, p.o + (size_t)(b * S + tq) * 1024 + 640 + head * 64, hh);
}

DI void kmax_item(KP p, int layer, int kidx) {
  const int tid = otid(); const int gid = kidx * NTHR + tid;
  const int row = gid >> 2, head = gid & 3, b = row >> 14;
  const uint4* kp = (const uint4*)(p.proj + (size_t)row * NPROJ + 256 + head * 64);
  float n0 = 0.f, n1 = 0.f;
#pragma unroll
  for (int c = 0; c < 8; ++c) {
    const uint4 v = kp[c];
    const unsigned e[4] = {v.x, v.y, v.z, v.w};
    float s = 0.f;
#pragma unroll
    for (int q = 0; q < 4; ++q) { const float a = bflo(e[q]), bq = bfhi(e[q]); s += a * a + bq * bq; }
    if (c >= 4) n1 += s; else n0 += s;
  }
#pragma unroll
  for (int o = 4; o <= 32; o <<= 1) { n0 = fmaxf(n0, __shfl_xor(n0, o)); n1 = fmaxf(n1, __shfl_xor(n1, o)); }
  if ((tid & 63) < 4) {
    unsigned* km = p.kmax + layer * 16 + (b * 4 + head) * 2;
    atomicMax(km, __float_as_uint(n0)); atomicMax(km + 1, __float_as_uint(n1));
  }
}

DI void phase_local(KP p, int layer, u16* sm) {
  constexpr int N_DIL = 2304, N_NA = 768, N_KM = 256;
  for (int it = blockIdx.x; it < N_DIL + N_NA + N_KM; it += gridDim.x) {
    __syncthreads();
    if (it < N_DIL) swin_attn_item(p, (it & 7) * (N_DIL / 8) + (it >> 3), sm);
    else if (it < N_DIL + N_NA) { const int j = it - N_DIL; na_attn_item(p, layer, (j & 7) * (N_NA / 8) + (j >> 3), sm); }
    else kmax_item(p, layer, it - N_DIL - N_NA);
  }
}

constexpr int VL_STRIDE = 80;
constexpr int VL_BUF = 64 * VL_STRIDE;
DI void phase_diff(KP p, int layer, u16* sm) {
  combine_dil(p);
  const int tid = otid(), lane = tid & 63, w = __builtin_amdgcn_readfirstlane(tid >> 6), r = lane & 31, hh = lane >> 5;
  u16* Ks = sm; unsigned char* Vl = (unsigned char*)(sm + 4 * KS_BUF);
  float lam;
  {
    const float* dl = p.diff_lambda + layer * 128;
    float a = 0.f, c2 = 0.f;
    if (lane < 32) { a = dl[lane] * dl[32 + lane]; c2 = dl[64 + lane] * dl[96 + lane]; }
    a = wave_sum(a); c2 = wave_sum(c2);
    lam = __expf(a) - __expf(c2) + p.lam_init[layer];
  }
  const float lam_init = p.lam_init[layer];
  const float* sg = p.diff_subln + layer * 64;
  for (int it = blockIdx.x; it < 512; it += gridDim.x) {
    const int bh = it >> 6, qb = it & 63, b = bh >> 2, head = bh & 3;
    const u16* prow = p.proj + (size_t)b * S * NPROJ;
    const int tq = qb * 256 + w * 32 + r;
    bf16x8 qf[2][2];
    float qn[2];
#pragma unroll
    for (int m = 0; m < 2; ++m) {
      qn[m] = 0.f;
#pragma unroll
      for (int s = 0; s < 2; ++s) {
        qf[m][s] = *(const bf16x8*)(prow + (size_t)tq * NPROJ + head * 64 + m * 32 + s * 16 + 8 * hh);
#pragma unroll
        for (int j = 0; j < 8; ++j) { const float v = bf2f((u16)qf[m][s][j]); qn[m] += v * v; }
      }
      qn[m] += __shfl_xor(qn[m], 32);
    }
    float mbnd[2];
#pragma unroll
    for (int m = 0; m < 2; ++m) {
      const float km = __uint_as_float(p.kmax[layer * 16 + bh * 2 + m]);
      mbnd[m] = fmaxf(sqrtf(qn[m] * km) - 19.5f, 0.f);
    }
    const bool noshift = __builtin_amdgcn_ballot_w64(mbnd[0] == 0.f && mbnd[1] == 0.f) == ~0ull;
    f32x16 O[2][2];
#pragma unroll
    for (int m = 0; m < 2; ++m)
#pragma unroll
      for (int mb = 0; mb < 2; ++mb)
#pragma unroll
        for (int i = 0; i < 16; ++i) O[m][mb][i] = 0.f;
    f32x4 L4[2];
#pragma unroll
    for (int m = 0; m < 2; ++m) L4[m] = (f32x4){0.f, 0.f, 0.f, 0.f};
    v8i_t ones8;
    {
      const bool on = (((lane & 15) < 8) == ((((lane >> 4) & 1)) == 0));
#pragma unroll
      for (int v = 0; v < 8; ++v) ones8[v] = on ? 0x38383838 : 0;
    }
    f32x16 cneg;
#pragma unroll
    for (int i = 0; i < 16; ++i) cneg[i] = -4.0f;
    asm volatile("" : "+v"(cneg));
    uint4 kra, krb; uint2 vra, vrb;
    const int key0 = tid >> 3, ch = tid & 7;
    const u16* kg = prow + (size_t)key0 * NPROJ + 256 + head * 64 + ch * 8;
    const unsigned char* vg = p.vt8 + ((size_t)bh * 64 + key0) * S + ch * 8;
    auto gload = [&](int st) __attribute__((always_inline)) {
      const int t0 = (st & 127) * 2;
      kra = *(const uint4*)(kg + (size_t)(t0 * 64) * NPROJ); krb = *(const uint4*)(kg + (size_t)(t0 * 64 + 64) * NPROJ);
      vra = *(const uint2*)(vg + t0 * 64); vrb = *(const uint2*)(vg + t0 * 64 + 64);
    };
    auto lstore = [&](int buf) __attribute__((always_inline)) {
      u16* kd = Ks + buf * (2 * KS_BUF) + key0 * KS_STRIDE + ch * 8;
      *(uint4*)kd = kra; *(uint4*)(kd + KS_BUF) = krb;
      unsigned char* vd = Vl + buf * (2 * VL_BUF) + key0 * VL_STRIDE + 4 * ch;
      *(unsigned*)vd = vra.x; *(unsigned*)(vd + 32) = vra.y;
      *(unsigned*)(vd + VL_BUF) = vrb.x; *(unsigned*)(vd + VL_BUF + 32) = vrb.y;
    };
    gload(0); lstore(0);
    __syncthreads();
    if (w >= 4) __builtin_amdgcn_s_setprio(1);
    auto tile_loop = [&](auto shifted) __attribute__((always_inline)) {
      constexpr bool SH = decltype(shifted)::value;
      for (int st = 0; st < 128; ++st) {
        const int buf = st & 1;
        gload(st + 1);
#pragma unroll
        for (int hf = 0; hf < 2; ++hf) {
          const u16* Kt = Ks + buf * (2 * KS_BUF) + hf * KS_BUF;
          const unsigned char* Vt = Vl + buf * (2 * VL_BUF) + hf * VL_BUF;
          f32x16 Sc[2][2];
#pragma unroll
          for (int sub = 0; sub < 2; ++sub)
#pragma unroll
            for (int m = 0; m < 2; ++m) {
#pragma unroll
              for (int i = 0; i < 16; ++i) Sc[sub][m][i] = cneg[i];
#pragma unroll
              for (int s = 0; s < 2; ++s) {
                const bf16x8 kf = *(const bf16x8*)(Kt + (sub * 32 + r) * KS_STRIDE + m * 32 + s * 16 + 8 * hh);
                Sc[sub][m] = MFMA32(kf, qf[m][s], Sc[sub][m]);
              }
            }
          v8i_t pf[2];
#pragma unroll
          for (int sub = 0; sub < 2; ++sub)
#pragma unroll
            for (int m = 0; m < 2; ++m)
#pragma unroll
              for (int g = 0; g < 4; ++g) {
                float pv[4];
#pragma unroll
                for (int e = 0; e < 4; ++e) pv[e] = exp2_hw(SH ? (Sc[sub][m][4 * g + e] - mbnd[m]) : Sc[sub][m][4 * g + e]);
                const unsigned ha = __builtin_bit_cast(unsigned, __builtin_amdgcn_cvt_pkrtz(pv[0], pv[1]));
                const unsigned hb = __builtin_bit_cast(unsigned, __builtin_amdgcn_cvt_pkrtz(pv[2], pv[3]));
                pf[m][4 * sub + g] = (int)__builtin_amdgcn_perm(hb, ha, 0x07050301u);
              }
#pragma unroll
          for (int mb = 0; mb < 2; ++mb) {
            const v8i_t vf = *(const v8i_t*)(Vt + (mb * 32 + r) * VL_STRIDE + 32 * hh);
            O[0][mb] = __builtin_amdgcn_mfma_scale_f32_32x32x64_f8f6f4(vf, pf[0], O[0][mb], 0, 1, 0, 0x7F7F7F7F, 0, 0x7F7F7F7F);
            O[1][mb] = __builtin_amdgcn_mfma_scale_f32_32x32x64_f8f6f4(vf, pf[1], O[1][mb], 0, 1, 0, 0x7F7F7F7F, 0, 0x7F7F7F7F);
          }
          L4[0] = __builtin_amdgcn_mfma_scale_f32_16x16x128_f8f6f4(ones8, pf[0], L4[0], 0, 1, 0, 0x7F7F7F7F, 0, 0x7F7F7F7F);
          L4[1] = __builtin_amdgcn_mfma_scale_f32_16x16x128_f8f6f4(ones8, pf[1], L4[1], 0, 1, 0, 0x7F7F7F7F, 0, 0x7F7F7F7F);
        }
        lstore(buf ^ 1);
        __syncthreads();
      }
    };
    if (noshift) tile_loop(std::false_type{}); else tile_loop(std::true_type{});
    __builtin_amdgcn_s_setprio(0);
    const int lsrc = (r & 15) + ((r >> 4) << 5);
    const float l0 = __shfl(L4[0][0], lsrc), l1 = __shfl(L4[1][0], lsrc);
    const float i0 = 1.f / l0, i1 = lam / l1;
    float ss = 0.f;
#pragma unroll
    for (int mb = 0; mb < 2; ++mb)
#pragma unroll
      for (int i = 0; i < 16; ++i) { const float v = O[0][mb][i] * i0 - O[1][mb][i] * i1; O[0][mb][i] = v; ss += v * v; }
    ss += __shfl_xor(ss, 32);
    const float inv = rsqrtf(ss * (1.f / 64.f) + 1e-6f) * (1.f - lam_init);
    u16* op = p.o + (size_t)(b * S + tq) * 1024 + head * 64;
#pragma unroll
    for (int mb = 0; mb < 2; ++mb)
#pragma unroll
      for (int g = 0; g < 4; ++g) {
        const int d = mb * 32 + 8 * g + 4 * hh;
        const float4 g4 = *(const float4*)(sg + d);
        *(uint2*)(op + d) = make_uint2(pack2(O[0][mb][4 * g] * inv * g4.x, O[0][mb][4 * g + 1] * inv * g4.y),
                                       pack2(O[0][mb][4 * g + 2] * inv * g4.z, O[0][mb][4 * g + 3] * inv * g4.w));
      }
  }
}

DI void phase_proj(KP p, int layer, LAS unsigned char* lds) {
  pg8::StaticOrder so; so.init(128, 12, gridDim.x, blockIdx.x);
  EpiProj e; e.proj = p.proj; e.vt8 = p.vt8;
  pg8::gemm_phase<pg8::AMapPlain>(lds, p.h, p.wt_in + (size_t)layer * 3072 * 1024, 1024, so, e);
}
DI void phase_resid(const u16* A, int K, const u16* Bt, const float* xold, float* xnew, const float* gate, LAS unsigned char* lds) {
  pg8::StaticOrder so; so.init(128, 4, gridDim.x, blockIdx.x);
  EpiResid e; e.xold = xold; e.xnew = xnew; e.gate = gate;
  pg8::gemm_phase<pg8::AMapPlain>(lds, A, Bt, K, so, e);
}
DI void phase_up(KP p, int layer, LAS unsigned char* lds) {
  pg8::StaticOrder so; so.init(134, 22, gridDim.x, blockIdx.x);
  EpiUp e; e.act = p.act; e.cw = p.conv_w + (size_t)layer * 3 * DFF; e.cb = p.conv_b + (size_t)layer * DFF;
  pg8::gemm_phase<pg8::AMapHalo>(lds, p.h, p.wt_up + (size_t)layer * 5632 * 1024, 1024, so, e);
}

constexpr int N_PHASES = 18;

DI void run_phase(KP p, int ph, unsigned char* smraw) {
  u16* sm = (u16*)smraw;
  LAS unsigned char* lds = (LAS unsigned char*)smraw;
  if (ph == 0) { phase_prep(p, (float*)smraw); return; }
  if (ph == 17) { phase_norm<1>(p.out, p.g_final, nullptr, 0, 0, nullptr, p.out); return; }
  const int layer = (ph - 1) >> 3, sub = (ph - 1) & 7;
  const float* modl = p.mod + layer * 2 * 6144;
  const float* xcur = (layer == 0) ? p.x : p.out;
  switch (sub) {
    case 0: phase_norm<0>(xcur, p.g_attn + layer * 1024, modl, 0, 1024, p.h, nullptr); break;
    case 1: phase_proj(p, layer, lds); break;
    case 2: phase_local(p, layer, sm); break;
    case 3: phase_diff(p, layer, sm); break;
    case 4: phase_resid(p.o, 1024, p.wt_out + (size_t)layer * 1024 * 1024, xcur, p.out, modl + 2048, lds); break;
    case 5: phase_norm<0>(p.out, p.g_ffn + layer * 1024, modl, 3072, 4096, p.h, nullptr); break;
    case 6: phase_up(p, layer, lds); break;
    case 7: phase_resid(p.act, DFF, p.wt_down + (size_t)layer * 1024 * DFF, p.out, p.out, modl + 5120, lds); break;
  }
}

__global__ void __launch_bounds__(NTHR, 2) mega_kernel(Params p) {
  extern __shared__ __attribute__((aligned(16))) unsigned char smraw[];
#if COOP
  cg::grid_group grid = cg::this_grid();
  u16* sm = (u16*)smraw;
  LAS unsigned char* lds = (LAS unsigned char*)smraw;
  if (threadIdx.x == 0) *(uint4*)(smraw + LDS_BYTES) = make_uint4(0u, 0u, 0u, 0u);
  __syncthreads();
  const XcdBarrier xb = xcd_barrier_post(kp_fresh()->bar, (volatile LAS unsigned*)(smraw + LDS_BYTES));
  phase_prep(*kp_fresh(), (float*)smraw);
  grid.sync();
#pragma unroll 1
  for (int layer = 0; layer < 2; ++layer) {
    { KP q = *kp_fresh(); phase_norm<0>((layer == 0) ? q.x : q.out, q.g_attn + layer * 1024, q.mod + layer * 2 * 6144, 0, 1024, q.h, nullptr); } xcd_barrier(xb);
    phase_proj(*kp_fresh(), layer, lds); xcd_barrier(xb);
    phase_local(*kp_fresh(), layer, sm); xcd_barrier(xb);
    phase_diff(*kp_fresh(), layer, sm); xcd_barrier(xb);
    { KP q = *kp_fresh(); phase_resid(q.o, 1024, q.wt_out + (size_t)layer * 1024 * 1024, (layer == 0) ? q.x : q.out, q.out, q.mod + layer * 2 * 6144 + 2048, lds); } xcd_barrier(xb);
    { KP q = *kp_fresh(); phase_norm<0>(q.out, q.g_ffn + layer * 1024, q.mod + layer * 2 * 6144, 3072, 4096, q.h, nullptr); } xcd_barrier(xb);
    phase_up(*kp_fresh(), layer, lds); xcd_barrier(xb);
    { KP q = *kp_fresh(); phase_resid(q.act, DFF, q.wt_down + (size_t)layer * 1024 * DFF, q.out, q.out, q.mod + layer * 2 * 6144 + 5120, lds); } xcd_barrier(xb);
  }
  { KP q = *kp_fresh(); phase_norm<1>(q.out, q.g_final, nullptr, 0, 0, nullptr, q.out); }
#else
  { KP q = *kp_fresh(); for (int ph = q.ph_lo; ph < q.ph_hi; ++ph) run_phase(q, ph, smraw); }
#endif
}

extern "C" void kernel_launch(void* const* d_in, const int* in_sizes, int n_in, void* d_out, int out_size, void* d_ws, size_t ws_size, hipStream_t stream) {
  (void)in_sizes; (void)n_in; (void)out_size;
  Params p;
  memset(&p, 0, sizeof(p));
  p.x = (const float*)d_in[0]; p.c = (const float*)d_in[1]; p.w_ada = (const float*)d_in[2]; p.b_ada = (const float*)d_in[3];
  p.g_attn = (const float*)d_in[4]; p.w_in = (const float*)d_in[5]; p.diff_lambda = (const float*)d_in[6]; p.diff_subln = (const float*)d_in[7];
  p.na_rpb = (const float*)d_in[8]; p.w_out = (const float*)d_in[9]; p.g_ffn = (const float*)d_in[10]; p.w_up = (const float*)d_in[11];
  p.conv_w = (const float*)d_in[12]; p.conv_b = (const float*)d_in[13]; p.w_down = (const float*)d_in[14]; p.g_final = (const float*)d_in[15];
  p.out = (float*)d_out;
  char* ws = (char*)d_ws; size_t off = 0;
  auto take = [&](size_t bytes) { char* q = ws + off; off += (bytes + 255) & ~(size_t)255; return q; };
  p.wt_in = (u16*)take((size_t)2 * 3072 * 1024 * 2);
  p.wt_out = (u16*)take((size_t)2 * 1024 * 1024 * 2);
  p.wt_up = (u16*)take((size_t)2 * 5632 * 1024 * 2);
  p.wt_down = (u16*)take((size_t)2 * 1024 * 2816 * 2);
  p.mod = (float*)take((size_t)2 * 2 * 6144 * 4);
  p.kmax = (unsigned*)take(256);
  p.bar = (unsigned*)take((size_t)XCD_BAR_WORDS * 4);
  (void)take(4096);
  p.h = (u16*)take((size_t)NTOK * 1024 * 2);
  p.o = (u16*)take((size_t)NTOK * 1024 * 2);
  p.proj = (u16*)take((size_t)NTOK * NPROJ * 2);
  p.odil = (u16*)take((size_t)3 * NTOK * 384 * 2);
  p.lse = (float*)take((size_t)3 * NTOK * 6 * 4);
  p.vt8 = (unsigned char*)take((size_t)2 * 4 * 64 * S);
  p.act = p.proj;
  if (off > ws_size) { fprintf(stderr, "workspace too small: need %zu have %zu\n", off, ws_size); return; }
  p.lam_init[0] = 0.2f; p.lam_init[1] = 0.35550906759096934f;
  static int grid_blocks = 0;
  if (!grid_blocks) {
    int dev = 0, cus = 0, per_cu = 0;
    (void)hipGetDevice(&dev);
    (void)hipDeviceGetAttribute(&cus, hipDeviceAttributeMultiprocessorCount, dev);
    (void)hipFuncSetAttribute((const void*)mega_kernel, hipFuncAttributeMaxDynamicSharedMemorySize, LDS_BYTES + 16);
    (void)hipOccupancyMaxActiveBlocksPerMultiprocessor(&per_cu, mega_kernel, NTHR, LDS_BYTES + 16);
    if (per_cu > 1) per_cu = 1;
    if (per_cu < 1) per_cu = 1;
    grid_blocks = cus * per_cu;
  }
#if COOP
  p.ph_lo = 0; p.ph_hi = N_PHASES;
  (void)hipMemsetAsync(p.bar, 0, (size_t)XCD_BAR_WORDS * 4, stream);
  void* args[] = {&p};
  hipError_t e = hipLaunchCooperativeKernel((void*)mega_kernel, dim3(grid_blocks), dim3(NTHR), args, LDS_BYTES + 16, stream);
  if (e != hipSuccess) fprintf(stderr, "cooperative launch failed: %s (grid %d)\n", hipGetErrorString(e), grid_blocks);
#else
  for (int ph = 0; ph < N_PHASES; ++ph) {
    p.ph_lo = ph; p.ph_hi = ph + 1;
    hipLaunchKernelGGL(mega_kernel, dim3(grid_blocks), dim3(NTHR), LDS_BYTES + 16, stream, p);
  }
#endif
}
```
